# Optimizing an MI355X kernel written in HIP

```python
import jax, jax.numpy as jnp
from jax import lax
import numpy as np

D_MODEL = 1024
BATCH = 8
SEQ = 4096
DEPTH = 1

CTX_LEN = 256
GRID_W = 64
ROPE_THETA = 10000.0
NORM_EPS = 1e-6
N_MOD = 6
NEG_INF = -1e30

MLA_HEADS = 8
MLA_NOPE = 64
MLA_ROPE = 32
MLA_QK = MLA_NOPE + MLA_ROPE
MLA_V = 64
MLA_Q_RANK = 384
MLA_KV_RANK = 256
Q_BLOCK = 128

SWA_HEADS = 8
SWA_KV_HEADS = 2
SWA_GROUP = SWA_HEADS // SWA_KV_HEADS
SWA_HD = 64
WINDOW = 128
BAND_BLOCK = 128

N_EXPERTS = 32
TOP_K = 4
D_EXPERT = D_MODEL
SWIGLU_LIMIT = 7.0
SWIGLU_ALPHA = 1.702
MOE_BLOCK = 256

KV_COLS = MLA_KV_RANK + MLA_ROPE + 2 * SWA_KV_HEADS * SWA_HD
KV_OFFSETS = (MLA_KV_RANK, MLA_KV_RANK + MLA_ROPE, MLA_KV_RANK + MLA_ROPE + SWA_KV_HEADS * SWA_HD)
Q_OFFSETS = (MLA_Q_RANK, MLA_Q_RANK + SWA_HEADS * SWA_HD, MLA_Q_RANK + SWA_HEADS * SWA_HD + D_MODEL)
IN_COLS = KV_COLS + MLA_Q_RANK + SWA_HEADS * SWA_HD + 2 * D_MODEL

kernel_name = "hybrid_mla_swa_moe_dit_layer"


def rmsnorm(x, g):
    xf = x.astype(jnp.float32)
    y = xf * lax.rsqrt(jnp.mean(xf * xf, axis=-1, keepdims=True) + NORM_EPS)
    return y.astype(x.dtype) * g


def ada_params(cond, w_ada, b_ada):
    m = jax.nn.silu(cond) @ w_ada + b_ada
    return jnp.split(m, N_MOD, axis=-1)


def modulate(x, g, shift, scale):
    return rmsnorm(x, g) * (1 + scale[..., None, :]) + shift[..., None, :]


def axial_rope_tables(row, col, dim, dtype):
    q = dim // 4
    freqs = ROPE_THETA ** (-jnp.arange(q, dtype=jnp.float32) / q)
    ang_r = row.astype(jnp.float32)[:, None] * freqs
    ang_c = col.astype(jnp.float32)[:, None] * freqs
    ang = jnp.concatenate([ang_r, ang_r, ang_c, ang_c], axis=-1)
    return jnp.cos(ang).astype(dtype), jnp.sin(ang).astype(dtype)


def rotate_axial(x):
    x1, x2, x3, x4 = jnp.split(x, 4, axis=-1)
    return jnp.concatenate([-x2, x1, -x4, x3], axis=-1)


def apply_rope(x, cos, sin):
    return x * cos[:, None, :] + rotate_axial(x) * sin[:, None, :]


def kv_side(h, p, rope):
    b, n = h.shape[:2]
    kv_lat, k_rope, k_swa, v_swa = jnp.split(h @ p['w_in'][:, :KV_COLS], KV_OFFSETS, axis=-1)
    kv = (rmsnorm(kv_lat, p['mla_kv_a_g']) @ p['w_kv_up']).reshape(b, n, MLA_HEADS, MLA_NOPE + MLA_V)
    k_nope, v_mla = kv[..., :MLA_NOPE], kv[..., MLA_NOPE:]
    k_r = jnp.broadcast_to(k_rope[:, :, None, :], (b, n, MLA_HEADS, MLA_ROPE))
    k_mla = rmsnorm(jnp.concatenate([k_nope, k_r], axis=-1), p['mla_k_g'])
    k_swa = rmsnorm(k_swa.reshape(b, n, SWA_KV_HEADS, SWA_HD), p['swa_k_g'])
    v_swa = v_swa.reshape(b, n, SWA_KV_HEADS, SWA_HD)
    if rope is not None:
        cos_m, sin_m, cos_s, sin_s = rope
        k_mla = jnp.concatenate([k_mla[..., :MLA_NOPE], apply_rope(k_mla[..., MLA_NOPE:], cos_m, sin_m)], axis=-1)
        k_swa = apply_rope(k_swa, cos_s, sin_s)
    return k_mla, v_mla, k_swa, v_swa


def q_side(h, p, rope):
    b, n = h.shape[:2]
    q_lat, q_swa, gate_a, gate_b = jnp.split(h @ p['w_in'][:, KV_COLS:], Q_OFFSETS, axis=-1)
    q_mla = (rmsnorm(q_lat, p['mla_q_a_g']) @ p['w_q_up']).reshape(b, n, MLA_HEADS, MLA_QK)
    q_mla = rmsnorm(q_mla, p['mla_q_g'])
    q_swa = rmsnorm(q_swa.reshape(b, n, SWA_HEADS, SWA_HD), p['swa_q_g'])
    if rope is not None:
        cos_m, sin_m, cos_s, sin_s = rope
        q_mla = jnp.concatenate([q_mla[..., :MLA_NOPE], apply_rope(q_mla[..., MLA_NOPE:], cos_m, sin_m)], axis=-1)
        q_swa = apply_rope(q_swa, cos_s, sin_s)
    return q_mla, q_swa, gate_a, gate_b


def dense_attend(q, k, v, scale):
    s = jnp.einsum('bqhd,bkhd->bhqk', q, k).astype(jnp.float32) * scale
    pr = jax.nn.softmax(s, axis=-1).astype(v.dtype)
    return jnp.einsum('bhqk,bkhd->bqhd', pr, v)


def mla_attend_latent(q, k_lat, v_lat, k_ctx, v_ctx):
    b, n = q.shape[:2]
    k = jnp.concatenate([k_lat, k_ctx], axis=1)
    v = jnp.concatenate([v_lat, v_ctx], axis=1)
    nb = n // Q_BLOCK
    qb = q.reshape(b, nb, Q_BLOCK, MLA_HEADS, MLA_QK).swapaxes(0, 1)
    o = lax.map(lambda qi: dense_attend(qi, k, v, MLA_QK ** -0.5), qb)
    return o.swapaxes(0, 1).reshape(b, n, MLA_HEADS * MLA_V)


def sink_logits(sink, lead_shape):
    s = sink.astype(jnp.float32).reshape(SWA_KV_HEADS, SWA_GROUP)[:, :, None, None]
    return jnp.broadcast_to(s, lead_shape + (1,))


def swa_attend_latent(q, k_lat, v_lat, k_ctx, v_ctx, sink):
    b, n = q.shape[:2]
    nb = n // BAND_BLOCK
    n_ctx = k_ctx.shape[1]
    nband = 3 * BAND_BLOCK
    qb = q.reshape(b, nb, BAND_BLOCK, SWA_KV_HEADS, SWA_GROUP, SWA_HD)

    def band(t):
        tp = jnp.pad(t.reshape(b, nb, BAND_BLOCK, SWA_KV_HEADS, SWA_HD), ((0, 0), (1, 1), (0, 0), (0, 0), (0, 0)))
        return jnp.concatenate([tp[:, :-2], tp[:, 1:-1], tp[:, 2:]], axis=2)

    kb, vb = band(k_lat), band(v_lat)
    scale = SWA_HD ** -0.5
    s_band = jnp.einsum('bnqkgd,bnjkd->bnkgqj', qb, kb).astype(jnp.float32) * scale
    qi = jnp.arange(BAND_BLOCK)[:, None]
    kj = jnp.arange(nband)[None, :]
    rel = qi + BAND_BLOCK - kj
    kpos = (jnp.arange(nb)[:, None, None] - 1) * BAND_BLOCK + kj[None]
    allowed = (jnp.abs(rel) <= WINDOW)[None] & (kpos >= 0) & (kpos < n)
    s_band = jnp.where(allowed[None, :, None, None], s_band, NEG_INF)
    s_ctx = jnp.einsum('bnqkgd,bckd->bnkgqc', qb, k_ctx).astype(jnp.float32) * scale
    s_all = jnp.concatenate([s_band, s_ctx, sink_logits(sink, s_band.shape[:-1])], axis=-1)
    pr = jax.nn.softmax(s_all, axis=-1).astype(v_lat.dtype)
    o = (jnp.einsum('bnkgqj,bnjkd->bnqkgd', pr[..., :nband], vb)
         + jnp.einsum('bnkgqc,bckd->bnqkgd', pr[..., nband:nband + n_ctx], v_ctx))
    return o.reshape(b, n, SWA_HEADS * SWA_HD)


def swa_attend_context(q, k_ctx, v_ctx, sink):
    b, n = q.shape[:2]
    qg = q.reshape(b, n, SWA_KV_HEADS, SWA_GROUP, SWA_HD)
    s = jnp.einsum('bqkgd,bckd->bkgqc', qg, k_ctx).astype(jnp.float32) * SWA_HD ** -0.5
    s_all = jnp.concatenate([s, sink_logits(sink, s.shape[:-1])], axis=-1)
    pr = jax.nn.softmax(s_all, axis=-1)[..., :n].astype(v_ctx.dtype)
    return jnp.einsum('bkgqc,bckd->bqkgd', pr, v_ctx).reshape(b, n, SWA_HEADS * SWA_HD)


def merge_branches(o_a, o_b, gate_a, gate_b, p):
    y = jax.nn.sigmoid(gate_a) * (o_a @ p['w_branch_a']) + jax.nn.sigmoid(gate_b) * (o_b @ p['w_branch_b'])
    return y @ p['w_out']


def clamped_swiglu(gu):
    x_glu, x_lin = gu[..., ::2], gu[..., 1::2]
    x_glu = jnp.minimum(x_glu, SWIGLU_LIMIT)
    x_lin = jnp.clip(x_lin, -SWIGLU_LIMIT, SWIGLU_LIMIT)
    return x_glu * jax.nn.sigmoid(SWIGLU_ALPHA * x_glu) * (x_lin + 1)


def moe(h, p):
    b, n, d = h.shape
    t = b * n
    a = t * TOP_K
    hf = h.reshape(t, d)
    logits = (hf @ p['w_router'] + p['b_router']).astype(jnp.float32)
    top_vals, top_idx = lax.top_k(logits, TOP_K)
    wts = jax.nn.softmax(top_vals, axis=-1).astype(h.dtype)
    expert_flat = top_idx.reshape(a).astype(jnp.int32)
    token_flat = jnp.arange(a, dtype=jnp.int32) // TOP_K
    w_flat = wts.reshape(a)
    order = jnp.argsort(expert_flat, stable=True)
    sorted_e = expert_flat[order]
    counts = jnp.bincount(expert_flat, length=N_EXPERTS)
    starts = jnp.cumsum(counts) - counts
    padded = (counts + MOE_BLOCK - 1) // MOE_BLOCK * MOE_BLOCK
    pends = jnp.cumsum(padded)
    pstarts = pends - padded
    dest = pstarts[sorted_e] + (jnp.arange(a, dtype=jnp.int32) - starts[sorted_e])
    n_slots = -(-(a + N_EXPERTS * (MOE_BLOCK - 1)) // MOE_BLOCK) * MOE_BLOCK
    nblk = n_slots // MOE_BLOCK
    slot_token = jnp.full((n_slots,), t, jnp.int32).at[dest].set(token_flat[order])
    slot_w = jnp.zeros((n_slots,), h.dtype).at[dest].set(w_flat[order])
    block_expert = jnp.clip(jnp.searchsorted(pends, jnp.arange(nblk) * MOE_BLOCK, side='right'), 0, N_EXPERTS - 1)
    x_pad = jnp.concatenate([hf, jnp.zeros((1, d), h.dtype)], axis=0)
    w_gu, b_gu, w_dn, b_dn = p['w_gate_up'], p['b_gate_up'], p['w_down'], p['b_down']

    def run_block(args):
        tok, e, w = args
        xb = x_pad[tok]
        act = clamped_swiglu(xb @ w_gu[e] + b_gu[e])
        return (act @ w_dn[e] + b_dn[e]) * w[:, None]

    out = lax.map(run_block, (slot_token.reshape(nblk, MOE_BLOCK), block_expert, slot_w.reshape(nblk, MOE_BLOCK)))
    y = jnp.zeros((t + 1, d), h.dtype).at[slot_token].add(out.reshape(n_slots, d))[:t]
    return y.reshape(b, n, d)


def hybrid_layer(x, ctx, mod, mod_ctx, p, rope, update_ctx):
    shift1, scale1, gate1, shift2, scale2, gate2 = mod
    cshift1, cscale1, cgate1, cshift2, cscale2, cgate2 = mod_ctx
    h = modulate(x, p['norm1_g'], shift1, scale1)
    hc = modulate(ctx, p['norm1_g'], cshift1, cscale1)
    k_mla_c, v_mla_c, k_swa_c, v_swa_c = kv_side(hc, p, None)
    k_mla, v_mla, k_swa, v_swa = kv_side(h, p, rope)
    q_mla, q_swa, gate_a, gate_b = q_side(h, p, rope)
    o_a = mla_attend_latent(q_mla, k_mla, v_mla, k_mla_c, v_mla_c)
    o_b = swa_attend_latent(q_swa, k_swa, v_swa, k_swa_c, v_swa_c, p['swa_sink'])
    x_new = x + gate1[..., None, :] * merge_branches(o_a, o_b, gate_a, gate_b, p)
    x_new = x_new + gate2[..., None, :] * moe(modulate(x_new, p['norm2_g'], shift2, scale2), p)
    if update_ctx:
        b, n_ctx = ctx.shape[:2]
        qc_mla, qc_swa, gca, gcb = q_side(hc, p, None)
        oc_a = dense_attend(qc_mla, k_mla_c, v_mla_c, MLA_QK ** -0.5).reshape(b, n_ctx, MLA_HEADS * MLA_V)
        oc_b = swa_attend_context(qc_swa, k_swa_c, v_swa_c, p['swa_sink'])
        ctx = ctx + cgate1[..., None, :] * merge_branches(oc_a, oc_b, gca, gcb, p)
        ctx = ctx + cgate2[..., None, :] * moe(modulate(ctx, p['norm2_g'], cshift2, cscale2), p)
    return x_new, ctx


def setup_inputs(seed: int = 0) -> dict:
    key = jax.random.key(seed)
    ks = jax.random.split(key, 32)
    f32 = jnp.float32

    def nrm(k, shape, scale):
        return jax.random.normal(k, shape, f32) * scale

    def gain(k, shape):
        return 1.0 + 0.02 * jax.random.normal(k, shape, f32)

    D, L, E, F = D_MODEL, DEPTH, N_EXPERTS, D_EXPERT
    return {
        "x": nrm(ks[0], (BATCH, SEQ, D), 1.0),
        "c": nrm(ks[1], (BATCH, D), 1.0),
        "ctx": nrm(ks[2], (BATCH, CTX_LEN, D), 1.0),
        "c_ctx": nrm(ks[3], (D,), 1.0),
        "w_ada": nrm(ks[4], (L, D, N_MOD * D), 0.5 * D ** -0.5),
        "b_ada": nrm(ks[5], (L, N_MOD * D), 0.02),
        "norm1_g": gain(ks[6], (L, D)),
        "norm2_g": gain(ks[7], (L, D)),
        "w_in": nrm(ks[8], (L, D, IN_COLS), D ** -0.5),
        "mla_q_a_g": gain(ks[9], (L, MLA_Q_RANK)),
        "mla_kv_a_g": gain(ks[10], (L, MLA_KV_RANK)),
        "w_q_up": nrm(ks[11], (L, MLA_Q_RANK, MLA_HEADS * MLA_QK), MLA_Q_RANK ** -0.5),
        "w_kv_up": nrm(ks[12], (L, MLA_KV_RANK, MLA_HEADS * (MLA_NOPE + MLA_V)), MLA_KV_RANK ** -0.5),
        "mla_q_g": gain(ks[13], (L, MLA_QK)),
        "mla_k_g": gain(ks[14], (L, MLA_QK)),
        "swa_q_g": gain(ks[15], (L, SWA_HD)),
        "swa_k_g": gain(ks[16], (L, SWA_HD)),
        "swa_sink": nrm(ks[17], (L, SWA_HEADS), 0.5),
        "w_branch_a": nrm(ks[18], (L, MLA_HEADS * MLA_V, D), (MLA_HEADS * MLA_V) ** -0.5),
        "w_branch_b": nrm(ks[19], (L, SWA_HEADS * SWA_HD, D), (SWA_HEADS * SWA_HD) ** -0.5),
        "w_out": nrm(ks[20], (L, D, D), D ** -0.5),
        "w_router": nrm(ks[21], (L, D, E), D ** -0.5),
        "b_router": nrm(ks[22], (L, E), 0.01),
        "w_gate_up": nrm(ks[23], (L, E, D, 2 * F), D ** -0.5),
        "b_gate_up": nrm(ks[24], (L, E, 2 * F), 0.02),
        "w_down": nrm(ks[25], (L, E, F, D), F ** -0.5),
        "b_down": nrm(ks[26], (L, E, D), 0.02),
    }


def reference(x, c, ctx, c_ctx, w_ada, b_ada, norm1_g, norm2_g, w_in, mla_q_a_g, mla_kv_a_g,
              w_q_up, w_kv_up, mla_q_g, mla_k_g, swa_q_g, swa_k_g, swa_sink, w_branch_a, w_branch_b,
              w_out, w_router, b_router, w_gate_up, b_gate_up, w_down, b_down):
    n = x.shape[1]
    ROWS = n // GRID_W
    row = jnp.repeat(jnp.arange(ROWS, dtype=jnp.int32), GRID_W)
    col = jnp.tile(jnp.arange(GRID_W, dtype=jnp.int32), ROWS)
    cos_m, sin_m = axial_rope_tables(row, col, MLA_ROPE, x.dtype)
    cos_s, sin_s = axial_rope_tables(row, col, SWA_HD, x.dtype)
    rope = (cos_m, sin_m, cos_s, sin_s)
    for l in range(DEPTH):
        p = dict(norm1_g=norm1_g[l], norm2_g=norm2_g[l], w_in=w_in[l], mla_q_a_g=mla_q_a_g[l],
                 mla_kv_a_g=mla_kv_a_g[l], w_q_up=w_q_up[l], w_kv_up=w_kv_up[l], mla_q_g=mla_q_g[l],
                 mla_k_g=mla_k_g[l], swa_q_g=swa_q_g[l], swa_k_g=swa_k_g[l], swa_sink=swa_sink[l],
                 w_branch_a=w_branch_a[l], w_branch_b=w_branch_b[l], w_out=w_out[l], w_router=w_router[l],
                 b_router=b_router[l], w_gate_up=w_gate_up[l], b_gate_up=b_gate_up[l], w_down=w_down[l],
                 b_down=b_down[l])
        mod = ada_params(c, w_ada[l], b_ada[l])
        mod_ctx = ada_params(c_ctx, w_ada[l], b_ada[l])
        x, ctx = hybrid_layer(x, ctx, mod, mod_ctx, p, rope, update_ctx=(l < DEPTH - 1))
    return x
```

```cpp
#include <hip/hip_runtime.h>
#include <cstdio>
#include <cstdint>

#ifndef MK_N_LAUNCHES
#define MK_N_LAUNCHES 1
#endif
#ifndef MK_F8
#define MK_F8 1
#endif
#ifndef MK_WIDE
#define MK_WIDE 0
#endif
#ifndef MK_MERGE78
#define MK_MERGE78 1
#endif
#ifndef MK_ATT2T
#define MK_ATT2T 1
#endif
#ifndef MK_ATT8
#define MK_ATT8 1
#endif
#ifndef MK_FUSE5
#define MK_FUSE5 1
#endif
#ifndef MK_FUSE3
#define MK_FUSE3 1
#endif
#ifndef MK_F8MID
#define MK_F8MID 1
#endif
#ifndef MK_F8Y
#define MK_F8Y 1
#endif
#ifndef MK_F8IN
#define MK_F8IN 1
#endif
#ifndef MK_XOVL
#define MK_XOVL 1
#endif
#ifndef MK_EPIX
#define MK_EPIX 2
#endif
#ifndef MK_MIDR
#define MK_MIDR 2
#endif
#ifndef MK_P1R
#define MK_P1R 2
#endif
#ifndef MK_P10R
#define MK_P10R 2
#endif
#ifndef MK_SWA2H
#define MK_SWA2H 1
#endif
#ifndef MK_XPOS5
#define MK_XPOS5 1
#endif
#ifndef MK_XPIPE
#define MK_XPIPE 1
#endif
#ifndef MK_XNB
#define MK_XNB 32
#endif
#ifndef MK_REPU
#define MK_REPU -1
#endif
#ifndef MK_REP
#define MK_REP -1
#endif
#ifndef MK_STAGE_A
#define MK_STAGE_A 0
#endif

#define GAS __attribute__((address_space(1)))
#define LAS __attribute__((address_space(3)))
typedef unsigned short bf16;
typedef short bf16x8 __attribute__((ext_vector_type(8)));
typedef short s16x4 __attribute__((ext_vector_type(4)));
typedef float f32x2 __attribute__((ext_vector_type(2)));
typedef float f32x4 __attribute__((ext_vector_type(4)));
typedef float f32x16 __attribute__((ext_vector_type(16)));
typedef unsigned u32x2 __attribute__((ext_vector_type(2)));
typedef unsigned u32x4 __attribute__((ext_vector_type(4)));
typedef GAS unsigned gu32;

#define RLX_AGENT __ATOMIC_RELAXED, __HIP_MEMORY_SCOPE_AGENT
#define LDS_WAIT() asm volatile("s_waitcnt lgkmcnt(0)" ::: "memory")
#define VM_WAIT() asm volatile("s_waitcnt vmcnt(0)" ::: "memory")

constexpr int D = 1024, NB = 8, SEQ = 4096, CTX = 256, KEYS = SEQ + CTX;
constexpr int MTOK = NB * SEQ, MCTX = NB * CTX, MALL = MTOK + MCTX;
constexpr int NMOD = 6 * D;
constexpr int IN_COLS = 3488, NRAW = 3584;
constexpr int C_KVLAT = 0, C_KSWA = 256, C_VSWA = 384, C_QLAT = 512, C_KROPE = 896, C_QSWA = 1024, C_GA = 1536, C_GB = 2560;
constexpr int NE = 32, TOPK = 4, NASSIGN = MTOK * TOPK;
constexpr int MAXTILES = NASSIGN / 256 + NE, NSLOT = MAXTILES * 256;
constexpr float EPS = 1e-6f, LOG2E = 1.4426950408889634f;
constexpr float QSCALE_S = 0.125f * LOG2E;
constexpr float QSCALE_M = 0.10206207261596577f * LOG2E;

constexpr size_t MiB = 1u << 20;
constexpr size_t WS_CTL = 0, CTL_ZERO_BYTES = 64 * 1024;
constexpr size_t WS_MODP = 1 * MiB;
constexpr size_t WS_MOD = 3 * MiB;
constexpr size_t WS_TRIG = WS_MOD + 256 * 1024;
constexpr size_t WS_RSKV = WS_TRIG + 64 * 1024;
constexpr size_t WS_RSQ = WS_RSKV + 256 * 1024;
constexpr size_t WS_TOPI = 4 * MiB;
constexpr size_t WS_TOPW = WS_TOPI + 512 * 1024;
constexpr size_t WS_TOKSLOT = WS_TOPW + 512 * 1024;
constexpr size_t WS_BCNT = WS_TOKSLOT + 512 * 1024;
constexpr size_t WS_SLOTTOK = 6 * MiB;
constexpr size_t WS_SLOTW = 7 * MiB;
constexpr size_t WS_W = 9 * MiB;
constexpr size_t WS_WIN = WS_W;
constexpr size_t WS_WKV = WS_WIN + (size_t)NRAW * D * 2;
constexpr size_t WS_WQ = WS_WKV + 1024 * 256 * 2;
constexpr size_t WS_WBA = WS_WQ + 1024 * 384 * 2;
constexpr size_t WS_WBB = WS_WBA + 1024 * 512 * 2;
constexpr size_t WS_WOUT = WS_WBB + 1024 * 512 * 2;
constexpr size_t WS_WGU = WS_WOUT + 1024 * 1024 * 2;
constexpr size_t WS_WDN = WS_WGU + (size_t)NE * 2048 * 1024 * 2;
constexpr size_t WS_WEND = WS_WDN + (size_t)NE * 1024 * 1024 * 2;
constexpr size_t WS_R1 = 214 * MiB;
constexpr size_t WS_R2 = 486 * MiB;
constexpr size_t WS_H = WS_R2, WS_KVUP = WS_R2 + 68 * MiB, WS_QUP = WS_R2 + 136 * MiB;
constexpr size_t WS_R3 = 670 * MiB;
constexpr size_t WS_QM = WS_R3, WS_KM = WS_R3 + 48 * MiB, WS_VM = WS_R3 + 99 * MiB, WS_QS = WS_R3 + 133 * MiB, WS_KS = WS_R3 + 165 * MiB, WS_VS = WS_R3 + 174 * MiB;
constexpr size_t WS_T = WS_R3, WS_H2 = WS_R3 + 64 * MiB;
constexpr size_t WS_R4 = 853 * MiB;
constexpr size_t WS_OA = WS_R4, WS_OB = WS_R4 + 32 * MiB;
constexpr size_t WS_SSQ = 918 * MiB;
constexpr size_t WS_SSKV = 920 * MiB;
constexpr size_t WS_SSQH = 922 * MiB;
constexpr size_t WS_END = 925 * MiB;
static_assert(WS_WEND <= WS_R1, "weights fit");
static_assert(WS_R1 + (size_t)NSLOT * 1024 * 2 <= WS_R2 && WS_R1 + (size_t)MALL * NRAW * 2 <= WS_R2, "R1");
static_assert(WS_QUP + (size_t)MTOK * 768 * 2 <= WS_R3, "R2");
static_assert(WS_KM + (size_t)NB * KEYS * 768 * 2 <= WS_VM && WS_VM + (size_t)MALL * 512 * 2 <= WS_QS && WS_QS + (size_t)MTOK * 512 * 2 <= WS_KS && WS_KS + (size_t)MALL * 128 * 2 <= WS_VS && WS_VS + (size_t)MALL * 128 * 2 <= WS_R4, "R3");
static_assert(WS_R2 + (size_t)NSLOT * 1024 * 2 <= WS_R4, "Y");
static_assert(WS_RSKV + (size_t)MALL * 4 <= WS_RSQ && WS_RSQ + (size_t)MTOK * 4 <= WS_TOPI && WS_BCNT + 256 * 32 * 4 <= WS_SLOTTOK && WS_SLOTTOK + (size_t)NSLOT * 4 <= WS_SLOTW && WS_SLOTW + (size_t)NSLOT * 4 <= WS_W, "misc");
static_assert(WS_MODP + 8 * 9 * NMOD * 4 <= WS_MOD && WS_MOD + 9 * NMOD * 4 <= WS_TRIG, "mod");
constexpr int CW_BAR = 4096;

constexpr int RING_BYTES = 131072;
constexpr int LDSCTL_OFF = RING_BYTES + 2048;
constexpr int MISC_OFF = LDSCTL_OFF;
constexpr int MOE_OFF = LDSCTL_OFF + 256;
constexpr int P10X_OFF = LDSCTL_OFF + 4096;
constexpr int TSX_OFF = P10X_OFF;
constexpr int TMX_OFF = P10X_OFF + 3072, GKX_OFF = TMX_OFF + 4096, GQX_OFF = GKX_OFF + 384;
constexpr int LDS_BYTES = 147456;
constexpr int NWAVES = 8;

__device__ __forceinline__ unsigned f2bf(float f) { unsigned u = __builtin_bit_cast(unsigned, f); return (u + 0x7fffu + ((u >> 16) & 1u)) >> 16; }
__device__ __forceinline__ unsigned pk2(float lo, float hi) { return f2bf(lo) | (f2bf(hi) << 16); }
__device__ __forceinline__ float bf2f(unsigned b) { return __builtin_bit_cast(float, b << 16); }
__device__ __forceinline__ float bflo(unsigned w) { return __builtin_bit_cast(float, w << 16); }
__device__ __forceinline__ float bfhi(unsigned w) { return __builtin_bit_cast(float, w & 0xffff0000u); }
typedef __bf16 bf16x2_t __attribute__((ext_vector_type(2)));
__device__ __forceinline__ unsigned cvt_pk_bf16(float lo, float hi) { const f32x2 v = {lo, hi}; const bf16x2_t b = __builtin_convertvector(v, bf16x2_t); return __builtin_bit_cast(unsigned, b); }
constexpr float F8_SW = 64.0f, F8_SA = 4.0f, F8_INV = 1.0f / (F8_SW * F8_SA), F8_SY = 32.0f, F8_SO = 64.0f, F8_INVM = 1.0f / (F8_SO * F8_SW);
__device__ __forceinline__ float f8clamp(float v) { return __builtin_amdgcn_fmed3f(v, -448.0f, 448.0f); }
__device__ __forceinline__ unsigned pk4_fp8(float a, float b, float c, float d) { int w = __builtin_amdgcn_cvt_pk_fp8_f32(f8clamp(a), f8clamp(b), 0, false); w = __builtin_amdgcn_cvt_pk_fp8_f32(f8clamp(c), f8clamp(d), w, true); return (unsigned)w; }
template <int CTRL> __device__ __forceinline__ float dpp_f(float v) { return __builtin_bit_cast(float, __builtin_amdgcn_update_dpp(0, __builtin_bit_cast(int, v), CTRL, 0xf, 0xf, false)); }
template <int CTRL> __device__ __forceinline__ int dpp_i(int v) { return __builtin_amdgcn_update_dpp(0, v, CTRL, 0xf, 0xf, false); }
__device__ __forceinline__ float wave_sum(float v) {
    v += dpp_f<0xB1>(v); v += dpp_f<0x4E>(v); v += dpp_f<0x141>(v); v += dpp_f<0x140>(v);
    const float r0 = __builtin_bit_cast(float, __builtin_amdgcn_readlane(__builtin_bit_cast(int, v), 0)), r1 = __builtin_bit_cast(float, __builtin_amdgcn_readlane(__builtin_bit_cast(int, v), 16));
    const float r2 = __builtin_bit_cast(float, __builtin_amdgcn_readlane(__builtin_bit_cast(int, v), 32)), r3 = __builtin_bit_cast(float, __builtin_amdgcn_readlane(__builtin_bit_cast(int, v), 48));
    return (r0 + r1) + (r2 + r3);
}
__device__ __forceinline__ float sigmoidf_(float x) { return __builtin_amdgcn_rcpf(1.0f + __builtin_amdgcn_exp2f(-x * LOG2E)); }

__device__ __forceinline__ void asm_load16(f32x4& dst, const float* p) { asm volatile("global_load_dwordx4 %0, %1, off" : "=v"(dst) : "v"(p) : "memory"); }
namespace pg8 {
constexpr int BM = 256, BK = 64, HALF = 128, HTB = HALF * BK * 2, STAGE_BYTES = 8 * HTB, NXCD = 8, WGM = 8;
__host__ __device__ __forceinline__ int lds_byte(int r, int c) { const int st = (r >> 4) * 2 + (c >> 5), rr = r & 15, cc = c & 31, ob = rr * 64 + cc * 2; return st * 1024 + (ob ^ (((ob >> 9) & 1) << 5)); }
__host__ __device__ __forceinline__ void stage_rc(int b, int& R, int& C) { const int st = b / 1024, sb = b % 1024, swz = sb ^ (((sb >> 9) & 1) << 5); R = (st >> 1) * 16 + swz / 64; C = (st & 1) * 32 + (swz % 64) / 2; }
__host__ __device__ __forceinline__ int perm32(int rho) { const int n = rho >> 4, i = rho & 15; return 8 * (i >> 2) + 4 * n + (i & 3); }

struct Unit { int pm, pn, ex; };

__device__ __forceinline__ void tile_map(int L, int nM, int nN, int& pm, int& pn) {
    const int nwg = nM * nN; int wgid = L;
    { const int q = nwg / NXCD, r = nwg % NXCD, xcd = wgid % NXCD, off = wgid / NXCD; wgid = (xcd < r ? xcd * (q + 1) : r * (q + 1) + (xcd - r) * q) + off; }
    const int nig = WGM * nN, gid = wgid / nig, fm = gid * WGM, gsz = (nM - fm) < WGM ? (nM - fm) : WGM;
    pm = fm + ((wgid % nig) % gsz); pn = (wgid % nig) / gsz;
}

typedef int i32x8 __attribute__((ext_vector_type(8)));
template <class E> struct epi_has_mid { template <class T> static constexpr bool test(decltype(T::MID)*) { return T::MID; } template <class T> static constexpr bool test(...) { return false; } static constexpr bool value = test<E>(nullptr); };
template <class E> struct epi_has_pre { template <class T> static constexpr bool test(decltype(T::PRE)*) { return T::PRE; } template <class T> static constexpr bool test(...) { return false; } static constexpr bool value = test<E>(nullptr); };
template <class Epi, class Sched, bool ALIGN_EPI, bool GATHER, bool F8 = false>
__device__ __forceinline__ void gemm_phase(LAS unsigned char* lds, const int nt, const unsigned lda_b, const unsigned ldb_b, const Sched& S, const Epi& E) {
    int tid = threadIdx.x; asm volatile("" : "+v"(tid));
    const int wid = __builtin_amdgcn_readfirstlane(tid >> 6), lane = tid & 63, wr = wid >> 2, wc = wid & 3, fr = lane & 15, fq = lane >> 4;
    unsigned voffA[2][2], voffB[2], voffAn[2][2]; int sR[2], sC[2];
#pragma unroll
    for (int i = 0; i < 2; ++i) { int R, C; stage_rc(tid * 16 + i * 8192, R, C); sR[i] = R; sC[i] = C; const int Rb = Epi::PERM ? ((R & ~31) + perm32(R & 31)) : R;
        voffB[i] = (unsigned)Rb * ldb_b + (unsigned)C * 2u; voffA[0][i] = (unsigned)R * lda_b + (unsigned)C * 2u; voffA[1][i] = voffA[0][i] + (unsigned)HALF * lda_b; voffAn[0][i] = voffA[0][i]; voffAn[1][i] = voffA[1][i]; }
    const size_t kstep = (size_t)(BK * 2);
    const size_t hstepB = (size_t)HALF * ldb_b;
    const unsigned ldsw = (unsigned)wid * 1024u;
    const int aoff = lds_byte(wr * 64 + fr, fq * 8), boff = lds_byte(wc * 32 + fr, fq * 8);
#define PG8_SA(b, h) (((b) * 2 + (h)) * HTB)
#define PG8_SB(b, h) ((4 + (b) * 2 + (h)) * HTB)
#define PG8_STAGE(bufoff, gbase, voff) do { _Pragma("unroll") for (int _i = 0; _i < 2; ++_i) \
        __builtin_amdgcn_global_load_lds((const unsigned*)((const char*)(gbase) + (voff)[_i]), (LAS unsigned*)(lds + (bufoff) + ldsw + _i * 8192), 16, 0, 0); } while (0)
#define PG8_LDA(dst, b, h) do { if constexpr (F8) { _Pragma("unroll") for (int m = 0; m < 4; ++m) { const u32x4 _lo = *(const LAS u32x4*)(lds + PG8_SA(b, h) + aoff + m * 2048), _hi = *(const LAS u32x4*)(lds + PG8_SA(b, h) + aoff + m * 2048 + 1024); \
        dst##8[m] = (i32x8){(int)_lo.x, (int)_lo.y, (int)_lo.z, (int)_lo.w, (int)_hi.x, (int)_hi.y, (int)_hi.z, (int)_hi.w}; } } else { \
        _Pragma("unroll") for (int m = 0; m < 4; ++m) _Pragma("unroll") for (int k = 0; k < 2; ++k) dst[m][k] = *(const LAS bf16x8*)(lds + PG8_SA(b, h) + aoff + m * 2048 + k * 1024); } } while (0)
#define PG8_LDB(dst, b, h) do { if constexpr (F8) { _Pragma("unroll") for (int n = 0; n < 2; ++n) { const u32x4 _lo = *(const LAS u32x4*)(lds + PG8_SB(b, h) + boff + n * 2048), _hi = *(const LAS u32x4*)(lds + PG8_SB(b, h) + boff + n * 2048 + 1024); \
        dst##8[n] = (i32x8){(int)_lo.x, (int)_lo.y, (int)_lo.z, (int)_lo.w, (int)_hi.x, (int)_hi.y, (int)_hi.z, (int)_hi.w}; } } else { \
        _Pragma("unroll") for (int n = 0; n < 2; ++n) _Pragma("unroll") for (int k = 0; k < 2; ++k) dst[n][k] = *(const LAS bf16x8*)(lds + PG8_SB(b, h) + boff + n * 2048 + k * 1024); } } while (0)
#define PG8_MMA(ai, bj, At, Bt) do { __builtin_amdgcn_s_setprio(1); if constexpr (F8) { _Pragma("unroll") for (int m = 0; m < 4; ++m) _Pragma("unroll") for (int n = 0; n < 2; ++n) \
        asm volatile("v_mfma_scale_f32_16x16x128_f8f6f4 %0, %1, %2, %0, %3, %3 op_sel_hi:[0,0,0]" : "+v"(acc[ai][bj][m][n]) : "v"(Bt##8[n]), "v"(At##8[m]), "v"(f8scale)); } else { \
        _Pragma("unroll") for (int m = 0; m < 4; ++m) _Pragma("unroll") for (int n = 0; n < 2; ++n) _Pragma("unroll") for (int k = 0; k < 2; ++k) \
        acc[ai][bj][m][n] = __builtin_amdgcn_mfma_f32_16x16x32_bf16(Bt[n][k], At[m][k], acc[ai][bj][m][n], 0, 0, 0); } __builtin_amdgcn_s_setprio(0); } while (0)
#define PG8_WAIT_V(n) asm volatile("s_waitcnt vmcnt(" #n ")" ::: "memory")
#define PG8_WAIT_L(n) asm volatile("s_waitcnt lgkmcnt(" #n ")" ::: "memory")
#define PG8_BAR __builtin_amdgcn_s_barrier()
#define PG8_SCHED __builtin_amdgcn_sched_barrier(0)
#define PG8_GATHER(dst, u) do { const int* _ix = S.a_rows(u); _Pragma("unroll") for (int _h = 0; _h < 2; ++_h) _Pragma("unroll") for (int _i = 0; _i < 2; ++_i) \
        dst[_h][_i] = (unsigned)_ix[_h * HALF + sR[_i]] * lda_b + (unsigned)sC[_i] * 2u; } while (0)
#define PG8_GATHER_ISSUE(u) do { const int* _ix = S.a_rows(u); _Pragma("unroll") for (int _h = 0; _h < 2; ++_h) _Pragma("unroll") for (int _i = 0; _i < 2; ++_i) \
        voffAn[_h][_i] = (unsigned)_ix[_h * HALF + sR[_i]]; } while (0)
    Unit cur, nxt; int ui = 0;
    if (!S.next(0, cur)) return;
    constexpr bool PRE = epi_has_pre<Epi>::value; f32x4 pre[4];
    if constexpr (PRE) E.pre(cur, wr, wc, fr, fq, pre);
    f32x4 acc[2][2][4][2];
#pragma unroll
    for (int a = 0; a < 2; ++a)
#pragma unroll
        for (int b = 0; b < 2; ++b)
#pragma unroll
            for (int m = 0; m < 4; ++m)
#pragma unroll
                for (int n = 0; n < 2; ++n) acc[a][b][m][n] = (f32x4){0.f, 0.f, 0.f, 0.f};
    bf16x8 At[4][2], B0[2][2], B1[2][2]; i32x8 At8[4], B08[2], B18[2]; const int f8scale = 0x7f7f7f7f;
    const char* cA = S.a_tile(cur); const char* cB = S.b_tile(cur);
    if constexpr (GATHER) { PG8_GATHER(voffA, cur); }
    PG8_STAGE(PG8_SB(0, 0), cB, voffB); PG8_STAGE(PG8_SB(0, 1), cB + hstepB, voffB); PG8_STAGE(PG8_SA(0, 0), cA, voffA[0]); PG8_STAGE(PG8_SA(0, 1), cA, voffA[1]);
    if (wr == 1) PG8_BAR;
    PG8_WAIT_V(2); PG8_BAR;
    PG8_STAGE(PG8_SB(1, 0), cB + kstep, voffB); PG8_STAGE(PG8_SA(1, 0), cA + kstep, voffA[0]); PG8_STAGE(PG8_SB(1, 1), cB + hstepB + kstep, voffB);
    PG8_WAIT_V(6); PG8_BAR;
    for (;;) {
        const bool has_next = S.next(ui + 1, nxt);
        const char* nA = has_next ? S.a_tile(nxt) : cA; const char* nB = has_next ? S.b_tile(nxt) : cB;
        if constexpr (GATHER) { if (has_next) { PG8_GATHER_ISSUE(nxt); } }
        constexpr bool MIDH = epi_has_mid<Epi>::value;
#pragma nounroll
        for (int kh = 0; kh < (MIDH ? 2 : 1); ++kh) {
        if constexpr (MIDH) { if (kh == 1) E.mid(acc, cur, wr, wc, fr, fq); }
        const int t_lo = MIDH ? kh * (nt >> 1) : 0, t_hi = MIDH ? (kh + 1) * (nt >> 1) : nt;
#pragma nounroll
        for (int t = t_lo; t < t_hi; t += 2) {
            const bool last = (t == nt - 2);
            const char* a1 = cA + (size_t)(t + 1) * kstep;
            const char* a2 = last ? nA : cA + (size_t)(t + 2) * kstep; const char* b2 = last ? nB : cB + (size_t)(t + 2) * kstep;
            const char* a3 = a2 + kstep; const char* b3 = b2 + kstep;
            unsigned v2[2][2];
#pragma unroll
            for (int h = 0; h < 2; ++h)
#pragma unroll
                for (int i = 0; i < 2; ++i) v2[h][i] = voffA[h][i];
            if constexpr (GATHER) { if (last && has_next) {
#pragma unroll
                for (int h = 0; h < 2; ++h)
#pragma unroll
                    for (int i = 0; i < 2; ++i) { voffAn[h][i] = voffAn[h][i] * lda_b + (unsigned)sC[i] * 2u; v2[h][i] = voffAn[h][i]; } } }
            PG8_LDB(B0, 0, 0); PG8_LDB(B1, 0, 1); PG8_SCHED; PG8_LDA(At, 0, 0); PG8_STAGE(PG8_SA(1, 1), a1, voffA[1]);
            PG8_WAIT_V(8); PG8_WAIT_L(0); PG8_BAR; PG8_MMA(0, 0, At, B0); PG8_MMA(0, 1, At, B1); PG8_BAR; PG8_SCHED;
            PG8_LDA(At, 0, 1); PG8_STAGE(PG8_SB(0, 0), b2, voffB); PG8_STAGE(PG8_SB(0, 1), b2 + hstepB, voffB); PG8_STAGE(PG8_SA(0, 0), a2, v2[0]);
            PG8_WAIT_V(8); PG8_WAIT_L(0); PG8_BAR; PG8_MMA(1, 0, At, B0); PG8_MMA(1, 1, At, B1); PG8_BAR; PG8_SCHED;
            PG8_LDB(B0, 1, 0); PG8_LDB(B1, 1, 1); PG8_SCHED; PG8_LDA(At, 1, 0); PG8_STAGE(PG8_SA(0, 1), a2, v2[1]);
            PG8_WAIT_V(8); PG8_WAIT_L(0); PG8_BAR; PG8_MMA(0, 0, At, B0); PG8_MMA(0, 1, At, B1); PG8_BAR; PG8_SCHED;
            PG8_LDA(At, 1, 1); PG8_STAGE(PG8_SB(1, 0), b3, voffB); PG8_STAGE(PG8_SB(1, 1), b3 + hstepB, voffB); PG8_STAGE(PG8_SA(1, 0), a3, v2[0]);
            PG8_WAIT_V(8); PG8_WAIT_L(0); PG8_BAR; PG8_MMA(1, 0, At, B0); PG8_MMA(1, 1, At, B1); PG8_BAR; PG8_SCHED;
        }
        }
        if constexpr (ALIGN_EPI) { if (wr == 0) PG8_BAR; }
        if constexpr (F8) asm volatile("s_nop 15\n\ts_nop 15" ::: "memory");
        if constexpr (PRE) { asm volatile("s_waitcnt vmcnt(16)" ::: "memory"); E(acc, cur, wr, wc, fr, fq, pre); } else E(acc, cur, wr, wc, fr, fq);
        if (!has_next) break;
#pragma unroll
        for (int a = 0; a < 2; ++a)
#pragma unroll
            for (int b = 0; b < 2; ++b)
#pragma unroll
                for (int m = 0; m < 4; ++m)
#pragma unroll
                    for (int n = 0; n < 2; ++n) acc[a][b][m][n] = (f32x4){0.f, 0.f, 0.f, 0.f};
        cur = nxt; cA = nA; cB = nB; ++ui;
        if constexpr (PRE) E.pre(cur, wr, wc, fr, fq, pre);
        if constexpr (GATHER) {
#pragma unroll
            for (int h = 0; h < 2; ++h)
#pragma unroll
                for (int i = 0; i < 2; ++i) voffA[h][i] = voffAn[h][i]; }
        if constexpr (ALIGN_EPI) { if (wr == 1) PG8_BAR; }
    }
    PG8_WAIT_V(0);
    if constexpr (!ALIGN_EPI) { if (wr == 0) PG8_BAR; }
    PG8_BAR;
#undef PG8_SA
#undef PG8_SB
#undef PG8_STAGE
#undef PG8_LDA
#undef PG8_LDB
#undef PG8_MMA
#undef PG8_WAIT_V
#undef PG8_WAIT_L
#undef PG8_BAR
#undef PG8_SCHED
#undef PG8_GATHER
}
}

#define XB_TMO      128
#define XB_XCNT(j)  (256  + 64 * (j))
#define XB_XSUB(j)  (1280 + 64 * (j))
#define XB_XGEN(j)  (2304 + 64 * (j))
#define XB_TOP      3328
#define XB_TOPGEN   3392
#define XCD_BAR_WORDS 3456
#define XB_SPIN_CAP (1u << 18)
__device__ __forceinline__ unsigned xb_ld(unsigned* p)              { return __hip_atomic_load(p, __ATOMIC_RELAXED, __HIP_MEMORY_SCOPE_AGENT); }
__device__ __forceinline__ unsigned xb_add(unsigned* p, unsigned v) { return __hip_atomic_fetch_add(p, v, __ATOMIC_RELAXED, __HIP_MEMORY_SCOPE_AGENT); }
__device__ __forceinline__ unsigned xb_xcc_id() { return (unsigned)__builtin_amdgcn_s_getreg((3 << 11) | 20) & 0xFu; }
#define XB_SPIN(cond, bar) do { unsigned _sp = 0; while (cond) { __builtin_amdgcn_s_sleep(1); \
    if ((++_sp & 255u) == 0u) { if (xb_ld(&(bar)[XB_TMO])) break; if (_sp > XB_SPIN_CAP) { atomicAdd(&(bar)[XB_TMO], 1u); break; } } } } while (0)
struct XcdBarrier { unsigned* bar; unsigned x; volatile LAS unsigned* st; };
__device__ __forceinline__ XcdBarrier xcd_barrier_post(unsigned* bar, volatile LAS unsigned* st) {
    XcdBarrier b; b.bar = bar; b.x = xb_xcc_id(); b.st = st;
    if (threadIdx.x == 0) (void)xb_add(&bar[XB_XCNT(b.x)], 1u);
    return b;
}
__device__ __forceinline__ void xcd_barrier_complete(unsigned* bar, unsigned x, unsigned& nloc, unsigned& nx) {
    const unsigned G = gridDim.x * gridDim.y * gridDim.z;
    unsigned sum, cnt, mine, sp = 0u;
    for (;;) {
        sum = 0u; cnt = 0u; mine = 0u;
#pragma unroll
        for (unsigned j = 0; j < 16; ++j) { const unsigned c = xb_ld(&bar[XB_XCNT(j)]); sum += c; cnt += (c > 0u) ? 1u : 0u; mine = (j == x) ? c : mine; }
        if (sum == G) break;
        __builtin_amdgcn_s_sleep(1);
        if ((++sp & 255u) == 0u) { if (xb_ld(&bar[XB_TMO])) break; if (sp > XB_SPIN_CAP) { atomicAdd(&bar[XB_TMO], 1u); break; } }
    }
    nloc = mine > 0u ? mine : 1u; nx = cnt > 0u ? cnt : 1u;
}
__device__ __forceinline__ void xcd_barrier(const XcdBarrier& b) {
    asm volatile("s_waitcnt vmcnt(0)" ::: "memory");
    __syncthreads();
    if (threadIdx.x == 0) {
        unsigned* bar = b.bar;
        __builtin_amdgcn_s_waitcnt(0);
        unsigned nloc = b.st[0], nx = b.st[1];
        if (nloc == 0u) { xcd_barrier_complete(bar, b.x, nloc, nx); b.st[0] = nloc; b.st[1] = nx; }
        const unsigned old = xb_add(&bar[XB_XSUB(b.x)], 1u);
        const unsigned gen = old / nloc;
        if (old + 1u == (gen + 1u) * nloc) {
            __builtin_amdgcn_fence(__ATOMIC_RELEASE, "agent");
            asm volatile("s_waitcnt vmcnt(0)" ::: "memory");
            const unsigned og = xb_add(&bar[XB_TOP], 1u);
            const unsigned tg = og / nx;
            if (og + 1u == (tg + 1u) * nx) xb_add(&bar[XB_TOPGEN], 1u);
            else XB_SPIN(xb_ld(&bar[XB_TOPGEN]) == tg, bar);
            __builtin_amdgcn_fence(__ATOMIC_ACQUIRE, "agent");
            xb_add(&bar[XB_XGEN(b.x)], 1u);
            asm volatile("s_waitcnt vmcnt(0)" ::: "memory");
        } else {
            XB_SPIN(xb_ld(&bar[XB_XGEN(b.x)]) == gen, bar);
            __builtin_amdgcn_fence(__ATOMIC_ACQUIRE, "agent");
            asm volatile("s_waitcnt vmcnt(0)" ::: "memory");
        }
    }
    __syncthreads();
}

struct Frame {
    LAS unsigned char* lds;
    volatile LAS unsigned* MISC;
    gu32* ctl;
    int tid, lane, wave, vcu, G;
    unsigned char* ws;
    const float *x, *c, *ctx, *c_ctx, *w_ada, *b_ada, *norm1_g, *norm2_g, *w_in, *mla_q_a_g, *mla_kv_a_g, *w_q_up, *w_kv_up, *mla_q_g, *mla_k_g, *swa_q_g, *swa_k_g, *swa_sink,
        *w_branch_a, *w_branch_b, *w_out, *w_router, *b_router, *w_gate_up, *b_gate_up, *w_down, *b_down;
    float* out;
};
#define WSP(T, off) ((T*)(F.ws + (off)))
#define CAS __attribute__((address_space(4)))
__device__ __forceinline__ void frame_load(Frame& F) {
    const CAS unsigned long long* a = (const CAS unsigned long long*)__builtin_amdgcn_kernarg_segment_ptr();
    asm volatile("" : "+s"(a));
    { int t = threadIdx.x; asm volatile("" : "+v"(t)); F.tid = t; F.lane = t & 63; }
    F.x = (const float*)a[0]; F.c = (const float*)a[1]; F.ctx = (const float*)a[2]; F.c_ctx = (const float*)a[3]; F.w_ada = (const float*)a[4]; F.b_ada = (const float*)a[5]; F.norm1_g = (const float*)a[6];
    F.norm2_g = (const float*)a[7]; F.w_in = (const float*)a[8]; F.mla_q_a_g = (const float*)a[9]; F.mla_kv_a_g = (const float*)a[10]; F.w_q_up = (const float*)a[11]; F.w_kv_up = (const float*)a[12];
    F.mla_q_g = (const float*)a[13]; F.mla_k_g = (const float*)a[14]; F.swa_q_g = (const float*)a[15]; F.swa_k_g = (const float*)a[16]; F.swa_sink = (const float*)a[17]; F.w_branch_a = (const float*)a[18];
    F.w_branch_b = (const float*)a[19]; F.w_out = (const float*)a[20]; F.w_router = (const float*)a[21]; F.b_router = (const float*)a[22]; F.w_gate_up = (const float*)a[23]; F.b_gate_up = (const float*)a[24];
    F.w_down = (const float*)a[25]; F.b_down = (const float*)a[26]; F.out = (float*)a[27]; F.ws = (unsigned char*)a[28];
}

__device__ __forceinline__ void tr_item(const float* W, int N, int k0, int sc0, int sstride, bf16* WT, int K, const float* gain, LAS float* scr, int lane, int rperm = 0) {
    { const GAS float* wp = (const GAS float*)W + (size_t)(k0 + (lane >> 5)) * N + sc0 + (lane & 31) * sstride; const GAS float* gp = (const GAS float*)gain + k0 + (lane >> 5);
#pragma nounroll
      for (int i0 = 0; i0 < 32; i0 += 16) { float tv[16], gv[16];
#pragma unroll
          for (int i = 0; i < 16; ++i) { tv[i] = wp[(size_t)(2 * (i0 + i)) * N]; gv[i] = gain ? gp[2 * (i0 + i)] : 1.0f; }
          asm volatile("" ::: "memory");
#pragma unroll
          for (int i = 0; i < 16; ++i) scr[(2 * (i0 + i) + (lane >> 5)) * 33 + (lane & 31)] = tv[i] * gv[i]; } }
    LDS_WAIT(); asm volatile("" ::: "memory");
    const int c = lane & 7;
#pragma unroll
    for (int j = 0; j < 4; ++j) { const int n = (lane >> 3) + 8 * j; const int nc = rperm == 1 ? (16 * ((n >> 2) & 1) + 4 * (n >> 3) + (n & 3)) : rperm == 2 ? (16 * ((n >> 2) & 1) + 8 * ((n >> 1) & 1) + 2 * (n >> 3) + (n & 1)) : n; const LAS float* s = scr + (8 * c) * 33 + nc;
        u32x4 o; o.x = pk2(s[0 * 33], s[1 * 33]); o.y = pk2(s[2 * 33], s[3 * 33]); o.z = pk2(s[4 * 33], s[5 * 33]); o.w = pk2(s[6 * 33], s[7 * 33]);
        *(u32x4*)(WT + (size_t)n * K + k0 + 8 * c) = o; }
    LDS_WAIT(); asm volatile("" ::: "memory");
}
template <bool RPERM = false, int NB = 16>
__device__ __forceinline__ void tr_item8(const float* W, int N, int k0, int sc0, int sstride, unsigned char* WT, int K, LAS float* scr, int lane) {
    const float* wp = W + (size_t)(k0 + (lane >> 5)) * N + sc0 + (lane & 31) * sstride;
#pragma nounroll
    for (int i0 = 0; i0 < 32; i0 += NB) { float tv[NB];
#pragma unroll
        for (int i = 0; i < NB; ++i) tv[i] = wp[(size_t)(2 * (i0 + i)) * N];
#pragma unroll
        for (int i = 0; i < NB; ++i) scr[(2 * (i0 + i) + (lane >> 5)) * 33 + (lane & 31)] = tv[i] * F8_SW; }
    LDS_WAIT(); asm volatile("" ::: "memory");
    const int c = lane & 3;
#pragma unroll
    for (int j = 0; j < 2; ++j) { const int n = (lane >> 2) + 16 * j; const int ncol = RPERM ? (16 * ((n >> 2) & 1) + 4 * (n >> 3) + (n & 3)) : n; const LAS float* s = scr + (16 * c) * 33 + ncol;
        u32x4 o; o.x = pk4_fp8(s[0 * 33], s[1 * 33], s[2 * 33], s[3 * 33]); o.y = pk4_fp8(s[4 * 33], s[5 * 33], s[6 * 33], s[7 * 33]);
        o.z = pk4_fp8(s[8 * 33], s[9 * 33], s[10 * 33], s[11 * 33]); o.w = pk4_fp8(s[12 * 33], s[13 * 33], s[14 * 33], s[15 * 33]);
        *(u32x4*)(WT + (size_t)n * K + k0 + 16 * c) = o; }
    LDS_WAIT(); asm volatile("" ::: "memory");
}
template <bool INTER>
__device__ __forceinline__ void tr_item8w(const float* W, int N, int k0, int sc0, unsigned char* WT, int K, LAS float* scr, int lane) {
    const float* wp = W + (size_t)(k0 + (lane >> 4)) * N + sc0 + (lane & 15) * 4;
    f32x4 tv[8];
#pragma unroll
    for (int i = 0; i < 8; ++i) tv[i] = *(const f32x4*)(wp + (size_t)(4 * i) * N);
#pragma unroll
    for (int i = 0; i < 8; ++i) { LAS float* sp = scr + (4 * i + (lane >> 4)) * 65 + (lane & 15) * 4; sp[0] = tv[i][0] * F8_SW; sp[1] = tv[i][1] * F8_SW; sp[2] = tv[i][2] * F8_SW; sp[3] = tv[i][3] * F8_SW; }
    LDS_WAIT(); asm volatile("" ::: "memory");
    const int col = INTER ? (2 * (lane & 31) + (lane >> 5)) : lane, drow = INTER ? ((lane & 31) + 128 * (lane >> 5)) : lane;
#pragma unroll
    for (int ch = 0; ch < 2; ++ch) { const LAS float* sr = scr + (16 * ch) * 65 + col;
        u32x4 o; o.x = pk4_fp8(sr[0 * 65], sr[1 * 65], sr[2 * 65], sr[3 * 65]); o.y = pk4_fp8(sr[4 * 65], sr[5 * 65], sr[6 * 65], sr[7 * 65]);
        o.z = pk4_fp8(sr[8 * 65], sr[9 * 65], sr[10 * 65], sr[11 * 65]); o.w = pk4_fp8(sr[12 * 65], sr[13 * 65], sr[14 * 65], sr[15 * 65]);
        *(u32x4*)(WT + (size_t)drow * K + k0 + 16 * ch) = o; }
    LDS_WAIT(); asm volatile("" ::: "memory");
}
__device__ __forceinline__ int win_src(int d) {
    if (MK_FUSE3) { if (d >= 256 && d < 512) { const int t = d - 256; return 288 + 64 * ((t >> 5) & 3) + 32 * (t >> 7); }
                    if (d >= 1024 && d < 1536) { const int t = d - 1024; return 928 + 64 * (4 * (t >> 8) + ((t >> 5) & 3)) + 32 * ((t >> 7) & 1); } }
    if (d < 256) return d; if (d < 384) return d - 256 + 288; if (d < 512) return d - 384 + 416; if (d < 896) return d - 512 + 544;
    if (d < 928) return d - 896 + 256; if (d < 1024) return -1; if (d < 1536) return d - 1024 + 928; if (d < 2560) return d - 1536 + 1440; return d - 2560 + 2464;
}
__device__ __forceinline__ void p0_experts(Frame& F);
__device__ __forceinline__ void p0_prologue(Frame& F) {
    LAS float* scr = (LAS float*)(F.lds + F.wave * 16384);
    const int gw = F.vcu * NWAVES + F.wave, NGW = F.G * NWAVES;
    constexpr int I_ADA = 768, I_TRIG = 24, I_WIN = 16 * 112, I_WKV = 4 * 32, I_WQ = 6 * (MK_FUSE5 ? 32 : 24), I_WB = 8 * 32, I_WOUT = 16 * 32, I_WGU = NE * 16 * 64, I_WDN = NE * 16 * 32;
    constexpr int NITEMS = I_ADA + I_TRIG + I_WIN + I_WKV + I_WQ + 2 * I_WB + I_WOUT;
    for (int it = gw; it < NITEMS; it += NGW) {
        const int lane = F.lane;
        int r = it;
        if (r < I_ADA) {
            const int cg = r % 96, kc = r / 96, k0 = kc * 128, col = cg * 64 + lane;
            float cv18[18];
#pragma unroll
            for (int j = 0; j < 18; ++j) { const int idx = j * 64 + lane, rr = idx >> 7, kk = idx & 127; cv18[j] = (rr < 8) ? ((const GAS float*)F.c)[rr * D + k0 + kk] : ((const GAS float*)F.c_ctx)[k0 + kk]; }
            asm volatile("" ::: "memory");
#pragma unroll
            for (int j = 0; j < 18; ++j) { const float v = cv18[j]; scr[j * 64 + lane] = v / (1.0f + __expf(-v)); }
            LDS_WAIT(); asm volatile("" ::: "memory");
            float acc[9];
#pragma unroll
            for (int q = 0; q < 9; ++q) acc[q] = 0.f;
            { const GAS float* wp0 = (const GAS float*)F.w_ada + (size_t)k0 * NMOD + col; float wa[16], wb[16];
#define ADA_LD(dst, kk) do { _Pragma("unroll") for (int u = 0; u < 16; ++u) dst[u] = wp0[(size_t)((kk) + u) * NMOD]; asm volatile("" ::: "memory"); } while (0)
#define ADA_MM(src, kk) do { _Pragma("unroll") for (int u4 = 0; u4 < 4; ++u4) _Pragma("unroll") for (int q = 0; q < 9; ++q) { const f32x4 sv = *(const LAS f32x4*)(scr + q * 128 + (kk) + 4 * u4); \
                  acc[q] += sv[0] * src[4 * u4] + sv[1] * src[4 * u4 + 1] + sv[2] * src[4 * u4 + 2] + sv[3] * src[4 * u4 + 3]; } } while (0)
              ADA_LD(wa, 0);
#pragma unroll
              for (int kk0 = 0; kk0 < 128; kk0 += 32) { ADA_LD(wb, kk0 + 16); ADA_MM(wa, kk0); if (kk0 + 32 < 128) ADA_LD(wa, kk0 + 32); ADA_MM(wb, kk0 + 16); }
#undef ADA_LD
#undef ADA_MM
            }
            float* mp = WSP(float, WS_MODP);
#pragma unroll
            for (int q = 0; q < 9; ++q) mp[(size_t)(kc * 9 + q) * NMOD + col] = acc[q];
            LDS_WAIT(); asm volatile("" ::: "memory");
            continue;
        } r -= I_ADA;
        if (r < I_TRIG) {
            float* ts = WSP(float, WS_TRIG); const int i = r * 64 + lane;
            if (i < 1024) { const int pos = i >> 4, f = i & 15; const float fr = exp2f(-13.287712379549449f * (float)f / 16.0f), a = (float)pos * fr; ts[i] = __cosf(a); ts[1024 + i] = __sinf(a); }
            else { const int j = i - 1024, pos = j >> 3, f = j & 7; const float fr = exp2f(-13.287712379549449f * (float)f / 8.0f), a = (float)pos * fr; ts[2048 + j] = __cosf(a); ts[2560 + j] = __sinf(a); }
            continue;
        } r -= I_TRIG;
        if (r < I_WIN) { const int kb = r / 112, db = r % 112, d0 = db * 32, sc = win_src(d0);
            if (MK_F8IN) { unsigned char* wt = WSP(unsigned char, WS_WIN) + (size_t)d0 * D;
                const bool rp = MK_FUSE3 && ((d0 >= 256 && d0 < 512) || (d0 >= 1024 && d0 < 1536));
                if (sc >= 0) { if (rp) tr_item8<true>(F.w_in, IN_COLS, kb * 64, sc, 1, wt, D, scr, lane); else tr_item8<false>(F.w_in, IN_COLS, kb * 64, sc, 1, wt, D, scr, lane); }
                else { const int c = lane & 3;
#pragma unroll
                    for (int j = 0; j < 2; ++j) { const int n = (lane >> 2) + 16 * j; *(u32x4*)(wt + (size_t)n * D + kb * 64 + 16 * c) = (u32x4){0u, 0u, 0u, 0u}; } }
            } else { bf16* wt = WSP(bf16, WS_WIN) + (size_t)d0 * D;
                const bool rp = MK_FUSE3 && ((d0 >= 256 && d0 < 512) || (d0 >= 1024 && d0 < 1536));
                if (sc >= 0) tr_item(F.w_in, IN_COLS, kb * 64, sc, 1, wt, D, nullptr, scr, lane, rp ? 1 : 0);
                else { const int c = lane & 7;
#pragma unroll
                    for (int j = 0; j < 4; ++j) { const int n = (lane >> 3) + 8 * j; *(u32x4*)(wt + (size_t)n * D + kb * 64 + 8 * c) = (u32x4){0u, 0u, 0u, 0u}; } } }
            continue; } r -= I_WIN;
        if (r < I_WKV) { const int kb = r / 32, db = r % 32; int sc = db * 32;
            if (MK_FUSE5) { const int d0 = db * 32, pn = d0 >> 8, t = d0 & 255, bj = t >> 7, wc = (t >> 5) & 3; sc = 128 * (2 * pn + (wc >> 1)) + 64 * (wc & 1) + 32 * bj; }
            tr_item(F.w_kv_up, 1024, kb * 64, sc, 1, WSP(bf16, WS_WKV) + (size_t)db * 32 * 256, 256, F.mla_kv_a_g, scr, lane); continue; } r -= I_WKV;
        if (r < I_WQ) {
            if (MK_FUSE5) { const int kb = r / 32, db = r % 32, d0 = db * 32, pn = d0 >> 8, t = d0 & 255, bj = t >> 7, wc = (t >> 5) & 3, head = 2 * pn + (wc >> 1); bf16* wt = WSP(bf16, WS_WQ) + (size_t)d0 * 384;
                if ((wc & 1) == 0) tr_item(F.w_q_up, 768, kb * 64, 96 * head + 32 * bj, 1, wt, 384, F.mla_q_a_g, scr, lane);
                else if (bj == 0) tr_item(F.w_q_up, 768, kb * 64, 96 * head + 64, 1, wt, 384, F.mla_q_a_g, scr, lane, 2);
                else { const int c = lane & 7;
#pragma unroll
                    for (int j = 0; j < 4; ++j) { const int n = (lane >> 3) + 8 * j; *(u32x4*)(wt + (size_t)n * 384 + kb * 64 + 8 * c) = (u32x4){0u, 0u, 0u, 0u}; } }
            } else { const int kb = r / 24, db = r % 24; tr_item(F.w_q_up, 768, kb * 64, db * 32, 1, WSP(bf16, WS_WQ) + (size_t)db * 32 * 384, 384, F.mla_q_a_g, scr, lane); }
            continue; } r -= I_WQ;
        if (r < I_WB) { const int kb = r / 32, db = r % 32; if (MK_F8MID && MK_MERGE78) tr_item8(F.w_branch_a, 1024, kb * 64, db * 32, 1, WSP(unsigned char, WS_WBA) + (size_t)db * 32 * 1024, 1024, scr, lane);
            else if (MK_F8MID) tr_item8(F.w_branch_a, 1024, kb * 64, db * 32, 1, WSP(unsigned char, WS_WBA) + (size_t)db * 32 * 512, 512, scr, lane);
            else tr_item(F.w_branch_a, 1024, kb * 64, db * 32, 1, WSP(bf16, WS_WBA) + (size_t)db * 32 * 512, 512, nullptr, scr, lane); continue; } r -= I_WB;
        if (r < I_WB) { const int kb = r / 32, db = r % 32; if (MK_F8MID && MK_MERGE78) tr_item8(F.w_branch_b, 1024, kb * 64, db * 32, 1, WSP(unsigned char, WS_WBA) + (size_t)db * 32 * 1024 + 512, 1024, scr, lane);
            else if (MK_F8MID) tr_item8(F.w_branch_b, 1024, kb * 64, db * 32, 1, WSP(unsigned char, WS_WBB) + (size_t)db * 32 * 512, 512, scr, lane);
            else tr_item(F.w_branch_b, 1024, kb * 64, db * 32, 1, WSP(bf16, WS_WBB) + (size_t)db * 32 * 512, 512, nullptr, scr, lane); continue; } r -= I_WB;
        if (r < I_WOUT) { const int kb = r / 32, db = r % 32; if (MK_F8MID) tr_item8(F.w_out, 1024, kb * 64, db * 32, 1, WSP(unsigned char, WS_WOUT) + (size_t)db * 32 * 1024, 1024, scr, lane);
            else tr_item(F.w_out, 1024, kb * 64, db * 32, 1, WSP(bf16, WS_WOUT) + (size_t)db * 32 * 1024, 1024, nullptr, scr, lane); continue; } r -= I_WOUT;
    }
    if (!MK_XOVL) p0_experts(F);
}
struct XItem { const float* wp; size_t rstep; unsigned char* dst; };
__device__ __forceinline__ XItem x_item(Frame& F, int r, int lane) {
    constexpr int I_WGU = NE * 16 * 64; XItem I;
    if (r < I_WGU) { const int e = r / 1024, q = r % 1024, kb = q / 64, db = q % 64, d0 = db * 32, pn = d0 >> 8, bj = (d0 >> 7) & 1, x0 = d0 & 127;
        I.wp = F.w_gate_up + (size_t)e * 1024 * 2048 + (size_t)(kb * 64 + (lane >> 5)) * 2048 + 2 * (128 * pn + x0) + bj + (lane & 31) * 2; I.rstep = 2 * 2048;
        I.dst = WSP(unsigned char, WS_WGU) + ((size_t)e * 2048 + d0) * 1024 + kb * 64; }
    else { r -= I_WGU; const int e = r / 512, q = r % 512, kb = q / 32, db = q % 32;
        I.wp = F.w_down + (size_t)e * 1024 * 1024 + (size_t)(kb * 64 + (lane >> 5)) * 1024 + db * 32 + (lane & 31); I.rstep = 2 * 1024;
        I.dst = WSP(unsigned char, WS_WDN) + ((size_t)e * 1024 + db * 32) * 1024 + kb * 64; }
    return I;
}
__device__ __forceinline__ void x_load(const XItem& I, float (&tv)[32]) {
#pragma unroll
    for (int i = 0; i < 32; ++i) tv[i] = I.wp[(size_t)i * I.rstep];
}
__device__ __forceinline__ void x_finish(const XItem& I, float (&tv)[32], LAS float* scr, int lane) {
#pragma unroll
    for (int i = 0; i < 32; ++i) scr[(2 * i + (lane >> 5)) * 33 + (lane & 31)] = tv[i] * F8_SW;
    LDS_WAIT(); asm volatile("" ::: "memory");
    const int c = lane & 3;
#pragma unroll
    for (int j = 0; j < 2; ++j) { const int n = (lane >> 2) + 16 * j; const LAS float* s = scr + (16 * c) * 33 + n;
        u32x4 o; o.x = pk4_fp8(s[0 * 33], s[1 * 33], s[2 * 33], s[3 * 33]); o.y = pk4_fp8(s[4 * 33], s[5 * 33], s[6 * 33], s[7 * 33]);
        o.z = pk4_fp8(s[8 * 33], s[9 * 33], s[10 * 33], s[11 * 33]); o.w = pk4_fp8(s[12 * 33], s[13 * 33], s[14 * 33], s[15 * 33]);
        *(u32x4*)(I.dst + (size_t)n * 1024 + 16 * c) = o; }
    LDS_WAIT(); asm volatile("" ::: "memory");
}
__device__ __forceinline__ void p0_experts(Frame& F) {
    int lane0 = F.lane, wv = F.wave; asm volatile("" : "+v"(lane0), "+s"(wv));
    LAS float* scr = (LAS float*)(F.lds + wv * 16384);
    const int gw = F.vcu * NWAVES + wv, NGW = F.G * NWAVES;
    constexpr int I_WGU = NE * 16 * 64, I_WDN = NE * 16 * 32;
    if (MK_F8 && !MK_WIDE && MK_XPIPE) {
        const int lane = lane0; int it = gw; if (it >= I_WGU + I_WDN) return;
        float ta[32], tb[32]; XItem A = x_item(F, it, lane), B = A; x_load(A, ta);
#pragma nounroll
        for (;;) {
            const int itb = it + NGW; const bool hb = itb < I_WGU + I_WDN; if (hb) { B = x_item(F, itb, lane); x_load(B, tb); }
            x_finish(A, ta, scr, lane); if (!hb) break;
            it = itb + NGW; const bool ha = it < I_WGU + I_WDN; if (ha) { A = x_item(F, it, lane); x_load(A, ta); }
            x_finish(B, tb, scr, lane); if (!ha) break;
        }
        return;
    }
    for (int it = gw; it < I_WGU + I_WDN; it += NGW) {
        const int lane = lane0; int r = it;
        if (r < I_WGU) {
            if (MK_F8 && MK_WIDE) {
                const int e = r / 1024, q = r % 1024, kb = q / 32, cb = q % 32, j0 = 32 * cb, pn = j0 >> 7, x0 = j0 & 127;
                tr_item8w<true>(F.w_gate_up + (size_t)e * 1024 * 2048, 2048, kb * 32, 64 * cb, WSP(unsigned char, WS_WGU) + ((size_t)e * 2048 + 256 * pn + x0) * 1024, 1024, scr, lane);
            } else if (MK_F8) { const int e = r / 1024, q = r % 1024, kb = q / 64, db = q % 64, d0 = db * 32, pn = d0 >> 8, bj = (d0 >> 7) & 1, x0 = d0 & 127;
                tr_item8<false, MK_XNB>(F.w_gate_up + (size_t)e * 1024 * 2048, 2048, kb * 64, 2 * (128 * pn + x0) + bj, 2, WSP(unsigned char, WS_WGU) + ((size_t)e * 2048 + d0) * 1024, 1024, scr, lane);
            } else { const int e = r / 1024, q = r % 1024, kb = q / 64, db = q % 64, d0 = db * 32, pn = d0 >> 8, bj = (d0 >> 7) & 1, x0 = d0 & 127;
                tr_item(F.w_gate_up + (size_t)e * 1024 * 2048, 2048, kb * 64, 2 * (128 * pn + x0) + bj, 2, WSP(bf16, WS_WGU) + ((size_t)e * 2048 + d0) * 1024, 1024, nullptr, scr, lane); }
            continue; } r -= I_WGU;
        { if (MK_F8 && MK_WIDE) { const int e = r / 512, q = r % 512, kb = q / 16, cb = q % 16;
              tr_item8w<false>(F.w_down + (size_t)e * 1024 * 1024, 1024, kb * 32, 64 * cb, WSP(unsigned char, WS_WDN) + ((size_t)e * 1024 + 64 * cb) * 1024, 1024, scr, lane); }
          else if (MK_F8) { const int e = r / 512, q = r % 512, kb = q / 32, db = q % 32;
              tr_item8<false, MK_XNB>(F.w_down + (size_t)e * 1024 * 1024, 1024, kb * 64, db * 32, 1, WSP(unsigned char, WS_WDN) + ((size_t)e * 1024 + db * 32) * 1024, 1024, scr, lane); }
          else { const int e = r / 512, q = r % 512, kb = q / 32, db = q % 32;
              tr_item(F.w_down + (size_t)e * 1024 * 1024, 1024, kb * 64, db * 32, 1, WSP(bf16, WS_WDN) + ((size_t)e * 1024 + db * 32) * 1024, 1024, nullptr, scr, lane); } }
    }
}

__device__ __forceinline__ void p1_norm1(Frame& F) {
    LAS float* AS = (LAS float*)F.lds;
    LAS float* CS = AS + 2048;
    const int b = blockIdx.x, bb = b >> 5; const float* mp = WSP(float, WS_MODP);
    { const GAS float* gmp = (const GAS float*)mp; const GAS float* gba = (const GAS float*)F.b_ada; const GAS float* gg1 = (const GAS float*)F.norm1_g;
#pragma unroll
      for (int h = 0; h < 2; ++h) { float pv[4][9], gv[4];
#pragma unroll
          for (int u = 0; u < 4; ++u) { const int i = F.tid + 512 * (4 * h + u), which = i >> 11, isscale = (i >> 10) & 1, col = i & 1023, rr = which ? 8 : bb, mc = isscale * 1024 + col;
              pv[u][8] = gba[mc]; gv[u] = gg1[col];
#pragma unroll
              for (int kc = 0; kc < 8; ++kc) pv[u][kc] = gmp[(size_t)(kc * 9 + rr) * NMOD + mc]; }
          asm volatile("" ::: "memory");
#pragma unroll
          for (int u = 0; u < 4; ++u) { const int i = F.tid + 512 * (4 * h + u), which = i >> 11, isscale = (i >> 10) & 1, col = i & 1023; float sacc = pv[u][8];
#pragma unroll
              for (int kc = 0; kc < 8; ++kc) sacc += pv[u][kc];
              if (isscale) AS[which * 1024 + col] = gv[u] * (1.0f + sacc); else CS[which * 1024 + col] = sacc; } } }
    if (F.tid < 216) { const int rr = F.tid / 24, mc = 24 * b + F.tid % 24; float s = F.b_ada[mc];
#pragma unroll
        for (int kc = 0; kc < 8; ++kc) s += mp[(size_t)(kc * 9 + rr) * NMOD + mc];
        WSP(float, WS_MOD)[rr * NMOD + mc] = s; }
    __syncthreads();
    bf16* H = WSP(bf16, WS_H);
    const GAS float* gx = (const GAS float*)F.x; GAS unsigned char* gH = (GAS unsigned char*)H; const int lane = F.lane;
#define P1_ROW(v, row, a, c) do { float ss = 0.f; _Pragma("unroll") for (int q = 0; q < 4; ++q) ss += (v[q].x * v[q].x + v[q].y * v[q].y) + (v[q].z * v[q].z + v[q].w * v[q].w); \
        const float rstd = rsqrtf(wave_sum(ss) * (1.0f / D) + EPS); \
        _Pragma("unroll") for (int q = 0; q < 4; ++q) { const f32x4 av = *(const LAS f32x4*)((a) + 4 * lane + 256 * q), cv = *(const LAS f32x4*)((c) + 4 * lane + 256 * q); \
            const float h0 = v[q].x * rstd * av.x + cv.x, h1 = v[q].y * rstd * av.y + cv.y, h2v = v[q].z * rstd * av.z + cv.z, h3 = v[q].w * rstd * av.w + cv.w; \
            if (MK_F8IN) *(GAS unsigned*)(gH + (size_t)(row) * D + 4 * lane + 256 * q) = pk4_fp8(h0 * F8_SA, h1 * F8_SA, h2v * F8_SA, h3 * F8_SA); \
            else { u32x2 o; o.x = pk2(h0, h1); o.y = pk2(h2v, h3); *(GAS u32x2*)((GAS bf16*)gH + (size_t)(row) * D + 4 * lane + 256 * q) = o; } } } while (0)
    { f32x4 vc[4]; const GAS float* xr = (const GAS float*)F.ctx + (size_t)(8 * b + F.wave) * D;
#pragma unroll
      for (int q = 0; q < 4; ++q) vc[q] = *(const GAS f32x4*)(xr + 4 * lane + 256 * q);
      P1_ROW(vc, MTOK + 8 * b + F.wave, AS + 1024, CS + 1024); }
#pragma nounroll
    for (int j0 = 0; j0 < 16; j0 += MK_P1R) {
        f32x4 v[MK_P1R][4];
#pragma unroll
        for (int t = 0; t < MK_P1R; ++t) { const GAS float* xr = gx + (size_t)(128 * b + 16 * F.wave + j0 + t) * D;
#pragma unroll
            for (int q = 0; q < 4; ++q) v[t][q] = *(const GAS f32x4*)(xr + 4 * lane + 256 * q); }
        asm volatile("" ::: "memory");
#pragma unroll
        for (int t = 0; t < MK_P1R; ++t) P1_ROW(v[t], 128 * b + 16 * F.wave + j0 + t, AS, CS);
    }
#undef P1_ROW
}

struct SchedInProj {
    int G, c; const char* A; const char* Bt;
    __device__ __forceinline__ bool next(int i, pg8::Unit& u) const { int L = i * G + c; constexpr int NU = 24 + 128 * 14; if (MK_REPU == 2) { if (L >= 2 * NU) return false; L %= NU; } else if (L >= NU) return false;
        if (L < 24) { u.pm = 128 + L / 3; const int s = L % 3; u.pn = (s == 2) ? 3 : s; }
        else if (MK_FUSE3 && L < 24 + 128 * 3) { int pn; pg8::tile_map(L - 24, 128, 3, u.pm, pn); u.pn = pn == 0 ? 1 : 3 + pn; }
        else if (MK_FUSE3) { int pn; pg8::tile_map(L - 24 - 128 * 3, 128, 11, u.pm, pn); u.pn = pn == 0 ? 0 : pn < 3 ? pn + 1 : pn + 3; }
        else pg8::tile_map(L - 24, 128, 14, u.pm, u.pn);
        u.ex = 0; return true; }
    __device__ __forceinline__ const char* a_tile(const pg8::Unit& u) const { return A + (size_t)u.pm * 256 * (D * (MK_F8IN ? 1 : 2)); }
    __device__ __forceinline__ const char* b_tile(const pg8::Unit& u) const { return Bt + (size_t)u.pn * 256 * (D * (MK_F8IN ? 1 : 2)); }
    __device__ __forceinline__ const int* a_rows(const pg8::Unit&) const { return nullptr; }
};
struct SchedDense {
    int G, c, nM, nN; const char* A; const char* Bt; size_t a_tstep, b_tstep; int rep = 1;
    __device__ __forceinline__ bool next(int i, pg8::Unit& u) const { int L = i * G + c; if (L >= rep * nM * nN) return false; L %= nM * nN; pg8::tile_map(L, nM, nN, u.pm, u.pn); u.ex = 0; return true; }
    __device__ __forceinline__ const char* a_tile(const pg8::Unit& u) const { return A + (size_t)u.pm * a_tstep; }
    __device__ __forceinline__ const char* b_tile(const pg8::Unit& u) const { return Bt + (size_t)u.pn * b_tstep; }
    __device__ __forceinline__ const int* a_rows(const pg8::Unit&) const { return nullptr; }
};
struct SchedMoe {
    int G, c, R, nN; const char* A; const char* Bt; size_t a_tstep, b_estep, b_tstep; const LAS unsigned char* texp; const int* rows; int rep = 1;
    __device__ __forceinline__ bool next(int i, pg8::Unit& u) const { int L = i * G + c; if (L >= rep * R * nN) return false; L %= R * nN; pg8::tile_map(L, R, nN, u.pm, u.pn); u.ex = texp[u.pm]; return true; }
    __device__ __forceinline__ const char* a_tile(const pg8::Unit& u) const { return A + (size_t)u.pm * a_tstep; }
    __device__ __forceinline__ const char* b_tile(const pg8::Unit& u) const { return Bt + (size_t)u.ex * b_estep + (size_t)u.pn * b_tstep; }
    __device__ __forceinline__ const int* a_rows(const pg8::Unit& u) const { return rows + (size_t)u.pm * 256; }
};

struct EpiStoreBf16 {
    static constexpr bool PERM = true;
    bf16* O; int ldc; const float* rowscale; float cscale;
    __device__ __forceinline__ void operator()(const f32x4 (&acc)[2][2][4][2], const pg8::Unit& u, int wr, int wc, int fr, int fq) const {
        const int row0 = u.pm * 256 + wr * 64 + fr, col0 = u.pn * 256 + wc * 32 + 8 * fq;
#pragma unroll
        for (int ai = 0; ai < 2; ++ai)
#pragma unroll
            for (int m = 0; m < 4; ++m) { const int row = row0 + ai * 128 + m * 16; const float sc = (rowscale ? rowscale[row] : 1.0f) * cscale; bf16* rowp = O + (size_t)row * ldc + col0;
#pragma unroll
                for (int bj = 0; bj < 2; ++bj) { const f32x4 v0 = acc[ai][bj][m][0] * sc, v1 = acc[ai][bj][m][1] * sc;
                    u32x4 w; w.x = cvt_pk_bf16(v0[0], v0[1]); w.y = cvt_pk_bf16(v0[2], v0[3]); w.z = cvt_pk_bf16(v1[0], v1[1]); w.w = cvt_pk_bf16(v1[2], v1[3]);
                    *(u32x4*)(rowp + bj * 128) = w; } }
    }
};
struct EpiInProj {
    static constexpr bool PERM = true;
    bf16* RAW; float* sskv; float* ssq; bf16* QS; bf16* KS; bf16* VS; const LAS float* ts; const LAS float* gq; const LAS float* gk;
    __device__ __forceinline__ void operator()(const f32x4 (&acc)[2][2][4][2], const pg8::Unit& u, int wr, int wc, int fr, int fq) const {
        constexpr float CS = MK_F8IN ? F8_INV : 1.0f; const int pn = u.pn; const bool lat = u.pm < 128;
        if (pn == 1 || pn == 4 || pn == 5) {
            const bool isq = pn != 1, isv = (!isq) && wc >= 2; const int head = isq ? 4 * (pn - 4) + wc : (wc & 1); const LAS float* gn = isq ? gq : gk;
            f32x4 g[4];
#pragma unroll
            for (int q4 = 0; q4 < 4; ++q4) g[q4] = *(const LAS f32x4*)(gn + 16 * q4 + 4 * fq);
#pragma unroll
            for (int ai = 0; ai < 2; ++ai)
#pragma unroll
                for (int m = 0; m < 4; ++m) { const int row = u.pm * 256 + ai * 128 + wr * 64 + m * 16 + fr;
                    f32x4 x[4] = {acc[ai][0][m][0] * CS, acc[ai][0][m][1] * CS, acc[ai][1][m][0] * CS, acc[ai][1][m][1] * CS};
                    int bidx, key, pos; if (lat) { bidx = row >> 12; pos = row & 4095; key = pos; } else { const int rc = row - MTOK; bidx = rc >> 8; key = SEQ + (rc & 255); pos = 0; }
                    if (!isv) { float ss = 0.f;
#pragma unroll
                        for (int q4 = 0; q4 < 4; ++q4) ss += (x[q4][0] * x[q4][0] + x[q4][1] * x[q4][1]) + (x[q4][2] * x[q4][2] + x[q4][3] * x[q4][3]);
                        ss += __shfl_xor(ss, 16); ss += __shfl_xor(ss, 32);
                        const float rstd = rsqrtf(ss * (1.0f / 64.0f) + EPS) * (isq ? QSCALE_S : 1.0f);
#pragma unroll
                        for (int q4 = 0; q4 < 4; ++q4) x[q4] = x[q4] * g[q4] * rstd;
                        if (lat) { const int pr = pos >> 6, pc = pos & 63;
                            const f32x4 cr = *(const LAS f32x4*)(ts + pr * 16 + 4 * fq), sr = *(const LAS f32x4*)(ts + 1024 + pr * 16 + 4 * fq), cc = *(const LAS f32x4*)(ts + pc * 16 + 4 * fq), sc = *(const LAS f32x4*)(ts + 1024 + pc * 16 + 4 * fq);
                            const f32x4 y1 = x[0] * cr - x[1] * sr, y2 = x[1] * cr + x[0] * sr, y3 = x[2] * cc - x[3] * sc, y4 = x[3] * cc + x[2] * sc; x[0] = y1; x[1] = y2; x[2] = y3; x[3] = y4; } }
                    GAS bf16* dst = isq ? ((GAS bf16*)QS + (size_t)row * 512 + head * 64) : ((GAS bf16*)(isv ? VS : KS) + ((size_t)bidx * KEYS + key) * 128 + head * 64);
#pragma unroll
                    for (int q4 = 0; q4 < 4; ++q4) { u32x2 w; w.x = cvt_pk_bf16(x[q4][0], x[q4][1]); w.y = cvt_pk_bf16(x[q4][2], x[q4][3]); *(GAS u32x2*)(dst + 16 * q4 + 4 * fq) = w; } }
        } else {
            const int row0 = u.pm * 256 + wr * 64 + fr, col0 = pn * 256 + wc * 32 + 8 * fq;
#pragma unroll
            for (int ai = 0; ai < 2; ++ai)
#pragma unroll
                for (int m = 0; m < 4; ++m) { const int row = row0 + ai * 128 + m * 16; GAS bf16* rowp = (GAS bf16*)RAW + (size_t)row * NRAW + col0; float ss0 = 0.f, ss1 = 0.f;
#pragma unroll
                    for (int bj = 0; bj < 2; ++bj) { const f32x4 v0 = acc[ai][bj][m][0] * CS, v1 = acc[ai][bj][m][1] * CS;
                        const float q = ((v0[0] * v0[0] + v0[1] * v0[1]) + (v0[2] * v0[2] + v0[3] * v0[3])) + ((v1[0] * v1[0] + v1[1] * v1[1]) + (v1[2] * v1[2] + v1[3] * v1[3])); if (bj == 0) ss0 = q; else ss1 = q;
                        u32x4 w; w.x = cvt_pk_bf16(v0[0], v0[1]); w.y = cvt_pk_bf16(v0[2], v0[3]); w.z = cvt_pk_bf16(v1[0], v1[1]); w.w = cvt_pk_bf16(v1[2], v1[3]);
                        *(GAS u32x4*)(rowp + bj * 128) = w; }
                    if (pn == 0 || pn == 2 || pn == 3) { float ss = (pn == 3) ? ss0 : ss0 + ss1; ss += __shfl_xor(ss, 16); ss += __shfl_xor(ss, 32);
                        if (fq == 0) { if (pn == 0) ((GAS float*)sskv)[row * 4 + wc] = ss; else if (lat) ((GAS float*)ssq)[row * 8 + (pn == 3 ? 4 : 0) + wc] = ss; } } }
        }
    }
};
template <int NP> struct EpiUp {
    static constexpr bool PERM = true;
    bf16* O; int ldc; const float* ssp; float invn;
    __device__ __forceinline__ void operator()(const f32x4 (&acc)[2][2][4][2], const pg8::Unit& u, int wr, int wc, int fr, int fq) const {
        const int row0 = u.pm * 256 + wr * 64 + fr, col0 = u.pn * 256 + wc * 32 + 8 * fq;
#pragma unroll
        for (int ai = 0; ai < 2; ++ai)
#pragma unroll
            for (int m = 0; m < 4; ++m) { const int row = row0 + ai * 128 + m * 16; float s = 0.f;
#pragma unroll
                for (int w = 0; w < NP; w += 4) { const f32x4 p = *(const f32x4*)(ssp + (size_t)row * NP + w); s += (p[0] + p[1]) + (p[2] + p[3]); }
                const float sc = rsqrtf(s * invn + EPS); bf16* rowp = O + (size_t)row * ldc + col0;
#pragma unroll
                for (int bj = 0; bj < 2; ++bj) { const f32x4 v0 = acc[ai][bj][m][0] * sc, v1 = acc[ai][bj][m][1] * sc;
                    u32x4 w; w.x = cvt_pk_bf16(v0[0], v0[1]); w.y = cvt_pk_bf16(v0[2], v0[3]); w.z = cvt_pk_bf16(v1[0], v1[1]); w.w = cvt_pk_bf16(v1[2], v1[3]);
                    *(u32x4*)(rowp + bj * 128) = w; } }
    }
};
template <bool K8> struct EpiKv {
    static constexpr bool PERM = true; static constexpr bool k8 = K8;
    const float* sskv; const bf16* RAW; bf16* KM; bf16* VM; const LAS float* tm; const LAS float* gk;
    __device__ __forceinline__ void operator()(const f32x4 (&acc)[2][2][4][2], const pg8::Unit& u, int wr, int wc, int fr, int fq) const {
        const int head = 2 * u.pn + (wc >> 1); const bool isv = wc & 1, lat = u.pm < 128;
        const LAS float* ggk = gk;
#pragma unroll
        for (int ai = 0; ai < 2; ++ai) {
            f32x4 pp[4]; unsigned krw[4][4];
#pragma unroll
            for (int m = 0; m < 4; ++m) { const int row = u.pm * 256 + ai * 128 + wr * 64 + m * 16 + fr; pp[m] = *(const GAS f32x4*)((const GAS float*)sskv + (size_t)row * 4);
                if (!isv) { const GAS bf16* rr = (const GAS bf16*)RAW + (size_t)row * NRAW + C_KROPE + 2 * fq;
#pragma unroll
                    for (int qd = 0; qd < 4; ++qd) krw[m][qd] = *(const GAS unsigned*)(rr + 8 * qd); } }
            asm volatile("" ::: "memory");
#pragma unroll
            for (int m = 0; m < 4; ++m) {
                const int row = u.pm * 256 + ai * 128 + wr * 64 + m * 16 + fr;
                const f32x4 p = pp[m]; const float rkv = rsqrtf(((p[0] + p[1]) + (p[2] + p[3])) * (1.0f / 256.0f) + EPS);
                int bidx, key, pos; if (lat) { bidx = row >> 12; pos = row & 4095; key = pos; } else { const int rc = row - MTOK; bidx = rc >> 8; key = SEQ + (rc & 255); pos = 0; }
                f32x4 x[2][2];
#pragma unroll
                for (int bj = 0; bj < 2; ++bj)
#pragma unroll
                    for (int n = 0; n < 2; ++n) x[bj][n] = acc[ai][bj][m][n] * rkv;
                if (isv) { GAS bf16* vo = (GAS bf16*)VM + ((size_t)bidx * KEYS + key) * 512 + head * 64 + 8 * fq;
#pragma unroll
                    for (int bj = 0; bj < 2; ++bj) { u32x4 w; w.x = cvt_pk_bf16(x[bj][0][0], x[bj][0][1]); w.y = cvt_pk_bf16(x[bj][0][2], x[bj][0][3]); w.z = cvt_pk_bf16(x[bj][1][0], x[bj][1][1]); w.w = cvt_pk_bf16(x[bj][1][2], x[bj][1][3]);
                        *(GAS u32x4*)(vo + 32 * bj) = w; }
                } else {
                    float kr[4][2]; float ss = 0.f;
#pragma unroll
                    for (int qd = 0; qd < 4; ++qd) { const unsigned w = krw[m][qd]; kr[qd][0] = bflo(w); kr[qd][1] = bfhi(w); ss += kr[qd][0] * kr[qd][0] + kr[qd][1] * kr[qd][1]; }
#pragma unroll
                    for (int bj = 0; bj < 2; ++bj)
#pragma unroll
                        for (int n = 0; n < 2; ++n) ss += (x[bj][n][0] * x[bj][n][0] + x[bj][n][1] * x[bj][n][1]) + (x[bj][n][2] * x[bj][n][2] + x[bj][n][3] * x[bj][n][3]);
                    ss += __shfl_xor(ss, 16); ss += __shfl_xor(ss, 32);
                    const float rstd = rsqrtf(ss * (1.0f / 96.0f) + EPS);
                    GAS bf16* ko = (GAS bf16*)KM + ((size_t)bidx * KEYS + key) * 768 + head * 96; GAS unsigned char* ko8 = (GAS unsigned char*)KM + ((size_t)bidx * KEYS + key) * 1024 + head * 128;
                    const int pr = pos >> 6, pc = pos & 63;
#pragma unroll
                    for (int ii = 0; ii < 2; ++ii) { const int i = 2 * fq + ii; float y0 = kr[0][ii] * rstd * ggk[64 + i], y1 = kr[1][ii] * rstd * ggk[72 + i], y2 = kr[2][ii] * rstd * ggk[80 + i], y3 = kr[3][ii] * rstd * ggk[88 + i];
                        if (lat) { const float cr = tm[pr * 8 + i], sr = tm[512 + pr * 8 + i], cc = tm[pc * 8 + i], sc = tm[512 + pc * 8 + i];
                            const float o0 = y0 * cr - y1 * sr, o1 = y1 * cr + y0 * sr, o2 = y2 * cc - y3 * sc, o3 = y3 * cc + y2 * sc; y0 = o0; y1 = o1; y2 = o2; y3 = o3; }
                        kr[0][ii] = y0; kr[1][ii] = y1; kr[2][ii] = y2; kr[3][ii] = y3; }
#pragma unroll
                    for (int qd = 0; qd < 4; ++qd) { if (k8) *(GAS unsigned short*)(ko8 + 64 + 32 * (qd & 1) + 8 * (qd >> 1) + 2 * fq) = (unsigned short)pk4_fp8(kr[qd][0] * 16.f, kr[qd][1] * 16.f, 0.f, 0.f); else *(GAS unsigned*)(ko + 64 + 8 * qd + 2 * fq) = cvt_pk_bf16(kr[qd][0], kr[qd][1]); }
#pragma unroll
                    for (int bj = 0; bj < 2; ++bj) { const f32x4 g0 = *(const LAS f32x4*)(ggk + 32 * bj + 8 * fq), g1 = *(const LAS f32x4*)(ggk + 32 * bj + 8 * fq + 4);
                        const f32x4 a = x[bj][0] * g0 * rstd, b = x[bj][1] * g1 * rstd;
                        if (k8) { u32x2 w; w.x = pk4_fp8(a[0] * 16.f, a[1] * 16.f, a[2] * 16.f, a[3] * 16.f); w.y = pk4_fp8(b[0] * 16.f, b[1] * 16.f, b[2] * 16.f, b[3] * 16.f); *(GAS u32x2*)(ko8 + 32 * (fq & 1) + 8 * (2 * bj + (fq >> 1))) = w; }
                        else { u32x4 w; w.x = cvt_pk_bf16(a[0], a[1]); w.y = cvt_pk_bf16(a[2], a[3]); w.z = cvt_pk_bf16(b[0], b[1]); w.w = cvt_pk_bf16(b[2], b[3]); *(GAS u32x4*)(ko + 32 * bj + 8 * fq) = w; } }
                    if (k8) *(GAS u32x2*)(ko8 + 64 + 32 * (fq >> 1) + 16 + 8 * (fq & 1)) = (u32x2){0u, 0u};
                } } }
    }
};
struct EpiQ {
    static constexpr bool PERM = true;
    const float* ssq; bf16* QM; float* ssqh; const LAS float* tm; const LAS float* gq;
    __device__ __forceinline__ void operator()(const f32x4 (&acc)[2][2][4][2], const pg8::Unit& u, int wr, int wc, int fr, int fq) const {
        const int head = 2 * u.pn + (wc >> 1); const bool isr = wc & 1;
        f32x4 g[2][2]; float gr[4][2];
#pragma unroll
        for (int bj = 0; bj < 2; ++bj)
#pragma unroll
            for (int n = 0; n < 2; ++n) g[bj][n] = *(const LAS f32x4*)(gq + 32 * bj + 8 * fq + 4 * n);
#pragma unroll
        for (int qd = 0; qd < 4; ++qd) { gr[qd][0] = gq[64 + 8 * qd + 2 * fq]; gr[qd][1] = gq[64 + 8 * qd + 2 * fq + 1]; }
#pragma unroll
        for (int ai = 0; ai < 2; ++ai) {
            f32x4 pq0[4], pq1[4];
#pragma unroll
            for (int m = 0; m < 4; ++m) { const int row = u.pm * 256 + ai * 128 + wr * 64 + m * 16 + fr; pq0[m] = *(const GAS f32x4*)((const GAS float*)ssq + (size_t)row * 8); pq1[m] = *(const GAS f32x4*)((const GAS float*)ssq + (size_t)row * 8 + 4); }
            asm volatile("" ::: "memory");
#pragma unroll
            for (int m = 0; m < 4; ++m) { const int row = u.pm * 256 + ai * 128 + wr * 64 + m * 16 + fr;
                const f32x4 p0 = pq0[m], p1 = pq1[m];
                const float rq = rsqrtf((((p0[0] + p0[1]) + (p0[2] + p0[3])) + ((p1[0] + p1[1]) + (p1[2] + p1[3]))) * (1.0f / 384.0f) + EPS);
                GAS bf16* qo = (GAS bf16*)QM + (size_t)row * 768 + head * 96;
                if (!isr) { float ss = 0.f;
#pragma unroll
                    for (int bj = 0; bj < 2; ++bj) { const f32x4 a = acc[ai][bj][m][0] * rq, b = acc[ai][bj][m][1] * rq;
                        ss += ((a[0] * a[0] + a[1] * a[1]) + (a[2] * a[2] + a[3] * a[3])) + ((b[0] * b[0] + b[1] * b[1]) + (b[2] * b[2] + b[3] * b[3]));
                        const f32x4 ag = a * g[bj][0] * QSCALE_M, bg = b * g[bj][1] * QSCALE_M;
                        u32x4 w; w.x = cvt_pk_bf16(ag[0], ag[1]); w.y = cvt_pk_bf16(ag[2], ag[3]); w.z = cvt_pk_bf16(bg[0], bg[1]); w.w = cvt_pk_bf16(bg[2], bg[3]); *(GAS u32x4*)(qo + 32 * bj + 8 * fq) = w; }
                    ss += __shfl_xor(ss, 16); ss += __shfl_xor(ss, 32);
                    if (fq == 0) ((GAS float*)ssqh)[((size_t)row * 8 + head) * 2] = ss;
                } else {
                    const f32x4 a = acc[ai][0][m][0] * rq, b = acc[ai][0][m][1] * rq;
                    float ss = ((a[0] * a[0] + a[1] * a[1]) + (a[2] * a[2] + a[3] * a[3])) + ((b[0] * b[0] + b[1] * b[1]) + (b[2] * b[2] + b[3] * b[3]));
                    ss += __shfl_xor(ss, 16); ss += __shfl_xor(ss, 32);
                    if (fq == 0) ((GAS float*)ssqh)[((size_t)row * 8 + head) * 2 + 1] = ss;
                    const int pos = row & 4095, pr = pos >> 6, pc = pos & 63; float o[4][2];
#pragma unroll
                    for (int ib = 0; ib < 2; ++ib) { const int i = 2 * fq + ib; const float y0 = a[ib] * gr[0][ib], y1 = a[2 + ib] * gr[1][ib], y2 = b[ib] * gr[2][ib], y3 = b[2 + ib] * gr[3][ib];
                        const float cr = tm[pr * 8 + i], sr = tm[512 + pr * 8 + i], cc = tm[pc * 8 + i], sc = tm[512 + pc * 8 + i];
                        o[0][ib] = (y0 * cr - y1 * sr) * QSCALE_M; o[1][ib] = (y1 * cr + y0 * sr) * QSCALE_M; o[2][ib] = (y2 * cc - y3 * sc) * QSCALE_M; o[3][ib] = (y3 * cc + y2 * sc) * QSCALE_M; }
#pragma unroll
                    for (int qd = 0; qd < 4; ++qd) *(GAS unsigned*)(qo + 64 + 8 * qd + 2 * fq) = cvt_pk_bf16(o[qd][0], o[qd][1]);
                } } }
    }
};
template <bool ADD> struct EpiBranch {
    static constexpr bool PERM = true;
    bf16* T; const bf16* gate; unsigned char* T8;
    __device__ __forceinline__ void operator()(const f32x4 (&acc)[2][2][4][2], const pg8::Unit& u, int wr, int wc, int fr, int fq) const {
        const int row0 = u.pm * 256 + wr * 64 + fr, col0 = u.pn * 256 + wc * 32 + 8 * fq; constexpr float ASC = MK_F8MID ? F8_INVM : 1.0f;
#pragma unroll
        for (int ai = 0; ai < 2; ++ai)
#pragma unroll
            for (int m = 0; m < 4; ++m) { const int row = row0 + ai * 128 + m * 16;
#pragma unroll
                for (int bj = 0; bj < 2; ++bj) { const int col = col0 + bj * 128;
                    const u32x4 g = *(const u32x4*)(gate + (size_t)row * NRAW + col);
                    f32x4 v0 = acc[ai][bj][m][0] * ASC, v1 = acc[ai][bj][m][1] * ASC;
                    v0[0] *= sigmoidf_(bflo(g.x)); v0[1] *= sigmoidf_(bfhi(g.x)); v0[2] *= sigmoidf_(bflo(g.y)); v0[3] *= sigmoidf_(bfhi(g.y));
                    v1[0] *= sigmoidf_(bflo(g.z)); v1[1] *= sigmoidf_(bfhi(g.z)); v1[2] *= sigmoidf_(bflo(g.w)); v1[3] *= sigmoidf_(bfhi(g.w));
                    bf16* tp = T + (size_t)row * D + col;
                    if (ADD) { const u32x4 t = *(const u32x4*)tp; v0[0] += bflo(t.x); v0[1] += bfhi(t.x); v0[2] += bflo(t.y); v0[3] += bfhi(t.y); v1[0] += bflo(t.z); v1[1] += bfhi(t.z); v1[2] += bflo(t.w); v1[3] += bfhi(t.w); }
                    if (ADD && MK_F8MID) { u32x2 w; w.x = pk4_fp8(v0[0] * F8_SO, v0[1] * F8_SO, v0[2] * F8_SO, v0[3] * F8_SO); w.y = pk4_fp8(v1[0] * F8_SO, v1[1] * F8_SO, v1[2] * F8_SO, v1[3] * F8_SO);
                        *(u32x2*)(T8 + (size_t)row * D + col) = w; }
                    else { u32x4 w; w.x = cvt_pk_bf16(v0[0], v0[1]); w.y = cvt_pk_bf16(v0[2], v0[3]); w.z = cvt_pk_bf16(v1[0], v1[1]); w.w = cvt_pk_bf16(v1[2], v1[3]);
                        *(u32x4*)tp = w; } } }
    }
};
struct EpiMerge {
    static constexpr int NST = 16; static constexpr bool PERM = true, MID = true;
    const bf16* RAW; unsigned char* T8;
    __device__ __forceinline__ void mid(f32x4 (&acc)[2][2][4][2], const pg8::Unit& u, int wr, int wc, int fr, int fq) const {
        asm volatile("" : "+v"(fr), "+v"(fq));
        const int row0 = u.pm * 256 + wr * 64 + fr, col0 = u.pn * 256 + wc * 32 + 8 * fq;
#pragma unroll
        for (int ai = 0; ai < 2; ++ai)
#pragma unroll
            for (int m2 = 0; m2 < 4; m2 += MK_MIDR) { asm volatile("" ::: "memory");
              u32x4 gav[MK_MIDR][2], gbv[MK_MIDR][2];
#pragma unroll
              for (int mm = 0; mm < MK_MIDR; ++mm) { const GAS bf16* rp = (const GAS bf16*)RAW + (size_t)(row0 + ai * 128 + (m2 + mm) * 16) * NRAW + col0;
#pragma unroll
                  for (int bj = 0; bj < 2; ++bj) { gav[mm][bj] = *(const GAS u32x4*)(rp + C_GA + bj * 128); gbv[mm][bj] = *(const GAS u32x4*)(rp + C_GB + bj * 128); } }
              asm volatile("" ::: "memory");
#pragma unroll
              for (int mm = 0; mm < MK_MIDR; ++mm) { const int m = m2 + mm;
#pragma unroll
                for (int bj = 0; bj < 2; ++bj) { const u32x4 ga = gav[mm][bj], gb = gbv[mm][bj];
                    const unsigned aw[4] = {ga.x, ga.y, ga.z, ga.w}, bw[4] = {gb.x, gb.y, gb.z, gb.w};
#pragma unroll
                    for (int q = 0; q < 4; ++q) { const float ea0 = __builtin_amdgcn_exp2f(-LOG2E * bflo(aw[q])), ea1 = __builtin_amdgcn_exp2f(-LOG2E * bfhi(aw[q])), eb0 = __builtin_amdgcn_exp2f(-LOG2E * bflo(bw[q])), eb1 = __builtin_amdgcn_exp2f(-LOG2E * bfhi(bw[q]));
                        acc[ai][bj][m][q >> 1][2 * (q & 1)] *= (1.0f + eb0) * __builtin_amdgcn_rcpf(1.0f + ea0); acc[ai][bj][m][q >> 1][2 * (q & 1) + 1] *= (1.0f + eb1) * __builtin_amdgcn_rcpf(1.0f + ea1); } } } }
    }
    __device__ __forceinline__ void operator()(const f32x4 (&acc)[2][2][4][2], const pg8::Unit& u, int wr, int wc, int fr, int fq) const {
        const int row0 = u.pm * 256 + wr * 64 + fr, col0 = u.pn * 256 + wc * 32 + 8 * fq; constexpr float SC = F8_INVM * F8_SO;
#pragma unroll
        for (int ai = 0; ai < 2; ++ai) {
            u32x4 gg[4][2];
#pragma unroll
            for (int m = 0; m < 4; ++m)
#pragma unroll
                for (int bj = 0; bj < 2; ++bj) gg[m][bj] = *(const GAS u32x4*)((const GAS bf16*)RAW + (size_t)(row0 + ai * 128 + m * 16) * NRAW + C_GB + col0 + bj * 128);
            asm volatile("" ::: "memory");
#pragma unroll
            for (int m = 0; m < 4; ++m) { const int row = row0 + ai * 128 + m * 16;
#pragma unroll
                for (int bj = 0; bj < 2; ++bj) { const u32x4 g = gg[m][bj]; const f32x4 v0 = acc[ai][bj][m][0] * SC, v1 = acc[ai][bj][m][1] * SC;
                    u32x2 w; w.x = pk4_fp8(v0[0] * sigmoidf_(bflo(g.x)), v0[1] * sigmoidf_(bfhi(g.x)), v0[2] * sigmoidf_(bflo(g.y)), v0[3] * sigmoidf_(bfhi(g.y)));
                    w.y = pk4_fp8(v1[0] * sigmoidf_(bflo(g.z)), v1[1] * sigmoidf_(bfhi(g.z)), v1[2] * sigmoidf_(bflo(g.w)), v1[3] * sigmoidf_(bfhi(g.w)));
                    *(GAS u32x2*)((GAS unsigned char*)T8 + (size_t)row * D + col0 + bj * 128) = w; } } }
    }
};
struct EpiOutRes {
    static constexpr bool PERM = false;
    const float* x; float* out; const float* mod;
    __device__ __forceinline__ void operator()(const f32x4 (&acc)[2][2][4][2], const pg8::Unit& u, int wr, int wc, int fr, int fq) const {
        const int row0 = u.pm * 256 + wr * 64 + fr, col0 = u.pn * 256 + wc * 32 + 4 * fq; const int bb = (u.pm * 256) >> 12;
        f32x4 gv[2][2];
#pragma unroll
        for (int bj = 0; bj < 2; ++bj)
#pragma unroll
            for (int n = 0; n < 2; ++n) gv[bj][n] = *(const f32x4*)(mod + (size_t)bb * NMOD + 2048 + col0 + bj * 128 + n * 16);
#pragma unroll
        for (int ai = 0; ai < 2; ++ai)
#pragma unroll
            for (int mh = 0; mh < 4; mh += MK_EPIX) {
                f32x4 xv[MK_EPIX][2][2];
#pragma unroll
                for (int m = 0; m < MK_EPIX; ++m) { const size_t ro = (size_t)(row0 + ai * 128 + (mh + m) * 16) * D + col0;
#pragma unroll
                    for (int bj = 0; bj < 2; ++bj)
#pragma unroll
                        for (int n = 0; n < 2; ++n) xv[m][bj][n] = *(const GAS f32x4*)((const GAS float*)x + ro + bj * 128 + n * 16); }
                asm volatile("" ::: "memory");
#pragma unroll
                for (int m = 0; m < MK_EPIX; ++m) { const size_t ro = (size_t)(row0 + ai * 128 + (mh + m) * 16) * D + col0;
#pragma unroll
                    for (int bj = 0; bj < 2; ++bj)
#pragma unroll
                        for (int n = 0; n < 2; ++n) *(GAS f32x4*)((GAS float*)out + ro + bj * 128 + n * 16) = xv[m][bj][n] + gv[bj][n] * (acc[ai][bj][mh + m][n] * (MK_F8MID ? F8_INVM : 1.0f)); } }
    }
};
struct EpiSwiglu {
    static constexpr bool PERM = true, PRE = true;
    unsigned char* ACT; const float* bgu;
    __device__ __forceinline__ void pre(const pg8::Unit& u, int wr, int wc, int fr, int fq, f32x4 (&b4)[4]) const { const float* bp = bgu + (size_t)u.ex * 2048 + 2 * (u.pn * 128 + wc * 32 + 8 * fq);
#pragma unroll
        for (int q = 0; q < 4; ++q) asm_load16(b4[q], bp + 4 * q); }
    __device__ __forceinline__ void operator()(const f32x4 (&acc)[2][2][4][2], const pg8::Unit& u, int wr, int wc, int fr, int fq, const f32x4 (&b4)[4]) const {
        const int row0 = u.pm * 256 + wr * 64 + fr, j0 = u.pn * 128 + wc * 32 + 8 * fq;
        constexpr float ASC = MK_F8 ? F8_INV : 1.0f, OSC = MK_F8 ? F8_SA : 1.0f;
#pragma unroll
        for (int ai = 0; ai < 2; ++ai)
#pragma unroll
            for (int m = 0; m < 4; ++m) { f32x2 o[4];
#pragma unroll
                for (int q = 0; q < 4; ++q) { const int n = q >> 1, e0 = 2 * (q & 1);
                    f32x2 g = (f32x2){acc[ai][0][m][n][e0], acc[ai][0][m][n][e0 + 1]} * ASC + (f32x2){b4[q][0], b4[q][2]};
                    f32x2 l = (f32x2){acc[ai][1][m][n][e0], acc[ai][1][m][n][e0 + 1]} * ASC + (f32x2){b4[q][1], b4[q][3]};
                    g.x = fminf(g.x, 7.0f); g.y = fminf(g.y, 7.0f); l.x = __builtin_amdgcn_fmed3f(l.x, -7.0f, 7.0f); l.y = __builtin_amdgcn_fmed3f(l.y, -7.0f, 7.0f);
                    const f32x2 z = g * (-1.702f * LOG2E); f32x2 d; d.x = __builtin_amdgcn_exp2f(z.x); d.y = __builtin_amdgcn_exp2f(z.y); d = d + 1.0f;
                    f32x2 r; r.x = __builtin_amdgcn_rcpf(d.x); r.y = __builtin_amdgcn_rcpf(d.y);
                    o[q] = (g * r) * (l * OSC + OSC); }
                if (MK_F8) { u32x2 w; int t = __builtin_amdgcn_cvt_pk_fp8_f32(o[0].x, o[0].y, 0, false); t = __builtin_amdgcn_cvt_pk_fp8_f32(o[1].x, o[1].y, t, true); w.x = (unsigned)t;
                    t = __builtin_amdgcn_cvt_pk_fp8_f32(o[2].x, o[2].y, 0, false); t = __builtin_amdgcn_cvt_pk_fp8_f32(o[3].x, o[3].y, t, true); w.y = (unsigned)t;
                    *(u32x2*)(ACT + (size_t)(row0 + ai * 128 + m * 16) * 1024 + j0) = w; }
                else { u32x4 w; w.x = cvt_pk_bf16(o[0].x, o[0].y); w.y = cvt_pk_bf16(o[1].x, o[1].y); w.z = cvt_pk_bf16(o[2].x, o[2].y); w.w = cvt_pk_bf16(o[3].x, o[3].y);
                    *(u32x4*)(ACT + ((size_t)(row0 + ai * 128 + m * 16) * 1024 + j0) * 2) = w; } }
    }
};
struct EpiDown {
    static constexpr bool PERM = true, PRE = true;
    unsigned char* Y; const float* bdn; const float* slotw;
    __device__ __forceinline__ void pre(const pg8::Unit& u, int wr, int wc, int fr, int fq, f32x4 (&bq)[4]) const { const float* bp = bdn + (size_t)u.ex * 1024 + u.pn * 256 + wc * 32 + 8 * fq;
#pragma unroll
        for (int bj = 0; bj < 2; ++bj)
#pragma unroll
            for (int n = 0; n < 2; ++n) asm_load16(bq[bj * 2 + n], bp + bj * 128 + 4 * n); }
    __device__ __forceinline__ void operator()(const f32x4 (&acc)[2][2][4][2], const pg8::Unit& u, int wr, int wc, int fr, int fq, const f32x4 (&bq)[4]) const {
        const int row0 = u.pm * 256 + wr * 64 + fr, col0 = u.pn * 256 + wc * 32 + 8 * fq;
        f32x4 bv[2][2];
#pragma unroll
        for (int bj = 0; bj < 2; ++bj)
#pragma unroll
            for (int n = 0; n < 2; ++n) bv[bj][n] = bq[bj * 2 + n];
        float swv[2][4];
#pragma unroll
        for (int ai = 0; ai < 2; ++ai)
#pragma unroll
            for (int m = 0; m < 4; ++m) swv[ai][m] = ((const GAS float*)slotw)[row0 + ai * 128 + m * 16];
        asm volatile("" ::: "memory");
#pragma unroll
        for (int ai = 0; ai < 2; ++ai)
#pragma unroll
            for (int m = 0; m < 4; ++m) { const int row = row0 + ai * 128 + m * 16; const float sw = swv[ai][m];
#pragma unroll
                for (int bj = 0; bj < 2; ++bj) { constexpr float ASC = MK_F8 ? F8_INV : 1.0f; const f32x4 v0 = (acc[ai][bj][m][0] * ASC + bv[bj][0]) * sw, v1 = (acc[ai][bj][m][1] * ASC + bv[bj][1]) * sw;
                    if (MK_F8Y) { u32x2 w; w.x = pk4_fp8(v0[0] * F8_SY, v0[1] * F8_SY, v0[2] * F8_SY, v0[3] * F8_SY); w.y = pk4_fp8(v1[0] * F8_SY, v1[1] * F8_SY, v1[2] * F8_SY, v1[3] * F8_SY);
                        *(GAS u32x2*)((GAS unsigned char*)Y + (size_t)row * 1024 + col0 + bj * 128) = w; }
                    else { u32x4 w; w.x = cvt_pk_bf16(v0[0], v0[1]); w.y = cvt_pk_bf16(v0[2], v0[3]); w.z = cvt_pk_bf16(v1[0], v1[1]); w.w = cvt_pk_bf16(v1[2], v1[3]);
                        *(u32x4*)(Y + ((size_t)row * 1024 + col0 + bj * 128) * 2) = w; } } }
    }
};

__device__ __forceinline__ void p3_post_inproj(Frame& F) {
    LAS unsigned char* scr = F.lds + F.wave * 4096;
    const bf16* RAW = WSP(bf16, WS_R1); const float* ts = WSP(float, WS_TRIG);
    const int gw = F.vcu * NWAVES + F.wave, NGW = F.G * NWAVES, lane = F.lane, g = lane >> 4, i = lane & 15;
    bf16* QS = WSP(bf16, WS_QS); bf16* KS = WSP(bf16, WS_KS); bf16* VS = WSP(bf16, WS_VS);
    for (int row = gw; row < MALL; row += NGW) {
        const bool lat = row < MTOK; const bf16* rp = RAW + (size_t)row * NRAW;
#pragma unroll
        for (int q = 0; q < 3; ++q) *(LAS u32x4*)(scr + (lane + 64 * q) * 16) = *(const u32x4*)(rp + (lane + 64 * q) * 8);
        LDS_WAIT(); asm volatile("" ::: "memory");
        const LAS bf16* s = (const LAS bf16*)scr;
        { const u32x2 w = *(const LAS u32x2*)(s + C_KVLAT + 4 * lane); const float a = bflo(w.x), b = bfhi(w.x), c = bflo(w.y), d = bfhi(w.y);
          const float ss = wave_sum((a * a + b * b) + (c * c + d * d)); if (lane == 0) WSP(float, WS_RSKV)[row] = rsqrtf(ss * (1.0f / 256.0f) + EPS); }
        if (lat) { float ss = 0.f;
#pragma unroll
            for (int q = 0; q < 3; ++q) { const unsigned w = *(const LAS unsigned*)(s + C_QLAT + 6 * lane + 2 * q); const float a = bflo(w), b = bfhi(w); ss += a * a + b * b; }
            ss = wave_sum(ss); if (lane == 0) WSP(float, WS_RSQ)[row] = rsqrtf(ss * (1.0f / 384.0f) + EPS); }
        int bidx, key, pos;
        if (lat) { bidx = row >> 12; pos = row & 4095; key = pos; } else { const int rc = row - MTOK; bidx = rc >> 8; key = SEQ + (rc & 255); pos = 0; }
        const int pr = pos >> 6, pc = pos & 63;
        const float cr = ts[pr * 16 + i], sr = ts[1024 + pr * 16 + i], cc = ts[pc * 16 + i], sc = ts[1024 + pc * 16 + i];
#pragma unroll
        for (int pass = 0; pass < 3; ++pass) {
            const bool isq = pass < 2; const int head = isq ? (pass * 4 + g) : g; const bool act = isq ? lat : (g < 2);
            const LAS bf16* hp = s + (isq ? C_QSWA : C_KSWA) + (act ? head : 0) * 64;
            float x1 = bf2f(hp[i]), x2 = bf2f(hp[16 + i]), x3 = bf2f(hp[32 + i]), x4 = bf2f(hp[48 + i]);
            float ss = (x1 * x1 + x2 * x2) + (x3 * x3 + x4 * x4);
            ss += __shfl_xor(ss, 1); ss += __shfl_xor(ss, 2); ss += __shfl_xor(ss, 4); ss += __shfl_xor(ss, 8);
            const float rstd = rsqrtf(ss * (1.0f / 64.0f) + EPS); const float* gn = isq ? F.swa_q_g : F.swa_k_g;
            x1 *= rstd * gn[i]; x2 *= rstd * gn[16 + i]; x3 *= rstd * gn[32 + i]; x4 *= rstd * gn[48 + i];
            float y1 = x1, y2 = x2, y3 = x3, y4 = x4;
            if (lat) { y1 = x1 * cr - x2 * sr; y2 = x2 * cr + x1 * sr; y3 = x3 * cc - x4 * sc; y4 = x4 * cc + x3 * sc; }
            if (act) {
                if (isq) { bf16* o = QS + (size_t)row * 512 + head * 64; o[i] = (bf16)f2bf(y1 * QSCALE_S); o[16 + i] = (bf16)f2bf(y2 * QSCALE_S); o[32 + i] = (bf16)f2bf(y3 * QSCALE_S); o[48 + i] = (bf16)f2bf(y4 * QSCALE_S); }
                else { bf16* o = KS + ((size_t)bidx * KEYS + key) * 128 + head * 64; o[i] = (bf16)f2bf(y1); o[16 + i] = (bf16)f2bf(y2); o[32 + i] = (bf16)f2bf(y3); o[48 + i] = (bf16)f2bf(y4); }
            }
        }
        if (lane < 16) *(u32x4*)(VS + ((size_t)bidx * KEYS + key) * 128 + lane * 8) = *(const LAS u32x4*)(s + C_VSWA + lane * 8);
        LDS_WAIT(); asm volatile("" ::: "memory");
    }
}

__device__ __forceinline__ void p5_post_up(Frame& F) {
    const bf16* RAW = WSP(bf16, WS_R1); const bf16* KVUP = WSP(bf16, WS_KVUP); const bf16* QUP = WSP(bf16, WS_QUP); const float* tm = WSP(float, WS_TRIG) + 2048;
    bf16* QM = WSP(bf16, WS_QM); bf16* KM = WSP(bf16, WS_KM); bf16* VM = WSP(bf16, WS_VM);
    const int gw = F.vcu * NWAVES + F.wave, NGW = F.G * NWAVES, lane = F.lane, h = lane >> 3, i = lane & 7;
    float gk[8], gq[8], gkr[4], gqr[4];
#pragma unroll
    for (int e = 0; e < 8; ++e) { gk[e] = F.mla_k_g[8 * i + e]; gq[e] = F.mla_q_g[8 * i + e]; }
#pragma unroll
    for (int q = 0; q < 4; ++q) { gkr[q] = F.mla_k_g[64 + 8 * q + i]; gqr[q] = F.mla_q_g[64 + 8 * q + i]; }
    for (int row = gw; row < MALL; row += NGW) {
        const bool lat = row < MTOK; int bidx, key, pos;
        if (lat) { bidx = row >> 12; pos = row & 4095; key = pos; } else { const int rc = row - MTOK; bidx = rc >> 8; key = SEQ + (rc & 255); pos = 0; }
        const int pr = pos >> 6, pc = pos & 63;
        const float cr = tm[pr * 8 + i], sr = tm[512 + pr * 8 + i], cc = tm[pc * 8 + i], sc = tm[512 + pc * 8 + i];
        {
            const bf16* kp = KVUP + (size_t)row * 1024 + h * 128; const u32x4 nw = *(const u32x4*)(kp + 8 * i); const u32x4 vw = *(const u32x4*)(kp + 64 + 8 * i);
            const bf16* rr = RAW + (size_t)row * NRAW + C_KROPE; float x[4];
#pragma unroll
            for (int q = 0; q < 4; ++q) x[q] = bf2f(rr[8 * q + i]);
            float n[8] = {bflo(nw.x), bfhi(nw.x), bflo(nw.y), bfhi(nw.y), bflo(nw.z), bfhi(nw.z), bflo(nw.w), bfhi(nw.w)};
            float ss = (x[0] * x[0] + x[1] * x[1]) + (x[2] * x[2] + x[3] * x[3]);
#pragma unroll
            for (int e = 0; e < 8; ++e) ss += n[e] * n[e];
            ss += __shfl_xor(ss, 1); ss += __shfl_xor(ss, 2); ss += __shfl_xor(ss, 4);
            const float rstd = rsqrtf(ss * (1.0f / 96.0f) + EPS);
            bf16* ko = KM + ((size_t)bidx * KEYS + key) * 768 + h * 96;
            u32x4 w; w.x = pk2(n[0] * rstd * gk[0], n[1] * rstd * gk[1]); w.y = pk2(n[2] * rstd * gk[2], n[3] * rstd * gk[3]); w.z = pk2(n[4] * rstd * gk[4], n[5] * rstd * gk[5]); w.w = pk2(n[6] * rstd * gk[6], n[7] * rstd * gk[7]);
            *(u32x4*)(ko + 8 * i) = w;
            float x1 = x[0] * rstd * gkr[0], x2 = x[1] * rstd * gkr[1], x3 = x[2] * rstd * gkr[2], x4 = x[3] * rstd * gkr[3], y1 = x1, y2 = x2, y3 = x3, y4 = x4;
            if (lat) { y1 = x1 * cr - x2 * sr; y2 = x2 * cr + x1 * sr; y3 = x3 * cc - x4 * sc; y4 = x4 * cc + x3 * sc; }
            ko[64 + i] = (bf16)f2bf(y1); ko[72 + i] = (bf16)f2bf(y2); ko[80 + i] = (bf16)f2bf(y3); ko[88 + i] = (bf16)f2bf(y4);
            *(u32x4*)(VM + ((size_t)bidx * KEYS + key) * 512 + h * 64 + 8 * i) = vw;
        }
        if (lat) {
            const bf16* qp = QUP + (size_t)row * 768 + h * 96; const u32x4 nw = *(const u32x4*)(qp + 8 * i); float x[4];
#pragma unroll
            for (int q = 0; q < 4; ++q) x[q] = bf2f(qp[64 + 8 * q + i]);
            float n[8] = {bflo(nw.x), bfhi(nw.x), bflo(nw.y), bfhi(nw.y), bflo(nw.z), bfhi(nw.z), bflo(nw.w), bfhi(nw.w)};
            float ss = (x[0] * x[0] + x[1] * x[1]) + (x[2] * x[2] + x[3] * x[3]);
#pragma unroll
            for (int e = 0; e < 8; ++e) ss += n[e] * n[e];
            ss += __shfl_xor(ss, 1); ss += __shfl_xor(ss, 2); ss += __shfl_xor(ss, 4);
            const float rstd = rsqrtf(ss * (1.0f / 96.0f) + EPS) * QSCALE_M;
            bf16* qo = QM + (size_t)row * 768 + h * 96;
            u32x4 w; w.x = pk2(n[0] * rstd * gq[0], n[1] * rstd * gq[1]); w.y = pk2(n[2] * rstd * gq[2], n[3] * rstd * gq[3]); w.z = pk2(n[4] * rstd * gq[4], n[5] * rstd * gq[5]); w.w = pk2(n[6] * rstd * gq[6], n[7] * rstd * gq[7]);
            *(u32x4*)(qo + 8 * i) = w;
            const float x1 = x[0] * rstd * gqr[0], x2 = x[1] * rstd * gqr[1], x3 = x[2] * rstd * gqr[2], x4 = x[3] * rstd * gqr[3];
            qo[64 + i] = (bf16)f2bf(x1 * cr - x2 * sr); qo[72 + i] = (bf16)f2bf(x2 * cr + x1 * sr); qo[80 + i] = (bf16)f2bf(x3 * cc - x4 * sc); qo[88 + i] = (bf16)f2bf(x4 * cc + x3 * sc);
        }
    }
}

namespace att {
constexpr int KBUF = 12288, VOFF = KBUF, BUF = KBUF + 8192, WSF = 2 * BUF, OST = WSF + 2048, LDS_NEED = OST + 8 * 4096;
__device__ __forceinline__ int crow(int r, int hi) { return (r & 3) + 8 * (r >> 2) + 4 * hi; }
__device__ __forceinline__ void glds16(const void* gsrc, unsigned lds_dst) { unsigned keep;
    asm volatile("s_mov_b32 %0, m0\n\ts_mov_b32 m0, %2\n\ts_nop 0\n\tglobal_load_lds_dwordx4 %1, off\n\ts_mov_b32 m0, %0" : "=&s"(keep) : "v"(gsrc), "s"(lds_dst) : "memory"); }
#define ATT_WAIT_BAR() asm volatile("s_waitcnt vmcnt(0) lgkmcnt(0)\n\ts_barrier" ::: "memory")
__device__ __forceinline__ s16x4 vtr(const LAS unsigned char* p) { return __builtin_bit_cast(s16x4, __builtin_amdgcn_ds_read_tr16_b64_v4i16((LAS s16x4*)p)); }
template <int DK, bool SWA, bool K8 = false>
__device__ __forceinline__ void unit(LAS unsigned char* lds, const bf16* Qw  , int QP, const bf16* Kb  , int KP,
                                     const bf16* Vb, int VP, bf16* Ow  , int q0  , float m_init, float l_init, const float* qss = nullptr  ) {
    int tid = threadIdx.x; asm volatile("" : "+v"(tid)); const int lane = tid & 63, r32 = lane & 31, hi = lane >> 5; const int wid = __builtin_amdgcn_readfirstlane(tid >> 6);
    constexpr int NKP = K8 ? 8 : DK / 8, NP = NKP + 8, NKS = DK / 16;
    int nband = 0, first = 0;
    if (SWA) { first = q0 - 128 < 0 ? 0 : q0 - 128; const int lastk = q0 + 384 > SEQ ? SEQ : q0 + 384; nband = (lastk - first) >> 6; }
    const int NT = SWA ? 4 + nband : KEYS / 64;
#define ATT_KEY0(ti) (SWA ? ((ti) < 4 ? SEQ + 64 * (ti) : first + 64 * ((ti) - 4)) : 64 * (ti))
#define ATT_ISSUE(ti, bufo) do { const int _k0 = ATT_KEY0(ti); _Pragma("unroll") for (int _q = 0; _q < 3; ++_q) { const int _p = wid + 8 * _q; if (_p < NP) { \
        const bf16* _src = (_p < NKP) ? (K8 ? (const bf16*)((const unsigned char*)Kb + (size_t)(_k0 + lane) * 1024 + _p * 16) : (Kb + (size_t)(_k0 + lane) * KP + _p * 8)) : (Vb + (size_t)(_k0 + 16 * ((_p - NKP) & 3) + (lane >> 2)) * VP + ((_p - NKP) >> 2) * 32 + (lane & 3) * 8); \
        const int _dst = (_p < NKP) ? (_p * 1024) : (VOFF + (_p - NKP) * 1024); \
        __builtin_amdgcn_global_load_lds((const unsigned*)_src, (LAS unsigned*)(lds + (bufo) + _dst), 16, 0, 0); } } } while (0)
    ATT_ISSUE(0, 0);
    bf16x8 qr[NKS];
#pragma unroll
    for (int ks = 0; ks < NKS; ++ks) qr[ks] = *(const bf16x8*)(Qw + (size_t)r32 * QP + ks * 16 + hi * 8);
    if (qss) { const f32x2 sq = *(const f32x2*)(qss + (size_t)r32 * 16); const float qs = rsqrtf((sq.x + sq.y) * (1.0f / 96.0f) + EPS) * (K8 ? 0.0625f : 1.0f);
#pragma unroll
        for (int ks = 0; ks < NKS; ++ks) { const u32x4 w = __builtin_bit_cast(u32x4, qr[ks]); u32x4 o;
            o.x = cvt_pk_bf16(bflo(w.x) * qs, bfhi(w.x) * qs); o.y = cvt_pk_bf16(bflo(w.y) * qs, bfhi(w.y) * qs); o.z = cvt_pk_bf16(bflo(w.z) * qs, bfhi(w.z) * qs); o.w = cvt_pk_bf16(bflo(w.w) * qs, bfhi(w.w) * qs);
            qr[ks] = __builtin_bit_cast(bf16x8, o); } }
    float m_run = m_init, l_run = (hi == 0) ? l_init : 0.f; f32x16 o0, o1;
#pragma unroll
    for (int r = 0; r < 16; ++r) { o0[r] = 0.f; o1[r] = 0.f; }
    LAS float* wsf = (LAS float*)(lds + WSF) + wid * 64;
    const int qpos = q0 + wid * 32 + r32;
    for (int ti = 0; ti < NT; ++ti) {
        const int bufo = (ti & 1) * BUF;
        asm volatile("s_waitcnt vmcnt(0)" ::: "memory"); __syncthreads();
        if (ti + 1 < NT) ATT_ISSUE(ti + 1, ((ti + 1) & 1) * BUF);
        const LAS unsigned char* kb = lds + bufo + hi * 1024 + r32 * 16;
        f32x16 p0, p1;
#pragma unroll
        for (int r = 0; r < 16; ++r) { p0[r] = 0.f; p1[r] = 0.f; }
#pragma unroll
        for (int ks = 0; ks < NKS; ++ks) { bf16x8 a0, a1;
            if constexpr (K8) { const LAS unsigned char* k8p = lds + bufo + (4 * (ks >> 2) + 2 * hi + ((ks & 3) >> 1)) * 1024 + r32 * 16 + 8 * (ks & 1);
#pragma unroll
                for (int hf = 0; hf < 2; ++hf) { const u32x2 w = *(const LAS u32x2*)(k8p + 512 * hf);
                    const f32x2 c0 = __builtin_amdgcn_cvt_pk_f32_fp8((int)w.x, false), c1 = __builtin_amdgcn_cvt_pk_f32_fp8((int)w.x, true), c2 = __builtin_amdgcn_cvt_pk_f32_fp8((int)w.y, false), c3 = __builtin_amdgcn_cvt_pk_f32_fp8((int)w.y, true);
                    const u32x4 o = {cvt_pk_bf16(c0.x, c0.y), cvt_pk_bf16(c1.x, c1.y), cvt_pk_bf16(c2.x, c2.y), cvt_pk_bf16(c3.x, c3.y)}; if (hf == 0) a0 = __builtin_bit_cast(bf16x8, o); else a1 = __builtin_bit_cast(bf16x8, o); }
            } else { a0 = *(const LAS bf16x8*)(kb + ks * 2048); a1 = *(const LAS bf16x8*)(kb + ks * 2048 + 512); }
            p0 = __builtin_amdgcn_mfma_f32_32x32x16_bf16(a0, qr[ks], p0, 0, 0, 0); p1 = __builtin_amdgcn_mfma_f32_32x32x16_bf16(a1, qr[ks], p1, 0, 0, 0); }
        if (SWA && ti >= 4) { const int k0 = ATT_KEY0(ti);
#pragma unroll
            for (int r = 0; r < 16; ++r) { const int kp = k0 + crow(r, hi), d0 = qpos - kp, d1 = d0 - 32;
                if (d0 > 128 || d0 < -128) p0[r] = -1e30f; if (d1 > 128 || d1 < -128) p1[r] = -1e30f; } }
        float tmax = fmaxf(p0[0], p1[0]);
#pragma unroll
        for (int r = 1; r < 16; ++r) tmax = fmaxf(tmax, fmaxf(p0[r], p1[r]));
        tmax = fmaxf(tmax, __shfl_xor(tmax, 32));
        if (__any(tmax > m_run)) {
            const float m_new = fmaxf(m_run, tmax), alpha = __builtin_amdgcn_exp2f(m_run - m_new); l_run *= alpha; m_run = m_new;
            if (hi == 0) wsf[r32] = alpha;
            LDS_WAIT(); asm volatile("" ::: "memory");
#pragma unroll
            for (int g = 0; g < 4; ++g) { const f32x4 a = *(const LAS f32x4*)(wsf + 8 * g + 4 * hi);
#pragma unroll
                for (int e = 0; e < 4; ++e) { o0[4 * g + e] *= a[e]; o1[4 * g + e] *= a[e]; } }
            LDS_WAIT(); asm volatile("" ::: "memory");
        }
        float ls = 0.f;
#pragma unroll
        for (int r = 0; r < 16; ++r) { p0[r] = __builtin_amdgcn_exp2f(p0[r] - m_run); p1[r] = __builtin_amdgcn_exp2f(p1[r] - m_run); ls += p0[r] + p1[r]; }
        l_run += ls;
        u32x4 pw0, pw1, pw2, pw3;
        pw0 = (u32x4){cvt_pk_bf16(p0[0], p0[1]), cvt_pk_bf16(p0[2], p0[3]), cvt_pk_bf16(p0[4], p0[5]), cvt_pk_bf16(p0[6], p0[7])};
        pw1 = (u32x4){cvt_pk_bf16(p0[8], p0[9]), cvt_pk_bf16(p0[10], p0[11]), cvt_pk_bf16(p0[12], p0[13]), cvt_pk_bf16(p0[14], p0[15])};
        pw2 = (u32x4){cvt_pk_bf16(p1[0], p1[1]), cvt_pk_bf16(p1[2], p1[3]), cvt_pk_bf16(p1[4], p1[5]), cvt_pk_bf16(p1[6], p1[7])};
        pw3 = (u32x4){cvt_pk_bf16(p1[8], p1[9]), cvt_pk_bf16(p1[10], p1[11]), cvt_pk_bf16(p1[12], p1[13]), cvt_pk_bf16(p1[14], p1[15])};
        const LAS unsigned char* vp = lds + bufo + VOFF + ((lane >> 4) & 1) * 32 + (lane & 3) * 8 + (4 * hi + ((lane & 15) >> 2)) * 64;
#define ATT_VFR(i) ({ const s16x4 _lo = vtr(vp + ((i) >> 2) * 4096 + ((i) & 3) * 1024), _hi = vtr(vp + ((i) >> 2) * 4096 + ((i) & 3) * 1024 + 512); (bf16x8){_lo[0], _lo[1], _lo[2], _lo[3], _hi[0], _hi[1], _hi[2], _hi[3]}; })
        o0 = __builtin_amdgcn_mfma_f32_32x32x16_bf16(__builtin_bit_cast(bf16x8, pw0), ATT_VFR(0), o0, 0, 0, 0);
        o1 = __builtin_amdgcn_mfma_f32_32x32x16_bf16(__builtin_bit_cast(bf16x8, pw0), ATT_VFR(4), o1, 0, 0, 0);
        o0 = __builtin_amdgcn_mfma_f32_32x32x16_bf16(__builtin_bit_cast(bf16x8, pw1), ATT_VFR(1), o0, 0, 0, 0);
        o1 = __builtin_amdgcn_mfma_f32_32x32x16_bf16(__builtin_bit_cast(bf16x8, pw1), ATT_VFR(5), o1, 0, 0, 0);
        o0 = __builtin_amdgcn_mfma_f32_32x32x16_bf16(__builtin_bit_cast(bf16x8, pw2), ATT_VFR(2), o0, 0, 0, 0);
        o1 = __builtin_amdgcn_mfma_f32_32x32x16_bf16(__builtin_bit_cast(bf16x8, pw2), ATT_VFR(6), o1, 0, 0, 0);
        o0 = __builtin_amdgcn_mfma_f32_32x32x16_bf16(__builtin_bit_cast(bf16x8, pw3), ATT_VFR(3), o0, 0, 0, 0);
        o1 = __builtin_amdgcn_mfma_f32_32x32x16_bf16(__builtin_bit_cast(bf16x8, pw3), ATT_VFR(7), o1, 0, 0, 0);
#undef ATT_VFR
    }
    l_run += __shfl_xor(l_run, 32);
    if (hi == 0) wsf[32 + r32] = l_run;
    LDS_WAIT(); asm volatile("" ::: "memory");
    LAS bf16* stg = (LAS bf16*)(lds + OST) + wid * 2048;
#pragma unroll
    for (int g = 0; g < 4; ++g) { const f32x4 lv = *(const LAS f32x4*)(wsf + 32 + 8 * g + 4 * hi);
#pragma unroll
        for (int e = 0; e < 4; ++e) { const int r = 4 * g + e, orow = crow(r, hi); const float rl = __builtin_amdgcn_rcpf(lv[e]);
            if (MK_F8MID) { LAS unsigned char* s8 = (LAS unsigned char*)stg; s8[orow * 64 + r32] = (unsigned char)pk4_fp8(o0[r] * rl * F8_SO, 0.f, 0.f, 0.f); s8[orow * 64 + 32 + r32] = (unsigned char)pk4_fp8(o1[r] * rl * F8_SO, 0.f, 0.f, 0.f); }
            else { stg[orow * 64 + r32] = (bf16)f2bf(o0[r] * rl); stg[orow * 64 + 32 + r32] = (bf16)f2bf(o1[r] * rl); } } }
    LDS_WAIT(); asm volatile("" ::: "memory");
    if (MK_F8MID) {
#pragma unroll
        for (int q = 0; q < 2; ++q) { const int row = q * 16 + (lane >> 2), ch = lane & 3; const u32x4 v = *(const LAS u32x4*)((LAS unsigned char*)stg + row * 64 + ch * 16); *(u32x4*)((unsigned char*)Ow + (size_t)row * ((MK_MERGE78 && MK_F8MID) ? 1024 : 512) + ch * 16) = v; }
    } else {
#pragma unroll
        for (int q = 0; q < 4; ++q) { const int row = q * 8 + (lane >> 3), ch = lane & 7; const u32x4 v = *(const LAS u32x4*)(stg + row * 64 + ch * 8); *(u32x4*)(Ow + (size_t)row * 512 + ch * 8) = v; } }
    LDS_WAIT(); __syncthreads();
#undef ATT_KEY0
#undef ATT_ISSUE
}

constexpr int WSF2 = 3 * BUF, OST2 = WSF2 + 2048, LDS_NEED2 = OST2 + 8 * 4096;
template <int DK, bool SWA, bool K8 = false>
__device__ __forceinline__ void unit2(LAS unsigned char* lds, const bf16* Qw, int QP, const bf16* Kb, int KP, const bf16* Vb, int VP, bf16* Ow, int q0, float negM, float l_init, const float* qss = nullptr) {
    int tid = threadIdx.x; asm volatile("" : "+v"(tid)); const int lane = tid & 63, r32 = lane & 31, hi = lane >> 5; const int wid = __builtin_amdgcn_readfirstlane(tid >> 6);
    constexpr int NKP = K8 ? 8 : DK / 8, NP = NKP + 8, NKS = DK / 16;
    int nband = 0, first = 0;
    if (SWA) { first = q0 - 128 < 0 ? 0 : q0 - 128; const int lastk = q0 + 384 > SEQ ? SEQ : q0 + 384; nband = (lastk - first) >> 6; }
    const int NT = SWA ? 4 + nband : KEYS / 64;
#define ATT_KEY0(ti) (SWA ? ((ti) < 4 ? SEQ + 64 * (ti) : first + 64 * ((ti) - 4)) : 64 * (ti))
#define ATT_ISSUE(ti, bufo) do { const int _k0 = ATT_KEY0(ti); _Pragma("unroll") for (int _q = 0; _q < 3; ++_q) { const int _p = wid + 8 * _q; if (_p < NP) { \
        const bf16* _src = (_p < NKP) ? (K8 ? (const bf16*)((const unsigned char*)Kb + (size_t)(_k0 + lane) * 1024 + _p * 16) : (Kb + (size_t)(_k0 + lane) * KP + _p * 8)) : (Vb + (size_t)(_k0 + 16 * ((_p - NKP) & 3) + (lane >> 2)) * VP + ((_p - NKP) >> 2) * 32 + (lane & 3) * 8); \
        const int _dst = (_p < NKP) ? (_p * 1024) : (VOFF + (_p - NKP) * 1024); \
        glds16(_src, (unsigned)__builtin_amdgcn_readfirstlane((int)(lds0 + (bufo) + _dst))); } } } while (0)
    const unsigned lds0 = (unsigned)(unsigned long long)lds;
    ATT_ISSUE(0, 0); ATT_ISSUE(1, BUF);
    bf16x8 qr[NKS];
#pragma unroll
    for (int ks = 0; ks < NKS; ++ks) qr[ks] = *(const bf16x8*)(Qw + (size_t)r32 * QP + ks * 16 + hi * 8);
    pg8::i32x8 qf[2] = {{0, 0, 0, 0, 0, 0, 0, 0}, {0, 0, 0, 0, 0, 0, 0, 0}};
    if (qss) { const f32x2 sq = *(const f32x2*)(qss + (size_t)r32 * 16); const float qs = rsqrtf((sq.x + sq.y) * (1.0f / 96.0f) + EPS);
        if (K8) { const float q8 = qs * 64.0f;
#pragma unroll
            for (int ks = 0; ks < NKS; ++ks) { const u32x4 w = __builtin_bit_cast(u32x4, qr[ks]);
                qf[ks >> 2][2 * (ks & 3)] = (int)pk4_fp8(bflo(w.x) * q8, bfhi(w.x) * q8, bflo(w.y) * q8, bfhi(w.y) * q8); qf[ks >> 2][2 * (ks & 3) + 1] = (int)pk4_fp8(bflo(w.z) * q8, bfhi(w.z) * q8, bflo(w.w) * q8, bfhi(w.w) * q8); }
        } else {
#pragma unroll
        for (int ks = 0; ks < NKS; ++ks) { const u32x4 w = __builtin_bit_cast(u32x4, qr[ks]); u32x4 o;
            o.x = cvt_pk_bf16(bflo(w.x) * qs, bfhi(w.x) * qs); o.y = cvt_pk_bf16(bflo(w.y) * qs, bfhi(w.y) * qs); o.z = cvt_pk_bf16(bflo(w.z) * qs, bfhi(w.z) * qs); o.w = cvt_pk_bf16(bflo(w.w) * qs, bfhi(w.w) * qs);
            qr[ks] = __builtin_bit_cast(bf16x8, o); } } }
    const f32x16 zero16 = {0.f, 0.f, 0.f, 0.f, 0.f, 0.f, 0.f, 0.f, 0.f, 0.f, 0.f, 0.f, 0.f, 0.f, 0.f, 0.f};
    float l_run = (hi == 0) ? l_init : 0.f; f32x16 o0, o1;
#pragma unroll
    for (int r = 0; r < 16; ++r) { o0[r] = 0.f; o1[r] = 0.f; }
    LAS float* wsf = (LAS float*)(lds + WSF2) + wid * 64;
    const int qpos = q0 + wid * 32 + r32;
    const LAS unsigned char* kb0 = lds + hi * 1024 + r32 * 16;
    const LAS unsigned char* vp0 = lds + VOFF + ((lane >> 4) & 1) * 32 + (lane & 3) * 8 + (4 * hi + ((lane & 15) >> 2)) * 64;
#define ATT_QK8_HALF(S, kb8, half) do { \
        { const u32x4 _l = *(const LAS u32x4*)((kb8) + (2 * hi) * 1024 + (half) * 512), _h = *(const LAS u32x4*)((kb8) + (2 * hi + 1) * 1024 + (half) * 512); \
          const pg8::i32x8 _a = {(int)_l.x, (int)_l.y, (int)_l.z, (int)_l.w, (int)_h.x, (int)_h.y, (int)_h.z, (int)_h.w}; \
          S = __builtin_amdgcn_mfma_scale_f32_32x32x64_f8f6f4(_a, qf[0], zero16, 0, 0, 0, 0x7b7b7b7b, 0, 0x79797979); } \
        { const u32x4 _l = *(const LAS u32x4*)((kb8) + (4 + 2 * hi) * 1024 + (half) * 512), _h = *(const LAS u32x4*)((kb8) + (5 + 2 * hi) * 1024 + (half) * 512); \
          const pg8::i32x8 _a = {(int)_l.x, (int)_l.y, (int)_l.z, (int)_l.w, (int)_h.x, (int)_h.y, (int)_h.z, (int)_h.w}; \
          S = __builtin_amdgcn_mfma_scale_f32_32x32x64_f8f6f4(_a, qf[1], S, 0, 0, 0, 0x7b7b7b7b, 0, 0x79797979); } } while (0)
#define ATT_QK(S0, S1, bufo) do { if constexpr (K8) { const LAS unsigned char* _k8 = lds + (bufo) + r32 * 16; ATT_QK8_HALF(S0, _k8, 0); ATT_QK8_HALF(S1, _k8, 1); } else { const LAS unsigned char* _kb = kb0 + (bufo); \
        { const bf16x8 _a0 = *(const LAS bf16x8*)(_kb), _a1 = *(const LAS bf16x8*)(_kb + 512); \
          S0 = __builtin_amdgcn_mfma_f32_32x32x16_bf16(_a0, qr[0], zero16, 0, 0, 0); S1 = __builtin_amdgcn_mfma_f32_32x32x16_bf16(_a1, qr[0], zero16, 0, 0, 0); } \
        _Pragma("unroll") for (int _ks = 1; _ks < NKS; ++_ks) { const bf16x8 _a0 = *(const LAS bf16x8*)(_kb + _ks * 2048), _a1 = *(const LAS bf16x8*)(_kb + _ks * 2048 + 512); \
          S0 = __builtin_amdgcn_mfma_f32_32x32x16_bf16(_a0, qr[_ks], S0, 0, 0, 0); S1 = __builtin_amdgcn_mfma_f32_32x32x16_bf16(_a1, qr[_ks], S1, 0, 0, 0); } } } while (0)
#define ATT_VFR(vp, i) ({ const s16x4 _lo = vtr((vp) + ((i) >> 2) * 4096 + ((i) & 3) * 1024), _hi = vtr((vp) + ((i) >> 2) * 4096 + ((i) & 3) * 1024 + 512); (bf16x8){_lo[0], _lo[1], _lo[2], _lo[3], _hi[0], _hi[1], _hi[2], _hi[3]}; })
#define ATT_STEP(C0, C1, N0, N1, tt) do { \
        ATT_WAIT_BAR(); \
        if ((tt) + 2 < NT) ATT_ISSUE((tt) + 2, bo_nn); \
        if ((tt) + 1 < NT) ATT_QK(N0, N1, bo_nxt); \
        if (SWA && (tt) >= 4) { const int _k0 = ATT_KEY0(tt); \
            _Pragma("unroll") for (int r = 0; r < 16; ++r) { const int _d0 = qpos - (_k0 + crow(r, hi)), _d1 = _d0 - 32; \
                if (_d0 > 128 || _d0 < -128) C0[r] = -1e30f; if (_d1 > 128 || _d1 < -128) C1[r] = -1e30f; } } \
        float _ls = 0.f; \
        _Pragma("unroll") for (int r = 0; r < 16; ++r) { C0[r] = __builtin_amdgcn_exp2f(C0[r]); C1[r] = __builtin_amdgcn_exp2f(C1[r]); _ls += C0[r] + C1[r]; } \
        l_run += _ls; \
        const u32x4 _pw0 = {cvt_pk_bf16(C0[0], C0[1]), cvt_pk_bf16(C0[2], C0[3]), cvt_pk_bf16(C0[4], C0[5]), cvt_pk_bf16(C0[6], C0[7])}; \
        const u32x4 _pw1 = {cvt_pk_bf16(C0[8], C0[9]), cvt_pk_bf16(C0[10], C0[11]), cvt_pk_bf16(C0[12], C0[13]), cvt_pk_bf16(C0[14], C0[15])}; \
        const u32x4 _pw2 = {cvt_pk_bf16(C1[0], C1[1]), cvt_pk_bf16(C1[2], C1[3]), cvt_pk_bf16(C1[4], C1[5]), cvt_pk_bf16(C1[6], C1[7])}; \
        const u32x4 _pw3 = {cvt_pk_bf16(C1[8], C1[9]), cvt_pk_bf16(C1[10], C1[11]), cvt_pk_bf16(C1[12], C1[13]), cvt_pk_bf16(C1[14], C1[15])}; \
        const LAS unsigned char* _vp = vp0 + bo_cur; \
        o0 = __builtin_amdgcn_mfma_f32_32x32x16_bf16(__builtin_bit_cast(bf16x8, _pw0), ATT_VFR(_vp, 0), o0, 0, 0, 0); \
        o1 = __builtin_amdgcn_mfma_f32_32x32x16_bf16(__builtin_bit_cast(bf16x8, _pw0), ATT_VFR(_vp, 4), o1, 0, 0, 0); \
        o0 = __builtin_amdgcn_mfma_f32_32x32x16_bf16(__builtin_bit_cast(bf16x8, _pw1), ATT_VFR(_vp, 1), o0, 0, 0, 0); \
        o1 = __builtin_amdgcn_mfma_f32_32x32x16_bf16(__builtin_bit_cast(bf16x8, _pw1), ATT_VFR(_vp, 5), o1, 0, 0, 0); \
        o0 = __builtin_amdgcn_mfma_f32_32x32x16_bf16(__builtin_bit_cast(bf16x8, _pw2), ATT_VFR(_vp, 2), o0, 0, 0, 0); \
        o1 = __builtin_amdgcn_mfma_f32_32x32x16_bf16(__builtin_bit_cast(bf16x8, _pw2), ATT_VFR(_vp, 6), o1, 0, 0, 0); \
        o0 = __builtin_amdgcn_mfma_f32_32x32x16_bf16(__builtin_bit_cast(bf16x8, _pw3), ATT_VFR(_vp, 3), o0, 0, 0, 0); \
        o1 = __builtin_amdgcn_mfma_f32_32x32x16_bf16(__builtin_bit_cast(bf16x8, _pw3), ATT_VFR(_vp, 7), o1, 0, 0, 0); \
        { const int _t = bo_cur; bo_cur = bo_nxt; bo_nxt = bo_nn; bo_nn = _t; } } while (0)
    ATT_WAIT_BAR();
    f32x16 sa0, sa1, sb0, sb1;
    ATT_QK(sa0, sa1, 0);
    int bo_cur = 0, bo_nxt = BUF, bo_nn = 2 * BUF;
    for (int t = 0; t < NT; t += 2) {
        ATT_STEP(sa0, sa1, sb0, sb1, t);
        ATT_STEP(sb0, sb1, sa0, sa1, t + 1);
    }
    l_run += __shfl_xor(l_run, 32);
    if (hi == 0) wsf[32 + r32] = l_run;
    LDS_WAIT(); asm volatile("" ::: "memory");
    LAS bf16* stg = (LAS bf16*)(lds + OST2) + wid * 2048;
#pragma unroll
    for (int g = 0; g < 4; ++g) { const f32x4 lv = *(const LAS f32x4*)(wsf + 32 + 8 * g + 4 * hi);
#pragma unroll
        for (int e = 0; e < 4; ++e) { const int r = 4 * g + e, orow = crow(r, hi); const float rl = __builtin_amdgcn_rcpf(lv[e]);
            if (MK_F8MID) { LAS unsigned char* s8 = (LAS unsigned char*)stg; s8[orow * 64 + r32] = (unsigned char)pk4_fp8(o0[r] * rl * F8_SO, 0.f, 0.f, 0.f); s8[orow * 64 + 32 + r32] = (unsigned char)pk4_fp8(o1[r] * rl * F8_SO, 0.f, 0.f, 0.f); }
            else { stg[orow * 64 + r32] = (bf16)f2bf(o0[r] * rl); stg[orow * 64 + 32 + r32] = (bf16)f2bf(o1[r] * rl); } } }
    LDS_WAIT(); asm volatile("" ::: "memory");
    if (MK_F8MID) {
#pragma unroll
        for (int q = 0; q < 2; ++q) { const int row = q * 16 + (lane >> 2), ch = lane & 3; const u32x4 v = *(const LAS u32x4*)((LAS unsigned char*)stg + row * 64 + ch * 16); *(u32x4*)((unsigned char*)Ow + (size_t)row * ((MK_MERGE78 && MK_F8MID) ? 1024 : 512) + ch * 16) = v; }
    } else {
#pragma unroll
        for (int q = 0; q < 4; ++q) { const int row = q * 8 + (lane >> 3), ch = lane & 7; const u32x4 v = *(const LAS u32x4*)(stg + row * 64 + ch * 8); *(u32x4*)(Ow + (size_t)row * 512 + ch * 8) = v; } }
    ATT_WAIT_BAR();
#undef ATT_KEY0
#undef ATT_ISSUE
#undef ATT_QK
#undef ATT_QK8_HALF
#undef ATT_VFR
#undef ATT_STEP
}
constexpr int SUB3 = 16384, SUP3 = 2 * SUB3, WSF3 = 3 * SUP3, OST3 = WSF3 + 2048, LDS_NEED3 = OST3 + 8 * 4096;
static_assert(LDS_NEED3 <= LDSCTL_OFF, "attention LDS"); static_assert(GQX_OFF + 384 <= LDS_BYTES && TSX_OFF + 2176 * 4 <= LDS_BYTES, "LDS map");
template <int DK, bool SWA, bool K8 = false>
__device__ __forceinline__ void unit3(LAS unsigned char* lds, const bf16* Qw, int QP, const bf16* Kb, int KP, const bf16* Vb, int VP, bf16* Ow, int q0, float negM, float l_init, const float* qss = nullptr, int qoff = -1, int qspan = 256) {
    int tid = threadIdx.x; asm volatile("" : "+v"(tid)); const int lane = tid & 63, r32 = lane & 31, hi = lane >> 5; const int wid = __builtin_amdgcn_readfirstlane(tid >> 6);
    constexpr int NKP = K8 ? 8 : DK / 8, NP = NKP + 8, NKS = DK / 16;
    int nband = 0, first = 0;
    if (SWA) { first = q0 - 128 < 0 ? 0 : q0 - 128; const int lastk = q0 + qspan + 128 > SEQ ? SEQ : q0 + qspan + 128; nband = (lastk - first) >> 6; }
    const int NT = SWA ? 4 + nband : KEYS / 64, NT2 = NT >> 1;
#define ATT_KEY0(ti) (SWA ? ((ti) < 4 ? SEQ + 64 * (ti) : first + 64 * ((ti) - 4)) : 64 * (ti))
#define ATT_ISSUE(Ts, bufo) do { _Pragma("unroll") for (int _q = 0; _q < 4; ++_q) { const int _sub = _q >> 1, _p = wid + 8 * (_q & 1); const int _k0 = ATT_KEY0(2 * (Ts) + _sub); \
        const bf16* _src = (_p < 8) ? (K8 ? (const bf16*)((const unsigned char*)Kb + (size_t)(_k0 + lane) * 1024 + _p * 16) : (Kb + (size_t)(_k0 + lane) * KP + _p * 8)) : (Vb + (size_t)(_k0 + 16 * ((_p - 8) & 3) + (lane >> 2)) * VP + ((_p - 8) >> 2) * 32 + (lane & 3) * 8); \
        const int _dst = _sub * SUB3 + ((_p < 8) ? (_p * 1024) : (8192 + (_p - 8) * 1024)); \
        glds16(_src, (unsigned)__builtin_amdgcn_readfirstlane((int)(lds0 + (bufo) + _dst))); } } while (0)
    const unsigned lds0 = (unsigned)(unsigned long long)lds;
    static_assert(K8 || DK == 64, "unit3 needs an 8 KiB K tile");
    ATT_ISSUE(0, 0); ATT_ISSUE(1, SUP3);
    bf16x8 qr[NKS];
#pragma unroll
    for (int ks = 0; ks < NKS; ++ks) qr[ks] = *(const bf16x8*)(Qw + (size_t)r32 * QP + ks * 16 + hi * 8);
    pg8::i32x8 qf[2] = {{0, 0, 0, 0, 0, 0, 0, 0}, {0, 0, 0, 0, 0, 0, 0, 0}};
    if (qss) { const f32x2 sq = *(const f32x2*)(qss + (size_t)r32 * 16); const float qs = rsqrtf((sq.x + sq.y) * (1.0f / 96.0f) + EPS);
        if (K8) { const float q8 = qs * 64.0f;
#pragma unroll
            for (int ks = 0; ks < NKS; ++ks) { const u32x4 w = __builtin_bit_cast(u32x4, qr[ks]);
                qf[ks >> 2][2 * (ks & 3)] = (int)pk4_fp8(bflo(w.x) * q8, bfhi(w.x) * q8, bflo(w.y) * q8, bfhi(w.y) * q8); qf[ks >> 2][2 * (ks & 3) + 1] = (int)pk4_fp8(bflo(w.z) * q8, bfhi(w.z) * q8, bflo(w.w) * q8, bfhi(w.w) * q8); }
        } else {
#pragma unroll
        for (int ks = 0; ks < NKS; ++ks) { const u32x4 w = __builtin_bit_cast(u32x4, qr[ks]); u32x4 o;
            o.x = cvt_pk_bf16(bflo(w.x) * qs, bfhi(w.x) * qs); o.y = cvt_pk_bf16(bflo(w.y) * qs, bfhi(w.y) * qs); o.z = cvt_pk_bf16(bflo(w.z) * qs, bfhi(w.z) * qs); o.w = cvt_pk_bf16(bflo(w.w) * qs, bfhi(w.w) * qs);
            qr[ks] = __builtin_bit_cast(bf16x8, o); } } }
    const f32x16 zero16 = {0.f, 0.f, 0.f, 0.f, 0.f, 0.f, 0.f, 0.f, 0.f, 0.f, 0.f, 0.f, 0.f, 0.f, 0.f, 0.f};
    float l_run = (hi == 0) ? l_init : 0.f; f32x16 o0, o1;
#pragma unroll
    for (int r = 0; r < 16; ++r) { o0[r] = 0.f; o1[r] = 0.f; }
    LAS float* wsf = (LAS float*)(lds + WSF3) + wid * 64;
    const int qpos = q0 + (qoff < 0 ? wid * 32 : qoff) + r32;
    const LAS unsigned char* kb0 = lds + hi * 1024 + r32 * 16;
    const LAS unsigned char* vp0 = lds + 8192 + ((lane >> 4) & 1) * 32 + (lane & 3) * 8 + (4 * hi + ((lane & 15) >> 2)) * 64;
#define ATT_QK8_HALF(S, kb8, half) do { \
        { const u32x4 _l = *(const LAS u32x4*)((kb8) + (2 * hi) * 1024 + (half) * 512), _h = *(const LAS u32x4*)((kb8) + (2 * hi + 1) * 1024 + (half) * 512); \
          const pg8::i32x8 _a = {(int)_l.x, (int)_l.y, (int)_l.z, (int)_l.w, (int)_h.x, (int)_h.y, (int)_h.z, (int)_h.w}; \
          S = __builtin_amdgcn_mfma_scale_f32_32x32x64_f8f6f4(_a, qf[0], zero16, 0, 0, 0, 0x7b7b7b7b, 0, 0x79797979); } \
        { const u32x4 _l = *(const LAS u32x4*)((kb8) + (4 + 2 * hi) * 1024 + (half) * 512), _h = *(const LAS u32x4*)((kb8) + (5 + 2 * hi) * 1024 + (half) * 512); \
          const pg8::i32x8 _a = {(int)_l.x, (int)_l.y, (int)_l.z, (int)_l.w, (int)_h.x, (int)_h.y, (int)_h.z, (int)_h.w}; \
          S = __builtin_amdgcn_mfma_scale_f32_32x32x64_f8f6f4(_a, qf[1], S, 0, 0, 0, 0x7b7b7b7b, 0, 0x79797979); } } while (0)
#define ATT_QK(S0, S1, bufo) do { if constexpr (K8) { const LAS unsigned char* _k8 = lds + (bufo) + r32 * 16; ATT_QK8_HALF(S0, _k8, 0); ATT_QK8_HALF(S1, _k8, 1); } else { const LAS unsigned char* _kb = kb0 + (bufo); \
        { const bf16x8 _a0 = *(const LAS bf16x8*)(_kb), _a1 = *(const LAS bf16x8*)(_kb + 512); \
          S0 = __builtin_amdgcn_mfma_f32_32x32x16_bf16(_a0, qr[0], zero16, 0, 0, 0); S1 = __builtin_amdgcn_mfma_f32_32x32x16_bf16(_a1, qr[0], zero16, 0, 0, 0); } \
        _Pragma("unroll") for (int _ks = 1; _ks < NKS; ++_ks) { const bf16x8 _a0 = *(const LAS bf16x8*)(_kb + _ks * 2048), _a1 = *(const LAS bf16x8*)(_kb + _ks * 2048 + 512); \
          S0 = __builtin_amdgcn_mfma_f32_32x32x16_bf16(_a0, qr[_ks], S0, 0, 0, 0); S1 = __builtin_amdgcn_mfma_f32_32x32x16_bf16(_a1, qr[_ks], S1, 0, 0, 0); } } } while (0)
#define ATT_VFR(vp, i) ({ const s16x4 _lo = vtr((vp) + ((i) >> 2) * 4096 + ((i) & 3) * 1024), _hi = vtr((vp) + ((i) >> 2) * 4096 + ((i) & 3) * 1024 + 512); (bf16x8){_lo[0], _lo[1], _lo[2], _lo[3], _hi[0], _hi[1], _hi[2], _hi[3]}; })
#define ATT_SOFTPV(C0, C1, tt, vbase) do { \
        if (SWA && (tt) >= 4) { const int _k0 = ATT_KEY0(tt); \
            _Pragma("unroll") for (int r = 0; r < 16; ++r) { const int _d0 = qpos - (_k0 + crow(r, hi)), _d1 = _d0 - 32; \
                if (_d0 > 128 || _d0 < -128) C0[r] = -1e30f; if (_d1 > 128 || _d1 < -128) C1[r] = -1e30f; } } \
        float _ls = 0.f; \
        _Pragma("unroll") for (int r = 0; r < 16; ++r) { C0[r] = __builtin_amdgcn_exp2f(C0[r]); C1[r] = __builtin_amdgcn_exp2f(C1[r]); _ls += C0[r] + C1[r]; } \
        l_run += _ls; \
        const u32x4 _pw0 = {cvt_pk_bf16(C0[0], C0[1]), cvt_pk_bf16(C0[2], C0[3]), cvt_pk_bf16(C0[4], C0[5]), cvt_pk_bf16(C0[6], C0[7])}; \
        const u32x4 _pw1 = {cvt_pk_bf16(C0[8], C0[9]), cvt_pk_bf16(C0[10], C0[11]), cvt_pk_bf16(C0[12], C0[13]), cvt_pk_bf16(C0[14], C0[15])}; \
        const u32x4 _pw2 = {cvt_pk_bf16(C1[0], C1[1]), cvt_pk_bf16(C1[2], C1[3]), cvt_pk_bf16(C1[4], C1[5]), cvt_pk_bf16(C1[6], C1[7])}; \
        const u32x4 _pw3 = {cvt_pk_bf16(C1[8], C1[9]), cvt_pk_bf16(C1[10], C1[11]), cvt_pk_bf16(C1[12], C1[13]), cvt_pk_bf16(C1[14], C1[15])}; \
        const LAS unsigned char* _vp = vp0 + (vbase); \
        o0 = __builtin_amdgcn_mfma_f32_32x32x16_bf16(__builtin_bit_cast(bf16x8, _pw0), ATT_VFR(_vp, 0), o0, 0, 0, 0); \
        o1 = __builtin_amdgcn_mfma_f32_32x32x16_bf16(__builtin_bit_cast(bf16x8, _pw0), ATT_VFR(_vp, 4), o1, 0, 0, 0); \
        o0 = __builtin_amdgcn_mfma_f32_32x32x16_bf16(__builtin_bit_cast(bf16x8, _pw1), ATT_VFR(_vp, 1), o0, 0, 0, 0); \
        o1 = __builtin_amdgcn_mfma_f32_32x32x16_bf16(__builtin_bit_cast(bf16x8, _pw1), ATT_VFR(_vp, 5), o1, 0, 0, 0); \
        o0 = __builtin_amdgcn_mfma_f32_32x32x16_bf16(__builtin_bit_cast(bf16x8, _pw2), ATT_VFR(_vp, 2), o0, 0, 0, 0); \
        o1 = __builtin_amdgcn_mfma_f32_32x32x16_bf16(__builtin_bit_cast(bf16x8, _pw2), ATT_VFR(_vp, 6), o1, 0, 0, 0); \
        o0 = __builtin_amdgcn_mfma_f32_32x32x16_bf16(__builtin_bit_cast(bf16x8, _pw3), ATT_VFR(_vp, 3), o0, 0, 0, 0); \
        o1 = __builtin_amdgcn_mfma_f32_32x32x16_bf16(__builtin_bit_cast(bf16x8, _pw3), ATT_VFR(_vp, 7), o1, 0, 0, 0); \
        } while (0)
    ATT_WAIT_BAR();
    f32x16 sa0, sa1, sb0, sb1;
    ATT_QK(sa0, sa1, 0);
    int bo_cur = 0, bo_nxt = SUP3, bo_nn = 2 * SUP3;
    for (int T = 0; T < NT2; ++T) {
        ATT_WAIT_BAR();
        if (T + 2 < NT2) ATT_ISSUE(T + 2, bo_nn);
        ATT_QK(sb0, sb1, bo_cur + SUB3); ATT_SOFTPV(sa0, sa1, 2 * T, bo_cur);
        if (T + 1 < NT2) ATT_QK(sa0, sa1, bo_nxt);
        ATT_SOFTPV(sb0, sb1, 2 * T + 1, bo_cur + SUB3);
        { const int _t = bo_cur; bo_cur = bo_nxt; bo_nxt = bo_nn; bo_nn = _t; }
    }
    l_run += __shfl_xor(l_run, 32);
    if (hi == 0) wsf[32 + r32] = l_run;
    LDS_WAIT(); asm volatile("" ::: "memory");
    LAS bf16* stg = (LAS bf16*)(lds + OST3) + wid * 2048;
#pragma unroll
    for (int g = 0; g < 4; ++g) { const f32x4 lv = *(const LAS f32x4*)(wsf + 32 + 8 * g + 4 * hi);
#pragma unroll
        for (int e = 0; e < 4; ++e) { const int r = 4 * g + e, orow = crow(r, hi); const float rl = __builtin_amdgcn_rcpf(lv[e]);
            if (MK_F8MID) { LAS unsigned char* s8 = (LAS unsigned char*)stg; s8[orow * 64 + r32] = (unsigned char)pk4_fp8(o0[r] * rl * F8_SO, 0.f, 0.f, 0.f); s8[orow * 64 + 32 + r32] = (unsigned char)pk4_fp8(o1[r] * rl * F8_SO, 0.f, 0.f, 0.f); }
            else { stg[orow * 64 + r32] = (bf16)f2bf(o0[r] * rl); stg[orow * 64 + 32 + r32] = (bf16)f2bf(o1[r] * rl); } } }
    LDS_WAIT(); asm volatile("" ::: "memory");
    if (MK_F8MID) {
#pragma unroll
        for (int q = 0; q < 2; ++q) { const int row = q * 16 + (lane >> 2), ch = lane & 3; const u32x4 v = *(const LAS u32x4*)((LAS unsigned char*)stg + row * 64 + ch * 16); *(GAS u32x4*)((GAS unsigned char*)Ow + (size_t)row * ((MK_MERGE78 && MK_F8MID) ? 1024 : 512) + ch * 16) = v; }
    } else {
#pragma unroll
        for (int q = 0; q < 4; ++q) { const int row = q * 8 + (lane >> 3), ch = lane & 7; const u32x4 v = *(const LAS u32x4*)(stg + row * 64 + ch * 8); *(GAS u32x4*)((GAS bf16*)Ow + (size_t)row * 512 + ch * 8) = v; } }
    asm volatile("s_waitcnt lgkmcnt(0)\n\ts_barrier" ::: "memory");
#undef ATT_KEY0
#undef ATT_ISSUE
#undef ATT_QK
#undef ATT_QK8_HALF
#undef ATT_VFR
#undef ATT_SOFTPV
}
}

__device__ __forceinline__ void p6_attention(Frame& F) {
    const bf16* QM = WSP(bf16, WS_QM); const bf16* KM = WSP(bf16, WS_KM); const bf16* VM = WSP(bf16, WS_VM);
    const bf16* QS = WSP(bf16, WS_QS); const bf16* KS = WSP(bf16, WS_KS); const bf16* VS = WSP(bf16, WS_VS);
    constexpr int OES = MK_F8MID ? 1 : 2; unsigned char* OAb = WSP(unsigned char, WS_OA); unsigned char* OBb = WSP(unsigned char, WS_OB);
#define OA_PTR(row0, h) ((bf16*)((MK_MERGE78 && MK_F8MID) ? OAb + (size_t)(row0) * 1024 + (h) * 64 : OAb + ((size_t)(row0) * 512 + (h) * 64) * OES))
#define OB_PTR(row0, h) ((bf16*)((MK_MERGE78 && MK_F8MID) ? OAb + (size_t)(row0) * 1024 + 512 + (h) * 64 : OBb + ((size_t)(row0) * 512 + (h) * 64) * OES))
    float gqm = 0.f, gkm = 0.f, gqs = 0.f, gks = 0.f;
    { const int l = F.lane;
      const float q0v = ((const GAS float*)F.mla_q_g)[l], q1v = ((const GAS float*)F.mla_q_g)[64 + (l & 31)], k0v = ((const GAS float*)F.mla_k_g)[l], k1v = ((const GAS float*)F.mla_k_g)[64 + (l & 31)];
      const float sqv = ((const GAS float*)F.swa_q_g)[l], skv = ((const GAS float*)F.swa_k_g)[l];
      gqm = fmaxf(fabsf(q0v), fabsf(q1v)); gkm = fmaxf(fabsf(k0v), fabsf(k1v)); gqs = fabsf(sqv); gks = fabsf(skv);
#pragma unroll
      for (int o = 1; o < 64; o <<= 1) { gqm = fmaxf(gqm, __shfl_xor(gqm, o)); gkm = fmaxf(gkm, __shfl_xor(gkm, o)); gqs = fmaxf(gqs, __shfl_xor(gqs, o)); gks = fmaxf(gks, __shfl_xor(gks, o)); }
      gqm = __builtin_bit_cast(float, __builtin_amdgcn_readfirstlane(__builtin_bit_cast(int, gqm))); gkm = __builtin_bit_cast(float, __builtin_amdgcn_readfirstlane(__builtin_bit_cast(int, gkm)));
      gqs = __builtin_bit_cast(float, __builtin_amdgcn_readfirstlane(__builtin_bit_cast(int, gqs))); gks = __builtin_bit_cast(float, __builtin_amdgcn_readfirstlane(__builtin_bit_cast(int, gks))); }
    const float Mm = QSCALE_M * 96.0f * gqm * gkm * 1.02f, Ms = QSCALE_S * 64.0f * gqs * gks * 1.02f;
    float snk = fabsf(((const GAS float*)F.swa_sink)[F.lane & 7] * LOG2E);
#pragma unroll
    for (int o = 1; o < 8; o <<= 1) snk = fmaxf(snk, __shfl_xor(snk, o));
    snk = __builtin_bit_cast(float, __builtin_amdgcn_readfirstlane(__builtin_bit_cast(int, snk)));
    const bool fast_m = Mm < 60.0f, fast_s = Ms < 60.0f && snk < 60.0f;
    const int NU = (1024 - F.vcu + F.G - 1) / F.G; int xp = MK_XOVL ? (MK_XPOS5 ? (int)(((blockIdx.x >> 3) & 7) * 5 >> 3) : (int)((blockIdx.x >> 3) & 7)) : -1;
#pragma nounroll
    for (int k = 0; k <= 2 * NU; ++k) {
        if (k == xp) { __syncthreads(); p0_experts(F); __syncthreads(); }
        if (k < NU) { const int u = F.vcu + k * F.G;
            const int bh = u >> 4, qb = u & 15, b = bh >> 3, h = bh & 7, q0 = qb * 256; const size_t row0 = (size_t)b * SEQ + q0 + F.wave * 32;
            if (fast_m && MK_ATT8 && MK_FUSE5 && MK_ATT2T) att::unit3<96, false, true>(F.lds, QM + row0 * 768 + h * 96, 768, (const bf16*)((const unsigned char*)KM + (size_t)b * KEYS * 1024 + h * 128), 0, VM + (size_t)b * KEYS * 512 + h * 64, 512, OA_PTR(row0, h), q0, 0.f, 0.f, WSP(float, WS_SSQH) + (row0 * 8 + h) * 2);
            else if (fast_m && MK_ATT8 && MK_FUSE5) att::unit2<96, false, true>(F.lds, QM + row0 * 768 + h * 96, 768, (const bf16*)((const unsigned char*)KM + (size_t)b * KEYS * 1024 + h * 128), 0, VM + (size_t)b * KEYS * 512 + h * 64, 512, OA_PTR(row0, h), q0, 0.f, 0.f, WSP(float, WS_SSQH) + (row0 * 8 + h) * 2);
            else if (fast_m) att::unit2<96, false>(F.lds, QM + row0 * 768 + h * 96, 768, KM + (size_t)b * KEYS * 768 + h * 96, 768, VM + (size_t)b * KEYS * 512 + h * 64, 512, OA_PTR(row0, h), q0, 0.f, 0.f, MK_FUSE5 ? WSP(float, WS_SSQH) + (row0 * 8 + h) * 2 : nullptr);
            else if (MK_ATT8 && MK_FUSE5) att::unit<96, false, true>(F.lds, QM + row0 * 768 + h * 96, 768, (const bf16*)((const unsigned char*)KM + (size_t)b * KEYS * 1024 + h * 128), 0, VM + (size_t)b * KEYS * 512 + h * 64, 512, OA_PTR(row0, h), q0, -1e30f, 0.f, WSP(float, WS_SSQH) + (row0 * 8 + h) * 2);
            else att::unit<96, false>(F.lds, QM + row0 * 768 + h * 96, 768, KM + (size_t)b * KEYS * 768 + h * 96, 768, VM + (size_t)b * KEYS * 512 + h * 64, 512, OA_PTR(row0, h), q0, -1e30f, 0.f, MK_FUSE5 ? WSP(float, WS_SSQH) + (row0 * 8 + h) * 2 : nullptr);
        } else if (k < 2 * NU) { const int u = F.vcu + (k - NU) * F.G;
            if (fast_s && MK_ATT2T && MK_SWA2H) {
                const int b = u >> 7, hp = (u >> 5) & 3, qb = u & 31, q0 = qb * 128, hd = 2 * hp + (F.wave >> 2), qo = (F.wave & 3) * 32; const size_t row0 = (size_t)b * SEQ + q0 + qo; const float sk = F.swa_sink[hd] * LOG2E;
                att::unit3<64, true>(F.lds, QS + row0 * 512 + hd * 64, 512, KS + (size_t)b * KEYS * 128 + (hp >> 1) * 64, 128, VS + (size_t)b * KEYS * 128 + (hp >> 1) * 64, 128, OB_PTR(row0, hd), q0, 0.f, __builtin_amdgcn_exp2f(sk), nullptr, qo, 128);
                continue; }
            const int bh = u >> 4, qb = u & 15, b = bh >> 3, h = bh & 7, q0 = qb * 256; const size_t row0 = (size_t)b * SEQ + q0 + F.wave * 32; const float sk = F.swa_sink[h] * LOG2E;
            if (fast_s && MK_ATT2T) att::unit3<64, true>(F.lds, QS + row0 * 512 + h * 64, 512, KS + (size_t)b * KEYS * 128 + (h >> 2) * 64, 128, VS + (size_t)b * KEYS * 128 + (h >> 2) * 64, 128, OB_PTR(row0, h), q0, 0.f, __builtin_amdgcn_exp2f(sk));
            else if (fast_s) att::unit2<64, true>(F.lds, QS + row0 * 512 + h * 64, 512, KS + (size_t)b * KEYS * 128 + (h >> 2) * 64, 128, VS + (size_t)b * KEYS * 128 + (h >> 2) * 64, 128, OB_PTR(row0, h), q0, 0.f, __builtin_amdgcn_exp2f(sk));
            else att::unit<64, true>(F.lds, QS + row0 * 512 + h * 64, 512, KS + (size_t)b * KEYS * 128 + (h >> 2) * 64, 128, VS + (size_t)b * KEYS * 128 + (h >> 2) * 64, 128, OB_PTR(row0, h), q0, sk, 1.0f);
        }
    }
}

constexpr int WRP_SEG = 256 * 32 + 16;
__device__ __forceinline__ void p10_norm2_router(Frame& F) {
    LAS float* WRP = (LAS float*)F.lds;
    LAS int* hist = (LAS int*)(F.lds + MOE_OFF);
    LAS float* BIASP = (LAS float*)(F.lds + P10X_OFF);
    LAS float* RS = BIASP + 32;
    LAS float* BPART = RS + 128;
    const int b = blockIdx.x, bb = b >> 5, lane = F.lane; const float* mod = WSP(float, WS_MOD) + (size_t)bb * NMOD;
    { const GAS float* gmod = (const GAS float*)mod; const GAS float* gwr = (const GAS float*)F.w_router; const GAS float* gg = (const GAS float*)F.norm2_g;
#pragma unroll
      for (int h = 0; h < 4; ++h) { f32x4 w[4]; float g[4], sc[4];
#pragma unroll
          for (int u = 0; u < 4; ++u) { const int idx = F.tid + 512 * (4 * h + u), k = idx >> 3, e4 = (idx & 7) * 4; g[u] = gg[k]; sc[u] = gmod[4096 + k]; w[u] = *(const GAS f32x4*)(gwr + (size_t)k * 32 + e4); }
          asm volatile("" ::: "memory");
#pragma unroll
          for (int u = 0; u < 4; ++u) { const int idx = F.tid + 512 * (4 * h + u), k = idx >> 3, e4 = (idx & 7) * 4; *(LAS f32x4*)(WRP + (k >> 8) * WRP_SEG + (k & 255) * 32 + e4) = w[u] * (g[u] * (1.0f + sc[u])); } }
      const int e = F.tid & 31, part = F.tid >> 5; float sacc = 0.f;
#pragma unroll
      for (int h = 0; h < 8; ++h) { float mv[8], wv[8];
#pragma unroll
          for (int u = 0; u < 8; ++u) { const int k = part * 64 + 8 * h + u; mv[u] = gmod[3072 + k]; wv[u] = gwr[(size_t)k * 32 + e]; }
          asm volatile("" ::: "memory");
#pragma unroll
          for (int u = 0; u < 8; ++u) sacc += mv[u] * wv[u]; }
      BPART[part * 32 + e] = sacc; }
    if (F.tid < 32) hist[F.tid] = 0;
    __syncthreads();
    if (F.tid < 32) { float sacc = F.b_router[F.tid];
#pragma unroll
        for (int p = 0; p < 16; ++p) sacc += BPART[p * 32 + F.tid];
        BIASP[F.tid] = sacc; }
    f32x4 av[4], cv[4];
#pragma unroll
    for (int q = 0; q < 4; ++q) { const int col = 4 * lane + 256 * q; const f32x4 g = *(const f32x4*)(F.norm2_g + col), sc = *(const f32x4*)(mod + 4096 + col); cv[q] = *(const f32x4*)(mod + 3072 + col); av[q] = g * (sc + 1.0f); }
    __syncthreads();
    bf16* H2 = WSP(bf16, WS_H2); int* topi = WSP(int, WS_TOPI); float* topw = WSP(float, WS_TOPW);
    const int tok0 = 128 * b + 16 * F.wave;
#pragma nounroll
    for (int j0 = 0; j0 < 16; j0 += MK_P10R) {
        f32x4 v[MK_P10R][4];
#pragma unroll
        for (int t = 0; t < MK_P10R; ++t) { const GAS float* xr = (const GAS float*)F.out + (size_t)(tok0 + j0 + t) * D;
#pragma unroll
            for (int q = 0; q < 4; ++q) v[t][q] = *(const GAS f32x4*)(xr + 4 * lane + 256 * q); }
        asm volatile("" ::: "memory");
#pragma unroll
        for (int t = 0; t < MK_P10R; ++t) { const int tok = tok0 + j0 + t; float ss = 0.f;
#pragma unroll
            for (int q = 0; q < 4; ++q) ss += (v[t][q].x * v[t][q].x + v[t][q].y * v[t][q].y) + (v[t][q].z * v[t][q].z + v[t][q].w * v[t][q].w);
            const float rstd = rsqrtf(wave_sum(ss) * (1.0f / D) + EPS);
            if (lane == 0) RS[F.wave * 16 + j0 + t] = rstd;
#pragma unroll
            for (int q = 0; q < 4; ++q) { const f32x4 h = v[t][q] * rstd * av[q] + cv[q];
                if (MK_F8) { *(GAS unsigned*)((GAS unsigned char*)H2 + (size_t)tok * D + 4 * lane + 256 * q) = pk4_fp8(h.x * F8_SA, h.y * F8_SA, h.z * F8_SA, h.w * F8_SA); }
                else { u32x2 o; o.x = pk2(h.x, h.y); o.y = pk2(h.z, h.w); *(GAS u32x2*)((GAS bf16*)H2 + (size_t)tok * D + 4 * lane + 256 * q) = o; } } }
    }
    LDS_WAIT(); asm volatile("" ::: "memory");
    const int i = lane & 15, q = lane >> 4;
    f32x4 acc0 = {0.f, 0.f, 0.f, 0.f}, acc1 = {0.f, 0.f, 0.f, 0.f};
    { const GAS float* xp = (const GAS float*)F.out + (size_t)(tok0 + i) * D + 256 * q; const LAS float* wp = WRP + q * WRP_SEG + i;
      f32x4 xa[8], xb[8];
#define P10_LD8(dst, m0) do { _Pragma("unroll") for (int u = 0; u < 8; ++u) dst[u] = *(const GAS f32x4*)(xp + 4 * ((m0) + u)); asm volatile("" ::: "memory"); } while (0)
#define P10_MM8(src, m0) do { _Pragma("unroll") for (int u = 0; u < 8; ++u) { _Pragma("unroll") for (int c = 0; c < 4; ++c) { const float b0 = wp[(4 * ((m0) + u) + c) * 32], b1 = wp[(4 * ((m0) + u) + c) * 32 + 16]; \
          acc0 = __builtin_amdgcn_mfma_f32_16x16x4f32(src[u][c], b0, acc0, 0, 0, 0); acc1 = __builtin_amdgcn_mfma_f32_16x16x4f32(src[u][c], b1, acc1, 0, 0, 0); } } } while (0)
      P10_LD8(xa, 0);
#pragma unroll
      for (int m0 = 0; m0 < 64; m0 += 16) {
          P10_LD8(xb, m0 + 8);
          P10_MM8(xa, m0);
          if (m0 + 16 < 64) P10_LD8(xa, m0 + 16);
          P10_MM8(xb, m0 + 8);
      }
#undef P10_LD8
#undef P10_MM8
    }
    const float bs0 = BIASP[i], bs1 = BIASP[16 + i];
#pragma unroll
    for (int r = 0; r < 4; ++r) {
        const float rs = RS[F.wave * 16 + 4 * q + r]; float v0 = acc0[r] * rs + bs0, v1 = acc1[r] * rs + bs1;
        float tv[4]; int tix[4];
#pragma unroll
        for (int k = 0; k < 4; ++k) {
            float bv; int bi; if (v0 >= v1) { bv = v0; bi = i; } else { bv = v1; bi = 16 + i; }
#pragma unroll
            for (int st = 0; st < 4; ++st) { const float ov = st == 0 ? dpp_f<0xB1>(bv) : st == 1 ? dpp_f<0x4E>(bv) : st == 2 ? dpp_f<0x141>(bv) : dpp_f<0x140>(bv);
                const int oi = st == 0 ? dpp_i<0xB1>(bi) : st == 1 ? dpp_i<0x4E>(bi) : st == 2 ? dpp_i<0x141>(bi) : dpp_i<0x140>(bi); if (ov > bv || (ov == bv && oi < bi)) { bv = ov; bi = oi; } }
            tv[k] = bv; tix[k] = bi; if (bi == i) v0 = -3.0e38f; if (bi == 16 + i) v1 = -3.0e38f;
        }
        const float e1 = __expf(tv[1] - tv[0]), e2 = __expf(tv[2] - tv[0]), e3 = __expf(tv[3] - tv[0]), inv = 1.0f / (1.0f + e1 + e2 + e3);
        if (i < 4) { const int tok = tok0 + 4 * q + r; const float w = (i == 0 ? 1.0f : i == 1 ? e1 : i == 2 ? e2 : e3) * inv; const int ix = i == 0 ? tix[0] : i == 1 ? tix[1] : i == 2 ? tix[2] : tix[3];
            topi[tok * 4 + i] = ix; topw[tok * 4 + i] = w; __hip_atomic_fetch_add(&hist[ix], 1, __ATOMIC_RELAXED, __HIP_MEMORY_SCOPE_WORKGROUP); }
    }
    __syncthreads();
    if (F.tid < 32) WSP(int, WS_BCNT)[b * 32 + F.tid] = hist[F.tid];
}

struct MoeTab { LAS int* base; LAS int* ntile; LAS int* total; LAS int* mine; LAS int* cursor; LAS int* R; LAS unsigned char* texp; };
__device__ __forceinline__ MoeTab moe_tab(Frame& F) { MoeTab t; LAS int* p = (LAS int*)(F.lds + MOE_OFF); t.base = p + 32; t.ntile = p + 64; t.total = p + 96; t.mine = p + 128; t.cursor = p + 160; t.R = p + 192; t.texp = (LAS unsigned char*)(p + 200); return t; }
__device__ __forceinline__ void moe_tables(Frame& F) {
    const MoeTab t = moe_tab(F); LAS int* part = (LAS int*)F.lds;
    const int* bc = WSP(int, WS_BCNT); const int b = blockIdx.x;
    __syncthreads();
    if (F.tid < 256) { const int e = F.tid & 31, pt = F.tid >> 5; int tot = 0, bef = 0;
        for (int q = 0; q < 32; ++q) { const int bq = pt * 32 + q; const int cval = bc[bq * 32 + e]; tot += cval; if (bq < b) bef += cval; }
        part[pt * 32 + e] = tot; part[256 + pt * 32 + e] = bef; }
    __syncthreads();
    if (F.tid < 32) { int tot = 0, bef = 0;
#pragma unroll
        for (int pt = 0; pt < 8; ++pt) { tot += part[pt * 32 + F.tid]; bef += part[256 + pt * 32 + F.tid]; }
        const int nt = (tot + 255) >> 8; t.total[F.tid] = tot; t.mine[F.tid] = bef; t.ntile[F.tid] = nt; t.cursor[F.tid] = 0;
        int inc = nt;
#pragma unroll
        for (int o = 1; o < 32; o <<= 1) { const int up = __shfl_up(inc, o); if ((int)F.tid >= o) inc += up; }
        const int r0 = inc - nt; t.base[F.tid] = r0 * 256; if (F.tid == 31) t.R[0] = inc;
        for (int q = 0; q < nt; ++q) t.texp[r0 + q] = (unsigned char)F.tid; }
    __syncthreads();
}
__device__ __forceinline__ void p11_slots(Frame& F) {
    moe_tables(F); const MoeTab t = moe_tab(F);
    const int b = blockIdx.x, tok = 128 * b + (F.tid >> 2), k = F.tid & 3;
    const int e = WSP(int, WS_TOPI)[tok * 4 + k]; const float w = WSP(float, WS_TOPW)[tok * 4 + k];
    const int rank = __hip_atomic_fetch_add(&t.cursor[e], 1, __ATOMIC_RELAXED, __HIP_MEMORY_SCOPE_WORKGROUP); const int slot = t.base[e] + t.mine[e] + rank;
    WSP(int, WS_SLOTTOK)[slot] = tok; WSP(float, WS_SLOTW)[slot] = w; WSP(int, WS_TOKSLOT)[tok * 4 + k] = slot;
    if (b < 32) { const int s0 = t.base[b] + t.total[b], s1 = t.base[b] + t.ntile[b] * 256; for (int s = s0 + F.tid; s < s1; s += 512) { WSP(int, WS_SLOTTOK)[s] = 0; WSP(float, WS_SLOTW)[s] = 0.f; } }
}
__device__ __forceinline__ void p14_combine(Frame& F) {
    const unsigned char* Y = WSP(unsigned char, WS_R2); const int* ts = WSP(int, WS_TOKSLOT); const float* mod = WSP(float, WS_MOD);
    const int gw = F.vcu * NWAVES + F.wave, NGW = F.G * NWAVES, lane = F.lane;
    static_assert(MK_F8Y, "combine is written for e4m3 Y");
    const GAS int* gts = (const GAS int*)ts; u32x4 nsa = {0u, 0u, 0u, 0u}, nsb = {0u, 0u, 0u, 0u};
    if (2 * gw < MTOK) { nsa = *(const GAS u32x4*)(gts + 2 * gw * 4); nsb = *(const GAS u32x4*)(gts + 2 * gw * 4 + 4); }
    for (int t0 = 2 * gw; t0 < MTOK; t0 += 2 * NGW) {
        const int bb = t0 >> 12; const u32x4 sa = nsa, sb = nsb;
        { const int tn = t0 + 2 * NGW; if (tn < MTOK) { nsa = *(const GAS u32x4*)(gts + tn * 4); nsb = *(const GAS u32x4*)(gts + tn * 4 + 4); } }
        const unsigned sl[2][4] = {{sa.x, sa.y, sa.z, sa.w}, {sb.x, sb.y, sb.z, sb.w}};
        unsigned yw[2][4][4]; f32x4 xv[2][4], g2[4];
#pragma unroll
        for (int t = 0; t < 2; ++t)
#pragma unroll
            for (int k = 0; k < 4; ++k)
#pragma unroll
                for (int q = 0; q < 4; ++q) yw[t][k][q] = *(const unsigned*)(Y + (size_t)sl[t][k] * 1024 + 256 * q + 4 * lane);
#pragma unroll
        for (int t = 0; t < 2; ++t)
#pragma unroll
            for (int q = 0; q < 4; ++q) xv[t][q] = *(const f32x4*)(F.out + (size_t)(t0 + t) * D + 256 * q + 4 * lane);
#pragma unroll
        for (int q = 0; q < 4; ++q) g2[q] = *(const f32x4*)(mod + (size_t)bb * NMOD + 5120 + 256 * q + 4 * lane);
#pragma unroll
        for (int t = 0; t < 2; ++t) {
            float s[16];
#pragma unroll
            for (int e = 0; e < 16; ++e) s[e] = 0.f;
#pragma unroll
            for (int k = 0; k < 4; ++k) {
#pragma unroll
                for (int q = 0; q < 4; ++q) { const f32x2 lo = __builtin_amdgcn_cvt_pk_f32_fp8((int)yw[t][k][q], false), hi = __builtin_amdgcn_cvt_pk_f32_fp8((int)yw[t][k][q], true);
                    s[4 * q] += lo.x; s[4 * q + 1] += lo.y; s[4 * q + 2] += hi.x; s[4 * q + 3] += hi.y; } }
#pragma unroll
            for (int q = 0; q < 4; ++q) *(f32x4*)(F.out + (size_t)(t0 + t) * D + 256 * q + 4 * lane) = xv[t][q] + g2[q] * ((f32x4){s[4 * q], s[4 * q + 1], s[4 * q + 2], s[4 * q + 3]} * (1.0f / F8_SY));
        }
    }
}

constexpr int NPHASE = 15;
struct Args { const float* in[27]; float* out; unsigned char* ws; int ph_lo, ph_hi; };
__global__ void __launch_bounds__(NWAVES * 64, 2) mk_fwd(Args args) {
    extern __shared__ __attribute__((aligned(16))) unsigned char lds_raw[];
    Frame F;
    F.lds = (LAS unsigned char*)lds_raw;
    F.MISC = (volatile LAS unsigned*)(F.lds + MISC_OFF);
    F.tid = threadIdx.x; F.lane = F.tid & 63; F.wave = __builtin_amdgcn_readfirstlane(F.tid >> 6);
    F.G = gridDim.x; { const int bx = blockIdx.x; F.vcu = (F.G % 8 == 0) ? (bx % 8) * (F.G / 8) + bx / 8 : bx; }
    F.ws = args.ws; F.ctl = (gu32*)(args.ws + WS_CTL); F.out = args.out;
    for (int u = F.tid; u < (LDS_BYTES - LDSCTL_OFF) / 4; u += NWAVES * 64) ((LAS unsigned*)(F.lds + LDSCTL_OFF))[u] = 0u;
    __syncthreads();
    XcdBarrier bar; bar.bar = (unsigned*)(F.ctl + CW_BAR); bar.x = 0; bar.st = nullptr;
    if (MK_N_LAUNCHES == 1) bar = xcd_barrier_post((unsigned*)(F.ctl + CW_BAR), F.MISC + 8);
    const int lo = args.ph_lo, hi = args.ph_hi;
#ifndef MK_PHMASK
#define MK_PHMASK 0x7fff
#endif
#define IN(k) ((((MK_PHMASK) >> (k)) & 1) && lo <= (k) && (k) < hi)
#define SEAM(k) do { if (IN(k) && IN((k) + 1)) xcd_barrier(bar); } while (0)

    if (IN(0)) { frame_load(F); p0_prologue(F); if (MK_REP == 0) p0_prologue(F); } SEAM(0);
#if !MK_STAGE_A
    if (IN(1)) { frame_load(F); p1_norm1(F); if (MK_REP == 10) { __syncthreads(); p1_norm1(F); } } SEAM(1);
    if (IN(2)) { frame_load(F);
        SchedInProj S{F.G, (int)blockIdx.x, (const char*)WSP(bf16, WS_H), (const char*)WSP(bf16, WS_WIN)};
        constexpr int ES = MK_F8IN ? 1 : 2;
        if (MK_FUSE3) { { LAS float* tl = (LAS float*)(F.lds + TSX_OFF); const GAS float* tsrc = (const GAS float*)WSP(float, WS_TRIG);
                { float t4[4];
#pragma unroll
                  for (int u = 0; u < 4; ++u) t4[u] = tsrc[F.tid + 512 * u];
#pragma unroll
                  for (int u = 0; u < 4; ++u) tl[F.tid + 512 * u] = t4[u]; }
                if (F.tid < 64) { tl[2048 + F.tid] = ((const GAS float*)F.swa_q_g)[F.tid]; tl[2112 + F.tid] = ((const GAS float*)F.swa_k_g)[F.tid]; }
                __syncthreads(); }
            EpiInProj E{WSP(bf16, WS_R1), WSP(float, WS_SSKV), WSP(float, WS_SSQ), WSP(bf16, WS_QS), WSP(bf16, WS_KS), WSP(bf16, WS_VS), (const LAS float*)(F.lds + TSX_OFF), (const LAS float*)(F.lds + TSX_OFF) + 2048, (const LAS float*)(F.lds + TSX_OFF) + 2112};
            pg8::gemm_phase<EpiInProj, SchedInProj, true, false, MK_F8IN != 0>(F.lds, D * ES / 128, D * ES, D * ES, S, E); }
        else { EpiStoreBf16 E{WSP(bf16, WS_R1), NRAW, nullptr, MK_F8IN ? F8_INV : 1.0f};
            pg8::gemm_phase<EpiStoreBf16, SchedInProj, true, false, MK_F8IN != 0>(F.lds, D * ES / 128, D * ES, D * ES, S, E); }
    } SEAM(2);
    if (!MK_FUSE3) { if (IN(3)) { frame_load(F); p3_post_inproj(F); } SEAM(3); }
    if (IN(4)) { frame_load(F);
        if (MK_FUSE5) { LAS float* tl = (LAS float*)(F.lds + TMX_OFF); const GAS float* tsrc = (const GAS float*)WSP(float, WS_TRIG) + 2048;
            { const float t0v = tsrc[F.tid], t1v = tsrc[F.tid + 512]; tl[F.tid] = t0v; tl[F.tid + 512] = t1v; }
            if (F.tid < 96) { ((LAS float*)(F.lds + GKX_OFF))[F.tid] = ((const GAS float*)F.mla_k_g)[F.tid]; ((LAS float*)(F.lds + GQX_OFF))[F.tid] = ((const GAS float*)F.mla_q_g)[F.tid]; }
            __syncthreads(); }
        { SchedDense S{F.G, (int)blockIdx.x, MALL / 256, 4, (const char*)(WSP(bf16, WS_R1) + C_KVLAT), (const char*)WSP(bf16, WS_WKV), (size_t)256 * NRAW * 2, (size_t)256 * 256 * 2}; S.rep = (MK_REPU == 4) ? 2 : 1;
          if (MK_FUSE5) { EpiKv<MK_ATT8 != 0> E{WSP(float, WS_SSKV), WSP(bf16, WS_R1), WSP(bf16, WS_KM), WSP(bf16, WS_VM), (const LAS float*)(F.lds + TMX_OFF), (const LAS float*)(F.lds + GKX_OFF)};
            pg8::gemm_phase<EpiKv<MK_ATT8 != 0>, SchedDense, true, false>(F.lds, 256 / 64, NRAW * 2, 256 * 2, S, E); }
          else if (MK_FUSE3) { EpiUp<4> E{WSP(bf16, WS_KVUP), 1024, WSP(float, WS_SSKV), 1.0f / 256.0f}; pg8::gemm_phase<EpiUp<4>, SchedDense, true, false>(F.lds, 256 / 64, NRAW * 2, 256 * 2, S, E); }
          else { EpiStoreBf16 E{WSP(bf16, WS_KVUP), 1024, WSP(float, WS_RSKV), 1.0f}; pg8::gemm_phase<EpiStoreBf16, SchedDense, true, false>(F.lds, 256 / 64, NRAW * 2, 256 * 2, S, E); } }
        frame_load(F);
        { SchedDense S{F.G, (int)blockIdx.x, MTOK / 256, MK_FUSE5 ? 4 : 3, (const char*)(WSP(bf16, WS_R1) + C_QLAT), (const char*)WSP(bf16, WS_WQ), (size_t)256 * NRAW * 2, (size_t)256 * 384 * 2}; S.rep = (MK_REPU == 4) ? 2 : 1;
          if (MK_FUSE5) { EpiQ E{WSP(float, WS_SSQ), WSP(bf16, WS_QM), WSP(float, WS_SSQH), (const LAS float*)(F.lds + TMX_OFF), (const LAS float*)(F.lds + GQX_OFF)}; pg8::gemm_phase<EpiQ, SchedDense, true, false>(F.lds, 384 / 64, NRAW * 2, 384 * 2, S, E); }
          else if (MK_FUSE3) { EpiUp<8> E{WSP(bf16, WS_QUP), 768, WSP(float, WS_SSQ), 1.0f / 384.0f}; pg8::gemm_phase<EpiUp<8>, SchedDense, true, false>(F.lds, 384 / 64, NRAW * 2, 384 * 2, S, E); }
          else { EpiStoreBf16 E{WSP(bf16, WS_QUP), 768, WSP(float, WS_RSQ), 1.0f}; pg8::gemm_phase<EpiStoreBf16, SchedDense, true, false>(F.lds, 384 / 64, NRAW * 2, 384 * 2, S, E); } }
    } SEAM(4);
    if (!MK_FUSE5) { if (IN(5)) { frame_load(F); p5_post_up(F); } SEAM(5); }
    if (IN(6)) { frame_load(F); p6_attention(F); if (MK_REP == 6) p6_attention(F); } SEAM(6);
    if (MK_MERGE78 && MK_F8MID) {
        if (IN(7)) { frame_load(F);
            SchedDense S{F.G, (int)blockIdx.x, MTOK / 256, 4, (const char*)WSP(unsigned char, WS_OA), (const char*)WSP(unsigned char, WS_WBA), (size_t)256 * 1024, (size_t)256 * 1024}; S.rep = (MK_REPU == 7) ? 2 : 1;
            EpiMerge E{WSP(bf16, WS_R1), WSP(unsigned char, WS_H2)};
            pg8::gemm_phase<EpiMerge, SchedDense, true, false, true>(F.lds, 8, 1024, 1024, S, E);
        } SEAM(8);
    } else {
    if (IN(7)) { frame_load(F);
        constexpr int ES = MK_F8MID ? 1 : 2;
        SchedDense S{F.G, (int)blockIdx.x, MTOK / 256, 4, (const char*)WSP(bf16, WS_OA), (const char*)WSP(bf16, WS_WBA), (size_t)256 * 512 * ES, (size_t)256 * 512 * ES}; S.rep = (MK_REPU == 7) ? 2 : 1;
        EpiBranch<false> E{WSP(bf16, WS_T), WSP(bf16, WS_R1) + C_GA, nullptr};
        pg8::gemm_phase<EpiBranch<false>, SchedDense, true, false, MK_F8MID != 0>(F.lds, 512 * ES / 128, 512 * ES, 512 * ES, S, E);
    }
    if (IN(8)) { frame_load(F);
        constexpr int ES = MK_F8MID ? 1 : 2;
        SchedDense S{F.G, (int)blockIdx.x, MTOK / 256, 4, (const char*)WSP(bf16, WS_OB), (const char*)WSP(bf16, WS_WBB), (size_t)256 * 512 * ES, (size_t)256 * 512 * ES}; S.rep = (MK_REPU == 7) ? 2 : 1;
        EpiBranch<true> E{WSP(bf16, WS_T), WSP(bf16, WS_R1) + C_GB, WSP(unsigned char, WS_H2)};
        pg8::gemm_phase<EpiBranch<true>, SchedDense, true, false, MK_F8MID != 0>(F.lds, 512 * ES / 128, 512 * ES, 512 * ES, S, E);
    } SEAM(8);
    }
    if (IN(9)) { frame_load(F);
        constexpr int ES = MK_F8MID ? 1 : 2;
        SchedDense S{F.G, (int)blockIdx.x, MTOK / 256, 4, (const char*)(MK_F8MID ? (void*)WSP(unsigned char, WS_H2) : (void*)WSP(bf16, WS_T)), (const char*)WSP(bf16, WS_WOUT), (size_t)256 * 1024 * ES, (size_t)256 * 1024 * ES}; S.rep = (MK_REPU == 9) ? 2 : 1;
        EpiOutRes E{F.x, F.out, WSP(float, WS_MOD)};
        pg8::gemm_phase<EpiOutRes, SchedDense, true, false, MK_F8MID != 0>(F.lds, 1024 * ES / 128, 1024 * ES, 1024 * ES, S, E);
    } SEAM(9);
#else
    if (IN(1)) { frame_load(F); p1_norm1(F);
        const int gw = F.vcu * NWAVES + F.wave, NGW = F.G * NWAVES;
        for (int row = gw; row < MTOK; row += NGW)
#pragma unroll
            for (int q = 0; q < 4; ++q) *(f32x4*)(F.out + (size_t)row * D + 4 * F.lane + 256 * q) = *(const f32x4*)(F.x + (size_t)row * D + 4 * F.lane + 256 * q);
    } SEAM(1);
#endif
#if MK_STAGE_A != 2
    if (IN(10)) { frame_load(F); p10_norm2_router(F); if (MK_REP == 10) p10_norm2_router(F); } SEAM(10);
    if (IN(11)) { frame_load(F); p11_slots(F); } SEAM(11);
    if (IN(12)) { frame_load(F);
        if (!IN(11)) moe_tables(F);
        const MoeTab t = moe_tab(F);
        constexpr int ES = MK_F8 ? 1 : 2;
        SchedMoe S{F.G, (int)blockIdx.x, t.R[0], 8, (const char*)WSP(bf16, WS_H2), (const char*)WSP(bf16, WS_WGU), 0, (size_t)2048 * 1024 * ES, (size_t)256 * 1024 * ES, t.texp, WSP(int, WS_SLOTTOK)}; S.rep = (MK_REPU == 12) ? 2 : 1;
        EpiSwiglu E{WSP(unsigned char, WS_R1), F.b_gate_up};
        pg8::gemm_phase<EpiSwiglu, SchedMoe, true, true, MK_F8 != 0>(F.lds, 1024 * ES / 128, 1024 * ES, 1024 * ES, S, E);
    } SEAM(12);
    if (IN(13)) { frame_load(F);
        if (!IN(11)) moe_tables(F);
        const MoeTab t = moe_tab(F);
        constexpr int ES = MK_F8 ? 1 : 2;
        SchedMoe S{F.G, (int)blockIdx.x, t.R[0], 4, (const char*)WSP(bf16, WS_R1), (const char*)WSP(bf16, WS_WDN), (size_t)256 * 1024 * ES, (size_t)1024 * 1024 * ES, (size_t)256 * 1024 * ES, t.texp, nullptr}; S.rep = (MK_REPU == 13) ? 2 : 1;
        EpiDown E{WSP(unsigned char, WS_R2), F.b_down, WSP(float, WS_SLOTW)};
        pg8::gemm_phase<EpiDown, SchedMoe, true, false, MK_F8 != 0>(F.lds, 1024 * ES / 128, 1024 * ES, 1024 * ES, S, E);
    } SEAM(13);
    if (IN(14)) { frame_load(F); p14_combine(F); }
#endif
#undef IN
#undef SEAM
}

extern "C" void kernel_launch(void* const* d_in, const int* in_sizes, int n_in, void* d_out, int out_size, void* d_ws, size_t ws_size, hipStream_t stream) {
    static int grid = 0;
    if (grid == 0) {
        if (n_in != 27 || in_sizes[0] != MTOK * D || out_size != MTOK * D || ws_size < WS_END) { fprintf(stderr, "kernel_launch: unexpected shapes (n_in %d, in0 %d, out %d, ws %zu < %zu); nothing launched\n", n_in, n_in > 0 ? in_sizes[0] : -1, out_size, ws_size, (size_t)WS_END); grid = -1; return; }
        int dev = 0, cus = 0, per_cu = 0;
        if (hipGetDevice(&dev) != hipSuccess || hipDeviceGetAttribute(&cus, hipDeviceAttributeMultiprocessorCount, dev) != hipSuccess) { grid = -1; return; }
        if (hipFuncSetAttribute((const void*)mk_fwd, hipFuncAttributeMaxDynamicSharedMemorySize, LDS_BYTES) != hipSuccess) { fprintf(stderr, "kernel_launch: hipFuncSetAttribute failed\n"); grid = -1; return; }
        if (hipOccupancyMaxActiveBlocksPerMultiprocessor(&per_cu, (const void*)mk_fwd, NWAVES * 64, LDS_BYTES) != hipSuccess || per_cu < 1) fprintf(stderr, "kernel_launch: occupancy query says %d\n", per_cu);
        (void)hipGetLastError();
        grid = cus;
        if (grid != 256) fprintf(stderr, "kernel_launch: %d CUs; the thin phases assume 256 workgroups\n", grid);
    }
    if (grid < 0) return;
    if (hipMemsetAsync((char*)d_ws + WS_CTL, 0, CTL_ZERO_BYTES, stream) != hipSuccess) return;
    Args a{};
    for (int i = 0; i < 27; ++i) a.in[i] = (const float*)d_in[i];
    a.out = (float*)d_out; a.ws = (unsigned char*)d_ws;
    if (MK_N_LAUNCHES == 1) { a.ph_lo = 0; a.ph_hi = NPHASE; hipLaunchKernelGGL(mk_fwd, dim3(grid), dim3(NWAVES * 64), LDS_BYTES, stream, a); }
    else for (int p = 0; p < NPHASE; ++p) { a.ph_lo = p; a.ph_hi = p + 1; hipLaunchKernelGGL(mk_fwd, dim3(grid), dim3(NWAVES * 64), LDS_BYTES, stream, a); }
}
```

```cpp
#include <hip/hip_runtime.h>
#include <cstdio>
#include <cstdint>

#ifndef MK_N_LAUNCHES
#define MK_N_LAUNCHES 1
#endif
#ifndef MK_F8
#define MK_F8 1
#endif
#ifndef MK_WIDE
#define MK_WIDE 0
#endif
#ifndef MK_MERGE78
#define MK_MERGE78 1
#endif
#ifndef MK_ATT2T
#define MK_ATT2T 1
#endif
#ifndef MK_ATT8
#define MK_ATT8 1
#endif
#ifndef MK_FUSE5
#define MK_FUSE5 1
#endif
#ifndef MK_FUSE3
#define MK_FUSE3 1
#endif
#ifndef MK_F8MID
#define MK_F8MID 1
#endif
#ifndef MK_F8Y
#define MK_F8Y 1
#endif
#ifndef MK_F8IN
#define MK_F8IN 1
#endif
#ifndef MK_XOVL
#define MK_XOVL 1
#endif
#ifndef MK_EPIX
#define MK_EPIX 2
#endif
#ifndef MK_MIDR
#define MK_MIDR 2
#endif
#ifndef MK_P1R
#define MK_P1R 2
#endif
#ifndef MK_P10R
#define MK_P10R 2
#endif
#ifndef MK_SWA2H
#define MK_SWA2H 1
#endif
#ifndef MK_XPOS5
#define MK_XPOS5 1
#endif
#ifndef MK_SIGPRE
#define MK_SIGPRE 1
#endif
#ifndef MK_XPIPE
#define MK_XPIPE 1
#endif
#ifndef MK_XNB
#define MK_XNB 32
#endif
#ifndef MK_REPU
#define MK_REPU -1
#endif
#ifndef MK_REP
#define MK_REP -1
#endif
#ifndef MK_STAGE_A
#define MK_STAGE_A 0
#endif

#define GAS __attribute__((address_space(1)))
#define LAS __attribute__((address_space(3)))
typedef unsigned short bf16;
typedef short bf16x8 __attribute__((ext_vector_type(8)));
typedef short s16x4 __attribute__((ext_vector_type(4)));
typedef float f32x2 __attribute__((ext_vector_type(2)));
typedef float f32x4 __attribute__((ext_vector_type(4)));
typedef float f32x16 __attribute__((ext_vector_type(16)));
typedef unsigned u32x2 __attribute__((ext_vector_type(2)));
typedef unsigned u32x4 __attribute__((ext_vector_type(4)));
typedef GAS unsigned gu32;

#define RLX_AGENT __ATOMIC_RELAXED, __HIP_MEMORY_SCOPE_AGENT
#define LDS_WAIT() asm volatile("s_waitcnt lgkmcnt(0)" ::: "memory")
#define VM_WAIT() asm volatile("s_waitcnt vmcnt(0)" ::: "memory")

constexpr int D = 1024, NB = 8, SEQ = 4096, CTX = 256, KEYS = SEQ + CTX;
constexpr int MTOK = NB * SEQ, MCTX = NB * CTX, MALL = MTOK + MCTX;
constexpr int NMOD = 6 * D;
constexpr int IN_COLS = 3488, NRAW = 3584;
constexpr int C_KVLAT = 0, C_KSWA = 256, C_VSWA = 384, C_QLAT = 512, C_KROPE = 896, C_QSWA = 1024, C_GA = 1536, C_GB = 2560;
constexpr int NE = 32, TOPK = 4, NASSIGN = MTOK * TOPK;
constexpr int MAXTILES = NASSIGN / 256 + NE, NSLOT = MAXTILES * 256;
constexpr float EPS = 1e-6f, LOG2E = 1.4426950408889634f;
constexpr float QSCALE_S = 0.125f * LOG2E;
constexpr float QSCALE_M = 0.10206207261596577f * LOG2E;

constexpr size_t MiB = 1u << 20;
constexpr size_t WS_CTL = 0, CTL_ZERO_BYTES = 64 * 1024;
constexpr size_t WS_MODP = 1 * MiB;
constexpr size_t WS_MOD = 3 * MiB;
constexpr size_t WS_TRIG = WS_MOD + 256 * 1024;
constexpr size_t WS_RSKV = WS_TRIG + 64 * 1024;
constexpr size_t WS_RSQ = WS_RSKV + 256 * 1024;
constexpr size_t WS_TOPI = 4 * MiB;
constexpr size_t WS_TOPW = WS_TOPI + 512 * 1024;
constexpr size_t WS_TOKSLOT = WS_TOPW + 512 * 1024;
constexpr size_t WS_BCNT = WS_TOKSLOT + 512 * 1024;
constexpr size_t WS_SLOTTOK = 6 * MiB;
constexpr size_t WS_SLOTW = 7 * MiB;
constexpr size_t WS_W = 9 * MiB;
constexpr size_t WS_WIN = WS_W;
constexpr size_t WS_WKV = WS_WIN + (size_t)NRAW * D * 2;
constexpr size_t WS_WQ = WS_WKV + 1024 * 256 * 2;
constexpr size_t WS_WBA = WS_WQ + 1024 * 384 * 2;
constexpr size_t WS_WBB = WS_WBA + 1024 * 512 * 2;
constexpr size_t WS_WOUT = WS_WBB + 1024 * 512 * 2;
constexpr size_t WS_WGU = WS_WOUT + 1024 * 1024 * 2;
constexpr size_t WS_WDN = WS_WGU + (size_t)NE * 2048 * 1024 * 2;
constexpr size_t WS_WEND = WS_WDN + (size_t)NE * 1024 * 1024 * 2;
constexpr size_t WS_R1 = 214 * MiB;
constexpr size_t WS_R2 = 486 * MiB;
constexpr size_t WS_H = WS_R2, WS_KVUP = WS_R2 + 68 * MiB, WS_QUP = WS_R2 + 136 * MiB;
constexpr size_t WS_R3 = 670 * MiB;
constexpr size_t WS_QM = WS_R3, WS_KM = WS_R3 + 48 * MiB, WS_VM = WS_R3 + 99 * MiB, WS_QS = WS_R3 + 133 * MiB, WS_KS = WS_R3 + 165 * MiB, WS_VS = WS_R3 + 174 * MiB;
constexpr size_t WS_T = WS_R3, WS_H2 = WS_R3 + 64 * MiB;
constexpr size_t WS_R4 = 853 * MiB;
constexpr size_t WS_OA = WS_R4, WS_OB = WS_R4 + 32 * MiB;
constexpr size_t WS_SSQ = 918 * MiB;
constexpr size_t WS_SSKV = 920 * MiB;
constexpr size_t WS_SSQH = 922 * MiB;
constexpr size_t WS_END = 925 * MiB;
static_assert(WS_WEND <= WS_R1, "weights fit");
static_assert(WS_R1 + (size_t)NSLOT * 1024 * 2 <= WS_R2 && WS_R1 + (size_t)MALL * NRAW * 2 <= WS_R2, "R1");
static_assert(WS_QUP + (size_t)MTOK * 768 * 2 <= WS_R3, "R2");
static_assert(WS_KM + (size_t)NB * KEYS * 768 * 2 <= WS_VM && WS_VM + (size_t)MALL * 512 * 2 <= WS_QS && WS_QS + (size_t)MTOK * 512 * 2 <= WS_KS && WS_KS + (size_t)MALL * 128 * 2 <= WS_VS && WS_VS + (size_t)MALL * 128 * 2 <= WS_R4, "R3");
static_assert(WS_R2 + (size_t)NSLOT * 1024 * 2 <= WS_R4, "Y");
static_assert(WS_RSKV + (size_t)MALL * 4 <= WS_RSQ && WS_RSQ + (size_t)MTOK * 4 <= WS_TOPI && WS_BCNT + 256 * 32 * 4 <= WS_SLOTTOK && WS_SLOTTOK + (size_t)NSLOT * 4 <= WS_SLOTW && WS_SLOTW + (size_t)NSLOT * 4 <= WS_W, "misc");
static_assert(WS_MODP + 8 * 9 * NMOD * 4 <= WS_MOD && WS_MOD + 9 * NMOD * 4 <= WS_TRIG, "mod");
constexpr int CW_BAR = 4096;

constexpr int RING_BYTES = 131072;
constexpr int LDSCTL_OFF = RING_BYTES + 2048;
constexpr int MISC_OFF = LDSCTL_OFF;
constexpr int MOE_OFF = LDSCTL_OFF + 256;
constexpr int P10X_OFF = LDSCTL_OFF + 4096;
constexpr int TSX_OFF = P10X_OFF;
constexpr int TMX_OFF = P10X_OFF + 3072, GKX_OFF = TMX_OFF + 4096, GQX_OFF = GKX_OFF + 384;
constexpr int LDS_BYTES = 147456;
constexpr int NWAVES = 8;

__device__ __forceinline__ unsigned f2bf(float f) { unsigned u = __builtin_bit_cast(unsigned, f); return (u + 0x7fffu + ((u >> 16) & 1u)) >> 16; }
__device__ __forceinline__ unsigned pk2(float lo, float hi) { return f2bf(lo) | (f2bf(hi) << 16); }
__device__ __forceinline__ float bf2f(unsigned b) { return __builtin_bit_cast(float, b << 16); }
__device__ __forceinline__ float bflo(unsigned w) { return __builtin_bit_cast(float, w << 16); }
__device__ __forceinline__ float bfhi(unsigned w) { return __builtin_bit_cast(float, w & 0xffff0000u); }
typedef __bf16 bf16x2_t __attribute__((ext_vector_type(2)));
__device__ __forceinline__ unsigned cvt_pk_bf16(float lo, float hi) { const f32x2 v = {lo, hi}; const bf16x2_t b = __builtin_convertvector(v, bf16x2_t); return __builtin_bit_cast(unsigned, b); }
constexpr float F8_SW = 64.0f, F8_SA = 4.0f, F8_INV = 1.0f / (F8_SW * F8_SA), F8_SY = 32.0f, F8_SO = 64.0f, F8_INVM = 1.0f / (F8_SO * F8_SW);
__device__ __forceinline__ float f8clamp(float v) { return __builtin_amdgcn_fmed3f(v, -448.0f, 448.0f); }
__device__ __forceinline__ unsigned pk4_fp8(float a, float b, float c, float d) { int w = __builtin_amdgcn_cvt_pk_fp8_f32(f8clamp(a), f8clamp(b), 0, false); w = __builtin_amdgcn_cvt_pk_fp8_f32(f8clamp(c), f8clamp(d), w, true); return (unsigned)w; }
template <int CTRL> __device__ __forceinline__ float dpp_f(float v) { return __builtin_bit_cast(float, __builtin_amdgcn_update_dpp(0, __builtin_bit_cast(int, v), CTRL, 0xf, 0xf, false)); }
template <int CTRL> __device__ __forceinline__ int dpp_i(int v) { return __builtin_amdgcn_update_dpp(0, v, CTRL, 0xf, 0xf, false); }
__device__ __forceinline__ float wave_sum(float v) {
    v += dpp_f<0xB1>(v); v += dpp_f<0x4E>(v); v += dpp_f<0x141>(v); v += dpp_f<0x140>(v);
    const float r0 = __builtin_bit_cast(float, __builtin_amdgcn_readlane(__builtin_bit_cast(int, v), 0)), r1 = __builtin_bit_cast(float, __builtin_amdgcn_readlane(__builtin_bit_cast(int, v), 16));
    const float r2 = __builtin_bit_cast(float, __builtin_amdgcn_readlane(__builtin_bit_cast(int, v), 32)), r3 = __builtin_bit_cast(float, __builtin_amdgcn_readlane(__builtin_bit_cast(int, v), 48));
    return (r0 + r1) + (r2 + r3);
}
__device__ __forceinline__ float sigmoidf_(float x) { return __builtin_amdgcn_rcpf(1.0f + __builtin_amdgcn_exp2f(-x * LOG2E)); }

__device__ __forceinline__ void asm_load16(f32x4& dst, const float* p) { asm volatile("global_load_dwordx4 %0, %1, off" : "=v"(dst) : "v"(p) : "memory"); }
namespace pg8 {
constexpr int BM = 256, BK = 64, HALF = 128, HTB = HALF * BK * 2, STAGE_BYTES = 8 * HTB, NXCD = 8, WGM = 8;
__host__ __device__ __forceinline__ int lds_byte(int r, int c) { const int st = (r >> 4) * 2 + (c >> 5), rr = r & 15, cc = c & 31, ob = rr * 64 + cc * 2; return st * 1024 + (ob ^ (((ob >> 9) & 1) << 5)); }
__host__ __device__ __forceinline__ void stage_rc(int b, int& R, int& C) { const int st = b / 1024, sb = b % 1024, swz = sb ^ (((sb >> 9) & 1) << 5); R = (st >> 1) * 16 + swz / 64; C = (st & 1) * 32 + (swz % 64) / 2; }
__host__ __device__ __forceinline__ int perm32(int rho) { const int n = rho >> 4, i = rho & 15; return 8 * (i >> 2) + 4 * n + (i & 3); }

struct Unit { int pm, pn, ex; };

__device__ __forceinline__ void tile_map(int L, int nM, int nN, int& pm, int& pn) {
    const int nwg = nM * nN; int wgid = L;
    { const int q = nwg / NXCD, r = nwg % NXCD, xcd = wgid % NXCD, off = wgid / NXCD; wgid = (xcd < r ? xcd * (q + 1) : r * (q + 1) + (xcd - r) * q) + off; }
    const int nig = WGM * nN, gid = wgid / nig, fm = gid * WGM, gsz = (nM - fm) < WGM ? (nM - fm) : WGM;
    pm = fm + ((wgid % nig) % gsz); pn = (wgid % nig) / gsz;
}

typedef int i32x8 __attribute__((ext_vector_type(8)));
template <class E> struct epi_has_mid { template <class T> static constexpr bool test(decltype(T::MID)*) { return T::MID; } template <class T> static constexpr bool test(...) { return false; } static constexpr bool value = test<E>(nullptr); };
template <class E> struct epi_has_pre { template <class T> static constexpr bool test(decltype(T::PRE)*) { return T::PRE; } template <class T> static constexpr bool test(...) { return false; } static constexpr bool value = test<E>(nullptr); };
template <class Epi, class Sched, bool ALIGN_EPI, bool GATHER, bool F8 = false>
__device__ __forceinline__ void gemm_phase(LAS unsigned char* lds, const int nt, const unsigned lda_b, const unsigned ldb_b, const Sched& S, const Epi& E) {
    int tid = threadIdx.x; asm volatile("" : "+v"(tid));
    const int wid = __builtin_amdgcn_readfirstlane(tid >> 6), lane = tid & 63, wr = wid >> 2, wc = wid & 3, fr = lane & 15, fq = lane >> 4;
    unsigned voffA[2][2], voffB[2], voffAn[2][2]; int sR[2], sC[2];
#pragma unroll
    for (int i = 0; i < 2; ++i) { int R, C; stage_rc(tid * 16 + i * 8192, R, C); sR[i] = R; sC[i] = C; const int Rb = Epi::PERM ? ((R & ~31) + perm32(R & 31)) : R;
        voffB[i] = (unsigned)Rb * ldb_b + (unsigned)C * 2u; voffA[0][i] = (unsigned)R * lda_b + (unsigned)C * 2u; voffA[1][i] = voffA[0][i] + (unsigned)HALF * lda_b; voffAn[0][i] = voffA[0][i]; voffAn[1][i] = voffA[1][i]; }
    const size_t kstep = (size_t)(BK * 2);
    const size_t hstepB = (size_t)HALF * ldb_b;
    const unsigned ldsw = (unsigned)wid * 1024u;
    const int aoff = lds_byte(wr * 64 + fr, fq * 8), boff = lds_byte(wc * 32 + fr, fq * 8);
#define PG8_SA(b, h) (((b) * 2 + (h)) * HTB)
#define PG8_SB(b, h) ((4 + (b) * 2 + (h)) * HTB)
#define PG8_STAGE(bufoff, gbase, voff) do { _Pragma("unroll") for (int _i = 0; _i < 2; ++_i) \
        __builtin_amdgcn_global_load_lds((const unsigned*)((const char*)(gbase) + (voff)[_i]), (LAS unsigned*)(lds + (bufoff) + ldsw + _i * 8192), 16, 0, 0); } while (0)
#define PG8_LDA(dst, b, h) do { if constexpr (F8) { _Pragma("unroll") for (int m = 0; m < 4; ++m) { const u32x4 _lo = *(const LAS u32x4*)(lds + PG8_SA(b, h) + aoff + m * 2048), _hi = *(const LAS u32x4*)(lds + PG8_SA(b, h) + aoff + m * 2048 + 1024); \
        dst##8[m] = (i32x8){(int)_lo.x, (int)_lo.y, (int)_lo.z, (int)_lo.w, (int)_hi.x, (int)_hi.y, (int)_hi.z, (int)_hi.w}; } } else { \
        _Pragma("unroll") for (int m = 0; m < 4; ++m) _Pragma("unroll") for (int k = 0; k < 2; ++k) dst[m][k] = *(const LAS bf16x8*)(lds + PG8_SA(b, h) + aoff + m * 2048 + k * 1024); } } while (0)
#define PG8_LDB(dst, b, h) do { if constexpr (F8) { _Pragma("unroll") for (int n = 0; n < 2; ++n) { const u32x4 _lo = *(const LAS u32x4*)(lds + PG8_SB(b, h) + boff + n * 2048), _hi = *(const LAS u32x4*)(lds + PG8_SB(b, h) + boff + n * 2048 + 1024); \
        dst##8[n] = (i32x8){(int)_lo.x, (int)_lo.y, (int)_lo.z, (int)_lo.w, (int)_hi.x, (int)_hi.y, (int)_hi.z, (int)_hi.w}; } } else { \
        _Pragma("unroll") for (int n = 0; n < 2; ++n) _Pragma("unroll") for (int k = 0; k < 2; ++k) dst[n][k] = *(const LAS bf16x8*)(lds + PG8_SB(b, h) + boff + n * 2048 + k * 1024); } } while (0)
#define PG8_MMA(ai, bj, At, Bt) do { __builtin_amdgcn_s_setprio(1); if constexpr (F8) { _Pragma("unroll") for (int m = 0; m < 4; ++m) _Pragma("unroll") for (int n = 0; n < 2; ++n) \
        asm volatile("v_mfma_scale_f32_16x16x128_f8f6f4 %0, %1, %2, %0, %3, %3 op_sel_hi:[0,0,0]" : "+v"(acc[ai][bj][m][n]) : "v"(Bt##8[n]), "v"(At##8[m]), "v"(f8scale)); } else { \
        _Pragma("unroll") for (int m = 0; m < 4; ++m) _Pragma("unroll") for (int n = 0; n < 2; ++n) _Pragma("unroll") for (int k = 0; k < 2; ++k) \
        acc[ai][bj][m][n] = __builtin_amdgcn_mfma_f32_16x16x32_bf16(Bt[n][k], At[m][k], acc[ai][bj][m][n], 0, 0, 0); } __builtin_amdgcn_s_setprio(0); } while (0)
#define PG8_WAIT_V(n) asm volatile("s_waitcnt vmcnt(" #n ")" ::: "memory")
#define PG8_WAIT_L(n) asm volatile("s_waitcnt lgkmcnt(" #n ")" ::: "memory")
#define PG8_BAR __builtin_amdgcn_s_barrier()
#define PG8_SCHED __builtin_amdgcn_sched_barrier(0)
#define PG8_GATHER(dst, u) do { const int* _ix = S.a_rows(u); _Pragma("unroll") for (int _h = 0; _h < 2; ++_h) _Pragma("unroll") for (int _i = 0; _i < 2; ++_i) \
        dst[_h][_i] = (unsigned)_ix[_h * HALF + sR[_i]] * lda_b + (unsigned)sC[_i] * 2u; } while (0)
#define PG8_GATHER_ISSUE(u) do { const int* _ix = S.a_rows(u); _Pragma("unroll") for (int _h = 0; _h < 2; ++_h) _Pragma("unroll") for (int _i = 0; _i < 2; ++_i) \
        voffAn[_h][_i] = (unsigned)_ix[_h * HALF + sR[_i]]; } while (0)
    Unit cur, nxt; int ui = 0;
    if (!S.next(0, cur)) return;
    constexpr bool PRE = epi_has_pre<Epi>::value; f32x4 pre[4];
    if constexpr (PRE) E.pre(cur, wr, wc, fr, fq, pre);
    f32x4 acc[2][2][4][2];
#pragma unroll
    for (int a = 0; a < 2; ++a)
#pragma unroll
        for (int b = 0; b < 2; ++b)
#pragma unroll
            for (int m = 0; m < 4; ++m)
#pragma unroll
                for (int n = 0; n < 2; ++n) acc[a][b][m][n] = (f32x4){0.f, 0.f, 0.f, 0.f};
    bf16x8 At[4][2], B0[2][2], B1[2][2]; i32x8 At8[4], B08[2], B18[2]; const int f8scale = 0x7f7f7f7f;
    const char* cA = S.a_tile(cur); const char* cB = S.b_tile(cur);
    if constexpr (GATHER) { PG8_GATHER(voffA, cur); }
    PG8_STAGE(PG8_SB(0, 0), cB, voffB); PG8_STAGE(PG8_SB(0, 1), cB + hstepB, voffB); PG8_STAGE(PG8_SA(0, 0), cA, voffA[0]); PG8_STAGE(PG8_SA(0, 1), cA, voffA[1]);
    if (wr == 1) PG8_BAR;
    PG8_WAIT_V(2); PG8_BAR;
    PG8_STAGE(PG8_SB(1, 0), cB + kstep, voffB); PG8_STAGE(PG8_SA(1, 0), cA + kstep, voffA[0]); PG8_STAGE(PG8_SB(1, 1), cB + hstepB + kstep, voffB);
    PG8_WAIT_V(6); PG8_BAR;
    for (;;) {
        const bool has_next = S.next(ui + 1, nxt);
        const char* nA = has_next ? S.a_tile(nxt) : cA; const char* nB = has_next ? S.b_tile(nxt) : cB;
        if constexpr (GATHER) { if (has_next) { PG8_GATHER_ISSUE(nxt); } }
        constexpr bool MIDH = epi_has_mid<Epi>::value;
#pragma nounroll
        for (int kh = 0; kh < (MIDH ? 2 : 1); ++kh) {
        if constexpr (MIDH) { if (kh == 1) E.mid(acc, cur, wr, wc, fr, fq); }
        const int t_lo = MIDH ? kh * (nt >> 1) : 0, t_hi = MIDH ? (kh + 1) * (nt >> 1) : nt;
#pragma nounroll
        for (int t = t_lo; t < t_hi; t += 2) {
            const bool last = (t == nt - 2);
            const char* a1 = cA + (size_t)(t + 1) * kstep;
            const char* a2 = last ? nA : cA + (size_t)(t + 2) * kstep; const char* b2 = last ? nB : cB + (size_t)(t + 2) * kstep;
            const char* a3 = a2 + kstep; const char* b3 = b2 + kstep;
            unsigned v2[2][2];
#pragma unroll
            for (int h = 0; h < 2; ++h)
#pragma unroll
                for (int i = 0; i < 2; ++i) v2[h][i] = voffA[h][i];
            if constexpr (GATHER) { if (last && has_next) {
#pragma unroll
                for (int h = 0; h < 2; ++h)
#pragma unroll
                    for (int i = 0; i < 2; ++i) { voffAn[h][i] = voffAn[h][i] * lda_b + (unsigned)sC[i] * 2u; v2[h][i] = voffAn[h][i]; } } }
            PG8_LDB(B0, 0, 0); PG8_LDB(B1, 0, 1); PG8_SCHED; PG8_LDA(At, 0, 0); PG8_STAGE(PG8_SA(1, 1), a1, voffA[1]);
            PG8_WAIT_V(8); PG8_WAIT_L(0); PG8_BAR; PG8_MMA(0, 0, At, B0); PG8_MMA(0, 1, At, B1); PG8_BAR; PG8_SCHED;
            PG8_LDA(At, 0, 1); PG8_STAGE(PG8_SB(0, 0), b2, voffB); PG8_STAGE(PG8_SB(0, 1), b2 + hstepB, voffB); PG8_STAGE(PG8_SA(0, 0), a2, v2[0]);
            PG8_WAIT_V(8); PG8_WAIT_L(0); PG8_BAR; PG8_MMA(1, 0, At, B0); PG8_MMA(1, 1, At, B1); PG8_BAR; PG8_SCHED;
            PG8_LDB(B0, 1, 0); PG8_LDB(B1, 1, 1); PG8_SCHED; PG8_LDA(At, 1, 0); PG8_STAGE(PG8_SA(0, 1), a2, v2[1]);
            PG8_WAIT_V(8); PG8_WAIT_L(0); PG8_BAR; PG8_MMA(0, 0, At, B0); PG8_MMA(0, 1, At, B1); PG8_BAR; PG8_SCHED;
            PG8_LDA(At, 1, 1); PG8_STAGE(PG8_SB(1, 0), b3, voffB); PG8_STAGE(PG8_SB(1, 1), b3 + hstepB, voffB); PG8_STAGE(PG8_SA(1, 0), a3, v2[0]);
            PG8_WAIT_V(8); PG8_WAIT_L(0); PG8_BAR; PG8_MMA(1, 0, At, B0); PG8_MMA(1, 1, At, B1); PG8_BAR; PG8_SCHED;
        }
        }
        if constexpr (ALIGN_EPI) { if (wr == 0) PG8_BAR; }
        if constexpr (F8) asm volatile("s_nop 15\n\ts_nop 15" ::: "memory");
        if constexpr (PRE) { asm volatile("s_waitcnt vmcnt(16)" ::: "memory"); E(acc, cur, wr, wc, fr, fq, pre); } else E(acc, cur, wr, wc, fr, fq);
        if (!has_next) break;
#pragma unroll
        for (int a = 0; a < 2; ++a)
#pragma unroll
            for (int b = 0; b < 2; ++b)
#pragma unroll
                for (int m = 0; m < 4; ++m)
#pragma unroll
                    for (int n = 0; n < 2; ++n) acc[a][b][m][n] = (f32x4){0.f, 0.f, 0.f, 0.f};
        cur = nxt; cA = nA; cB = nB; ++ui;
        if constexpr (PRE) E.pre(cur, wr, wc, fr, fq, pre);
        if constexpr (GATHER) {
#pragma unroll
            for (int h = 0; h < 2; ++h)
#pragma unroll
                for (int i = 0; i < 2; ++i) voffA[h][i] = voffAn[h][i]; }
        if constexpr (ALIGN_EPI) { if (wr == 1) PG8_BAR; }
    }
    PG8_WAIT_V(0);
    if constexpr (!ALIGN_EPI) { if (wr == 0) PG8_BAR; }
    PG8_BAR;
#undef PG8_SA
#undef PG8_SB
#undef PG8_STAGE
#undef PG8_LDA
#undef PG8_LDB
#undef PG8_MMA
#undef PG8_WAIT_V
#undef PG8_WAIT_L
#undef PG8_BAR
#undef PG8_SCHED
#undef PG8_GATHER
}
}

#define XB_TMO      128
#define XB_XCNT(j)  (256  + 64 * (j))
#define XB_XSUB(j)  (1280 + 64 * (j))
#define XB_XGEN(j)  (2304 + 64 * (j))
#define XB_TOP      3328
#define XB_TOPGEN   3392
#define XCD_BAR_WORDS 3456
#define XB_SPIN_CAP (1u << 18)
__device__ __forceinline__ unsigned xb_ld(unsigned* p)              { return __hip_atomic_load(p, __ATOMIC_RELAXED, __HIP_MEMORY_SCOPE_AGENT); }
__device__ __forceinline__ unsigned xb_add(unsigned* p, unsigned v) { return __hip_atomic_fetch_add(p, v, __ATOMIC_RELAXED, __HIP_MEMORY_SCOPE_AGENT); }
__device__ __forceinline__ unsigned xb_xcc_id() { return (unsigned)__builtin_amdgcn_s_getreg((3 << 11) | 20) & 0xFu; }
#define XB_SPIN(cond, bar) do { unsigned _sp = 0; while (cond) { __builtin_amdgcn_s_sleep(1); \
    if ((++_sp & 255u) == 0u) { if (xb_ld(&(bar)[XB_TMO])) break; if (_sp > XB_SPIN_CAP) { atomicAdd(&(bar)[XB_TMO], 1u); break; } } } } while (0)
struct XcdBarrier { unsigned* bar; unsigned x; volatile LAS unsigned* st; };
__device__ __forceinline__ XcdBarrier xcd_barrier_post(unsigned* bar, volatile LAS unsigned* st) {
    XcdBarrier b; b.bar = bar; b.x = xb_xcc_id(); b.st = st;
    if (threadIdx.x == 0) (void)xb_add(&bar[XB_XCNT(b.x)], 1u);
    return b;
}
__device__ __forceinline__ void xcd_barrier_complete(unsigned* bar, unsigned x, unsigned& nloc, unsigned& nx) {
    const unsigned G = gridDim.x * gridDim.y * gridDim.z;
    unsigned sum, cnt, mine, sp = 0u;
    for (;;) {
        sum = 0u; cnt = 0u; mine = 0u;
#pragma unroll
        for (unsigned j = 0; j < 16; ++j) { const unsigned c = xb_ld(&bar[XB_XCNT(j)]); sum += c; cnt += (c > 0u) ? 1u : 0u; mine = (j == x) ? c : mine; }
        if (sum == G) break;
        __builtin_amdgcn_s_sleep(1);
        if ((++sp & 255u) == 0u) { if (xb_ld(&bar[XB_TMO])) break; if (sp > XB_SPIN_CAP) { atomicAdd(&bar[XB_TMO], 1u); break; } }
    }
    nloc = mine > 0u ? mine : 1u; nx = cnt > 0u ? cnt : 1u;
}
__device__ __forceinline__ void xcd_barrier(const XcdBarrier& b) {
    asm volatile("s_waitcnt vmcnt(0)" ::: "memory");
    __syncthreads();
    if (threadIdx.x == 0) {
        unsigned* bar = b.bar;
        __builtin_amdgcn_s_waitcnt(0);
        unsigned nloc = b.st[0], nx = b.st[1];
        if (nloc == 0u) { xcd_barrier_complete(bar, b.x, nloc, nx); b.st[0] = nloc; b.st[1] = nx; }
        const unsigned old = xb_add(&bar[XB_XSUB(b.x)], 1u);
        const unsigned gen = old / nloc;
        if (old + 1u == (gen + 1u) * nloc) {
            __builtin_amdgcn_fence(__ATOMIC_RELEASE, "agent");
            asm volatile("s_waitcnt vmcnt(0)" ::: "memory");
            const unsigned og = xb_add(&bar[XB_TOP], 1u);
            const unsigned tg = og / nx;
            if (og + 1u == (tg + 1u) * nx) xb_add(&bar[XB_TOPGEN], 1u);
            else XB_SPIN(xb_ld(&bar[XB_TOPGEN]) == tg, bar);
            __builtin_amdgcn_fence(__ATOMIC_ACQUIRE, "agent");
            xb_add(&bar[XB_XGEN(b.x)], 1u);
            asm volatile("s_waitcnt vmcnt(0)" ::: "memory");
        } else {
            XB_SPIN(xb_ld(&bar[XB_XGEN(b.x)]) == gen, bar);
            __builtin_amdgcn_fence(__ATOMIC_ACQUIRE, "agent");
            asm volatile("s_waitcnt vmcnt(0)" ::: "memory");
        }
    }
    __syncthreads();
}

struct Frame {
    LAS unsigned char* lds;
    volatile LAS unsigned* MISC;
    gu32* ctl;
    int tid, lane, wave, vcu, G;
    unsigned char* ws;
    const float *x, *c, *ctx, *c_ctx, *w_ada, *b_ada, *norm1_g, *norm2_g, *w_in, *mla_q_a_g, *mla_kv_a_g, *w_q_up, *w_kv_up, *mla_q_g, *mla_k_g, *swa_q_g, *swa_k_g, *swa_sink,
        *w_branch_a, *w_branch_b, *w_out, *w_router, *b_router, *w_gate_up, *b_gate_up, *w_down, *b_down;
    float* out;
};
#define WSP(T, off) ((T*)(F.ws + (off)))
#define CAS __attribute__((address_space(4)))
__device__ __forceinline__ void frame_load(Frame& F) {
    const CAS unsigned long long* a = (const CAS unsigned long long*)__builtin_amdgcn_kernarg_segment_ptr();
    asm volatile("" : "+s"(a));
    { int t = threadIdx.x; asm volatile("" : "+v"(t)); F.tid = t; F.lane = t & 63; }
    F.x = (const float*)a[0]; F.c = (const float*)a[1]; F.ctx = (const float*)a[2]; F.c_ctx = (const float*)a[3]; F.w_ada = (const float*)a[4]; F.b_ada = (const float*)a[5]; F.norm1_g = (const float*)a[6];
    F.norm2_g = (const float*)a[7]; F.w_in = (const float*)a[8]; F.mla_q_a_g = (const float*)a[9]; F.mla_kv_a_g = (const float*)a[10]; F.w_q_up = (const float*)a[11]; F.w_kv_up = (const float*)a[12];
    F.mla_q_g = (const float*)a[13]; F.mla_k_g = (const float*)a[14]; F.swa_q_g = (const float*)a[15]; F.swa_k_g = (const float*)a[16]; F.swa_sink = (const float*)a[17]; F.w_branch_a = (const float*)a[18];
    F.w_branch_b = (const float*)a[19]; F.w_out = (const float*)a[20]; F.w_router = (const float*)a[21]; F.b_router = (const float*)a[22]; F.w_gate_up = (const float*)a[23]; F.b_gate_up = (const float*)a[24];
    F.w_down = (const float*)a[25]; F.b_down = (const float*)a[26]; F.out = (float*)a[27]; F.ws = (unsigned char*)a[28];
}

__device__ __forceinline__ void tr_item(const float* W, int N, int k0, int sc0, int sstride, bf16* WT, int K, const float* gain, LAS float* scr, int lane, int rperm = 0) {
    { const GAS float* wp = (const GAS float*)W + (size_t)(k0 + (lane >> 5)) * N + sc0 + (lane & 31) * sstride; const GAS float* gp = (const GAS float*)gain + k0 + (lane >> 5);
#pragma nounroll
      for (int i0 = 0; i0 < 32; i0 += 16) { float tv[16], gv[16];
#pragma unroll
          for (int i = 0; i < 16; ++i) { tv[i] = wp[(size_t)(2 * (i0 + i)) * N]; gv[i] = gain ? gp[2 * (i0 + i)] : 1.0f; }
          asm volatile("" ::: "memory");
#pragma unroll
          for (int i = 0; i < 16; ++i) scr[(2 * (i0 + i) + (lane >> 5)) * 33 + (lane & 31)] = tv[i] * gv[i]; } }
    LDS_WAIT(); asm volatile("" ::: "memory");
    const int c = lane & 7;
#pragma unroll
    for (int j = 0; j < 4; ++j) { const int n = (lane >> 3) + 8 * j; const int nc = rperm == 1 ? (16 * ((n >> 2) & 1) + 4 * (n >> 3) + (n & 3)) : rperm == 2 ? (16 * ((n >> 2) & 1) + 8 * ((n >> 1) & 1) + 2 * (n >> 3) + (n & 1)) : n; const LAS float* s = scr + (8 * c) * 33 + nc;
        u32x4 o; o.x = pk2(s[0 * 33], s[1 * 33]); o.y = pk2(s[2 * 33], s[3 * 33]); o.z = pk2(s[4 * 33], s[5 * 33]); o.w = pk2(s[6 * 33], s[7 * 33]);
        *(u32x4*)(WT + (size_t)n * K + k0 + 8 * c) = o; }
    LDS_WAIT(); asm volatile("" ::: "memory");
}
template <bool RPERM = false, int NB = 16>
__device__ __forceinline__ void tr_item8(const float* W, int N, int k0, int sc0, int sstride, unsigned char* WT, int K, LAS float* scr, int lane) {
    const float* wp = W + (size_t)(k0 + (lane >> 5)) * N + sc0 + (lane & 31) * sstride;
#pragma nounroll
    for (int i0 = 0; i0 < 32; i0 += NB) { float tv[NB];
#pragma unroll
        for (int i = 0; i < NB; ++i) tv[i] = wp[(size_t)(2 * (i0 + i)) * N];
#pragma unroll
        for (int i = 0; i < NB; ++i) scr[(2 * (i0 + i) + (lane >> 5)) * 33 + (lane & 31)] = tv[i] * F8_SW; }
    LDS_WAIT(); asm volatile("" ::: "memory");
    const int c = lane & 3;
#pragma unroll
    for (int j = 0; j < 2; ++j) { const int n = (lane >> 2) + 16 * j; const int ncol = RPERM ? (16 * ((n >> 2) & 1) + 4 * (n >> 3) + (n & 3)) : n; const LAS float* s = scr + (16 * c) * 33 + ncol;
        u32x4 o; o.x = pk4_fp8(s[0 * 33], s[1 * 33], s[2 * 33], s[3 * 33]); o.y = pk4_fp8(s[4 * 33], s[5 * 33], s[6 * 33], s[7 * 33]);
        o.z = pk4_fp8(s[8 * 33], s[9 * 33], s[10 * 33], s[11 * 33]); o.w = pk4_fp8(s[12 * 33], s[13 * 33], s[14 * 33], s[15 * 33]);
        *(u32x4*)(WT + (size_t)n * K + k0 + 16 * c) = o; }
    LDS_WAIT(); asm volatile("" ::: "memory");
}
template <bool INTER>
__device__ __forceinline__ void tr_item8w(const float* W, int N, int k0, int sc0, unsigned char* WT, int K, LAS float* scr, int lane) {
    const float* wp = W + (size_t)(k0 + (lane >> 4)) * N + sc0 + (lane & 15) * 4;
    f32x4 tv[8];
#pragma unroll
    for (int i = 0; i < 8; ++i) tv[i] = *(const f32x4*)(wp + (size_t)(4 * i) * N);
#pragma unroll
    for (int i = 0; i < 8; ++i) { LAS float* sp = scr + (4 * i + (lane >> 4)) * 65 + (lane & 15) * 4; sp[0] = tv[i][0] * F8_SW; sp[1] = tv[i][1] * F8_SW; sp[2] = tv[i][2] * F8_SW; sp[3] = tv[i][3] * F8_SW; }
    LDS_WAIT(); asm volatile("" ::: "memory");
    const int col = INTER ? (2 * (lane & 31) + (lane >> 5)) : lane, drow = INTER ? ((lane & 31) + 128 * (lane >> 5)) : lane;
#pragma unroll
    for (int ch = 0; ch < 2; ++ch) { const LAS float* sr = scr + (16 * ch) * 65 + col;
        u32x4 o; o.x = pk4_fp8(sr[0 * 65], sr[1 * 65], sr[2 * 65], sr[3 * 65]); o.y = pk4_fp8(sr[4 * 65], sr[5 * 65], sr[6 * 65], sr[7 * 65]);
        o.z = pk4_fp8(sr[8 * 65], sr[9 * 65], sr[10 * 65], sr[11 * 65]); o.w = pk4_fp8(sr[12 * 65], sr[13 * 65], sr[14 * 65], sr[15 * 65]);
        *(u32x4*)(WT + (size_t)drow * K + k0 + 16 * ch) = o; }
    LDS_WAIT(); asm volatile("" ::: "memory");
}
__device__ __forceinline__ int win_src(int d) {
    if (MK_FUSE3) { if (d >= 256 && d < 512) { const int t = d - 256; return 288 + 64 * ((t >> 5) & 3) + 32 * (t >> 7); }
                    if (d >= 1024 && d < 1536) { const int t = d - 1024; return 928 + 64 * (4 * (t >> 8) + ((t >> 5) & 3)) + 32 * ((t >> 7) & 1); } }
    if (d < 256) return d; if (d < 384) return d - 256 + 288; if (d < 512) return d - 384 + 416; if (d < 896) return d - 512 + 544;
    if (d < 928) return d - 896 + 256; if (d < 1024) return -1; if (d < 1536) return d - 1024 + 928; if (d < 2560) return d - 1536 + 1440; return d - 2560 + 2464;
}
__device__ __forceinline__ void p0_experts(Frame& F);
__device__ __forceinline__ void p0_prologue(Frame& F) {
    LAS float* scr = (LAS float*)(F.lds + F.wave * 16384);
    const int gw = F.vcu * NWAVES + F.wave, NGW = F.G * NWAVES;
    constexpr int I_ADA = 768, I_TRIG = 24, I_WIN = 16 * 112, I_WKV = 4 * 32, I_WQ = 6 * (MK_FUSE5 ? 32 : 24), I_WB = 8 * 32, I_WOUT = 16 * 32, I_WGU = NE * 16 * 64, I_WDN = NE * 16 * 32;
    constexpr int NITEMS = I_ADA + I_TRIG + I_WIN + I_WKV + I_WQ + 2 * I_WB + I_WOUT;
    for (int it = gw; it < NITEMS; it += NGW) {
        const int lane = F.lane;
        int r = it;
        if (r < I_ADA) {
            const int cg = r % 96, kc = r / 96, k0 = kc * 128, col = cg * 64 + lane;
            float cv18[18];
#pragma unroll
            for (int j = 0; j < 18; ++j) { const int idx = j * 64 + lane, rr = idx >> 7, kk = idx & 127; cv18[j] = (rr < 8) ? ((const GAS float*)F.c)[rr * D + k0 + kk] : ((const GAS float*)F.c_ctx)[k0 + kk]; }
            asm volatile("" ::: "memory");
#pragma unroll
            for (int j = 0; j < 18; ++j) { const float v = cv18[j]; scr[j * 64 + lane] = v / (1.0f + __expf(-v)); }
            LDS_WAIT(); asm volatile("" ::: "memory");
            float acc[9];
#pragma unroll
            for (int q = 0; q < 9; ++q) acc[q] = 0.f;
            { const GAS float* wp0 = (const GAS float*)F.w_ada + (size_t)k0 * NMOD + col; float wa[16], wb[16];
#define ADA_LD(dst, kk) do { _Pragma("unroll") for (int u = 0; u < 16; ++u) dst[u] = wp0[(size_t)((kk) + u) * NMOD]; asm volatile("" ::: "memory"); } while (0)
#define ADA_MM(src, kk) do { _Pragma("unroll") for (int u4 = 0; u4 < 4; ++u4) _Pragma("unroll") for (int q = 0; q < 9; ++q) { const f32x4 sv = *(const LAS f32x4*)(scr + q * 128 + (kk) + 4 * u4); \
                  acc[q] += sv[0] * src[4 * u4] + sv[1] * src[4 * u4 + 1] + sv[2] * src[4 * u4 + 2] + sv[3] * src[4 * u4 + 3]; } } while (0)
              ADA_LD(wa, 0);
#pragma unroll
              for (int kk0 = 0; kk0 < 128; kk0 += 32) { ADA_LD(wb, kk0 + 16); ADA_MM(wa, kk0); if (kk0 + 32 < 128) ADA_LD(wa, kk0 + 32); ADA_MM(wb, kk0 + 16); }
#undef ADA_LD
#undef ADA_MM
            }
            float* mp = WSP(float, WS_MODP);
#pragma unroll
            for (int q = 0; q < 9; ++q) mp[(size_t)(kc * 9 + q) * NMOD + col] = acc[q];
            LDS_WAIT(); asm volatile("" ::: "memory");
            continue;
        } r -= I_ADA;
        if (r < I_TRIG) {
            float* ts = WSP(float, WS_TRIG); const int i = r * 64 + lane;
            if (i < 1024) { const int pos = i >> 4, f = i & 15; const float fr = exp2f(-13.287712379549449f * (float)f / 16.0f), a = (float)pos * fr; ts[i] = __cosf(a); ts[1024 + i] = __sinf(a); }
            else { const int j = i - 1024, pos = j >> 3, f = j & 7; const float fr = exp2f(-13.287712379549449f * (float)f / 8.0f), a = (float)pos * fr; ts[2048 + j] = __cosf(a); ts[2560 + j] = __sinf(a); }
            continue;
        } r -= I_TRIG;
        if (r < I_WIN) { const int kb = r / 112, db = r % 112, d0 = db * 32, sc = win_src(d0);
            if (MK_F8IN) { unsigned char* wt = WSP(unsigned char, WS_WIN) + (size_t)d0 * D;
                const bool rp = MK_FUSE3 && ((d0 >= 256 && d0 < 512) || (d0 >= 1024 && d0 < 1536));
                if (sc >= 0) { if (rp) tr_item8<true>(F.w_in, IN_COLS, kb * 64, sc, 1, wt, D, scr, lane); else tr_item8<false>(F.w_in, IN_COLS, kb * 64, sc, 1, wt, D, scr, lane); }
                else { const int c = lane & 3;
#pragma unroll
                    for (int j = 0; j < 2; ++j) { const int n = (lane >> 2) + 16 * j; *(u32x4*)(wt + (size_t)n * D + kb * 64 + 16 * c) = (u32x4){0u, 0u, 0u, 0u}; } }
            } else { bf16* wt = WSP(bf16, WS_WIN) + (size_t)d0 * D;
                const bool rp = MK_FUSE3 && ((d0 >= 256 && d0 < 512) || (d0 >= 1024 && d0 < 1536));
                if (sc >= 0) tr_item(F.w_in, IN_COLS, kb * 64, sc, 1, wt, D, nullptr, scr, lane, rp ? 1 : 0);
                else { const int c = lane & 7;
#pragma unroll
                    for (int j = 0; j < 4; ++j) { const int n = (lane >> 3) + 8 * j; *(u32x4*)(wt + (size_t)n * D + kb * 64 + 8 * c) = (u32x4){0u, 0u, 0u, 0u}; } } }
            continue; } r -= I_WIN;
        if (r < I_WKV) { const int kb = r / 32, db = r % 32; int sc = db * 32;
            if (MK_FUSE5) { const int d0 = db * 32, pn = d0 >> 8, t = d0 & 255, bj = t >> 7, wc = (t >> 5) & 3; sc = 128 * (2 * pn + (wc >> 1)) + 64 * (wc & 1) + 32 * bj; }
            tr_item(F.w_kv_up, 1024, kb * 64, sc, 1, WSP(bf16, WS_WKV) + (size_t)db * 32 * 256, 256, F.mla_kv_a_g, scr, lane); continue; } r -= I_WKV;
        if (r < I_WQ) {
            if (MK_FUSE5) { const int kb = r / 32, db = r % 32, d0 = db * 32, pn = d0 >> 8, t = d0 & 255, bj = t >> 7, wc = (t >> 5) & 3, head = 2 * pn + (wc >> 1); bf16* wt = WSP(bf16, WS_WQ) + (size_t)d0 * 384;
                if ((wc & 1) == 0) tr_item(F.w_q_up, 768, kb * 64, 96 * head + 32 * bj, 1, wt, 384, F.mla_q_a_g, scr, lane);
                else if (bj == 0) tr_item(F.w_q_up, 768, kb * 64, 96 * head + 64, 1, wt, 384, F.mla_q_a_g, scr, lane, 2);
                else { const int c = lane & 7;
#pragma unroll
                    for (int j = 0; j < 4; ++j) { const int n = (lane >> 3) + 8 * j; *(u32x4*)(wt + (size_t)n * 384 + kb * 64 + 8 * c) = (u32x4){0u, 0u, 0u, 0u}; } }
            } else { const int kb = r / 24, db = r % 24; tr_item(F.w_q_up, 768, kb * 64, db * 32, 1, WSP(bf16, WS_WQ) + (size_t)db * 32 * 384, 384, F.mla_q_a_g, scr, lane); }
            continue; } r -= I_WQ;
        if (r < I_WB) { const int kb = r / 32, db = r % 32; if (MK_F8MID && MK_MERGE78) tr_item8(F.w_branch_a, 1024, kb * 64, db * 32, 1, WSP(unsigned char, WS_WBA) + (size_t)db * 32 * 1024, 1024, scr, lane);
            else if (MK_F8MID) tr_item8(F.w_branch_a, 1024, kb * 64, db * 32, 1, WSP(unsigned char, WS_WBA) + (size_t)db * 32 * 512, 512, scr, lane);
            else tr_item(F.w_branch_a, 1024, kb * 64, db * 32, 1, WSP(bf16, WS_WBA) + (size_t)db * 32 * 512, 512, nullptr, scr, lane); continue; } r -= I_WB;
        if (r < I_WB) { const int kb = r / 32, db = r % 32; if (MK_F8MID && MK_MERGE78) tr_item8(F.w_branch_b, 1024, kb * 64, db * 32, 1, WSP(unsigned char, WS_WBA) + (size_t)db * 32 * 1024 + 512, 1024, scr, lane);
            else if (MK_F8MID) tr_item8(F.w_branch_b, 1024, kb * 64, db * 32, 1, WSP(unsigned char, WS_WBB) + (size_t)db * 32 * 512, 512, scr, lane);
            else tr_item(F.w_branch_b, 1024, kb * 64, db * 32, 1, WSP(bf16, WS_WBB) + (size_t)db * 32 * 512, 512, nullptr, scr, lane); continue; } r -= I_WB;
        if (r < I_WOUT) { const int kb = r / 32, db = r % 32; if (MK_F8MID) tr_item8(F.w_out, 1024, kb * 64, db * 32, 1, WSP(unsigned char, WS_WOUT) + (size_t)db * 32 * 1024, 1024, scr, lane);
            else tr_item(F.w_out, 1024, kb * 64, db * 32, 1, WSP(bf16, WS_WOUT) + (size_t)db * 32 * 1024, 1024, nullptr, scr, lane); continue; } r -= I_WOUT;
    }
    if (!MK_XOVL) p0_experts(F);
}
struct XItem { const float* wp; size_t rstep; unsigned char* dst; };
__device__ __forceinline__ XItem x_item(Frame& F, int r, int lane) {
    constexpr int I_WGU = NE * 16 * 64; XItem I;
    if (r < I_WGU) { const int e = r / 1024, q = r % 1024, kb = q / 64, db = q % 64, d0 = db * 32, pn = d0 >> 8, bj = (d0 >> 7) & 1, x0 = d0 & 127;
        I.wp = F.w_gate_up + (size_t)e * 1024 * 2048 + (size_t)(kb * 64 + (lane >> 5)) * 2048 + 2 * (128 * pn + x0) + bj + (lane & 31) * 2; I.rstep = 2 * 2048;
        I.dst = WSP(unsigned char, WS_WGU) + ((size_t)e * 2048 + d0) * 1024 + kb * 64; }
    else { r -= I_WGU; const int e = r / 512, q = r % 512, kb = q / 32, db = q % 32;
        I.wp = F.w_down + (size_t)e * 1024 * 1024 + (size_t)(kb * 64 + (lane >> 5)) * 1024 + db * 32 + (lane & 31); I.rstep = 2 * 1024;
        I.dst = WSP(unsigned char, WS_WDN) + ((size_t)e * 1024 + db * 32) * 1024 + kb * 64; }
    return I;
}
__device__ __forceinline__ void x_load(const XItem& I, float (&tv)[32]) {
#pragma unroll
    for (int i = 0; i < 32; ++i) tv[i] = I.wp[(size_t)i * I.rstep];
}
__device__ __forceinline__ void x_finish(const XItem& I, float (&tv)[32], LAS float* scr, int lane) {
#pragma unroll
    for (int i = 0; i < 32; ++i) scr[(2 * i + (lane >> 5)) * 33 + (lane & 31)] = tv[i] * F8_SW;
    LDS_WAIT(); asm volatile("" ::: "memory");
    const int c = lane & 3;
#pragma unroll
    for (int j = 0; j < 2; ++j) { const int n = (lane >> 2) + 16 * j; const LAS float* s = scr + (16 * c) * 33 + n;
        u32x4 o; o.x = pk4_fp8(s[0 * 33], s[1 * 33], s[2 * 33], s[3 * 33]); o.y = pk4_fp8(s[4 * 33], s[5 * 33], s[6 * 33], s[7 * 33]);
        o.z = pk4_fp8(s[8 * 33], s[9 * 33], s[10 * 33], s[11 * 33]); o.w = pk4_fp8(s[12 * 33], s[13 * 33], s[14 * 33], s[15 * 33]);
        *(u32x4*)(I.dst + (size_t)n * 1024 + 16 * c) = o; }
    LDS_WAIT(); asm volatile("" ::: "memory");
}
__device__ __forceinline__ void p0_experts(Frame& F) {
    int lane0 = F.lane, wv = F.wave; asm volatile("" : "+v"(lane0), "+s"(wv));
    LAS float* scr = (LAS float*)(F.lds + wv * 16384);
    const int gw = F.vcu * NWAVES + wv, NGW = F.G * NWAVES;
    constexpr int I_WGU = NE * 16 * 64, I_WDN = NE * 16 * 32;
    if (MK_F8 && !MK_WIDE && MK_XPIPE) {
        const int lane = lane0; int it = gw; if (it >= I_WGU + I_WDN) return;
        float ta[32], tb[32]; XItem A = x_item(F, it, lane), B = A; x_load(A, ta);
#pragma nounroll
        for (;;) {
            const int itb = it + NGW; const bool hb = itb < I_WGU + I_WDN; if (hb) { B = x_item(F, itb, lane); x_load(B, tb); }
            x_finish(A, ta, scr, lane); if (!hb) break;
            it = itb + NGW; const bool ha = it < I_WGU + I_WDN; if (ha) { A = x_item(F, it, lane); x_load(A, ta); }
            x_finish(B, tb, scr, lane); if (!ha) break;
        }
        return;
    }
    for (int it = gw; it < I_WGU + I_WDN; it += NGW) {
        const int lane = lane0; int r = it;
        if (r < I_WGU) {
            if (MK_F8 && MK_WIDE) {
                const int e = r / 1024, q = r % 1024, kb = q / 32, cb = q % 32, j0 = 32 * cb, pn = j0 >> 7, x0 = j0 & 127;
                tr_item8w<true>(F.w_gate_up + (size_t)e * 1024 * 2048, 2048, kb * 32, 64 * cb, WSP(unsigned char, WS_WGU) + ((size_t)e * 2048 + 256 * pn + x0) * 1024, 1024, scr, lane);
            } else if (MK_F8) { const int e = r / 1024, q = r % 1024, kb = q / 64, db = q % 64, d0 = db * 32, pn = d0 >> 8, bj = (d0 >> 7) & 1, x0 = d0 & 127;
                tr_item8<false, MK_XNB>(F.w_gate_up + (size_t)e * 1024 * 2048, 2048, kb * 64, 2 * (128 * pn + x0) + bj, 2, WSP(unsigned char, WS_WGU) + ((size_t)e * 2048 + d0) * 1024, 1024, scr, lane);
            } else { const int e = r / 1024, q = r % 1024, kb = q / 64, db = q % 64, d0 = db * 32, pn = d0 >> 8, bj = (d0 >> 7) & 1, x0 = d0 & 127;
                tr_item(F.w_gate_up + (size_t)e * 1024 * 2048, 2048, kb * 64, 2 * (128 * pn + x0) + bj, 2, WSP(bf16, WS_WGU) + ((size_t)e * 2048 + d0) * 1024, 1024, nullptr, scr, lane); }
            continue; } r -= I_WGU;
        { if (MK_F8 && MK_WIDE) { const int e = r / 512, q = r % 512, kb = q / 16, cb = q % 16;
              tr_item8w<false>(F.w_down + (size_t)e * 1024 * 1024, 1024, kb * 32, 64 * cb, WSP(unsigned char, WS_WDN) + ((size_t)e * 1024 + 64 * cb) * 1024, 1024, scr, lane); }
          else if (MK_F8) { const int e = r / 512, q = r % 512, kb = q / 32, db = q % 32;
              tr_item8<false, MK_XNB>(F.w_down + (size_t)e * 1024 * 1024, 1024, kb * 64, db * 32, 1, WSP(unsigned char, WS_WDN) + ((size_t)e * 1024 + db * 32) * 1024, 1024, scr, lane); }
          else { const int e = r / 512, q = r % 512, kb = q / 32, db = q % 32;
              tr_item(F.w_down + (size_t)e * 1024 * 1024, 1024, kb * 64, db * 32, 1, WSP(bf16, WS_WDN) + ((size_t)e * 1024 + db * 32) * 1024, 1024, nullptr, scr, lane); } }
    }
}

__device__ __forceinline__ void p1_norm1(Frame& F) {
    LAS float* AS = (LAS float*)F.lds;
    LAS float* CS = AS + 2048;
    const int b = blockIdx.x, bb = b >> 5; const float* mp = WSP(float, WS_MODP);
    { const GAS float* gmp = (const GAS float*)mp; const GAS float* gba = (const GAS float*)F.b_ada; const GAS float* gg1 = (const GAS float*)F.norm1_g;
#pragma unroll
      for (int h = 0; h < 2; ++h) { float pv[4][9], gv[4];
#pragma unroll
          for (int u = 0; u < 4; ++u) { const int i = F.tid + 512 * (4 * h + u), which = i >> 11, isscale = (i >> 10) & 1, col = i & 1023, rr = which ? 8 : bb, mc = isscale * 1024 + col;
              pv[u][8] = gba[mc]; gv[u] = gg1[col];
#pragma unroll
              for (int kc = 0; kc < 8; ++kc) pv[u][kc] = gmp[(size_t)(kc * 9 + rr) * NMOD + mc]; }
          asm volatile("" ::: "memory");
#pragma unroll
          for (int u = 0; u < 4; ++u) { const int i = F.tid + 512 * (4 * h + u), which = i >> 11, isscale = (i >> 10) & 1, col = i & 1023; float sacc = pv[u][8];
#pragma unroll
              for (int kc = 0; kc < 8; ++kc) sacc += pv[u][kc];
              if (isscale) AS[which * 1024 + col] = gv[u] * (1.0f + sacc); else CS[which * 1024 + col] = sacc; } } }
    if (F.tid < 216) { const int rr = F.tid / 24, mc = 24 * b + F.tid % 24; float s = F.b_ada[mc];
#pragma unroll
        for (int kc = 0; kc < 8; ++kc) s += mp[(size_t)(kc * 9 + rr) * NMOD + mc];
        WSP(float, WS_MOD)[rr * NMOD + mc] = s; }
    __syncthreads();
    bf16* H = WSP(bf16, WS_H);
    const GAS float* gx = (const GAS float*)F.x; GAS unsigned char* gH = (GAS unsigned char*)H; const int lane = F.lane;
#define P1_ROW(v, row, a, c) do { float ss = 0.f; _Pragma("unroll") for (int q = 0; q < 4; ++q) ss += (v[q].x * v[q].x + v[q].y * v[q].y) + (v[q].z * v[q].z + v[q].w * v[q].w); \
        const float rstd = rsqrtf(wave_sum(ss) * (1.0f / D) + EPS); \
        _Pragma("unroll") for (int q = 0; q < 4; ++q) { const f32x4 av = *(const LAS f32x4*)((a) + 4 * lane + 256 * q), cv = *(const LAS f32x4*)((c) + 4 * lane + 256 * q); \
            const float h0 = v[q].x * rstd * av.x + cv.x, h1 = v[q].y * rstd * av.y + cv.y, h2v = v[q].z * rstd * av.z + cv.z, h3 = v[q].w * rstd * av.w + cv.w; \
            if (MK_F8IN) *(GAS unsigned*)(gH + (size_t)(row) * D + 4 * lane + 256 * q) = pk4_fp8(h0 * F8_SA, h1 * F8_SA, h2v * F8_SA, h3 * F8_SA); \
            else { u32x2 o; o.x = pk2(h0, h1); o.y = pk2(h2v, h3); *(GAS u32x2*)((GAS bf16*)gH + (size_t)(row) * D + 4 * lane + 256 * q) = o; } } } while (0)
    { f32x4 vc[4]; const GAS float* xr = (const GAS float*)F.ctx + (size_t)(8 * b + F.wave) * D;
#pragma unroll
      for (int q = 0; q < 4; ++q) vc[q] = *(const GAS f32x4*)(xr + 4 * lane + 256 * q);
      P1_ROW(vc, MTOK + 8 * b + F.wave, AS + 1024, CS + 1024); }
#pragma nounroll
    for (int j0 = 0; j0 < 16; j0 += MK_P1R) {
        f32x4 v[MK_P1R][4];
#pragma unroll
        for (int t = 0; t < MK_P1R; ++t) { const GAS float* xr = gx + (size_t)(128 * b + 16 * F.wave + j0 + t) * D;
#pragma unroll
            for (int q = 0; q < 4; ++q) v[t][q] = *(const GAS f32x4*)(xr + 4 * lane + 256 * q); }
        asm volatile("" ::: "memory");
#pragma unroll
        for (int t = 0; t < MK_P1R; ++t) P1_ROW(v[t], 128 * b + 16 * F.wave + j0 + t, AS, CS);
    }
#undef P1_ROW
}

struct SchedInProj {
    int G, c; const char* A; const char* Bt;
    __device__ __forceinline__ bool next(int i, pg8::Unit& u) const { int L = i * G + c; constexpr int NU = 24 + 128 * 14; if (MK_REPU == 2) { if (L >= 2 * NU) return false; L %= NU; } else if (L >= NU) return false;
        if (L < 24) { u.pm = 128 + L / 3; const int s = L % 3; u.pn = (s == 2) ? 3 : s; }
        else if (MK_FUSE3 && L < 24 + 128 * 3) { int pn; pg8::tile_map(L - 24, 128, 3, u.pm, pn); u.pn = pn == 0 ? 1 : 3 + pn; }
        else if (MK_FUSE3) { int pn; pg8::tile_map(L - 24 - 128 * 3, 128, 11, u.pm, pn); u.pn = pn == 0 ? 0 : pn < 3 ? pn + 1 : pn + 3; }
        else pg8::tile_map(L - 24, 128, 14, u.pm, u.pn);
        u.ex = 0; return true; }
    __device__ __forceinline__ const char* a_tile(const pg8::Unit& u) const { return A + (size_t)u.pm * 256 * (D * (MK_F8IN ? 1 : 2)); }
    __device__ __forceinline__ const char* b_tile(const pg8::Unit& u) const { return Bt + (size_t)u.pn * 256 * (D * (MK_F8IN ? 1 : 2)); }
    __device__ __forceinline__ const int* a_rows(const pg8::Unit&) const { return nullptr; }
};
struct SchedDense {
    int G, c, nM, nN; const char* A; const char* Bt; size_t a_tstep, b_tstep; int rep = 1;
    __device__ __forceinline__ bool next(int i, pg8::Unit& u) const { int L = i * G + c; if (L >= rep * nM * nN) return false; L %= nM * nN; pg8::tile_map(L, nM, nN, u.pm, u.pn); u.ex = 0; return true; }
    __device__ __forceinline__ const char* a_tile(const pg8::Unit& u) const { return A + (size_t)u.pm * a_tstep; }
    __device__ __forceinline__ const char* b_tile(const pg8::Unit& u) const { return Bt + (size_t)u.pn * b_tstep; }
    __device__ __forceinline__ const int* a_rows(const pg8::Unit&) const { return nullptr; }
};
struct SchedMoe {
    int G, c, R, nN; const char* A; const char* Bt; size_t a_tstep, b_estep, b_tstep; const LAS unsigned char* texp; const int* rows; int rep = 1;
    __device__ __forceinline__ bool next(int i, pg8::Unit& u) const { int L = i * G + c; if (L >= rep * R * nN) return false; L %= R * nN; pg8::tile_map(L, R, nN, u.pm, u.pn); u.ex = texp[u.pm]; return true; }
    __device__ __forceinline__ const char* a_tile(const pg8::Unit& u) const { return A + (size_t)u.pm * a_tstep; }
    __device__ __forceinline__ const char* b_tile(const pg8::Unit& u) const { return Bt + (size_t)u.ex * b_estep + (size_t)u.pn * b_tstep; }
    __device__ __forceinline__ const int* a_rows(const pg8::Unit& u) const { return rows + (size_t)u.pm * 256; }
};

struct EpiStoreBf16 {
    static constexpr bool PERM = true;
    bf16* O; int ldc; const float* rowscale; float cscale;
    __device__ __forceinline__ void operator()(const f32x4 (&acc)[2][2][4][2], const pg8::Unit& u, int wr, int wc, int fr, int fq) const {
        const int row0 = u.pm * 256 + wr * 64 + fr, col0 = u.pn * 256 + wc * 32 + 8 * fq;
#pragma unroll
        for (int ai = 0; ai < 2; ++ai)
#pragma unroll
            for (int m = 0; m < 4; ++m) { const int row = row0 + ai * 128 + m * 16; const float sc = (rowscale ? rowscale[row] : 1.0f) * cscale; bf16* rowp = O + (size_t)row * ldc + col0;
#pragma unroll
                for (int bj = 0; bj < 2; ++bj) { const f32x4 v0 = acc[ai][bj][m][0] * sc, v1 = acc[ai][bj][m][1] * sc;
                    u32x4 w; w.x = cvt_pk_bf16(v0[0], v0[1]); w.y = cvt_pk_bf16(v0[2], v0[3]); w.z = cvt_pk_bf16(v1[0], v1[1]); w.w = cvt_pk_bf16(v1[2], v1[3]);
                    *(u32x4*)(rowp + bj * 128) = w; } }
    }
};
struct EpiInProj {
    static constexpr bool PERM = true;
    bf16* RAW; float* sskv; float* ssq; bf16* QS; bf16* KS; bf16* VS; const LAS float* ts; const LAS float* gq; const LAS float* gk;
    __device__ __forceinline__ void operator()(const f32x4 (&acc)[2][2][4][2], const pg8::Unit& u, int wr, int wc, int fr, int fq) const {
        constexpr float CS = MK_F8IN ? F8_INV : 1.0f; const int pn = u.pn; const bool lat = u.pm < 128;
        if (pn == 1 || pn == 4 || pn == 5) {
            const bool isq = pn != 1, isv = (!isq) && wc >= 2; const int head = isq ? 4 * (pn - 4) + wc : (wc & 1); const LAS float* gn = isq ? gq : gk;
            f32x4 g[4];
#pragma unroll
            for (int q4 = 0; q4 < 4; ++q4) g[q4] = *(const LAS f32x4*)(gn + 16 * q4 + 4 * fq);
#pragma unroll
            for (int ai = 0; ai < 2; ++ai)
#pragma unroll
                for (int m = 0; m < 4; ++m) { const int row = u.pm * 256 + ai * 128 + wr * 64 + m * 16 + fr;
                    f32x4 x[4] = {acc[ai][0][m][0] * CS, acc[ai][0][m][1] * CS, acc[ai][1][m][0] * CS, acc[ai][1][m][1] * CS};
                    int bidx, key, pos; if (lat) { bidx = row >> 12; pos = row & 4095; key = pos; } else { const int rc = row - MTOK; bidx = rc >> 8; key = SEQ + (rc & 255); pos = 0; }
                    if (!isv) { float ss = 0.f;
#pragma unroll
                        for (int q4 = 0; q4 < 4; ++q4) ss += (x[q4][0] * x[q4][0] + x[q4][1] * x[q4][1]) + (x[q4][2] * x[q4][2] + x[q4][3] * x[q4][3]);
                        ss += __shfl_xor(ss, 16); ss += __shfl_xor(ss, 32);
                        const float rstd = rsqrtf(ss * (1.0f / 64.0f) + EPS) * (isq ? QSCALE_S : 1.0f);
#pragma unroll
                        for (int q4 = 0; q4 < 4; ++q4) x[q4] = x[q4] * g[q4] * rstd;
                        if (lat) { const int pr = pos >> 6, pc = pos & 63;
                            const f32x4 cr = *(const LAS f32x4*)(ts + pr * 16 + 4 * fq), sr = *(const LAS f32x4*)(ts + 1024 + pr * 16 + 4 * fq), cc = *(const LAS f32x4*)(ts + pc * 16 + 4 * fq), sc = *(const LAS f32x4*)(ts + 1024 + pc * 16 + 4 * fq);
                            const f32x4 y1 = x[0] * cr - x[1] * sr, y2 = x[1] * cr + x[0] * sr, y3 = x[2] * cc - x[3] * sc, y4 = x[3] * cc + x[2] * sc; x[0] = y1; x[1] = y2; x[2] = y3; x[3] = y4; } }
                    GAS bf16* dst = isq ? ((GAS bf16*)QS + (size_t)row * 512 + head * 64) : ((GAS bf16*)(isv ? VS : KS) + ((size_t)bidx * KEYS + key) * 128 + head * 64);
#pragma unroll
                    for (int q4 = 0; q4 < 4; ++q4) { u32x2 w; w.x = cvt_pk_bf16(x[q4][0], x[q4][1]); w.y = cvt_pk_bf16(x[q4][2], x[q4][3]); *(GAS u32x2*)(dst + 16 * q4 + 4 * fq) = w; } }
        } else {
            const int row0 = u.pm * 256 + wr * 64 + fr, col0 = pn * 256 + wc * 32 + 8 * fq;
#pragma unroll
            for (int ai = 0; ai < 2; ++ai)
#pragma unroll
                for (int m = 0; m < 4; ++m) { const int row = row0 + ai * 128 + m * 16; GAS bf16* rowp = (GAS bf16*)RAW + (size_t)row * NRAW + col0; float ss0 = 0.f, ss1 = 0.f;
#pragma unroll
                    for (int bj = 0; bj < 2; ++bj) { f32x4 v0 = acc[ai][bj][m][0] * CS, v1 = acc[ai][bj][m][1] * CS;
                        if (MK_SIGPRE && pn >= 6) {
#pragma unroll
                            for (int e = 0; e < 4; ++e) { v0[e] = sigmoidf_(v0[e]); v1[e] = sigmoidf_(v1[e]); } }
                        const float q = ((v0[0] * v0[0] + v0[1] * v0[1]) + (v0[2] * v0[2] + v0[3] * v0[3])) + ((v1[0] * v1[0] + v1[1] * v1[1]) + (v1[2] * v1[2] + v1[3] * v1[3])); if (bj == 0) ss0 = q; else ss1 = q;
                        u32x4 w; w.x = cvt_pk_bf16(v0[0], v0[1]); w.y = cvt_pk_bf16(v0[2], v0[3]); w.z = cvt_pk_bf16(v1[0], v1[1]); w.w = cvt_pk_bf16(v1[2], v1[3]);
                        *(GAS u32x4*)(rowp + bj * 128) = w; }
                    if (pn == 0 || pn == 2 || pn == 3) { float ss = (pn == 3) ? ss0 : ss0 + ss1; ss += __shfl_xor(ss, 16); ss += __shfl_xor(ss, 32);
                        if (fq == 0) { if (pn == 0) ((GAS float*)sskv)[row * 4 + wc] = ss; else if (lat) ((GAS float*)ssq)[row * 8 + (pn == 3 ? 4 : 0) + wc] = ss; } } }
        }
    }
};
template <int NP> struct EpiUp {
    static constexpr bool PERM = true;
    bf16* O; int ldc; const float* ssp; float invn;
    __device__ __forceinline__ void operator()(const f32x4 (&acc)[2][2][4][2], const pg8::Unit& u, int wr, int wc, int fr, int fq) const {
        const int row0 = u.pm * 256 + wr * 64 + fr, col0 = u.pn * 256 + wc * 32 + 8 * fq;
#pragma unroll
        for (int ai = 0; ai < 2; ++ai)
#pragma unroll
            for (int m = 0; m < 4; ++m) { const int row = row0 + ai * 128 + m * 16; float s = 0.f;
#pragma unroll
                for (int w = 0; w < NP; w += 4) { const f32x4 p = *(const f32x4*)(ssp + (size_t)row * NP + w); s += (p[0] + p[1]) + (p[2] + p[3]); }
                const float sc = rsqrtf(s * invn + EPS); bf16* rowp = O + (size_t)row * ldc + col0;
#pragma unroll
                for (int bj = 0; bj < 2; ++bj) { const f32x4 v0 = acc[ai][bj][m][0] * sc, v1 = acc[ai][bj][m][1] * sc;
                    u32x4 w; w.x = cvt_pk_bf16(v0[0], v0[1]); w.y = cvt_pk_bf16(v0[2], v0[3]); w.z = cvt_pk_bf16(v1[0], v1[1]); w.w = cvt_pk_bf16(v1[2], v1[3]);
                    *(u32x4*)(rowp + bj * 128) = w; } }
    }
};
template <bool K8> struct EpiKv {
    static constexpr bool PERM = true; static constexpr bool k8 = K8;
    const float* sskv; const bf16* RAW; bf16* KM; bf16* VM; const LAS float* tm; const LAS float* gk;
    __device__ __forceinline__ void operator()(const f32x4 (&acc)[2][2][4][2], const pg8::Unit& u, int wr, int wc, int fr, int fq) const {
        const int head = 2 * u.pn + (wc >> 1); const bool isv = wc & 1, lat = u.pm < 128;
        const LAS float* ggk = gk;
#pragma unroll
        for (int ai = 0; ai < 2; ++ai) {
            f32x4 pp[4]; unsigned krw[4][4];
#pragma unroll
            for (int m = 0; m < 4; ++m) { const int row = u.pm * 256 + ai * 128 + wr * 64 + m * 16 + fr; pp[m] = *(const GAS f32x4*)((const GAS float*)sskv + (size_t)row * 4);
                if (!isv) { const GAS bf16* rr = (const GAS bf16*)RAW + (size_t)row * NRAW + C_KROPE + 2 * fq;
#pragma unroll
                    for (int qd = 0; qd < 4; ++qd) krw[m][qd] = *(const GAS unsigned*)(rr + 8 * qd); } }
            asm volatile("" ::: "memory");
#pragma unroll
            for (int m = 0; m < 4; ++m) {
                const int row = u.pm * 256 + ai * 128 + wr * 64 + m * 16 + fr;
                const f32x4 p = pp[m]; const float rkv = rsqrtf(((p[0] + p[1]) + (p[2] + p[3])) * (1.0f / 256.0f) + EPS);
                int bidx, key, pos; if (lat) { bidx = row >> 12; pos = row & 4095; key = pos; } else { const int rc = row - MTOK; bidx = rc >> 8; key = SEQ + (rc & 255); pos = 0; }
                f32x4 x[2][2];
#pragma unroll
                for (int bj = 0; bj < 2; ++bj)
#pragma unroll
                    for (int n = 0; n < 2; ++n) x[bj][n] = acc[ai][bj][m][n] * rkv;
                if (isv) { GAS bf16* vo = (GAS bf16*)VM + ((size_t)bidx * KEYS + key) * 512 + head * 64 + 8 * fq;
#pragma unroll
                    for (int bj = 0; bj < 2; ++bj) { u32x4 w; w.x = cvt_pk_bf16(x[bj][0][0], x[bj][0][1]); w.y = cvt_pk_bf16(x[bj][0][2], x[bj][0][3]); w.z = cvt_pk_bf16(x[bj][1][0], x[bj][1][1]); w.w = cvt_pk_bf16(x[bj][1][2], x[bj][1][3]);
                        *(GAS u32x4*)(vo + 32 * bj) = w; }
                } else {
                    float kr[4][2]; float ss = 0.f;
#pragma unroll
                    for (int qd = 0; qd < 4; ++qd) { const unsigned w = krw[m][qd]; kr[qd][0] = bflo(w); kr[qd][1] = bfhi(w); ss += kr[qd][0] * kr[qd][0] + kr[qd][1] * kr[qd][1]; }
#pragma unroll
                    for (int bj = 0; bj < 2; ++bj)
#pragma unroll
                        for (int n = 0; n < 2; ++n) ss += (x[bj][n][0] * x[bj][n][0] + x[bj][n][1] * x[bj][n][1]) + (x[bj][n][2] * x[bj][n][2] + x[bj][n][3] * x[bj][n][3]);
                    ss += __shfl_xor(ss, 16); ss += __shfl_xor(ss, 32);
                    const float rstd = rsqrtf(ss * (1.0f / 96.0f) + EPS);
                    GAS bf16* ko = (GAS bf16*)KM + ((size_t)bidx * KEYS + key) * 768 + head * 96; GAS unsigned char* ko8 = (GAS unsigned char*)KM + ((size_t)bidx * KEYS + key) * 1024 + head * 128;
                    const int pr = pos >> 6, pc = pos & 63;
#pragma unroll
                    for (int ii = 0; ii < 2; ++ii) { const int i = 2 * fq + ii; float y0 = kr[0][ii] * rstd * ggk[64 + i], y1 = kr[1][ii] * rstd * ggk[72 + i], y2 = kr[2][ii] * rstd * ggk[80 + i], y3 = kr[3][ii] * rstd * ggk[88 + i];
                        if (lat) { const float cr = tm[pr * 8 + i], sr = tm[512 + pr * 8 + i], cc = tm[pc * 8 + i], sc = tm[512 + pc * 8 + i];
                            const float o0 = y0 * cr - y1 * sr, o1 = y1 * cr + y0 * sr, o2 = y2 * cc - y3 * sc, o3 = y3 * cc + y2 * sc; y0 = o0; y1 = o1; y2 = o2; y3 = o3; }
                        kr[0][ii] = y0; kr[1][ii] = y1; kr[2][ii] = y2; kr[3][ii] = y3; }
#pragma unroll
                    for (int qd = 0; qd < 4; ++qd) { if (k8) *(GAS unsigned short*)(ko8 + 64 + 32 * (qd & 1) + 8 * (qd >> 1) + 2 * fq) = (unsigned short)pk4_fp8(kr[qd][0] * 16.f, kr[qd][1] * 16.f, 0.f, 0.f); else *(GAS unsigned*)(ko + 64 + 8 * qd + 2 * fq) = cvt_pk_bf16(kr[qd][0], kr[qd][1]); }
#pragma unroll
                    for (int bj = 0; bj < 2; ++bj) { const f32x4 g0 = *(const LAS f32x4*)(ggk + 32 * bj + 8 * fq), g1 = *(const LAS f32x4*)(ggk + 32 * bj + 8 * fq + 4);
                        const f32x4 a = x[bj][0] * g0 * rstd, b = x[bj][1] * g1 * rstd;
                        if (k8) { u32x2 w; w.x = pk4_fp8(a[0] * 16.f, a[1] * 16.f, a[2] * 16.f, a[3] * 16.f); w.y = pk4_fp8(b[0] * 16.f, b[1] * 16.f, b[2] * 16.f, b[3] * 16.f); *(GAS u32x2*)(ko8 + 32 * (fq & 1) + 8 * (2 * bj + (fq >> 1))) = w; }
                        else { u32x4 w; w.x = cvt_pk_bf16(a[0], a[1]); w.y = cvt_pk_bf16(a[2], a[3]); w.z = cvt_pk_bf16(b[0], b[1]); w.w = cvt_pk_bf16(b[2], b[3]); *(GAS u32x4*)(ko + 32 * bj + 8 * fq) = w; } }
                    if (k8) *(GAS u32x2*)(ko8 + 64 + 32 * (fq >> 1) + 16 + 8 * (fq & 1)) = (u32x2){0u, 0u};
                } } }
    }
};
struct EpiQ {
    static constexpr bool PERM = true;
    const float* ssq; bf16* QM; float* ssqh; const LAS float* tm; const LAS float* gq;
    __device__ __forceinline__ void operator()(const f32x4 (&acc)[2][2][4][2], const pg8::Unit& u, int wr, int wc, int fr, int fq) const {
        const int head = 2 * u.pn + (wc >> 1); const bool isr = wc & 1;
        f32x4 g[2][2]; float gr[4][2];
#pragma unroll
        for (int bj = 0; bj < 2; ++bj)
#pragma unroll
            for (int n = 0; n < 2; ++n) g[bj][n] = *(const LAS f32x4*)(gq + 32 * bj + 8 * fq + 4 * n);
#pragma unroll
        for (int qd = 0; qd < 4; ++qd) { gr[qd][0] = gq[64 + 8 * qd + 2 * fq]; gr[qd][1] = gq[64 + 8 * qd + 2 * fq + 1]; }
#pragma unroll
        for (int ai = 0; ai < 2; ++ai) {
            f32x4 pq0[4], pq1[4];
#pragma unroll
            for (int m = 0; m < 4; ++m) { const int row = u.pm * 256 + ai * 128 + wr * 64 + m * 16 + fr; pq0[m] = *(const GAS f32x4*)((const GAS float*)ssq + (size_t)row * 8); pq1[m] = *(const GAS f32x4*)((const GAS float*)ssq + (size_t)row * 8 + 4); }
            asm volatile("" ::: "memory");
#pragma unroll
            for (int m = 0; m < 4; ++m) { const int row = u.pm * 256 + ai * 128 + wr * 64 + m * 16 + fr;
                const f32x4 p0 = pq0[m], p1 = pq1[m];
                const float rq = rsqrtf((((p0[0] + p0[1]) + (p0[2] + p0[3])) + ((p1[0] + p1[1]) + (p1[2] + p1[3]))) * (1.0f / 384.0f) + EPS);
                GAS bf16* qo = (GAS bf16*)QM + (size_t)row * 768 + head * 96;
                if (!isr) { float ss = 0.f;
#pragma unroll
                    for (int bj = 0; bj < 2; ++bj) { const f32x4 a = acc[ai][bj][m][0] * rq, b = acc[ai][bj][m][1] * rq;
                        ss += ((a[0] * a[0] + a[1] * a[1]) + (a[2] * a[2] + a[3] * a[3])) + ((b[0] * b[0] + b[1] * b[1]) + (b[2] * b[2] + b[3] * b[3]));
                        const f32x4 ag = a * g[bj][0] * QSCALE_M, bg = b * g[bj][1] * QSCALE_M;
                        u32x4 w; w.x = cvt_pk_bf16(ag[0], ag[1]); w.y = cvt_pk_bf16(ag[2], ag[3]); w.z = cvt_pk_bf16(bg[0], bg[1]); w.w = cvt_pk_bf16(bg[2], bg[3]); *(GAS u32x4*)(qo + 32 * bj + 8 * fq) = w; }
                    ss += __shfl_xor(ss, 16); ss += __shfl_xor(ss, 32);
                    if (fq == 0) ((GAS float*)ssqh)[((size_t)row * 8 + head) * 2] = ss;
                } else {
                    const f32x4 a = acc[ai][0][m][0] * rq, b = acc[ai][0][m][1] * rq;
                    float ss = ((a[0] * a[0] + a[1] * a[1]) + (a[2] * a[2] + a[3] * a[3])) + ((b[0] * b[0] + b[1] * b[1]) + (b[2] * b[2] + b[3] * b[3]));
                    ss += __shfl_xor(ss, 16); ss += __shfl_xor(ss, 32);
                    if (fq == 0) ((GAS float*)ssqh)[((size_t)row * 8 + head) * 2 + 1] = ss;
                    const int pos = row & 4095, pr = pos >> 6, pc = pos & 63; float o[4][2];
#pragma unroll
                    for (int ib = 0; ib < 2; ++ib) { const int i = 2 * fq + ib; const float y0 = a[ib] * gr[0][ib], y1 = a[2 + ib] * gr[1][ib], y2 = b[ib] * gr[2][ib], y3 = b[2 + ib] * gr[3][ib];
                        const float cr = tm[pr * 8 + i], sr = tm[512 + pr * 8 + i], cc = tm[pc * 8 + i], sc = tm[512 + pc * 8 + i];
                        o[0][ib] = (y0 * cr - y1 * sr) * QSCALE_M; o[1][ib] = (y1 * cr + y0 * sr) * QSCALE_M; o[2][ib] = (y2 * cc - y3 * sc) * QSCALE_M; o[3][ib] = (y3 * cc + y2 * sc) * QSCALE_M; }
#pragma unroll
                    for (int qd = 0; qd < 4; ++qd) *(GAS unsigned*)(qo + 64 + 8 * qd + 2 * fq) = cvt_pk_bf16(o[qd][0], o[qd][1]);
                } } }
    }
};
template <bool ADD> struct EpiBranch {
    static constexpr bool PERM = true;
    bf16* T; const bf16* gate; unsigned char* T8;
    __device__ __forceinline__ void operator()(const f32x4 (&acc)[2][2][4][2], const pg8::Unit& u, int wr, int wc, int fr, int fq) const {
        const int row0 = u.pm * 256 + wr * 64 + fr, col0 = u.pn * 256 + wc * 32 + 8 * fq; constexpr float ASC = MK_F8MID ? F8_INVM : 1.0f;
#pragma unroll
        for (int ai = 0; ai < 2; ++ai)
#pragma unroll
            for (int m = 0; m < 4; ++m) { const int row = row0 + ai * 128 + m * 16;
#pragma unroll
                for (int bj = 0; bj < 2; ++bj) { const int col = col0 + bj * 128;
                    const u32x4 g = *(const u32x4*)(gate + (size_t)row * NRAW + col);
                    f32x4 v0 = acc[ai][bj][m][0] * ASC, v1 = acc[ai][bj][m][1] * ASC;
                    v0[0] *= sigmoidf_(bflo(g.x)); v0[1] *= sigmoidf_(bfhi(g.x)); v0[2] *= sigmoidf_(bflo(g.y)); v0[3] *= sigmoidf_(bfhi(g.y));
                    v1[0] *= sigmoidf_(bflo(g.z)); v1[1] *= sigmoidf_(bfhi(g.z)); v1[2] *= sigmoidf_(bflo(g.w)); v1[3] *= sigmoidf_(bfhi(g.w));
                    bf16* tp = T + (size_t)row * D + col;
                    if (ADD) { const u32x4 t = *(const u32x4*)tp; v0[0] += bflo(t.x); v0[1] += bfhi(t.x); v0[2] += bflo(t.y); v0[3] += bfhi(t.y); v1[0] += bflo(t.z); v1[1] += bfhi(t.z); v1[2] += bflo(t.w); v1[3] += bfhi(t.w); }
                    if (ADD && MK_F8MID) { u32x2 w; w.x = pk4_fp8(v0[0] * F8_SO, v0[1] * F8_SO, v0[2] * F8_SO, v0[3] * F8_SO); w.y = pk4_fp8(v1[0] * F8_SO, v1[1] * F8_SO, v1[2] * F8_SO, v1[3] * F8_SO);
                        *(u32x2*)(T8 + (size_t)row * D + col) = w; }
                    else { u32x4 w; w.x = cvt_pk_bf16(v0[0], v0[1]); w.y = cvt_pk_bf16(v0[2], v0[3]); w.z = cvt_pk_bf16(v1[0], v1[1]); w.w = cvt_pk_bf16(v1[2], v1[3]);
                        *(u32x4*)tp = w; } } }
    }
};
static_assert(!MK_SIGPRE || (MK_MERGE78 && MK_FUSE3 && MK_F8MID), "MK_SIGPRE needs the merged branch GEMM and the fused in-proj epilogue");
struct EpiMerge {
    static constexpr int NST = 16; static constexpr bool PERM = true, MID = true;
    const bf16* RAW; unsigned char* T8;
    __device__ __forceinline__ void mid(f32x4 (&acc)[2][2][4][2], const pg8::Unit& u, int wr, int wc, int fr, int fq) const {
        asm volatile("" : "+v"(fr), "+v"(fq));
        const int row0 = u.pm * 256 + wr * 64 + fr, col0 = u.pn * 256 + wc * 32 + 8 * fq;
#pragma unroll
        for (int ai = 0; ai < 2; ++ai)
#pragma unroll
            for (int m2 = 0; m2 < 4; m2 += MK_MIDR) { asm volatile("" ::: "memory");
              u32x4 gav[MK_MIDR][2], gbv[MK_MIDR][2];
#pragma unroll
              for (int mm = 0; mm < MK_MIDR; ++mm) { const GAS bf16* rp = (const GAS bf16*)RAW + (size_t)(row0 + ai * 128 + (m2 + mm) * 16) * NRAW + col0;
#pragma unroll
                  for (int bj = 0; bj < 2; ++bj) { gav[mm][bj] = *(const GAS u32x4*)(rp + C_GA + bj * 128); gbv[mm][bj] = *(const GAS u32x4*)(rp + C_GB + bj * 128); } }
              asm volatile("" ::: "memory");
#pragma unroll
              for (int mm = 0; mm < MK_MIDR; ++mm) { const int m = m2 + mm;
#pragma unroll
                for (int bj = 0; bj < 2; ++bj) { const u32x4 ga = gav[mm][bj], gb = gbv[mm][bj];
                    const unsigned aw[4] = {ga.x, ga.y, ga.z, ga.w}, bw[4] = {gb.x, gb.y, gb.z, gb.w};
#pragma unroll
                    for (int q = 0; q < 4; ++q) {
                        if (MK_SIGPRE) { acc[ai][bj][m][q >> 1][2 * (q & 1)] *= bflo(aw[q]) * __builtin_amdgcn_rcpf(bflo(bw[q])); acc[ai][bj][m][q >> 1][2 * (q & 1) + 1] *= bfhi(aw[q]) * __builtin_amdgcn_rcpf(bfhi(bw[q])); }
                        else { const float ea0 = __builtin_amdgcn_exp2f(-LOG2E * bflo(aw[q])), ea1 = __builtin_amdgcn_exp2f(-LOG2E * bfhi(aw[q])), eb0 = __builtin_amdgcn_exp2f(-LOG2E * bflo(bw[q])), eb1 = __builtin_amdgcn_exp2f(-LOG2E * bfhi(bw[q]));
                        acc[ai][bj][m][q >> 1][2 * (q & 1)] *= (1.0f + eb0) * __builtin_amdgcn_rcpf(1.0f + ea0); acc[ai][bj][m][q >> 1][2 * (q & 1) + 1] *= (1.0f + eb1) * __builtin_amdgcn_rcpf(1.0f + ea1); } } } } }
    }
    __device__ __forceinline__ void operator()(const f32x4 (&acc)[2][2][4][2], const pg8::Unit& u, int wr, int wc, int fr, int fq) const {
        const int row0 = u.pm * 256 + wr * 64 + fr, col0 = u.pn * 256 + wc * 32 + 8 * fq; constexpr float SC = F8_INVM * F8_SO;
#pragma unroll
        for (int ai = 0; ai < 2; ++ai) {
            u32x4 gg[4][2];
#pragma unroll
            for (int m = 0; m < 4; ++m)
#pragma unroll
                for (int bj = 0; bj < 2; ++bj) gg[m][bj] = *(const GAS u32x4*)((const GAS bf16*)RAW + (size_t)(row0 + ai * 128 + m * 16) * NRAW + C_GB + col0 + bj * 128);
            asm volatile("" ::: "memory");
#pragma unroll
            for (int m = 0; m < 4; ++m) { const int row = row0 + ai * 128 + m * 16;
#pragma unroll
                for (int bj = 0; bj < 2; ++bj) { const u32x4 g = gg[m][bj]; const f32x4 v0 = acc[ai][bj][m][0] * SC, v1 = acc[ai][bj][m][1] * SC;
                    u32x2 w;
                    if (MK_SIGPRE) { w.x = pk4_fp8(v0[0] * bflo(g.x), v0[1] * bfhi(g.x), v0[2] * bflo(g.y), v0[3] * bfhi(g.y)); w.y = pk4_fp8(v1[0] * bflo(g.z), v1[1] * bfhi(g.z), v1[2] * bflo(g.w), v1[3] * bfhi(g.w)); }
                    else { w.x = pk4_fp8(v0[0] * sigmoidf_(bflo(g.x)), v0[1] * sigmoidf_(bfhi(g.x)), v0[2] * sigmoidf_(bflo(g.y)), v0[3] * sigmoidf_(bfhi(g.y)));
                    w.y = pk4_fp8(v1[0] * sigmoidf_(bflo(g.z)), v1[1] * sigmoidf_(bfhi(g.z)), v1[2] * sigmoidf_(bflo(g.w)), v1[3] * sigmoidf_(bfhi(g.w))); }
                    *(GAS u32x2*)((GAS unsigned char*)T8 + (size_t)row * D + col0 + bj * 128) = w; } } }
    }
};
struct EpiOutRes {
    static constexpr bool PERM = false;
    const float* x; float* out; const float* mod;
    __device__ __forceinline__ void operator()(const f32x4 (&acc)[2][2][4][2], const pg8::Unit& u, int wr, int wc, int fr, int fq) const {
        const int row0 = u.pm * 256 + wr * 64 + fr, col0 = u.pn * 256 + wc * 32 + 4 * fq; const int bb = (u.pm * 256) >> 12;
        f32x4 gv[2][2];
#pragma unroll
        for (int bj = 0; bj < 2; ++bj)
#pragma unroll
            for (int n = 0; n < 2; ++n) gv[bj][n] = *(const f32x4*)(mod + (size_t)bb * NMOD + 2048 + col0 + bj * 128 + n * 16);
#pragma unroll
        for (int ai = 0; ai < 2; ++ai)
#pragma unroll
            for (int mh = 0; mh < 4; mh += MK_EPIX) {
                f32x4 xv[MK_EPIX][2][2];
#pragma unroll
                for (int m = 0; m < MK_EPIX; ++m) { const size_t ro = (size_t)(row0 + ai * 128 + (mh + m) * 16) * D + col0;
#pragma unroll
                    for (int bj = 0; bj < 2; ++bj)
#pragma unroll
                        for (int n = 0; n < 2; ++n) xv[m][bj][n] = *(const GAS f32x4*)((const GAS float*)x + ro + bj * 128 + n * 16); }
                asm volatile("" ::: "memory");
#pragma unroll
                for (int m = 0; m < MK_EPIX; ++m) { const size_t ro = (size_t)(row0 + ai * 128 + (mh + m) * 16) * D + col0;
#pragma unroll
                    for (int bj = 0; bj < 2; ++bj)
#pragma unroll
                        for (int n = 0; n < 2; ++n) *(GAS f32x4*)((GAS float*)out + ro + bj * 128 + n * 16) = xv[m][bj][n] + gv[bj][n] * (acc[ai][bj][mh + m][n] * (MK_F8MID ? F8_INVM : 1.0f)); } }
    }
};
struct EpiSwiglu {
    static constexpr bool PERM = true, PRE = true;
    unsigned char* ACT; const float* bgu;
    __device__ __forceinline__ void pre(const pg8::Unit& u, int wr, int wc, int fr, int fq, f32x4 (&b4)[4]) const { const float* bp = bgu + (size_t)u.ex * 2048 + 2 * (u.pn * 128 + wc * 32 + 8 * fq);
#pragma unroll
        for (int q = 0; q < 4; ++q) asm_load16(b4[q], bp + 4 * q); }
    __device__ __forceinline__ void operator()(const f32x4 (&acc)[2][2][4][2], const pg8::Unit& u, int wr, int wc, int fr, int fq, const f32x4 (&b4)[4]) const {
        const int row0 = u.pm * 256 + wr * 64 + fr, j0 = u.pn * 128 + wc * 32 + 8 * fq;
        constexpr float ASC = MK_F8 ? F8_INV : 1.0f, OSC = MK_F8 ? F8_SA : 1.0f;
#pragma unroll
        for (int ai = 0; ai < 2; ++ai)
#pragma unroll
            for (int m = 0; m < 4; ++m) { f32x2 o[4];
#pragma unroll
                for (int q = 0; q < 4; ++q) { const int n = q >> 1, e0 = 2 * (q & 1);
                    f32x2 g = (f32x2){acc[ai][0][m][n][e0], acc[ai][0][m][n][e0 + 1]} * ASC + (f32x2){b4[q][0], b4[q][2]};
                    f32x2 l = (f32x2){acc[ai][1][m][n][e0], acc[ai][1][m][n][e0 + 1]} * ASC + (f32x2){b4[q][1], b4[q][3]};
                    g.x = fminf(g.x, 7.0f); g.y = fminf(g.y, 7.0f); l.x = __builtin_amdgcn_fmed3f(l.x, -7.0f, 7.0f); l.y = __builtin_amdgcn_fmed3f(l.y, -7.0f, 7.0f);
                    const f32x2 z = g * (-1.702f * LOG2E); f32x2 d; d.x = __builtin_amdgcn_exp2f(z.x); d.y = __builtin_amdgcn_exp2f(z.y); d = d + 1.0f;
                    f32x2 r; r.x = __builtin_amdgcn_rcpf(d.x); r.y = __builtin_amdgcn_rcpf(d.y);
                    o[q] = (g * r) * (l * OSC + OSC); }
                if (MK_F8) { u32x2 w; int t = __builtin_amdgcn_cvt_pk_fp8_f32(o[0].x, o[0].y, 0, false); t = __builtin_amdgcn_cvt_pk_fp8_f32(o[1].x, o[1].y, t, true); w.x = (unsigned)t;
                    t = __builtin_amdgcn_cvt_pk_fp8_f32(o[2].x, o[2].y, 0, false); t = __builtin_amdgcn_cvt_pk_fp8_f32(o[3].x, o[3].y, t, true); w.y = (unsigned)t;
                    *(u32x2*)(ACT + (size_t)(row0 + ai * 128 + m * 16) * 1024 + j0) = w; }
                else { u32x4 w; w.x = cvt_pk_bf16(o[0].x, o[0].y); w.y = cvt_pk_bf16(o[1].x, o[1].y); w.z = cvt_pk_bf16(o[2].x, o[2].y); w.w = cvt_pk_bf16(o[3].x, o[3].y);
                    *(u32x4*)(ACT + ((size_t)(row0 + ai * 128 + m * 16) * 1024 + j0) * 2) = w; } }
    }
};
struct EpiDown {
    static constexpr bool PERM = true, PRE = true;
    unsigned char* Y; const float* bdn; const float* slotw;
    __device__ __forceinline__ void pre(const pg8::Unit& u, int wr, int wc, int fr, int fq, f32x4 (&bq)[4]) const { const float* bp = bdn + (size_t)u.ex * 1024 + u.pn * 256 + wc * 32 + 8 * fq;
#pragma unroll
        for (int bj = 0; bj < 2; ++bj)
#pragma unroll
            for (int n = 0; n < 2; ++n) asm_load16(bq[bj * 2 + n], bp + bj * 128 + 4 * n); }
    __device__ __forceinline__ void operator()(const f32x4 (&acc)[2][2][4][2], const pg8::Unit& u, int wr, int wc, int fr, int fq, const f32x4 (&bq)[4]) const {
        const int row0 = u.pm * 256 + wr * 64 + fr, col0 = u.pn * 256 + wc * 32 + 8 * fq;
        f32x4 bv[2][2];
#pragma unroll
        for (int bj = 0; bj < 2; ++bj)
#pragma unroll
            for (int n = 0; n < 2; ++n) bv[bj][n] = bq[bj * 2 + n];
        float swv[2][4];
#pragma unroll
        for (int ai = 0; ai < 2; ++ai)
#pragma unroll
            for (int m = 0; m < 4; ++m) swv[ai][m] = ((const GAS float*)slotw)[row0 + ai * 128 + m * 16];
        asm volatile("" ::: "memory");
#pragma unroll
        for (int ai = 0; ai < 2; ++ai)
#pragma unroll
            for (int m = 0; m < 4; ++m) { const int row = row0 + ai * 128 + m * 16; const float sw = swv[ai][m];
#pragma unroll
                for (int bj = 0; bj < 2; ++bj) { constexpr float ASC = MK_F8 ? F8_INV : 1.0f; const f32x4 v0 = (acc[ai][bj][m][0] * ASC + bv[bj][0]) * sw, v1 = (acc[ai][bj][m][1] * ASC + bv[bj][1]) * sw;
                    if (MK_F8Y) { u32x2 w; w.x = pk4_fp8(v0[0] * F8_SY, v0[1] * F8_SY, v0[2] * F8_SY, v0[3] * F8_SY); w.y = pk4_fp8(v1[0] * F8_SY, v1[1] * F8_SY, v1[2] * F8_SY, v1[3] * F8_SY);
                        *(GAS u32x2*)((GAS unsigned char*)Y + (size_t)row * 1024 + col0 + bj * 128) = w; }
                    else { u32x4 w; w.x = cvt_pk_bf16(v0[0], v0[1]); w.y = cvt_pk_bf16(v0[2], v0[3]); w.z = cvt_pk_bf16(v1[0], v1[1]); w.w = cvt_pk_bf16(v1[2], v1[3]);
                        *(u32x4*)(Y + ((size_t)row * 1024 + col0 + bj * 128) * 2) = w; } } }
    }
};

__device__ __forceinline__ void p3_post_inproj(Frame& F) {
    LAS unsigned char* scr = F.lds + F.wave * 4096;
    const bf16* RAW = WSP(bf16, WS_R1); const float* ts = WSP(float, WS_TRIG);
    const int gw = F.vcu * NWAVES + F.wave, NGW = F.G * NWAVES, lane = F.lane, g = lane >> 4, i = lane & 15;
    bf16* QS = WSP(bf16, WS_QS); bf16* KS = WSP(bf16, WS_KS); bf16* VS = WSP(bf16, WS_VS);
    for (int row = gw; row < MALL; row += NGW) {
        const bool lat = row < MTOK; const bf16* rp = RAW + (size_t)row * NRAW;
#pragma unroll
        for (int q = 0; q < 3; ++q) *(LAS u32x4*)(scr + (lane + 64 * q) * 16) = *(const u32x4*)(rp + (lane + 64 * q) * 8);
        LDS_WAIT(); asm volatile("" ::: "memory");
        const LAS bf16* s = (const LAS bf16*)scr;
        { const u32x2 w = *(const LAS u32x2*)(s + C_KVLAT + 4 * lane); const float a = bflo(w.x), b = bfhi(w.x), c = bflo(w.y), d = bfhi(w.y);
          const float ss = wave_sum((a * a + b * b) + (c * c + d * d)); if (lane == 0) WSP(float, WS_RSKV)[row] = rsqrtf(ss * (1.0f / 256.0f) + EPS); }
        if (lat) { float ss = 0.f;
#pragma unroll
            for (int q = 0; q < 3; ++q) { const unsigned w = *(const LAS unsigned*)(s + C_QLAT + 6 * lane + 2 * q); const float a = bflo(w), b = bfhi(w); ss += a * a + b * b; }
            ss = wave_sum(ss); if (lane == 0) WSP(float, WS_RSQ)[row] = rsqrtf(ss * (1.0f / 384.0f) + EPS); }
        int bidx, key, pos;
        if (lat) { bidx = row >> 12; pos = row & 4095; key = pos; } else { const int rc = row - MTOK; bidx = rc >> 8; key = SEQ + (rc & 255); pos = 0; }
        const int pr = pos >> 6, pc = pos & 63;
        const float cr = ts[pr * 16 + i], sr = ts[1024 + pr * 16 + i], cc = ts[pc * 16 + i], sc = ts[1024 + pc * 16 + i];
#pragma unroll
        for (int pass = 0; pass < 3; ++pass) {
            const bool isq = pass < 2; const int head = isq ? (pass * 4 + g) : g; const bool act = isq ? lat : (g < 2);
            const LAS bf16* hp = s + (isq ? C_QSWA : C_KSWA) + (act ? head : 0) * 64;
            float x1 = bf2f(hp[i]), x2 = bf2f(hp[16 + i]), x3 = bf2f(hp[32 + i]), x4 = bf2f(hp[48 + i]);
            float ss = (x1 * x1 + x2 * x2) + (x3 * x3 + x4 * x4);
            ss += __shfl_xor(ss, 1); ss += __shfl_xor(ss, 2); ss += __shfl_xor(ss, 4); ss += __shfl_xor(ss, 8);
            const float rstd = rsqrtf(ss * (1.0f / 64.0f) + EPS); const float* gn = isq ? F.swa_q_g : F.swa_k_g;
            x1 *= rstd * gn[i]; x2 *= rstd * gn[16 + i]; x3 *= rstd * gn[32 + i]; x4 *= rstd * gn[48 + i];
            float y1 = x1, y2 = x2, y3 = x3, y4 = x4;
            if (lat) { y1 = x1 * cr - x2 * sr; y2 = x2 * cr + x1 * sr; y3 = x3 * cc - x4 * sc; y4 = x4 * cc + x3 * sc; }
            if (act) {
                if (isq) { bf16* o = QS + (size_t)row * 512 + head * 64; o[i] = (bf16)f2bf(y1 * QSCALE_S); o[16 + i] = (bf16)f2bf(y2 * QSCALE_S); o[32 + i] = (bf16)f2bf(y3 * QSCALE_S); o[48 + i] = (bf16)f2bf(y4 * QSCALE_S); }
                else { bf16* o = KS + ((size_t)bidx * KEYS + key) * 128 + head * 64; o[i] = (bf16)f2bf(y1); o[16 + i] = (bf16)f2bf(y2); o[32 + i] = (bf16)f2bf(y3); o[48 + i] = (bf16)f2bf(y4); }
            }
        }
        if (lane < 16) *(u32x4*)(VS + ((size_t)bidx * KEYS + key) * 128 + lane * 8) = *(const LAS u32x4*)(s + C_VSWA + lane * 8);
        LDS_WAIT(); asm volatile("" ::: "memory");
    }
}

__device__ __forceinline__ void p5_post_up(Frame& F) {
    const bf16* RAW = WSP(bf16, WS_R1); const bf16* KVUP = WSP(bf16, WS_KVUP); const bf16* QUP = WSP(bf16, WS_QUP); const float* tm = WSP(float, WS_TRIG) + 2048;
    bf16* QM = WSP(bf16, WS_QM); bf16* KM = WSP(bf16, WS_KM); bf16* VM = WSP(bf16, WS_VM);
    const int gw = F.vcu * NWAVES + F.wave, NGW = F.G * NWAVES, lane = F.lane, h = lane >> 3, i = lane & 7;
    float gk[8], gq[8], gkr[4], gqr[4];
#pragma unroll
    for (int e = 0; e < 8; ++e) { gk[e] = F.mla_k_g[8 * i + e]; gq[e] = F.mla_q_g[8 * i + e]; }
#pragma unroll
    for (int q = 0; q < 4; ++q) { gkr[q] = F.mla_k_g[64 + 8 * q + i]; gqr[q] = F.mla_q_g[64 + 8 * q + i]; }
    for (int row = gw; row < MALL; row += NGW) {
        const bool lat = row < MTOK; int bidx, key, pos;
        if (lat) { bidx = row >> 12; pos = row & 4095; key = pos; } else { const int rc = row - MTOK; bidx = rc >> 8; key = SEQ + (rc & 255); pos = 0; }
        const int pr = pos >> 6, pc = pos & 63;
        const float cr = tm[pr * 8 + i], sr = tm[512 + pr * 8 + i], cc = tm[pc * 8 + i], sc = tm[512 + pc * 8 + i];
        {
            const bf16* kp = KVUP + (size_t)row * 1024 + h * 128; const u32x4 nw = *(const u32x4*)(kp + 8 * i); const u32x4 vw = *(const u32x4*)(kp + 64 + 8 * i);
            const bf16* rr = RAW + (size_t)row * NRAW + C_KROPE; float x[4];
#pragma unroll
            for (int q = 0; q < 4; ++q) x[q] = bf2f(rr[8 * q + i]);
            float n[8] = {bflo(nw.x), bfhi(nw.x), bflo(nw.y), bfhi(nw.y), bflo(nw.z), bfhi(nw.z), bflo(nw.w), bfhi(nw.w)};
            float ss = (x[0] * x[0] + x[1] * x[1]) + (x[2] * x[2] + x[3] * x[3]);
#pragma unroll
            for (int e = 0; e < 8; ++e) ss += n[e] * n[e];
            ss += __shfl_xor(ss, 1); ss += __shfl_xor(ss, 2); ss += __shfl_xor(ss, 4);
            const float rstd = rsqrtf(ss * (1.0f / 96.0f) + EPS);
            bf16* ko = KM + ((size_t)bidx * KEYS + key) * 768 + h * 96;
            u32x4 w; w.x = pk2(n[0] * rstd * gk[0], n[1] * rstd * gk[1]); w.y = pk2(n[2] * rstd * gk[2], n[3] * rstd * gk[3]); w.z = pk2(n[4] * rstd * gk[4], n[5] * rstd * gk[5]); w.w = pk2(n[6] * rstd * gk[6], n[7] * rstd * gk[7]);
            *(u32x4*)(ko + 8 * i) = w;
            float x1 = x[0] * rstd * gkr[0], x2 = x[1] * rstd * gkr[1], x3 = x[2] * rstd * gkr[2], x4 = x[3] * rstd * gkr[3], y1 = x1, y2 = x2, y3 = x3, y4 = x4;
            if (lat) { y1 = x1 * cr - x2 * sr; y2 = x2 * cr + x1 * sr; y3 = x3 * cc - x4 * sc; y4 = x4 * cc + x3 * sc; }
            ko[64 + i] = (bf16)f2bf(y1); ko[72 + i] = (bf16)f2bf(y2); ko[80 + i] = (bf16)f2bf(y3); ko[88 + i] = (bf16)f2bf(y4);
            *(u32x4*)(VM + ((size_t)bidx * KEYS + key) * 512 + h * 64 + 8 * i) = vw;
        }
        if (lat) {
            const bf16* qp = QUP + (size_t)row * 768 + h * 96; const u32x4 nw = *(const u32x4*)(qp + 8 * i); float x[4];
#pragma unroll
            for (int q = 0; q < 4; ++q) x[q] = bf2f(qp[64 + 8 * q + i]);
            float n[8] = {bflo(nw.x), bfhi(nw.x), bflo(nw.y), bfhi(nw.y), bflo(nw.z), bfhi(nw.z), bflo(nw.w), bfhi(nw.w)};
            float ss = (x[0] * x[0] + x[1] * x[1]) + (x[2] * x[2] + x[3] * x[3]);
#pragma unroll
            for (int e = 0; e < 8; ++e) ss += n[e] * n[e];
            ss += __shfl_xor(ss, 1); ss += __shfl_xor(ss, 2); ss += __shfl_xor(ss, 4);
            const float rstd = rsqrtf(ss * (1.0f / 96.0f) + EPS) * QSCALE_M;
            bf16* qo = QM + (size_t)row * 768 + h * 96;
            u32x4 w; w.x = pk2(n[0] * rstd * gq[0], n[1] * rstd * gq[1]); w.y = pk2(n[2] * rstd * gq[2], n[3] * rstd * gq[3]); w.z = pk2(n[4] * rstd * gq[4], n[5] * rstd * gq[5]); w.w = pk2(n[6] * rstd * gq[6], n[7] * rstd * gq[7]);
            *(u32x4*)(qo + 8 * i) = w;
            const float x1 = x[0] * rstd * gqr[0], x2 = x[1] * rstd * gqr[1], x3 = x[2] * rstd * gqr[2], x4 = x[3] * rstd * gqr[3];
            qo[64 + i] = (bf16)f2bf(x1 * cr - x2 * sr); qo[72 + i] = (bf16)f2bf(x2 * cr + x1 * sr); qo[80 + i] = (bf16)f2bf(x3 * cc - x4 * sc); qo[88 + i] = (bf16)f2bf(x4 * cc + x3 * sc);
        }
    }
}

namespace att {
constexpr int KBUF = 12288, VOFF = KBUF, BUF = KBUF + 8192, WSF = 2 * BUF, OST = WSF + 2048, LDS_NEED = OST + 8 * 4096;
__device__ __forceinline__ int crow(int r, int hi) { return (r & 3) + 8 * (r >> 2) + 4 * hi; }
__device__ __forceinline__ void glds16(const void* gsrc, unsigned lds_dst) { unsigned keep;
    asm volatile("s_mov_b32 %0, m0\n\ts_mov_b32 m0, %2\n\ts_nop 0\n\tglobal_load_lds_dwordx4 %1, off\n\ts_mov_b32 m0, %0" : "=&s"(keep) : "v"(gsrc), "s"(lds_dst) : "memory"); }
#define ATT_WAIT_BAR() asm volatile("s_waitcnt vmcnt(0) lgkmcnt(0)\n\ts_barrier" ::: "memory")
__device__ __forceinline__ s16x4 vtr(const LAS unsigned char* p) { return __builtin_bit_cast(s16x4, __builtin_amdgcn_ds_read_tr16_b64_v4i16((LAS s16x4*)p)); }
template <int DK, bool SWA, bool K8 = false>
__device__ __forceinline__ void unit(LAS unsigned char* lds, const bf16* Qw  , int QP, const bf16* Kb  , int KP,
                                     const bf16* Vb, int VP, bf16* Ow  , int q0  , float m_init, float l_init, const float* qss = nullptr  ) {
    int tid = threadIdx.x; asm volatile("" : "+v"(tid)); const int lane = tid & 63, r32 = lane & 31, hi = lane >> 5; const int wid = __builtin_amdgcn_readfirstlane(tid >> 6);
    constexpr int NKP = K8 ? 8 : DK / 8, NP = NKP + 8, NKS = DK / 16;
    int nband = 0, first = 0;
    if (SWA) { first = q0 - 128 < 0 ? 0 : q0 - 128; const int lastk = q0 + 384 > SEQ ? SEQ : q0 + 384; nband = (lastk - first) >> 6; }
    const int NT = SWA ? 4 + nband : KEYS / 64;
#define ATT_KEY0(ti) (SWA ? ((ti) < 4 ? SEQ + 64 * (ti) : first + 64 * ((ti) - 4)) : 64 * (ti))
#define ATT_ISSUE(ti, bufo) do { const int _k0 = ATT_KEY0(ti); _Pragma("unroll") for (int _q = 0; _q < 3; ++_q) { const int _p = wid + 8 * _q; if (_p < NP) { \
        const bf16* _src = (_p < NKP) ? (K8 ? (const bf16*)((const unsigned char*)Kb + (size_t)(_k0 + lane) * 1024 + _p * 16) : (Kb + (size_t)(_k0 + lane) * KP + _p * 8)) : (Vb + (size_t)(_k0 + 16 * ((_p - NKP) & 3) + (lane >> 2)) * VP + ((_p - NKP) >> 2) * 32 + (lane & 3) * 8); \
        const int _dst = (_p < NKP) ? (_p * 1024) : (VOFF + (_p - NKP) * 1024); \
        __builtin_amdgcn_global_load_lds((const unsigned*)_src, (LAS unsigned*)(lds + (bufo) + _dst), 16, 0, 0); } } } while (0)
    ATT_ISSUE(0, 0);
    bf16x8 qr[NKS];
#pragma unroll
    for (int ks = 0; ks < NKS; ++ks) qr[ks] = *(const bf16x8*)(Qw + (size_t)r32 * QP + ks * 16 + hi * 8);
    if (qss) { const f32x2 sq = *(const f32x2*)(qss + (size_t)r32 * 16); const float qs = rsqrtf((sq.x + sq.y) * (1.0f / 96.0f) + EPS) * (K8 ? 0.0625f : 1.0f);
#pragma unroll
        for (int ks = 0; ks < NKS; ++ks) { const u32x4 w = __builtin_bit_cast(u32x4, qr[ks]); u32x4 o;
            o.x = cvt_pk_bf16(bflo(w.x) * qs, bfhi(w.x) * qs); o.y = cvt_pk_bf16(bflo(w.y) * qs, bfhi(w.y) * qs); o.z = cvt_pk_bf16(bflo(w.z) * qs, bfhi(w.z) * qs); o.w = cvt_pk_bf16(bflo(w.w) * qs, bfhi(w.w) * qs);
            qr[ks] = __builtin_bit_cast(bf16x8, o); } }
    float m_run = m_init, l_run = (hi == 0) ? l_init : 0.f; f32x16 o0, o1;
#pragma unroll
    for (int r = 0; r < 16; ++r) { o0[r] = 0.f; o1[r] = 0.f; }
    LAS float* wsf = (LAS float*)(lds + WSF) + wid * 64;
    const int qpos = q0 + wid * 32 + r32;
    for (int ti = 0; ti < NT; ++ti) {
        const int bufo = (ti & 1) * BUF;
        asm volatile("s_waitcnt vmcnt(0)" ::: "memory"); __syncthreads();
        if (ti + 1 < NT) ATT_ISSUE(ti + 1, ((ti + 1) & 1) * BUF);
        const LAS unsigned char* kb = lds + bufo + hi * 1024 + r32 * 16;
        f32x16 p0, p1;
#pragma unroll
        for (int r = 0; r < 16; ++r) { p0[r] = 0.f; p1[r] = 0.f; }
#pragma unroll
        for (int ks = 0; ks < NKS; ++ks) { bf16x8 a0, a1;
            if constexpr (K8) { const LAS unsigned char* k8p = lds + bufo + (4 * (ks >> 2) + 2 * hi + ((ks & 3) >> 1)) * 1024 + r32 * 16 + 8 * (ks & 1);
#pragma unroll
                for (int hf = 0; hf < 2; ++hf) { const u32x2 w = *(const LAS u32x2*)(k8p + 512 * hf);
                    const f32x2 c0 = __builtin_amdgcn_cvt_pk_f32_fp8((int)w.x, false), c1 = __builtin_amdgcn_cvt_pk_f32_fp8((int)w.x, true), c2 = __builtin_amdgcn_cvt_pk_f32_fp8((int)w.y, false), c3 = __builtin_amdgcn_cvt_pk_f32_fp8((int)w.y, true);
                    const u32x4 o = {cvt_pk_bf16(c0.x, c0.y), cvt_pk_bf16(c1.x, c1.y), cvt_pk_bf16(c2.x, c2.y), cvt_pk_bf16(c3.x, c3.y)}; if (hf == 0) a0 = __builtin_bit_cast(bf16x8, o); else a1 = __builtin_bit_cast(bf16x8, o); }
            } else { a0 = *(const LAS bf16x8*)(kb + ks * 2048); a1 = *(const LAS bf16x8*)(kb + ks * 2048 + 512); }
            p0 = __builtin_amdgcn_mfma_f32_32x32x16_bf16(a0, qr[ks], p0, 0, 0, 0); p1 = __builtin_amdgcn_mfma_f32_32x32x16_bf16(a1, qr[ks], p1, 0, 0, 0); }
        if (SWA && ti >= 4) { const int k0 = ATT_KEY0(ti);
#pragma unroll
            for (int r = 0; r < 16; ++r) { const int kp = k0 + crow(r, hi), d0 = qpos - kp, d1 = d0 - 32;
                if (d0 > 128 || d0 < -128) p0[r] = -1e30f; if (d1 > 128 || d1 < -128) p1[r] = -1e30f; } }
        float tmax = fmaxf(p0[0], p1[0]);
#pragma unroll
        for (int r = 1; r < 16; ++r) tmax = fmaxf(tmax, fmaxf(p0[r], p1[r]));
        tmax = fmaxf(tmax, __shfl_xor(tmax, 32));
        if (__any(tmax > m_run)) {
            const float m_new = fmaxf(m_run, tmax), alpha = __builtin_amdgcn_exp2f(m_run - m_new); l_run *= alpha; m_run = m_new;
            if (hi == 0) wsf[r32] = alpha;
            LDS_WAIT(); asm volatile("" ::: "memory");
#pragma unroll
            for (int g = 0; g < 4; ++g) { const f32x4 a = *(const LAS f32x4*)(wsf + 8 * g + 4 * hi);
#pragma unroll
                for (int e = 0; e < 4; ++e) { o0[4 * g + e] *= a[e]; o1[4 * g + e] *= a[e]; } }
            LDS_WAIT(); asm volatile("" ::: "memory");
        }
        float ls = 0.f;
#pragma unroll
        for (int r = 0; r < 16; ++r) { p0[r] = __builtin_amdgcn_exp2f(p0[r] - m_run); p1[r] = __builtin_amdgcn_exp2f(p1[r] - m_run); ls += p0[r] + p1[r]; }
        l_run += ls;
        u32x4 pw0, pw1, pw2, pw3;
        pw0 = (u32x4){cvt_pk_bf16(p0[0], p0[1]), cvt_pk_bf16(p0[2], p0[3]), cvt_pk_bf16(p0[4], p0[5]), cvt_pk_bf16(p0[6], p0[7])};
        pw1 = (u32x4){cvt_pk_bf16(p0[8], p0[9]), cvt_pk_bf16(p0[10], p0[11]), cvt_pk_bf16(p0[12], p0[13]), cvt_pk_bf16(p0[14], p0[15])};
        pw2 = (u32x4){cvt_pk_bf16(p1[0], p1[1]), cvt_pk_bf16(p1[2], p1[3]), cvt_pk_bf16(p1[4], p1[5]), cvt_pk_bf16(p1[6], p1[7])};
        pw3 = (u32x4){cvt_pk_bf16(p1[8], p1[9]), cvt_pk_bf16(p1[10], p1[11]), cvt_pk_bf16(p1[12], p1[13]), cvt_pk_bf16(p1[14], p1[15])};
        const LAS unsigned char* vp = lds + bufo + VOFF + ((lane >> 4) & 1) * 32 + (lane & 3) * 8 + (4 * hi + ((lane & 15) >> 2)) * 64;
#define ATT_VFR(i) ({ const s16x4 _lo = vtr(vp + ((i) >> 2) * 4096 + ((i) & 3) * 1024), _hi = vtr(vp + ((i) >> 2) * 4096 + ((i) & 3) * 1024 + 512); (bf16x8){_lo[0], _lo[1], _lo[2], _lo[3], _hi[0], _hi[1], _hi[2], _hi[3]}; })
        o0 = __builtin_amdgcn_mfma_f32_32x32x16_bf16(__builtin_bit_cast(bf16x8, pw0), ATT_VFR(0), o0, 0, 0, 0);
        o1 = __builtin_amdgcn_mfma_f32_32x32x16_bf16(__builtin_bit_cast(bf16x8, pw0), ATT_VFR(4), o1, 0, 0, 0);
        o0 = __builtin_amdgcn_mfma_f32_32x32x16_bf16(__builtin_bit_cast(bf16x8, pw1), ATT_VFR(1), o0, 0, 0, 0);
        o1 = __builtin_amdgcn_mfma_f32_32x32x16_bf16(__builtin_bit_cast(bf16x8, pw1), ATT_VFR(5), o1, 0, 0, 0);
        o0 = __builtin_amdgcn_mfma_f32_32x32x16_bf16(__builtin_bit_cast(bf16x8, pw2), ATT_VFR(2), o0, 0, 0, 0);
        o1 = __builtin_amdgcn_mfma_f32_32x32x16_bf16(__builtin_bit_cast(bf16x8, pw2), ATT_VFR(6), o1, 0, 0, 0);
        o0 = __builtin_amdgcn_mfma_f32_32x32x16_bf16(__builtin_bit_cast(bf16x8, pw3), ATT_VFR(3), o0, 0, 0, 0);
        o1 = __builtin_amdgcn_mfma_f32_32x32x16_bf16(__builtin_bit_cast(bf16x8, pw3), ATT_VFR(7), o1, 0, 0, 0);
#undef ATT_VFR
    }
    l_run += __shfl_xor(l_run, 32);
    if (hi == 0) wsf[32 + r32] = l_run;
    LDS_WAIT(); asm volatile("" ::: "memory");
    LAS bf16* stg = (LAS bf16*)(lds + OST) + wid * 2048;
#pragma unroll
    for (int g = 0; g < 4; ++g) { const f32x4 lv = *(const LAS f32x4*)(wsf + 32 + 8 * g + 4 * hi);
#pragma unroll
        for (int e = 0; e < 4; ++e) { const int r = 4 * g + e, orow = crow(r, hi); const float rl = __builtin_amdgcn_rcpf(lv[e]);
            if (MK_F8MID) { LAS unsigned char* s8 = (LAS unsigned char*)stg; s8[orow * 64 + r32] = (unsigned char)pk4_fp8(o0[r] * rl * F8_SO, 0.f, 0.f, 0.f); s8[orow * 64 + 32 + r32] = (unsigned char)pk4_fp8(o1[r] * rl * F8_SO, 0.f, 0.f, 0.f); }
            else { stg[orow * 64 + r32] = (bf16)f2bf(o0[r] * rl); stg[orow * 64 + 32 + r32] = (bf16)f2bf(o1[r] * rl); } } }
    LDS_WAIT(); asm volatile("" ::: "memory");
    if (MK_F8MID) {
#pragma unroll
        for (int q = 0; q < 2; ++q) { const int row = q * 16 + (lane >> 2), ch = lane & 3; const u32x4 v = *(const LAS u32x4*)((LAS unsigned char*)stg + row * 64 + ch * 16); *(u32x4*)((unsigned char*)Ow + (size_t)row * ((MK_MERGE78 && MK_F8MID) ? 1024 : 512) + ch * 16) = v; }
    } else {
#pragma unroll
        for (int q = 0; q < 4; ++q) { const int row = q * 8 + (lane >> 3), ch = lane & 7; const u32x4 v = *(const LAS u32x4*)(stg + row * 64 + ch * 8); *(u32x4*)(Ow + (size_t)row * 512 + ch * 8) = v; } }
    LDS_WAIT(); __syncthreads();
#undef ATT_KEY0
#undef ATT_ISSUE
}

constexpr int WSF2 = 3 * BUF, OST2 = WSF2 + 2048, LDS_NEED2 = OST2 + 8 * 4096;
template <int DK, bool SWA, bool K8 = false>
__device__ __forceinline__ void unit2(LAS unsigned char* lds, const bf16* Qw, int QP, const bf16* Kb, int KP, const bf16* Vb, int VP, bf16* Ow, int q0, float negM, float l_init, const float* qss = nullptr) {
    int tid = threadIdx.x; asm volatile("" : "+v"(tid)); const int lane = tid & 63, r32 = lane & 31, hi = lane >> 5; const int wid = __builtin_amdgcn_readfirstlane(tid >> 6);
    constexpr int NKP = K8 ? 8 : DK / 8, NP = NKP + 8, NKS = DK / 16;
    int nband = 0, first = 0;
    if (SWA) { first = q0 - 128 < 0 ? 0 : q0 - 128; const int lastk = q0 + 384 > SEQ ? SEQ : q0 + 384; nband = (lastk - first) >> 6; }
    const int NT = SWA ? 4 + nband : KEYS / 64;
#define ATT_KEY0(ti) (SWA ? ((ti) < 4 ? SEQ + 64 * (ti) : first + 64 * ((ti) - 4)) : 64 * (ti))
#define ATT_ISSUE(ti, bufo) do { const int _k0 = ATT_KEY0(ti); _Pragma("unroll") for (int _q = 0; _q < 3; ++_q) { const int _p = wid + 8 * _q; if (_p < NP) { \
        const bf16* _src = (_p < NKP) ? (K8 ? (const bf16*)((const unsigned char*)Kb + (size_t)(_k0 + lane) * 1024 + _p * 16) : (Kb + (size_t)(_k0 + lane) * KP + _p * 8)) : (Vb + (size_t)(_k0 + 16 * ((_p - NKP) & 3) + (lane >> 2)) * VP + ((_p - NKP) >> 2) * 32 + (lane & 3) * 8); \
        const int _dst = (_p < NKP) ? (_p * 1024) : (VOFF + (_p - NKP) * 1024); \
        glds16(_src, (unsigned)__builtin_amdgcn_readfirstlane((int)(lds0 + (bufo) + _dst))); } } } while (0)
    const unsigned lds0 = (unsigned)(unsigned long long)lds;
    ATT_ISSUE(0, 0); ATT_ISSUE(1, BUF);
    bf16x8 qr[NKS];
#pragma unroll
    for (int ks = 0; ks < NKS; ++ks) qr[ks] = *(const bf16x8*)(Qw + (size_t)r32 * QP + ks * 16 + hi * 8);
    pg8::i32x8 qf[2] = {{0, 0, 0, 0, 0, 0, 0, 0}, {0, 0, 0, 0, 0, 0, 0, 0}};
    if (qss) { const f32x2 sq = *(const f32x2*)(qss + (size_t)r32 * 16); const float qs = rsqrtf((sq.x + sq.y) * (1.0f / 96.0f) + EPS);
        if (K8) { const float q8 = qs * 64.0f;
#pragma unroll
            for (int ks = 0; ks < NKS; ++ks) { const u32x4 w = __builtin_bit_cast(u32x4, qr[ks]);
                qf[ks >> 2][2 * (ks & 3)] = (int)pk4_fp8(bflo(w.x) * q8, bfhi(w.x) * q8, bflo(w.y) * q8, bfhi(w.y) * q8); qf[ks >> 2][2 * (ks & 3) + 1] = (int)pk4_fp8(bflo(w.z) * q8, bfhi(w.z) * q8, bflo(w.w) * q8, bfhi(w.w) * q8); }
        } else {
#pragma unroll
        for (int ks = 0; ks < NKS; ++ks) { const u32x4 w = __builtin_bit_cast(u32x4, qr[ks]); u32x4 o;
            o.x = cvt_pk_bf16(bflo(w.x) * qs, bfhi(w.x) * qs); o.y = cvt_pk_bf16(bflo(w.y) * qs, bfhi(w.y) * qs); o.z = cvt_pk_bf16(bflo(w.z) * qs, bfhi(w.z) * qs); o.w = cvt_pk_bf16(bflo(w.w) * qs, bfhi(w.w) * qs);
            qr[ks] = __builtin_bit_cast(bf16x8, o); } } }
    const f32x16 zero16 = {0.f, 0.f, 0.f, 0.f, 0.f, 0.f, 0.f, 0.f, 0.f, 0.f, 0.f, 0.f, 0.f, 0.f, 0.f, 0.f};
    float l_run = (hi == 0) ? l_init : 0.f; f32x16 o0, o1;
#pragma unroll
    for (int r = 0; r < 16; ++r) { o0[r] = 0.f; o1[r] = 0.f; }
    LAS float* wsf = (LAS float*)(lds + WSF2) + wid * 64;
    const int qpos = q0 + wid * 32 + r32;
    const LAS unsigned char* kb0 = lds + hi * 1024 + r32 * 16;
    const LAS unsigned char* vp0 = lds + VOFF + ((lane >> 4) & 1) * 32 + (lane & 3) * 8 + (4 * hi + ((lane & 15) >> 2)) * 64;
#define ATT_QK8_HALF(S, kb8, half) do { \
        { const u32x4 _l = *(const LAS u32x4*)((kb8) + (2 * hi) * 1024 + (half) * 512), _h = *(const LAS u32x4*)((kb8) + (2 * hi + 1) * 1024 + (half) * 512); \
          const pg8::i32x8 _a = {(int)_l.x, (int)_l.y, (int)_l.z, (int)_l.w, (int)_h.x, (int)_h.y, (int)_h.z, (int)_h.w}; \
          S = __builtin_amdgcn_mfma_scale_f32_32x32x64_f8f6f4(_a, qf[0], zero16, 0, 0, 0, 0x7b7b7b7b, 0, 0x79797979); } \
        { const u32x4 _l = *(const LAS u32x4*)((kb8) + (4 + 2 * hi) * 1024 + (half) * 512), _h = *(const LAS u32x4*)((kb8) + (5 + 2 * hi) * 1024 + (half) * 512); \
          const pg8::i32x8 _a = {(int)_l.x, (int)_l.y, (int)_l.z, (int)_l.w, (int)_h.x, (int)_h.y, (int)_h.z, (int)_h.w}; \
          S = __builtin_amdgcn_mfma_scale_f32_32x32x64_f8f6f4(_a, qf[1], S, 0, 0, 0, 0x7b7b7b7b, 0, 0x79797979); } } while (0)
#define ATT_QK(S0, S1, bufo) do { if constexpr (K8) { const LAS unsigned char* _k8 = lds + (bufo) + r32 * 16; ATT_QK8_HALF(S0, _k8, 0); ATT_QK8_HALF(S1, _k8, 1); } else { const LAS unsigned char* _kb = kb0 + (bufo); \
        { const bf16x8 _a0 = *(const LAS bf16x8*)(_kb), _a1 = *(const LAS bf16x8*)(_kb + 512); \
          S0 = __builtin_amdgcn_mfma_f32_32x32x16_bf16(_a0, qr[0], zero16, 0, 0, 0); S1 = __builtin_amdgcn_mfma_f32_32x32x16_bf16(_a1, qr[0], zero16, 0, 0, 0); } \
        _Pragma("unroll") for (int _ks = 1; _ks < NKS; ++_ks) { const bf16x8 _a0 = *(const LAS bf16x8*)(_kb + _ks * 2048), _a1 = *(const LAS bf16x8*)(_kb + _ks * 2048 + 512); \
          S0 = __builtin_amdgcn_mfma_f32_32x32x16_bf16(_a0, qr[_ks], S0, 0, 0, 0); S1 = __builtin_amdgcn_mfma_f32_32x32x16_bf16(_a1, qr[_ks], S1, 0, 0, 0); } } } while (0)
#define ATT_VFR(vp, i) ({ const s16x4 _lo = vtr((vp) + ((i) >> 2) * 4096 + ((i) & 3) * 1024), _hi = vtr((vp) + ((i) >> 2) * 4096 + ((i) & 3) * 1024 + 512); (bf16x8){_lo[0], _lo[1], _lo[2], _lo[3], _hi[0], _hi[1], _hi[2], _hi[3]}; })
#define ATT_STEP(C0, C1, N0, N1, tt) do { \
        ATT_WAIT_BAR(); \
        if ((tt) + 2 < NT) ATT_ISSUE((tt) + 2, bo_nn); \
        if ((tt) + 1 < NT) ATT_QK(N0, N1, bo_nxt); \
        if (SWA && (tt) >= 4) { const int _k0 = ATT_KEY0(tt); \
            _Pragma("unroll") for (int r = 0; r < 16; ++r) { const int _d0 = qpos - (_k0 + crow(r, hi)), _d1 = _d0 - 32; \
                if (_d0 > 128 || _d0 < -128) C0[r] = -1e30f; if (_d1 > 128 || _d1 < -128) C1[r] = -1e30f; } } \
        float _ls = 0.f; \
        _Pragma("unroll") for (int r = 0; r < 16; ++r) { C0[r] = __builtin_amdgcn_exp2f(C0[r]); C1[r] = __builtin_amdgcn_exp2f(C1[r]); _ls += C0[r] + C1[r]; } \
        l_run += _ls; \
        const u32x4 _pw0 = {cvt_pk_bf16(C0[0], C0[1]), cvt_pk_bf16(C0[2], C0[3]), cvt_pk_bf16(C0[4], C0[5]), cvt_pk_bf16(C0[6], C0[7])}; \
        const u32x4 _pw1 = {cvt_pk_bf16(C0[8], C0[9]), cvt_pk_bf16(C0[10], C0[11]), cvt_pk_bf16(C0[12], C0[13]), cvt_pk_bf16(C0[14], C0[15])}; \
        const u32x4 _pw2 = {cvt_pk_bf16(C1[0], C1[1]), cvt_pk_bf16(C1[2], C1[3]), cvt_pk_bf16(C1[4], C1[5]), cvt_pk_bf16(C1[6], C1[7])}; \
        const u32x4 _pw3 = {cvt_pk_bf16(C1[8], C1[9]), cvt_pk_bf16(C1[10], C1[11]), cvt_pk_bf16(C1[12], C1[13]), cvt_pk_bf16(C1[14], C1[15])}; \
        const LAS unsigned char* _vp = vp0 + bo_cur; \
        o0 = __builtin_amdgcn_mfma_f32_32x32x16_bf16(__builtin_bit_cast(bf16x8, _pw0), ATT_VFR(_vp, 0), o0, 0, 0, 0); \
        o1 = __builtin_amdgcn_mfma_f32_32x32x16_bf16(__builtin_bit_cast(bf16x8, _pw0), ATT_VFR(_vp, 4), o1, 0, 0, 0); \
        o0 = __builtin_amdgcn_mfma_f32_32x32x16_bf16(__builtin_bit_cast(bf16x8, _pw1), ATT_VFR(_vp, 1), o0, 0, 0, 0); \
        o1 = __builtin_amdgcn_mfma_f32_32x32x16_bf16(__builtin_bit_cast(bf16x8, _pw1), ATT_VFR(_vp, 5), o1, 0, 0, 0); \
        o0 = __builtin_amdgcn_mfma_f32_32x32x16_bf16(__builtin_bit_cast(bf16x8, _pw2), ATT_VFR(_vp, 2), o0, 0, 0, 0); \
        o1 = __builtin_amdgcn_mfma_f32_32x32x16_bf16(__builtin_bit_cast(bf16x8, _pw2), ATT_VFR(_vp, 6), o1, 0, 0, 0); \
        o0 = __builtin_amdgcn_mfma_f32_32x32x16_bf16(__builtin_bit_cast(bf16x8, _pw3), ATT_VFR(_vp, 3), o0, 0, 0, 0); \
        o1 = __builtin_amdgcn_mfma_f32_32x32x16_bf16(__builtin_bit_cast(bf16x8, _pw3), ATT_VFR(_vp, 7), o1, 0, 0, 0); \
        { const int _t = bo_cur; bo_cur = bo_nxt; bo_nxt = bo_nn; bo_nn = _t; } } while (0)
    ATT_WAIT_BAR();
    f32x16 sa0, sa1, sb0, sb1;
    ATT_QK(sa0, sa1, 0);
    int bo_cur = 0, bo_nxt = BUF, bo_nn = 2 * BUF;
    for (int t = 0; t < NT; t += 2) {
        ATT_STEP(sa0, sa1, sb0, sb1, t);
        ATT_STEP(sb0, sb1, sa0, sa1, t + 1);
    }
    l_run += __shfl_xor(l_run, 32);
    if (hi == 0) wsf[32 + r32] = l_run;
    LDS_WAIT(); asm volatile("" ::: "memory");
    LAS bf16* stg = (LAS bf16*)(lds + OST2) + wid * 2048;
#pragma unroll
    for (int g = 0; g < 4; ++g) { const f32x4 lv = *(const LAS f32x4*)(wsf + 32 + 8 * g + 4 * hi);
#pragma unroll
        for (int e = 0; e < 4; ++e) { const int r = 4 * g + e, orow = crow(r, hi); const float rl = __builtin_amdgcn_rcpf(lv[e]);
            if (MK_F8MID) { LAS unsigned char* s8 = (LAS unsigned char*)stg; s8[orow * 64 + r32] = (unsigned char)pk4_fp8(o0[r] * rl * F8_SO, 0.f, 0.f, 0.f); s8[orow * 64 + 32 + r32] = (unsigned char)pk4_fp8(o1[r] * rl * F8_SO, 0.f, 0.f, 0.f); }
            else { stg[orow * 64 + r32] = (bf16)f2bf(o0[r] * rl); stg[orow * 64 + 32 + r32] = (bf16)f2bf(o1[r] * rl); } } }
    LDS_WAIT(); asm volatile("" ::: "memory");
    if (MK_F8MID) {
#pragma unroll
        for (int q = 0; q < 2; ++q) { const int row = q * 16 + (lane >> 2), ch = lane & 3; const u32x4 v = *(const LAS u32x4*)((LAS unsigned char*)stg + row * 64 + ch * 16); *(u32x4*)((unsigned char*)Ow + (size_t)row * ((MK_MERGE78 && MK_F8MID) ? 1024 : 512) + ch * 16) = v; }
    } else {
#pragma unroll
        for (int q = 0; q < 4; ++q) { const int row = q * 8 + (lane >> 3), ch = lane & 7; const u32x4 v = *(const LAS u32x4*)(stg + row * 64 + ch * 8); *(u32x4*)(Ow + (size_t)row * 512 + ch * 8) = v; } }
    ATT_WAIT_BAR();
#undef ATT_KEY0
#undef ATT_ISSUE
#undef ATT_QK
#undef ATT_QK8_HALF
#undef ATT_VFR
#undef ATT_STEP
}
constexpr int SUB3 = 16384, SUP3 = 2 * SUB3, WSF3 = 3 * SUP3, OST3 = WSF3 + 2048, LDS_NEED3 = OST3 + 8 * 4096;
static_assert(LDS_NEED3 <= LDSCTL_OFF, "attention LDS"); static_assert(GQX_OFF + 384 <= LDS_BYTES && TSX_OFF + 2176 * 4 <= LDS_BYTES, "LDS map");
template <int DK, bool SWA, bool K8 = false>
__device__ __forceinline__ void unit3(LAS unsigned char* lds, const bf16* Qw, int QP, const bf16* Kb, int KP, const bf16* Vb, int VP, bf16* Ow, int q0, float negM, float l_init, const float* qss = nullptr, int qoff = -1, int qspan = 256) {
    int tid = threadIdx.x; asm volatile("" : "+v"(tid)); const int lane = tid & 63, r32 = lane & 31, hi = lane >> 5; const int wid = __builtin_amdgcn_readfirstlane(tid >> 6);
    constexpr int NKP = K8 ? 8 : DK / 8, NP = NKP + 8, NKS = DK / 16;
    int nband = 0, first = 0;
    if (SWA) { first = q0 - 128 < 0 ? 0 : q0 - 128; const int lastk = q0 + qspan + 128 > SEQ ? SEQ : q0 + qspan + 128; nband = (lastk - first) >> 6; }
    const int NT = SWA ? 4 + nband : KEYS / 64, NT2 = NT >> 1;
#define ATT_KEY0(ti) (SWA ? ((ti) < 4 ? SEQ + 64 * (ti) : first + 64 * ((ti) - 4)) : 64 * (ti))
#define ATT_ISSUE(Ts, bufo) do { _Pragma("unroll") for (int _q = 0; _q < 4; ++_q) { const int _sub = _q >> 1, _p = wid + 8 * (_q & 1); const int _k0 = ATT_KEY0(2 * (Ts) + _sub); \
        const bf16* _src = (_p < 8) ? (K8 ? (const bf16*)((const unsigned char*)Kb + (size_t)(_k0 + lane) * 1024 + _p * 16) : (Kb + (size_t)(_k0 + lane) * KP + _p * 8)) : (Vb + (size_t)(_k0 + 16 * ((_p - 8) & 3) + (lane >> 2)) * VP + ((_p - 8) >> 2) * 32 + (lane & 3) * 8); \
        const int _dst = _sub * SUB3 + ((_p < 8) ? (_p * 1024) : (8192 + (_p - 8) * 1024)); \
        glds16(_src, (unsigned)__builtin_amdgcn_readfirstlane((int)(lds0 + (bufo) + _dst))); } } while (0)
    const unsigned lds0 = (unsigned)(unsigned long long)lds;
    static_assert(K8 || DK == 64, "unit3 needs an 8 KiB K tile");
    ATT_ISSUE(0, 0); ATT_ISSUE(1, SUP3);
    bf16x8 qr[NKS];
#pragma unroll
    for (int ks = 0; ks < NKS; ++ks) qr[ks] = *(const bf16x8*)(Qw + (size_t)r32 * QP + ks * 16 + hi * 8);
    pg8::i32x8 qf[2] = {{0, 0, 0, 0, 0, 0, 0, 0}, {0, 0, 0, 0, 0, 0, 0, 0}};
    if (qss) { const f32x2 sq = *(const f32x2*)(qss + (size_t)r32 * 16); const float qs = rsqrtf((sq.x + sq.y) * (1.0f / 96.0f) + EPS);
        if (K8) { const float q8 = qs * 64.0f;
#pragma unroll
            for (int ks = 0; ks < NKS; ++ks) { const u32x4 w = __builtin_bit_cast(u32x4, qr[ks]);
                qf[ks >> 2][2 * (ks & 3)] = (int)pk4_fp8(bflo(w.x) * q8, bfhi(w.x) * q8, bflo(w.y) * q8, bfhi(w.y) * q8); qf[ks >> 2][2 * (ks & 3) + 1] = (int)pk4_fp8(bflo(w.z) * q8, bfhi(w.z) * q8, bflo(w.w) * q8, bfhi(w.w) * q8); }
        } else {
#pragma unroll
        for (int ks = 0; ks < NKS; ++ks) { const u32x4 w = __builtin_bit_cast(u32x4, qr[ks]); u32x4 o;
            o.x = cvt_pk_bf16(bflo(w.x) * qs, bfhi(w.x) * qs); o.y = cvt_pk_bf16(bflo(w.y) * qs, bfhi(w.y) * qs); o.z = cvt_pk_bf16(bflo(w.z) * qs, bfhi(w.z) * qs); o.w = cvt_pk_bf16(bflo(w.w) * qs, bfhi(w.w) * qs);
            qr[ks] = __builtin_bit_cast(bf16x8, o); } } }
    const f32x16 zero16 = {0.f, 0.f, 0.f, 0.f, 0.f, 0.f, 0.f, 0.f, 0.f, 0.f, 0.f, 0.f, 0.f, 0.f, 0.f, 0.f};
    float l_run = (hi == 0) ? l_init : 0.f; f32x16 o0, o1;
#pragma unroll
    for (int r = 0; r < 16; ++r) { o0[r] = 0.f; o1[r] = 0.f; }
    LAS float* wsf = (LAS float*)(lds + WSF3) + wid * 64;
    const int qpos = q0 + (qoff < 0 ? wid * 32 : qoff) + r32;
    const LAS unsigned char* kb0 = lds + hi * 1024 + r32 * 16;
    const LAS unsigned char* vp0 = lds + 8192 + ((lane >> 4) & 1) * 32 + (lane & 3) * 8 + (4 * hi + ((lane & 15) >> 2)) * 64;
#define ATT_QK8_HALF(S, kb8, half) do { \
        { const u32x4 _l = *(const LAS u32x4*)((kb8) + (2 * hi) * 1024 + (half) * 512), _h = *(const LAS u32x4*)((kb8) + (2 * hi + 1) * 1024 + (half) * 512); \
          const pg8::i32x8 _a = {(int)_l.x, (int)_l.y, (int)_l.z, (int)_l.w, (int)_h.x, (int)_h.y, (int)_h.z, (int)_h.w}; \
          S = __builtin_amdgcn_mfma_scale_f32_32x32x64_f8f6f4(_a, qf[0], zero16, 0, 0, 0, 0x7b7b7b7b, 0, 0x79797979); } \
        { const u32x4 _l = *(const LAS u32x4*)((kb8) + (4 + 2 * hi) * 1024 + (half) * 512), _h = *(const LAS u32x4*)((kb8) + (5 + 2 * hi) * 1024 + (half) * 512); \
          const pg8::i32x8 _a = {(int)_l.x, (int)_l.y, (int)_l.z, (int)_l.w, (int)_h.x, (int)_h.y, (int)_h.z, (int)_h.w}; \
          S = __builtin_amdgcn_mfma_scale_f32_32x32x64_f8f6f4(_a, qf[1], S, 0, 0, 0, 0x7b7b7b7b, 0, 0x79797979); } } while (0)
#define ATT_QK(S0, S1, bufo) do { if constexpr (K8) { const LAS unsigned char* _k8 = lds + (bufo) + r32 * 16; ATT_QK8_HALF(S0, _k8, 0); ATT_QK8_HALF(S1, _k8, 1); } else { const LAS unsigned char* _kb = kb0 + (bufo); \
        { const bf16x8 _a0 = *(const LAS bf16x8*)(_kb), _a1 = *(const LAS bf16x8*)(_kb + 512); \
          S0 = __builtin_amdgcn_mfma_f32_32x32x16_bf16(_a0, qr[0], zero16, 0, 0, 0); S1 = __builtin_amdgcn_mfma_f32_32x32x16_bf16(_a1, qr[0], zero16, 0, 0, 0); } \
        _Pragma("unroll") for (int _ks = 1; _ks < NKS; ++_ks) { const bf16x8 _a0 = *(const LAS bf16x8*)(_kb + _ks * 2048), _a1 = *(const LAS bf16x8*)(_kb + _ks * 2048 + 512); \
          S0 = __builtin_amdgcn_mfma_f32_32x32x16_bf16(_a0, qr[_ks], S0, 0, 0, 0); S1 = __builtin_amdgcn_mfma_f32_32x32x16_bf16(_a1, qr[_ks], S1, 0, 0, 0); } } } while (0)
#define ATT_VFR(vp, i) ({ const s16x4 _lo = vtr((vp) + ((i) >> 2) * 4096 + ((i) & 3) * 1024), _hi = vtr((vp) + ((i) >> 2) * 4096 + ((i) & 3) * 1024 + 512); (bf16x8){_lo[0], _lo[1], _lo[2], _lo[3], _hi[0], _hi[1], _hi[2], _hi[3]}; })
#define ATT_SOFTPV(C0, C1, tt, vbase) do { \
        if (SWA && (tt) >= 4) { const int _k0 = ATT_KEY0(tt); \
            _Pragma("unroll") for (int r = 0; r < 16; ++r) { const int _d0 = qpos - (_k0 + crow(r, hi)), _d1 = _d0 - 32; \
                if (_d0 > 128 || _d0 < -128) C0[r] = -1e30f; if (_d1 > 128 || _d1 < -128) C1[r] = -1e30f; } } \
        float _ls = 0.f; \
        _Pragma("unroll") for (int r = 0; r < 16; ++r) { C0[r] = __builtin_amdgcn_exp2f(C0[r]); C1[r] = __builtin_amdgcn_exp2f(C1[r]); _ls += C0[r] + C1[r]; } \
        l_run += _ls; \
        const u32x4 _pw0 = {cvt_pk_bf16(C0[0], C0[1]), cvt_pk_bf16(C0[2], C0[3]), cvt_pk_bf16(C0[4], C0[5]), cvt_pk_bf16(C0[6], C0[7])}; \
        const u32x4 _pw1 = {cvt_pk_bf16(C0[8], C0[9]), cvt_pk_bf16(C0[10], C0[11]), cvt_pk_bf16(C0[12], C0[13]), cvt_pk_bf16(C0[14], C0[15])}; \
        const u32x4 _pw2 = {cvt_pk_bf16(C1[0], C1[1]), cvt_pk_bf16(C1[2], C1[3]), cvt_pk_bf16(C1[4], C1[5]), cvt_pk_bf16(C1[6], C1[7])}; \
        const u32x4 _pw3 = {cvt_pk_bf16(C1[8], C1[9]), cvt_pk_bf16(C1[10], C1[11]), cvt_pk_bf16(C1[12], C1[13]), cvt_pk_bf16(C1[14], C1[15])}; \
        const LAS unsigned char* _vp = vp0 + (vbase); \
        o0 = __builtin_amdgcn_mfma_f32_32x32x16_bf16(__builtin_bit_cast(bf16x8, _pw0), ATT_VFR(_vp, 0), o0, 0, 0, 0); \
        o1 = __builtin_amdgcn_mfma_f32_32x32x16_bf16(__builtin_bit_cast(bf16x8, _pw0), ATT_VFR(_vp, 4), o1, 0, 0, 0); \
        o0 = __builtin_amdgcn_mfma_f32_32x32x16_bf16(__builtin_bit_cast(bf16x8, _pw1), ATT_VFR(_vp, 1), o0, 0, 0, 0); \
        o1 = __builtin_amdgcn_mfma_f32_32x32x16_bf16(__builtin_bit_cast(bf16x8, _pw1), ATT_VFR(_vp, 5), o1, 0, 0, 0); \
        o0 = __builtin_amdgcn_mfma_f32_32x32x16_bf16(__builtin_bit_cast(bf16x8, _pw2), ATT_VFR(_vp, 2), o0, 0, 0, 0); \
        o1 = __builtin_amdgcn_mfma_f32_32x32x16_bf16(__builtin_bit_cast(bf16x8, _pw2), ATT_VFR(_vp, 6), o1, 0, 0, 0); \
        o0 = __builtin_amdgcn_mfma_f32_32x32x16_bf16(__builtin_bit_cast(bf16x8, _pw3), ATT_VFR(_vp, 3), o0, 0, 0, 0); \
        o1 = __builtin_amdgcn_mfma_f32_32x32x16_bf16(__builtin_bit_cast(bf16x8, _pw3), ATT_VFR(_vp, 7), o1, 0, 0, 0); \
        } while (0)
    ATT_WAIT_BAR();
    f32x16 sa0, sa1, sb0, sb1;
    ATT_QK(sa0, sa1, 0);
    int bo_cur = 0, bo_nxt = SUP3, bo_nn = 2 * SUP3;
    for (int T = 0; T < NT2; ++T) {
        ATT_WAIT_BAR();
        if (T + 2 < NT2) ATT_ISSUE(T + 2, bo_nn);
        ATT_QK(sb0, sb1, bo_cur + SUB3); ATT_SOFTPV(sa0, sa1, 2 * T, bo_cur);
        if (T + 1 < NT2) ATT_QK(sa0, sa1, bo_nxt);
        ATT_SOFTPV(sb0, sb1, 2 * T + 1, bo_cur + SUB3);
        { const int _t = bo_cur; bo_cur = bo_nxt; bo_nxt = bo_nn; bo_nn = _t; }
    }
    l_run += __shfl_xor(l_run, 32);
    if (hi == 0) wsf[32 + r32] = l_run;
    LDS_WAIT(); asm volatile("" ::: "memory");
    LAS bf16* stg = (LAS bf16*)(lds + OST3) + wid * 2048;
#pragma unroll
    for (int g = 0; g < 4; ++g) { const f32x4 lv = *(const LAS f32x4*)(wsf + 32 + 8 * g + 4 * hi);
#pragma unroll
        for (int e = 0; e < 4; ++e) { const int r = 4 * g + e, orow = crow(r, hi); const float rl = __builtin_amdgcn_rcpf(lv[e]);
            if (MK_F8MID) { LAS unsigned char* s8 = (LAS unsigned char*)stg; s8[orow * 64 + r32] = (unsigned char)pk4_fp8(o0[r] * rl * F8_SO, 0.f, 0.f, 0.f); s8[orow * 64 + 32 + r32] = (unsigned char)pk4_fp8(o1[r] * rl * F8_SO, 0.f, 0.f, 0.f); }
            else { stg[orow * 64 + r32] = (bf16)f2bf(o0[r] * rl); stg[orow * 64 + 32 + r32] = (bf16)f2bf(o1[r] * rl); } } }
    LDS_WAIT(); asm volatile("" ::: "memory");
    if (MK_F8MID) {
#pragma unroll
        for (int q = 0; q < 2; ++q) { const int row = q * 16 + (lane >> 2), ch = lane & 3; const u32x4 v = *(const LAS u32x4*)((LAS unsigned char*)stg + row * 64 + ch * 16); *(GAS u32x4*)((GAS unsigned char*)Ow + (size_t)row * ((MK_MERGE78 && MK_F8MID) ? 1024 : 512) + ch * 16) = v; }
    } else {
#pragma unroll
        for (int q = 0; q < 4; ++q) { const int row = q * 8 + (lane >> 3), ch = lane & 7; const u32x4 v = *(const LAS u32x4*)(stg + row * 64 + ch * 8); *(GAS u32x4*)((GAS bf16*)Ow + (size_t)row * 512 + ch * 8) = v; } }
    asm volatile("s_waitcnt lgkmcnt(0)\n\ts_barrier" ::: "memory");
#undef ATT_KEY0
#undef ATT_ISSUE
#undef ATT_QK
#undef ATT_QK8_HALF
#undef ATT_VFR
#undef ATT_SOFTPV
}
}

__device__ __forceinline__ void p6_attention(Frame& F) {
    const bf16* QM = WSP(bf16, WS_QM); const bf16* KM = WSP(bf16, WS_KM); const bf16* VM = WSP(bf16, WS_VM);
    const bf16* QS = WSP(bf16, WS_QS); const bf16* KS = WSP(bf16, WS_KS); const bf16* VS = WSP(bf16, WS_VS);
    constexpr int OES = MK_F8MID ? 1 : 2; unsigned char* OAb = WSP(unsigned char, WS_OA); unsigned char* OBb = WSP(unsigned char, WS_OB);
#define OA_PTR(row0, h) ((bf16*)((MK_MERGE78 && MK_F8MID) ? OAb + (size_t)(row0) * 1024 + (h) * 64 : OAb + ((size_t)(row0) * 512 + (h) * 64) * OES))
#define OB_PTR(row0, h) ((bf16*)((MK_MERGE78 && MK_F8MID) ? OAb + (size_t)(row0) * 1024 + 512 + (h) * 64 : OBb + ((size_t)(row0) * 512 + (h) * 64) * OES))
    float gqm = 0.f, gkm = 0.f, gqs = 0.f, gks = 0.f;
    { const int l = F.lane;
      const float q0v = ((const GAS float*)F.mla_q_g)[l], q1v = ((const GAS float*)F.mla_q_g)[64 + (l & 31)], k0v = ((const GAS float*)F.mla_k_g)[l], k1v = ((const GAS float*)F.mla_k_g)[64 + (l & 31)];
      const float sqv = ((const GAS float*)F.swa_q_g)[l], skv = ((const GAS float*)F.swa_k_g)[l];
      gqm = fmaxf(fabsf(q0v), fabsf(q1v)); gkm = fmaxf(fabsf(k0v), fabsf(k1v)); gqs = fabsf(sqv); gks = fabsf(skv);
#pragma unroll
      for (int o = 1; o < 64; o <<= 1) { gqm = fmaxf(gqm, __shfl_xor(gqm, o)); gkm = fmaxf(gkm, __shfl_xor(gkm, o)); gqs = fmaxf(gqs, __shfl_xor(gqs, o)); gks = fmaxf(gks, __shfl_xor(gks, o)); }
      gqm = __builtin_bit_cast(float, __builtin_amdgcn_readfirstlane(__builtin_bit_cast(int, gqm))); gkm = __builtin_bit_cast(float, __builtin_amdgcn_readfirstlane(__builtin_bit_cast(int, gkm)));
      gqs = __builtin_bit_cast(float, __builtin_amdgcn_readfirstlane(__builtin_bit_cast(int, gqs))); gks = __builtin_bit_cast(float, __builtin_amdgcn_readfirstlane(__builtin_bit_cast(int, gks))); }
    const float Mm = QSCALE_M * 96.0f * gqm * gkm * 1.02f, Ms = QSCALE_S * 64.0f * gqs * gks * 1.02f;
    float snk = fabsf(((const GAS float*)F.swa_sink)[F.lane & 7] * LOG2E);
#pragma unroll
    for (int o = 1; o < 8; o <<= 1) snk = fmaxf(snk, __shfl_xor(snk, o));
    snk = __builtin_bit_cast(float, __builtin_amdgcn_readfirstlane(__builtin_bit_cast(int, snk)));
    const bool fast_m = Mm < 60.0f, fast_s = Ms < 60.0f && snk < 60.0f;
    const int NU = (1024 - F.vcu + F.G - 1) / F.G; int xp = MK_XOVL ? (MK_XPOS5 ? (int)(((blockIdx.x >> 3) & 7) * 5 >> 3) : (int)((blockIdx.x >> 3) & 7)) : -1;
#pragma nounroll
    for (int k = 0; k <= 2 * NU; ++k) {
        if (k == xp) { __syncthreads(); p0_experts(F); __syncthreads(); }
        if (k < NU) { const int u = F.vcu + k * F.G;
            const int bh = u >> 4, qb = u & 15, b = bh >> 3, h = bh & 7, q0 = qb * 256; const size_t row0 = (size_t)b * SEQ + q0 + F.wave * 32;
            if (fast_m && MK_ATT8 && MK_FUSE5 && MK_ATT2T) att::unit3<96, false, true>(F.lds, QM + row0 * 768 + h * 96, 768, (const bf16*)((const unsigned char*)KM + (size_t)b * KEYS * 1024 + h * 128), 0, VM + (size_t)b * KEYS * 512 + h * 64, 512, OA_PTR(row0, h), q0, 0.f, 0.f, WSP(float, WS_SSQH) + (row0 * 8 + h) * 2);
            else if (fast_m && MK_ATT8 && MK_FUSE5) att::unit2<96, false, true>(F.lds, QM + row0 * 768 + h * 96, 768, (const bf16*)((const unsigned char*)KM + (size_t)b * KEYS * 1024 + h * 128), 0, VM + (size_t)b * KEYS * 512 + h * 64, 512, OA_PTR(row0, h), q0, 0.f, 0.f, WSP(float, WS_SSQH) + (row0 * 8 + h) * 2);
            else if (fast_m) att::unit2<96, false>(F.lds, QM + row0 * 768 + h * 96, 768, KM + (size_t)b * KEYS * 768 + h * 96, 768, VM + (size_t)b * KEYS * 512 + h * 64, 512, OA_PTR(row0, h), q0, 0.f, 0.f, MK_FUSE5 ? WSP(float, WS_SSQH) + (row0 * 8 + h) * 2 : nullptr);
            else if (MK_ATT8 && MK_FUSE5) att::unit<96, false, true>(F.lds, QM + row0 * 768 + h * 96, 768, (const bf16*)((const unsigned char*)KM + (size_t)b * KEYS * 1024 + h * 128), 0, VM + (size_t)b * KEYS * 512 + h * 64, 512, OA_PTR(row0, h), q0, -1e30f, 0.f, WSP(float, WS_SSQH) + (row0 * 8 + h) * 2);
            else att::unit<96, false>(F.lds, QM + row0 * 768 + h * 96, 768, KM + (size_t)b * KEYS * 768 + h * 96, 768, VM + (size_t)b * KEYS * 512 + h * 64, 512, OA_PTR(row0, h), q0, -1e30f, 0.f, MK_FUSE5 ? WSP(float, WS_SSQH) + (row0 * 8 + h) * 2 : nullptr);
        } else if (k < 2 * NU) { const int u = F.vcu + (k - NU) * F.G;
            if (fast_s && MK_ATT2T && MK_SWA2H) {
                const int b = u >> 7, hp = (u >> 5) & 3, qb = u & 31, q0 = qb * 128, hd = 2 * hp + (F.wave >> 2), qo = (F.wave & 3) * 32; const size_t row0 = (size_t)b * SEQ + q0 + qo; const float sk = F.swa_sink[hd] * LOG2E;
                att::unit3<64, true>(F.lds, QS + row0 * 512 + hd * 64, 512, KS + (size_t)b * KEYS * 128 + (hp >> 1) * 64, 128, VS + (size_t)b * KEYS * 128 + (hp >> 1) * 64, 128, OB_PTR(row0, hd), q0, 0.f, __builtin_amdgcn_exp2f(sk), nullptr, qo, 128);
                continue; }
            const int bh = u >> 4, qb = u & 15, b = bh >> 3, h = bh & 7, q0 = qb * 256; const size_t row0 = (size_t)b * SEQ + q0 + F.wave * 32; const float sk = F.swa_sink[h] * LOG2E;
            if (fast_s && MK_ATT2T) att::unit3<64, true>(F.lds, QS + row0 * 512 + h * 64, 512, KS + (size_t)b * KEYS * 128 + (h >> 2) * 64, 128, VS + (size_t)b * KEYS * 128 + (h >> 2) * 64, 128, OB_PTR(row0, h), q0, 0.f, __builtin_amdgcn_exp2f(sk));
            else if (fast_s) att::unit2<64, true>(F.lds, QS + row0 * 512 + h * 64, 512, KS + (size_t)b * KEYS * 128 + (h >> 2) * 64, 128, VS + (size_t)b * KEYS * 128 + (h >> 2) * 64, 128, OB_PTR(row0, h), q0, 0.f, __builtin_amdgcn_exp2f(sk));
            else att::unit<64, true>(F.lds, QS + row0 * 512 + h * 64, 512, KS + (size_t)b * KEYS * 128 + (h >> 2) * 64, 128, VS + (size_t)b * KEYS * 128 + (h >> 2) * 64, 128, OB_PTR(row0, h), q0, sk, 1.0f);
        }
    }
}

constexpr int WRP_SEG = 256 * 32 + 16;
__device__ __forceinline__ void p10_norm2_router(Frame& F) {
    LAS float* WRP = (LAS float*)F.lds;
    LAS int* hist = (LAS int*)(F.lds + MOE_OFF);
    LAS float* BIASP = (LAS float*)(F.lds + P10X_OFF);
    LAS float* RS = BIASP + 32;
    LAS float* BPART = RS + 128;
    const int b = blockIdx.x, bb = b >> 5, lane = F.lane; const float* mod = WSP(float, WS_MOD) + (size_t)bb * NMOD;
    { const GAS float* gmod = (const GAS float*)mod; const GAS float* gwr = (const GAS float*)F.w_router; const GAS float* gg = (const GAS float*)F.norm2_g;
#pragma unroll
      for (int h = 0; h < 4; ++h) { f32x4 w[4]; float g[4], sc[4];
#pragma unroll
          for (int u = 0; u < 4; ++u) { const int idx = F.tid + 512 * (4 * h + u), k = idx >> 3, e4 = (idx & 7) * 4; g[u] = gg[k]; sc[u] = gmod[4096 + k]; w[u] = *(const GAS f32x4*)(gwr + (size_t)k * 32 + e4); }
          asm volatile("" ::: "memory");
#pragma unroll
          for (int u = 0; u < 4; ++u) { const int idx = F.tid + 512 * (4 * h + u), k = idx >> 3, e4 = (idx & 7) * 4; *(LAS f32x4*)(WRP + (k >> 8) * WRP_SEG + (k & 255) * 32 + e4) = w[u] * (g[u] * (1.0f + sc[u])); } }
      const int e = F.tid & 31, part = F.tid >> 5; float sacc = 0.f;
#pragma unroll
      for (int h = 0; h < 8; ++h) { float mv[8], wv[8];
#pragma unroll
          for (int u = 0; u < 8; ++u) { const int k = part * 64 + 8 * h + u; mv[u] = gmod[3072 + k]; wv[u] = gwr[(size_t)k * 32 + e]; }
          asm volatile("" ::: "memory");
#pragma unroll
          for (int u = 0; u < 8; ++u) sacc += mv[u] * wv[u]; }
      BPART[part * 32 + e] = sacc; }
    if (F.tid < 32) hist[F.tid] = 0;
    __syncthreads();
    if (F.tid < 32) { float sacc = F.b_router[F.tid];
#pragma unroll
        for (int p = 0; p < 16; ++p) sacc += BPART[p * 32 + F.tid];
        BIASP[F.tid] = sacc; }
    f32x4 av[4], cv[4];
#pragma unroll
    for (int q = 0; q < 4; ++q) { const int col = 4 * lane + 256 * q; const f32x4 g = *(const f32x4*)(F.norm2_g + col), sc = *(const f32x4*)(mod + 4096 + col); cv[q] = *(const f32x4*)(mod + 3072 + col); av[q] = g * (sc + 1.0f); }
    __syncthreads();
    bf16* H2 = WSP(bf16, WS_H2); int* topi = WSP(int, WS_TOPI); float* topw = WSP(float, WS_TOPW);
    const int tok0 = 128 * b + 16 * F.wave;
#pragma nounroll
    for (int j0 = 0; j0 < 16; j0 += MK_P10R) {
        f32x4 v[MK_P10R][4];
#pragma unroll
        for (int t = 0; t < MK_P10R; ++t) { const GAS float* xr = (const GAS float*)F.out + (size_t)(tok0 + j0 + t) * D;
#pragma unroll
            for (int q = 0; q < 4; ++q) v[t][q] = *(const GAS f32x4*)(xr + 4 * lane + 256 * q); }
        asm volatile("" ::: "memory");
#pragma unroll
        for (int t = 0; t < MK_P10R; ++t) { const int tok = tok0 + j0 + t; float ss = 0.f;
#pragma unroll
            for (int q = 0; q < 4; ++q) ss += (v[t][q].x * v[t][q].x + v[t][q].y * v[t][q].y) + (v[t][q].z * v[t][q].z + v[t][q].w * v[t][q].w);
            const float rstd = rsqrtf(wave_sum(ss) * (1.0f / D) + EPS);
            if (lane == 0) RS[F.wave * 16 + j0 + t] = rstd;
#pragma unroll
            for (int q = 0; q < 4; ++q) { const f32x4 h = v[t][q] * rstd * av[q] + cv[q];
                if (MK_F8) { *(GAS unsigned*)((GAS unsigned char*)H2 + (size_t)tok * D + 4 * lane + 256 * q) = pk4_fp8(h.x * F8_SA, h.y * F8_SA, h.z * F8_SA, h.w * F8_SA); }
                else { u32x2 o; o.x = pk2(h.x, h.y); o.y = pk2(h.z, h.w); *(GAS u32x2*)((GAS bf16*)H2 + (size_t)tok * D + 4 * lane + 256 * q) = o; } } }
    }
    LDS_WAIT(); asm volatile("" ::: "memory");
    const int i = lane & 15, q = lane >> 4;
    f32x4 acc0 = {0.f, 0.f, 0.f, 0.f}, acc1 = {0.f, 0.f, 0.f, 0.f};
    { const GAS float* xp = (const GAS float*)F.out + (size_t)(tok0 + i) * D + 256 * q; const LAS float* wp = WRP + q * WRP_SEG + i;
      f32x4 xa[8], xb[8];
#define P10_LD8(dst, m0) do { _Pragma("unroll") for (int u = 0; u < 8; ++u) dst[u] = *(const GAS f32x4*)(xp + 4 * ((m0) + u)); asm volatile("" ::: "memory"); } while (0)
#define P10_MM8(src, m0) do { _Pragma("unroll") for (int u = 0; u < 8; ++u) { _Pragma("unroll") for (int c = 0; c < 4; ++c) { const float b0 = wp[(4 * ((m0) + u) + c) * 32], b1 = wp[(4 * ((m0) + u) + c) * 32 + 16]; \
          acc0 = __builtin_amdgcn_mfma_f32_16x16x4f32(src[u][c], b0, acc0, 0, 0, 0); acc1 = __builtin_amdgcn_mfma_f32_16x16x4f32(src[u][c], b1, acc1, 0, 0, 0); } } } while (0)
      P10_LD8(xa, 0);
#pragma unroll
      for (int m0 = 0; m0 < 64; m0 += 16) {
          P10_LD8(xb, m0 + 8);
          P10_MM8(xa, m0);
          if (m0 + 16 < 64) P10_LD8(xa, m0 + 16);
          P10_MM8(xb, m0 + 8);
      }
#undef P10_LD8
#undef P10_MM8
    }
    const float bs0 = BIASP[i], bs1 = BIASP[16 + i];
#pragma unroll
    for (int r = 0; r < 4; ++r) {
        const float rs = RS[F.wave * 16 + 4 * q + r]; float v0 = acc0[r] * rs + bs0, v1 = acc1[r] * rs + bs1;
        float tv[4]; int tix[4];
#pragma unroll
        for (int k = 0; k < 4; ++k) {
            float bv; int bi; if (v0 >= v1) { bv = v0; bi = i; } else { bv = v1; bi = 16 + i; }
#pragma unroll
            for (int st = 0; st < 4; ++st) { const float ov = st == 0 ? dpp_f<0xB1>(bv) : st == 1 ? dpp_f<0x4E>(bv) : st == 2 ? dpp_f<0x141>(bv) : dpp_f<0x140>(bv);
                const int oi = st == 0 ? dpp_i<0xB1>(bi) : st == 1 ? dpp_i<0x4E>(bi) : st == 2 ? dpp_i<0x141>(bi) : dpp_i<0x140>(bi); if (ov > bv || (ov == bv && oi < bi)) { bv = ov; bi = oi; } }
            tv[k] = bv; tix[k] = bi; if (bi == i) v0 = -3.0e38f; if (bi == 16 + i) v1 = -3.0e38f;
        }
        const float e1 = __expf(tv[1] - tv[0]), e2 = __expf(tv[2] - tv[0]), e3 = __expf(tv[3] - tv[0]), inv = 1.0f / (1.0f + e1 + e2 + e3);
        if (i < 4) { const int tok = tok0 + 4 * q + r; const float w = (i == 0 ? 1.0f : i == 1 ? e1 : i == 2 ? e2 : e3) * inv; const int ix = i == 0 ? tix[0] : i == 1 ? tix[1] : i == 2 ? tix[2] : tix[3];
            topi[tok * 4 + i] = ix; topw[tok * 4 + i] = w; __hip_atomic_fetch_add(&hist[ix], 1, __ATOMIC_RELAXED, __HIP_MEMORY_SCOPE_WORKGROUP); }
    }
    __syncthreads();
    if (F.tid < 32) WSP(int, WS_BCNT)[b * 32 + F.tid] = hist[F.tid];
}

struct MoeTab { LAS int* base; LAS int* ntile; LAS int* total; LAS int* mine; LAS int* cursor; LAS int* R; LAS unsigned char* texp; };
__device__ __forceinline__ MoeTab moe_tab(Frame& F) { MoeTab t; LAS int* p = (LAS int*)(F.lds + MOE_OFF); t.base = p + 32; t.ntile = p + 64; t.total = p + 96; t.mine = p + 128; t.cursor = p + 160; t.R = p + 192; t.texp = (LAS unsigned char*)(p + 200); return t; }
__device__ __forceinline__ void moe_tables(Frame& F) {
    const MoeTab t = moe_tab(F); LAS int* part = (LAS int*)F.lds;
    const int* bc = WSP(int, WS_BCNT); const int b = blockIdx.x;
    __syncthreads();
    if (F.tid < 256) { const int e = F.tid & 31, pt = F.tid >> 5; int tot = 0, bef = 0;
        for (int q = 0; q < 32; ++q) { const int bq = pt * 32 + q; const int cval = bc[bq * 32 + e]; tot += cval; if (bq < b) bef += cval; }
        part[pt * 32 + e] = tot; part[256 + pt * 32 + e] = bef; }
    __syncthreads();
    if (F.tid < 32) { int tot = 0, bef = 0;
#pragma unroll
        for (int pt = 0; pt < 8; ++pt) { tot += part[pt * 32 + F.tid]; bef += part[256 + pt * 32 + F.tid]; }
        const int nt = (tot + 255) >> 8; t.total[F.tid] = tot; t.mine[F.tid] = bef; t.ntile[F.tid] = nt; t.cursor[F.tid] = 0;
        int inc = nt;
#pragma unroll
        for (int o = 1; o < 32; o <<= 1) { const int up = __shfl_up(inc, o); if ((int)F.tid >= o) inc += up; }
        const int r0 = inc - nt; t.base[F.tid] = r0 * 256; if (F.tid == 31) t.R[0] = inc;
        for (int q = 0; q < nt; ++q) t.texp[r0 + q] = (unsigned char)F.tid; }
    __syncthreads();
}
__device__ __forceinline__ void p11_slots(Frame& F) {
    moe_tables(F); const MoeTab t = moe_tab(F);
    const int b = blockIdx.x, tok = 128 * b + (F.tid >> 2), k = F.tid & 3;
    const int e = WSP(int, WS_TOPI)[tok * 4 + k]; const float w = WSP(float, WS_TOPW)[tok * 4 + k];
    const int rank = __hip_atomic_fetch_add(&t.cursor[e], 1, __ATOMIC_RELAXED, __HIP_MEMORY_SCOPE_WORKGROUP); const int slot = t.base[e] + t.mine[e] + rank;
    WSP(int, WS_SLOTTOK)[slot] = tok; WSP(float, WS_SLOTW)[slot] = w; WSP(int, WS_TOKSLOT)[tok * 4 + k] = slot;
    if (b < 32) { const int s0 = t.base[b] + t.total[b], s1 = t.base[b] + t.ntile[b] * 256; for (int s = s0 + F.tid; s < s1; s += 512) { WSP(int, WS_SLOTTOK)[s] = 0; WSP(float, WS_SLOTW)[s] = 0.f; } }
}
__device__ __forceinline__ void p14_combine(Frame& F) {
    const unsigned char* Y = WSP(unsigned char, WS_R2); const int* ts = WSP(int, WS_TOKSLOT); const float* mod = WSP(float, WS_MOD);
    const int gw = F.vcu * NWAVES + F.wave, NGW = F.G * NWAVES, lane = F.lane;
    static_assert(MK_F8Y, "combine is written for e4m3 Y");
    const GAS int* gts = (const GAS int*)ts; u32x4 nsa = {0u, 0u, 0u, 0u}, nsb = {0u, 0u, 0u, 0u};
    if (2 * gw < MTOK) { nsa = *(const GAS u32x4*)(gts + 2 * gw * 4); nsb = *(const GAS u32x4*)(gts + 2 * gw * 4 + 4); }
    for (int t0 = 2 * gw; t0 < MTOK; t0 += 2 * NGW) {
        const int bb = t0 >> 12; const u32x4 sa = nsa, sb = nsb;
        { const int tn = t0 + 2 * NGW; if (tn < MTOK) { nsa = *(const GAS u32x4*)(gts + tn * 4); nsb = *(const GAS u32x4*)(gts + tn * 4 + 4); } }
        const unsigned sl[2][4] = {{sa.x, sa.y, sa.z, sa.w}, {sb.x, sb.y, sb.z, sb.w}};
        unsigned yw[2][4][4]; f32x4 xv[2][4], g2[4];
#pragma unroll
        for (int t = 0; t < 2; ++t)
#pragma unroll
            for (int k = 0; k < 4; ++k)
#pragma unroll
                for (int q = 0; q < 4; ++q) yw[t][k][q] = *(const unsigned*)(Y + (size_t)sl[t][k] * 1024 + 256 * q + 4 * lane);
#pragma unroll
        for (int t = 0; t < 2; ++t)
#pragma unroll
            for (int q = 0; q < 4; ++q) xv[t][q] = *(const f32x4*)(F.out + (size_t)(t0 + t) * D + 256 * q + 4 * lane);
#pragma unroll
        for (int q = 0; q < 4; ++q) g2[q] = *(const f32x4*)(mod + (size_t)bb * NMOD + 5120 + 256 * q + 4 * lane);
#pragma unroll
        for (int t = 0; t < 2; ++t) {
            float s[16];
#pragma unroll
            for (int e = 0; e < 16; ++e) s[e] = 0.f;
#pragma unroll
            for (int k = 0; k < 4; ++k) {
#pragma unroll
                for (int q = 0; q < 4; ++q) { const f32x2 lo = __builtin_amdgcn_cvt_pk_f32_fp8((int)yw[t][k][q], false), hi = __builtin_amdgcn_cvt_pk_f32_fp8((int)yw[t][k][q], true);
                    s[4 * q] += lo.x; s[4 * q + 1] += lo.y; s[4 * q + 2] += hi.x; s[4 * q + 3] += hi.y; } }
#pragma unroll
            for (int q = 0; q < 4; ++q) *(f32x4*)(F.out + (size_t)(t0 + t) * D + 256 * q + 4 * lane) = xv[t][q] + g2[q] * ((f32x4){s[4 * q], s[4 * q + 1], s[4 * q + 2], s[4 * q + 3]} * (1.0f / F8_SY));
        }
    }
}

constexpr int NPHASE = 15;
struct Args { const float* in[27]; float* out; unsigned char* ws; int ph_lo, ph_hi; };
__global__ void __launch_bounds__(NWAVES * 64, 2) mk_fwd(Args args) {
    extern __shared__ __attribute__((aligned(16))) unsigned char lds_raw[];
    Frame F;
    F.lds = (LAS unsigned char*)lds_raw;
    F.MISC = (volatile LAS unsigned*)(F.lds + MISC_OFF);
    F.tid = threadIdx.x; F.lane = F.tid & 63; F.wave = __builtin_amdgcn_readfirstlane(F.tid >> 6);
    F.G = gridDim.x; { const int bx = blockIdx.x; F.vcu = (F.G % 8 == 0) ? (bx % 8) * (F.G / 8) + bx / 8 : bx; }
    F.ws = args.ws; F.ctl = (gu32*)(args.ws + WS_CTL); F.out = args.out;
    for (int u = F.tid; u < (LDS_BYTES - LDSCTL_OFF) / 4; u += NWAVES * 64) ((LAS unsigned*)(F.lds + LDSCTL_OFF))[u] = 0u;
    __syncthreads();
    XcdBarrier bar; bar.bar = (unsigned*)(F.ctl + CW_BAR); bar.x = 0; bar.st = nullptr;
    if (MK_N_LAUNCHES == 1) bar = xcd_barrier_post((unsigned*)(F.ctl + CW_BAR), F.MISC + 8);
    const int lo = args.ph_lo, hi = args.ph_hi;
#ifndef MK_PHMASK
#define MK_PHMASK 0x7fff
#endif
#define IN(k) ((((MK_PHMASK) >> (k)) & 1) && lo <= (k) && (k) < hi)
#define SEAM(k) do { if (IN(k) && IN((k) + 1)) xcd_barrier(bar); } while (0)

    if (IN(0)) { frame_load(F); p0_prologue(F); if (MK_REP == 0) p0_prologue(F); } SEAM(0);
#if !MK_STAGE_A
    if (IN(1)) { frame_load(F); p1_norm1(F); if (MK_REP == 10) { __syncthreads(); p1_norm1(F); } } SEAM(1);
    if (IN(2)) { frame_load(F);
        SchedInProj S{F.G, (int)blockIdx.x, (const char*)WSP(bf16, WS_H), (const char*)WSP(bf16, WS_WIN)};
        constexpr int ES = MK_F8IN ? 1 : 2;
        if (MK_FUSE3) { { LAS float* tl = (LAS float*)(F.lds + TSX_OFF); const GAS float* tsrc = (const GAS float*)WSP(float, WS_TRIG);
                { float t4[4];
#pragma unroll
                  for (int u = 0; u < 4; ++u) t4[u] = tsrc[F.tid + 512 * u];
#pragma unroll
                  for (int u = 0; u < 4; ++u) tl[F.tid + 512 * u] = t4[u]; }
                if (F.tid < 64) { tl[2048 + F.tid] = ((const GAS float*)F.swa_q_g)[F.tid]; tl[2112 + F.tid] = ((const GAS float*)F.swa_k_g)[F.tid]; }
                __syncthreads(); }
            EpiInProj E{WSP(bf16, WS_R1), WSP(float, WS_SSKV), WSP(float, WS_SSQ), WSP(bf16, WS_QS), WSP(bf16, WS_KS), WSP(bf16, WS_VS), (const LAS float*)(F.lds + TSX_OFF), (const LAS float*)(F.lds + TSX_OFF) + 2048, (const LAS float*)(F.lds + TSX_OFF) + 2112};
            pg8::gemm_phase<EpiInProj, SchedInProj, true, false, MK_F8IN != 0>(F.lds, D * ES / 128, D * ES, D * ES, S, E); }
        else { EpiStoreBf16 E{WSP(bf16, WS_R1), NRAW, nullptr, MK_F8IN ? F8_INV : 1.0f};
            pg8::gemm_phase<EpiStoreBf16, SchedInProj, true, false, MK_F8IN != 0>(F.lds, D * ES / 128, D * ES, D * ES, S, E); }
    } SEAM(2);
    if (!MK_FUSE3) { if (IN(3)) { frame_load(F); p3_post_inproj(F); } SEAM(3); }
    if (IN(4)) { frame_load(F);
        if (MK_FUSE5) { LAS float* tl = (LAS float*)(F.lds + TMX_OFF); const GAS float* tsrc = (const GAS float*)WSP(float, WS_TRIG) + 2048;
            { const float t0v = tsrc[F.tid], t1v = tsrc[F.tid + 512]; tl[F.tid] = t0v; tl[F.tid + 512] = t1v; }
            if (F.tid < 96) { ((LAS float*)(F.lds + GKX_OFF))[F.tid] = ((const GAS float*)F.mla_k_g)[F.tid]; ((LAS float*)(F.lds + GQX_OFF))[F.tid] = ((const GAS float*)F.mla_q_g)[F.tid]; }
            __syncthreads(); }
        { SchedDense S{F.G, (int)blockIdx.x, MALL / 256, 4, (const char*)(WSP(bf16, WS_R1) + C_KVLAT), (const char*)WSP(bf16, WS_WKV), (size_t)256 * NRAW * 2, (size_t)256 * 256 * 2}; S.rep = (MK_REPU == 4) ? 2 : 1;
          if (MK_FUSE5) { EpiKv<MK_ATT8 != 0> E{WSP(float, WS_SSKV), WSP(bf16, WS_R1), WSP(bf16, WS_KM), WSP(bf16, WS_VM), (const LAS float*)(F.lds + TMX_OFF), (const LAS float*)(F.lds + GKX_OFF)};
            pg8::gemm_phase<EpiKv<MK_ATT8 != 0>, SchedDense, true, false>(F.lds, 256 / 64, NRAW * 2, 256 * 2, S, E); }
          else if (MK_FUSE3) { EpiUp<4> E{WSP(bf16, WS_KVUP), 1024, WSP(float, WS_SSKV), 1.0f / 256.0f}; pg8::gemm_phase<EpiUp<4>, SchedDense, true, false>(F.lds, 256 / 64, NRAW * 2, 256 * 2, S, E); }
          else { EpiStoreBf16 E{WSP(bf16, WS_KVUP), 1024, WSP(float, WS_RSKV), 1.0f}; pg8::gemm_phase<EpiStoreBf16, SchedDense, true, false>(F.lds, 256 / 64, NRAW * 2, 256 * 2, S, E); } }
        frame_load(F);
        { SchedDense S{F.G, (int)blockIdx.x, MTOK / 256, MK_FUSE5 ? 4 : 3, (const char*)(WSP(bf16, WS_R1) + C_QLAT), (const char*)WSP(bf16, WS_WQ), (size_t)256 * NRAW * 2, (size_t)256 * 384 * 2}; S.rep = (MK_REPU == 4) ? 2 : 1;
          if (MK_FUSE5) { EpiQ E{WSP(float, WS_SSQ), WSP(bf16, WS_QM), WSP(float, WS_SSQH), (const LAS float*)(F.lds + TMX_OFF), (const LAS float*)(F.lds + GQX_OFF)}; pg8::gemm_phase<EpiQ, SchedDense, true, false>(F.lds, 384 / 64, NRAW * 2, 384 * 2, S, E); }
          else if (MK_FUSE3) { EpiUp<8> E{WSP(bf16, WS_QUP), 768, WSP(float, WS_SSQ), 1.0f / 384.0f}; pg8::gemm_phase<EpiUp<8>, SchedDense, true, false>(F.lds, 384 / 64, NRAW * 2, 384 * 2, S, E); }
          else { EpiStoreBf16 E{WSP(bf16, WS_QUP), 768, WSP(float, WS_RSQ), 1.0f}; pg8::gemm_phase<EpiStoreBf16, SchedDense, true, false>(F.lds, 384 / 64, NRAW * 2, 384 * 2, S, E); } }
    } SEAM(4);
    if (!MK_FUSE5) { if (IN(5)) { frame_load(F); p5_post_up(F); } SEAM(5); }
    if (IN(6)) { frame_load(F); p6_attention(F); if (MK_REP == 6) p6_attention(F); } SEAM(6);
    if (MK_MERGE78 && MK_F8MID) {
        if (IN(7)) { frame_load(F);
            SchedDense S{F.G, (int)blockIdx.x, MTOK / 256, 4, (const char*)WSP(unsigned char, WS_OA), (const char*)WSP(unsigned char, WS_WBA), (size_t)256 * 1024, (size_t)256 * 1024}; S.rep = (MK_REPU == 7) ? 2 : 1;
            EpiMerge E{WSP(bf16, WS_R1), WSP(unsigned char, WS_H2)};
            pg8::gemm_phase<EpiMerge, SchedDense, true, false, true>(F.lds, 8, 1024, 1024, S, E);
        } SEAM(8);
    } else {
    if (IN(7)) { frame_load(F);
        constexpr int ES = MK_F8MID ? 1 : 2;
        SchedDense S{F.G, (int)blockIdx.x, MTOK / 256, 4, (const char*)WSP(bf16, WS_OA), (const char*)WSP(bf16, WS_WBA), (size_t)256 * 512 * ES, (size_t)256 * 512 * ES}; S.rep = (MK_REPU == 7) ? 2 : 1;
        EpiBranch<false> E{WSP(bf16, WS_T), WSP(bf16, WS_R1) + C_GA, nullptr};
        pg8::gemm_phase<EpiBranch<false>, SchedDense, true, false, MK_F8MID != 0>(F.lds, 512 * ES / 128, 512 * ES, 512 * ES, S, E);
    }
    if (IN(8)) { frame_load(F);
        constexpr int ES = MK_F8MID ? 1 : 2;
        SchedDense S{F.G, (int)blockIdx.x, MTOK / 256, 4, (const char*)WSP(bf16, WS_OB), (const char*)WSP(bf16, WS_WBB), (size_t)256 * 512 * ES, (size_t)256 * 512 * ES}; S.rep = (MK_REPU == 7) ? 2 : 1;
        EpiBranch<true> E{WSP(bf16, WS_T), WSP(bf16, WS_R1) + C_GB, WSP(unsigned char, WS_H2)};
        pg8::gemm_phase<EpiBranch<true>, SchedDense, true, false, MK_F8MID != 0>(F.lds, 512 * ES / 128, 512 * ES, 512 * ES, S, E);
    } SEAM(8);
    }
    if (IN(9)) { frame_load(F);
        constexpr int ES = MK_F8MID ? 1 : 2;
        SchedDense S{F.G, (int)blockIdx.x, MTOK / 256, 4, (const char*)(MK_F8MID ? (void*)WSP(unsigned char, WS_H2) : (void*)WSP(bf16, WS_T)), (const char*)WSP(bf16, WS_WOUT), (size_t)256 * 1024 * ES, (size_t)256 * 1024 * ES}; S.rep = (MK_REPU == 9) ? 2 : 1;
        EpiOutRes E{F.x, F.out, WSP(float, WS_MOD)};
        pg8::gemm_phase<EpiOutRes, SchedDense, true, false, MK_F8MID != 0>(F.lds, 1024 * ES / 128, 1024 * ES, 1024 * ES, S, E);
    } SEAM(9);
#else
    if (IN(1)) { frame_load(F); p1_norm1(F);
        const int gw = F.vcu * NWAVES + F.wave, NGW = F.G * NWAVES;
        for (int row = gw; row < MTOK; row += NGW)
#pragma unroll
            for (int q = 0; q < 4; ++q) *(f32x4*)(F.out + (size_t)row * D + 4 * F.lane + 256 * q) = *(const f32x4*)(F.x + (size_t)row * D + 4 * F.lane + 256 * q);
    } SEAM(1);
#endif
#if MK_STAGE_A != 2
    if (IN(10)) { frame_load(F); p10_norm2_router(F); if (MK_REP == 10) p10_norm2_router(F); } SEAM(10);
    if (IN(11)) { frame_load(F); p11_slots(F); } SEAM(11);
    if (IN(12)) { frame_load(F);
        if (!IN(11)) moe_tables(F);
        const MoeTab t = moe_tab(F);
        constexpr int ES = MK_F8 ? 1 : 2;
        SchedMoe S{F.G, (int)blockIdx.x, t.R[0], 8, (const char*)WSP(bf16, WS_H2), (const char*)WSP(bf16, WS_WGU), 0, (size_t)2048 * 1024 * ES, (size_t)256 * 1024 * ES, t.texp, WSP(int, WS_SLOTTOK)}; S.rep = (MK_REPU == 12) ? 2 : 1;
        EpiSwiglu E{WSP(unsigned char, WS_R1), F.b_gate_up};
        pg8::gemm_phase<EpiSwiglu, SchedMoe, true, true, MK_F8 != 0>(F.lds, 1024 * ES / 128, 1024 * ES, 1024 * ES, S, E);
    } SEAM(12);
    if (IN(13)) { frame_load(F);
        if (!IN(11)) moe_tables(F);
        const MoeTab t = moe_tab(F);
        constexpr int ES = MK_F8 ? 1 : 2;
        SchedMoe S{F.G, (int)blockIdx.x, t.R[0], 4, (const char*)WSP(bf16, WS_R1), (const char*)WSP(bf16, WS_WDN), (size_t)256 * 1024 * ES, (size_t)1024 * 1024 * ES, (size_t)256 * 1024 * ES, t.texp, nullptr}; S.rep = (MK_REPU == 13) ? 2 : 1;
        EpiDown E{WSP(unsigned char, WS_R2), F.b_down, WSP(float, WS_SLOTW)};
        pg8::gemm_phase<EpiDown, SchedMoe, true, false, MK_F8 != 0>(F.lds, 1024 * ES / 128, 1024 * ES, 1024 * ES, S, E);
    } SEAM(13);
    if (IN(14)) { frame_load(F); p14_combine(F); }
#endif
#undef IN
#undef SEAM
}

extern "C" void kernel_launch(void* const* d_in, const int* in_sizes, int n_in, void* d_out, int out_size, void* d_ws, size_t ws_size, hipStream_t stream) {
    static int grid = 0;
    if (grid == 0) {
        if (n_in != 27 || in_sizes[0] != MTOK * D || out_size != MTOK * D || ws_size < WS_END) { fprintf(stderr, "kernel_launch: unexpected shapes (n_in %d, in0 %d, out %d, ws %zu < %zu); nothing launched\n", n_in, n_in > 0 ? in_sizes[0] : -1, out_size, ws_size, (size_t)WS_END); grid = -1; return; }
        int dev = 0, cus = 0, per_cu = 0;
        if (hipGetDevice(&dev) != hipSuccess || hipDeviceGetAttribute(&cus, hipDeviceAttributeMultiprocessorCount, dev) != hipSuccess) { grid = -1; return; }
        if (hipFuncSetAttribute((const void*)mk_fwd, hipFuncAttributeMaxDynamicSharedMemorySize, LDS_BYTES) != hipSuccess) { fprintf(stderr, "kernel_launch: hipFuncSetAttribute failed\n"); grid = -1; return; }
        if (hipOccupancyMaxActiveBlocksPerMultiprocessor(&per_cu, (const void*)mk_fwd, NWAVES * 64, LDS_BYTES) != hipSuccess || per_cu < 1) fprintf(stderr, "kernel_launch: occupancy query says %d\n", per_cu);
        (void)hipGetLastError();
        grid = cus;
        if (grid != 256) fprintf(stderr, "kernel_launch: %d CUs; the thin phases assume 256 workgroups\n", grid);
    }
    if (grid < 0) return;
    if (hipMemsetAsync((char*)d_ws + WS_CTL, 0, CTL_ZERO_BYTES, stream) != hipSuccess) return;
    Args a{};
    for (int i = 0; i < 27; ++i) a.in[i] = (const float*)d_in[i];
    a.out = (float*)d_out; a.ws = (unsigned char*)d_ws;
    if (MK_N_LAUNCHES == 1) { a.ph_lo = 0; a.ph_hi = NPHASE; hipLaunchKernelGGL(mk_fwd, dim3(grid), dim3(NWAVES * 64), LDS_BYTES, stream, a); }
    else for (int p = 0; p < NPHASE; ++p) { a.ph_lo = p; a.ph_hi = p + 1; hipLaunchKernelGGL(mk_fwd, dim3(grid), dim3(NWAVES * 64), LDS_BYTES, stream, a); }
}
```

```cpp
#include <hip/hip_runtime.h>
#include <cstdio>
#include <cstdint>

#ifndef MK_N_LAUNCHES
#define MK_N_LAUNCHES 1
#endif
#ifndef MK_F8
#define MK_F8 1
#endif
#ifndef MK_WIDE
#define MK_WIDE 0
#endif
#ifndef MK_MERGE78
#define MK_MERGE78 1
#endif
#ifndef MK_ATT2T
#define MK_ATT2T 1
#endif
#ifndef MK_ATT8
#define MK_ATT8 1
#endif
#ifndef MK_FUSE5
#define MK_FUSE5 1
#endif
#ifndef MK_FUSE3
#define MK_FUSE3 1
#endif
#ifndef MK_F8MID
#define MK_F8MID 1
#endif
#ifndef MK_F8Y
#define MK_F8Y 1
#endif
#ifndef MK_F8IN
#define MK_F8IN 1
#endif
#ifndef MK_XOVL
#define MK_XOVL 1
#endif
#ifndef MK_EPIX
#define MK_EPIX 2
#endif
#ifndef MK_MIDR
#define MK_MIDR 2
#endif
#ifndef MK_P1R
#define MK_P1R 2
#endif
#ifndef MK_P10R
#define MK_P10R 2
#endif
#ifndef MK_SWA2H
#define MK_SWA2H 1
#endif
#ifndef MK_XPOS5
#define MK_XPOS5 1
#endif
#ifndef MK_SIGPRE
#define MK_SIGPRE 1
#endif
#ifndef MK_NTOUT
#define MK_NTOUT 1
#endif
#ifndef MK_XPIPE
#define MK_XPIPE 1
#endif
#ifndef MK_XNB
#define MK_XNB 32
#endif
#ifndef MK_REPU
#define MK_REPU -1
#endif
#ifndef MK_REP
#define MK_REP -1
#endif
#ifndef MK_STAGE_A
#define MK_STAGE_A 0
#endif

#define GAS __attribute__((address_space(1)))
#define LAS __attribute__((address_space(3)))
typedef unsigned short bf16;
typedef short bf16x8 __attribute__((ext_vector_type(8)));
typedef short s16x4 __attribute__((ext_vector_type(4)));
typedef float f32x2 __attribute__((ext_vector_type(2)));
typedef float f32x4 __attribute__((ext_vector_type(4)));
typedef float f32x16 __attribute__((ext_vector_type(16)));
typedef unsigned u32x2 __attribute__((ext_vector_type(2)));
typedef unsigned u32x4 __attribute__((ext_vector_type(4)));
typedef GAS unsigned gu32;

#define RLX_AGENT __ATOMIC_RELAXED, __HIP_MEMORY_SCOPE_AGENT
#define LDS_WAIT() asm volatile("s_waitcnt lgkmcnt(0)" ::: "memory")
#define VM_WAIT() asm volatile("s_waitcnt vmcnt(0)" ::: "memory")

constexpr int D = 1024, NB = 8, SEQ = 4096, CTX = 256, KEYS = SEQ + CTX;
constexpr int MTOK = NB * SEQ, MCTX = NB * CTX, MALL = MTOK + MCTX;
constexpr int NMOD = 6 * D;
constexpr int IN_COLS = 3488, NRAW = 3584;
constexpr int C_KVLAT = 0, C_KSWA = 256, C_VSWA = 384, C_QLAT = 512, C_KROPE = 896, C_QSWA = 1024, C_GA = 1536, C_GB = 2560;
constexpr int NE = 32, TOPK = 4, NASSIGN = MTOK * TOPK;
constexpr int MAXTILES = NASSIGN / 256 + NE, NSLOT = MAXTILES * 256;
constexpr float EPS = 1e-6f, LOG2E = 1.4426950408889634f;
constexpr float QSCALE_S = 0.125f * LOG2E;
constexpr float QSCALE_M = 0.10206207261596577f * LOG2E;

constexpr size_t MiB = 1u << 20;
constexpr size_t WS_CTL = 0, CTL_ZERO_BYTES = 64 * 1024;
constexpr size_t WS_MODP = 1 * MiB;
constexpr size_t WS_MOD = 3 * MiB;
constexpr size_t WS_TRIG = WS_MOD + 256 * 1024;
constexpr size_t WS_RSKV = WS_TRIG + 64 * 1024;
constexpr size_t WS_RSQ = WS_RSKV + 256 * 1024;
constexpr size_t WS_TOPI = 4 * MiB;
constexpr size_t WS_TOPW = WS_TOPI + 512 * 1024;
constexpr size_t WS_TOKSLOT = WS_TOPW + 512 * 1024;
constexpr size_t WS_BCNT = WS_TOKSLOT + 512 * 1024;
constexpr size_t WS_SLOTTOK = 6 * MiB;
constexpr size_t WS_SLOTW = 7 * MiB;
constexpr size_t WS_W = 9 * MiB;
constexpr size_t WS_WIN = WS_W;
constexpr size_t WS_WKV = WS_WIN + (size_t)NRAW * D * 2;
constexpr size_t WS_WQ = WS_WKV + 1024 * 256 * 2;
constexpr size_t WS_WBA = WS_WQ + 1024 * 384 * 2;
constexpr size_t WS_WBB = WS_WBA + 1024 * 512 * 2;
constexpr size_t WS_WOUT = WS_WBB + 1024 * 512 * 2;
constexpr size_t WS_WGU = WS_WOUT + 1024 * 1024 * 2;
constexpr size_t WS_WDN = WS_WGU + (size_t)NE * 2048 * 1024 * 2;
constexpr size_t WS_WEND = WS_WDN + (size_t)NE * 1024 * 1024 * 2;
constexpr size_t WS_R1 = 214 * MiB;
constexpr size_t WS_R2 = 486 * MiB;
constexpr size_t WS_H = WS_R2, WS_KVUP = WS_R2 + 68 * MiB, WS_QUP = WS_R2 + 136 * MiB;
constexpr size_t WS_R3 = 670 * MiB;
constexpr size_t WS_QM = WS_R3, WS_KM = WS_R3 + 48 * MiB, WS_VM = WS_R3 + 99 * MiB, WS_QS = WS_R3 + 133 * MiB, WS_KS = WS_R3 + 165 * MiB, WS_VS = WS_R3 + 174 * MiB;
constexpr size_t WS_T = WS_R3, WS_H2 = WS_R3 + 64 * MiB;
constexpr size_t WS_R4 = 853 * MiB;
constexpr size_t WS_OA = WS_R4, WS_OB = WS_R4 + 32 * MiB;
constexpr size_t WS_SSQ = 918 * MiB;
constexpr size_t WS_SSKV = 920 * MiB;
constexpr size_t WS_SSQH = 922 * MiB;
constexpr size_t WS_END = 925 * MiB;
static_assert(WS_WEND <= WS_R1, "weights fit");
static_assert(WS_R1 + (size_t)NSLOT * 1024 * 2 <= WS_R2 && WS_R1 + (size_t)MALL * NRAW * 2 <= WS_R2, "R1");
static_assert(WS_QUP + (size_t)MTOK * 768 * 2 <= WS_R3, "R2");
static_assert(WS_KM + (size_t)NB * KEYS * 768 * 2 <= WS_VM && WS_VM + (size_t)MALL * 512 * 2 <= WS_QS && WS_QS + (size_t)MTOK * 512 * 2 <= WS_KS && WS_KS + (size_t)MALL * 128 * 2 <= WS_VS && WS_VS + (size_t)MALL * 128 * 2 <= WS_R4, "R3");
static_assert(WS_R2 + (size_t)NSLOT * 1024 * 2 <= WS_R4, "Y");
static_assert(WS_RSKV + (size_t)MALL * 4 <= WS_RSQ && WS_RSQ + (size_t)MTOK * 4 <= WS_TOPI && WS_BCNT + 256 * 32 * 4 <= WS_SLOTTOK && WS_SLOTTOK + (size_t)NSLOT * 4 <= WS_SLOTW && WS_SLOTW + (size_t)NSLOT * 4 <= WS_W, "misc");
static_assert(WS_MODP + 8 * 9 * NMOD * 4 <= WS_MOD && WS_MOD + 9 * NMOD * 4 <= WS_TRIG, "mod");
constexpr int CW_BAR = 4096;

constexpr int RING_BYTES = 131072;
constexpr int LDSCTL_OFF = RING_BYTES + 2048;
constexpr int MISC_OFF = LDSCTL_OFF;
constexpr int MOE_OFF = LDSCTL_OFF + 256;
constexpr int P10X_OFF = LDSCTL_OFF + 4096;
constexpr int TSX_OFF = P10X_OFF;
constexpr int TMX_OFF = P10X_OFF + 3072, GKX_OFF = TMX_OFF + 4096, GQX_OFF = GKX_OFF + 384;
constexpr int LDS_BYTES = 147456;
constexpr int NWAVES = 8;

__device__ __forceinline__ unsigned f2bf(float f) { unsigned u = __builtin_bit_cast(unsigned, f); return (u + 0x7fffu + ((u >> 16) & 1u)) >> 16; }
__device__ __forceinline__ unsigned pk2(float lo, float hi) { return f2bf(lo) | (f2bf(hi) << 16); }
__device__ __forceinline__ float bf2f(unsigned b) { return __builtin_bit_cast(float, b << 16); }
__device__ __forceinline__ float bflo(unsigned w) { return __builtin_bit_cast(float, w << 16); }
__device__ __forceinline__ float bfhi(unsigned w) { return __builtin_bit_cast(float, w & 0xffff0000u); }
typedef __bf16 bf16x2_t __attribute__((ext_vector_type(2)));
__device__ __forceinline__ unsigned cvt_pk_bf16(float lo, float hi) { const f32x2 v = {lo, hi}; const bf16x2_t b = __builtin_convertvector(v, bf16x2_t); return __builtin_bit_cast(unsigned, b); }
constexpr float F8_SW = 64.0f, F8_SA = 4.0f, F8_INV = 1.0f / (F8_SW * F8_SA), F8_SY = 32.0f, F8_SO = 64.0f, F8_INVM = 1.0f / (F8_SO * F8_SW);
__device__ __forceinline__ float f8clamp(float v) { return __builtin_amdgcn_fmed3f(v, -448.0f, 448.0f); }
__device__ __forceinline__ unsigned pk4_fp8(float a, float b, float c, float d) { int w = __builtin_amdgcn_cvt_pk_fp8_f32(f8clamp(a), f8clamp(b), 0, false); w = __builtin_amdgcn_cvt_pk_fp8_f32(f8clamp(c), f8clamp(d), w, true); return (unsigned)w; }
template <int CTRL> __device__ __forceinline__ float dpp_f(float v) { return __builtin_bit_cast(float, __builtin_amdgcn_update_dpp(0, __builtin_bit_cast(int, v), CTRL, 0xf, 0xf, false)); }
template <int CTRL> __device__ __forceinline__ int dpp_i(int v) { return __builtin_amdgcn_update_dpp(0, v, CTRL, 0xf, 0xf, false); }
__device__ __forceinline__ float wave_sum(float v) {
    v += dpp_f<0xB1>(v); v += dpp_f<0x4E>(v); v += dpp_f<0x141>(v); v += dpp_f<0x140>(v);
    const float r0 = __builtin_bit_cast(float, __builtin_amdgcn_readlane(__builtin_bit_cast(int, v), 0)), r1 = __builtin_bit_cast(float, __builtin_amdgcn_readlane(__builtin_bit_cast(int, v), 16));
    const float r2 = __builtin_bit_cast(float, __builtin_amdgcn_readlane(__builtin_bit_cast(int, v), 32)), r3 = __builtin_bit_cast(float, __builtin_amdgcn_readlane(__builtin_bit_cast(int, v), 48));
    return (r0 + r1) + (r2 + r3);
}
__device__ __forceinline__ float sigmoidf_(float x) { return __builtin_amdgcn_rcpf(1.0f + __builtin_amdgcn_exp2f(-x * LOG2E)); }

__device__ __forceinline__ void asm_load16(f32x4& dst, const float* p) { asm volatile("global_load_dwordx4 %0, %1, off" : "=v"(dst) : "v"(p) : "memory"); }
namespace pg8 {
constexpr int BM = 256, BK = 64, HALF = 128, HTB = HALF * BK * 2, STAGE_BYTES = 8 * HTB, NXCD = 8, WGM = 8;
__host__ __device__ __forceinline__ int lds_byte(int r, int c) { const int st = (r >> 4) * 2 + (c >> 5), rr = r & 15, cc = c & 31, ob = rr * 64 + cc * 2; return st * 1024 + (ob ^ (((ob >> 9) & 1) << 5)); }
__host__ __device__ __forceinline__ void stage_rc(int b, int& R, int& C) { const int st = b / 1024, sb = b % 1024, swz = sb ^ (((sb >> 9) & 1) << 5); R = (st >> 1) * 16 + swz / 64; C = (st & 1) * 32 + (swz % 64) / 2; }
__host__ __device__ __forceinline__ int perm32(int rho) { const int n = rho >> 4, i = rho & 15; return 8 * (i >> 2) + 4 * n + (i & 3); }

struct Unit { int pm, pn, ex; };

__device__ __forceinline__ void tile_map(int L, int nM, int nN, int& pm, int& pn) {
    const int nwg = nM * nN; int wgid = L;
    { const int q = nwg / NXCD, r = nwg % NXCD, xcd = wgid % NXCD, off = wgid / NXCD; wgid = (xcd < r ? xcd * (q + 1) : r * (q + 1) + (xcd - r) * q) + off; }
    const int nig = WGM * nN, gid = wgid / nig, fm = gid * WGM, gsz = (nM - fm) < WGM ? (nM - fm) : WGM;
    pm = fm + ((wgid % nig) % gsz); pn = (wgid % nig) / gsz;
}

typedef int i32x8 __attribute__((ext_vector_type(8)));
template <class E> struct epi_has_mid { template <class T> static constexpr bool test(decltype(T::MID)*) { return T::MID; } template <class T> static constexpr bool test(...) { return false; } static constexpr bool value = test<E>(nullptr); };
template <class E> struct epi_has_pre { template <class T> static constexpr bool test(decltype(T::PRE)*) { return T::PRE; } template <class T> static constexpr bool test(...) { return false; } static constexpr bool value = test<E>(nullptr); };
template <class Epi, class Sched, bool ALIGN_EPI, bool GATHER, bool F8 = false>
__device__ __forceinline__ void gemm_phase(LAS unsigned char* lds, const int nt, const unsigned lda_b, const unsigned ldb_b, const Sched& S, const Epi& E) {
    int tid = threadIdx.x; asm volatile("" : "+v"(tid));
    const int wid = __builtin_amdgcn_readfirstlane(tid >> 6), lane = tid & 63, wr = wid >> 2, wc = wid & 3, fr = lane & 15, fq = lane >> 4;
    unsigned voffA[2][2], voffB[2], voffAn[2][2]; int sR[2], sC[2];
#pragma unroll
    for (int i = 0; i < 2; ++i) { int R, C; stage_rc(tid * 16 + i * 8192, R, C); sR[i] = R; sC[i] = C; const int Rb = Epi::PERM ? ((R & ~31) + perm32(R & 31)) : R;
        voffB[i] = (unsigned)Rb * ldb_b + (unsigned)C * 2u; voffA[0][i] = (unsigned)R * lda_b + (unsigned)C * 2u; voffA[1][i] = voffA[0][i] + (unsigned)HALF * lda_b; voffAn[0][i] = voffA[0][i]; voffAn[1][i] = voffA[1][i]; }
    const size_t kstep = (size_t)(BK * 2);
    const size_t hstepB = (size_t)HALF * ldb_b;
    const unsigned ldsw = (unsigned)wid * 1024u;
    const int aoff = lds_byte(wr * 64 + fr, fq * 8), boff = lds_byte(wc * 32 + fr, fq * 8);
#define PG8_SA(b, h) (((b) * 2 + (h)) * HTB)
#define PG8_SB(b, h) ((4 + (b) * 2 + (h)) * HTB)
#define PG8_STAGE(bufoff, gbase, voff) do { _Pragma("unroll") for (int _i = 0; _i < 2; ++_i) \
        __builtin_amdgcn_global_load_lds((const unsigned*)((const char*)(gbase) + (voff)[_i]), (LAS unsigned*)(lds + (bufoff) + ldsw + _i * 8192), 16, 0, 0); } while (0)
#define PG8_LDA(dst, b, h) do { if constexpr (F8) { _Pragma("unroll") for (int m = 0; m < 4; ++m) { const u32x4 _lo = *(const LAS u32x4*)(lds + PG8_SA(b, h) + aoff + m * 2048), _hi = *(const LAS u32x4*)(lds + PG8_SA(b, h) + aoff + m * 2048 + 1024); \
        dst##8[m] = (i32x8){(int)_lo.x, (int)_lo.y, (int)_lo.z, (int)_lo.w, (int)_hi.x, (int)_hi.y, (int)_hi.z, (int)_hi.w}; } } else { \
        _Pragma("unroll") for (int m = 0; m < 4; ++m) _Pragma("unroll") for (int k = 0; k < 2; ++k) dst[m][k] = *(const LAS bf16x8*)(lds + PG8_SA(b, h) + aoff + m * 2048 + k * 1024); } } while (0)
#define PG8_LDB(dst, b, h) do { if constexpr (F8) { _Pragma("unroll") for (int n = 0; n < 2; ++n) { const u32x4 _lo = *(const LAS u32x4*)(lds + PG8_SB(b, h) + boff + n * 2048), _hi = *(const LAS u32x4*)(lds + PG8_SB(b, h) + boff + n * 2048 + 1024); \
        dst##8[n] = (i32x8){(int)_lo.x, (int)_lo.y, (int)_lo.z, (int)_lo.w, (int)_hi.x, (int)_hi.y, (int)_hi.z, (int)_hi.w}; } } else { \
        _Pragma("unroll") for (int n = 0; n < 2; ++n) _Pragma("unroll") for (int k = 0; k < 2; ++k) dst[n][k] = *(const LAS bf16x8*)(lds + PG8_SB(b, h) + boff + n * 2048 + k * 1024); } } while (0)
#define PG8_MMA(ai, bj, At, Bt) do { __builtin_amdgcn_s_setprio(1); if constexpr (F8) { _Pragma("unroll") for (int m = 0; m < 4; ++m) _Pragma("unroll") for (int n = 0; n < 2; ++n) \
        asm volatile("v_mfma_scale_f32_16x16x128_f8f6f4 %0, %1, %2, %0, %3, %3 op_sel_hi:[0,0,0]" : "+v"(acc[ai][bj][m][n]) : "v"(Bt##8[n]), "v"(At##8[m]), "v"(f8scale)); } else { \
        _Pragma("unroll") for (int m = 0; m < 4; ++m) _Pragma("unroll") for (int n = 0; n < 2; ++n) _Pragma("unroll") for (int k = 0; k < 2; ++k) \
        acc[ai][bj][m][n] = __builtin_amdgcn_mfma_f32_16x16x32_bf16(Bt[n][k], At[m][k], acc[ai][bj][m][n], 0, 0, 0); } __builtin_amdgcn_s_setprio(0); } while (0)
#define PG8_WAIT_V(n) asm volatile("s_waitcnt vmcnt(" #n ")" ::: "memory")
#define PG8_WAIT_L(n) asm volatile("s_waitcnt lgkmcnt(" #n ")" ::: "memory")
#define PG8_BAR __builtin_amdgcn_s_barrier()
#define PG8_SCHED __builtin_amdgcn_sched_barrier(0)
#define PG8_GATHER(dst, u) do { const int* _ix = S.a_rows(u); _Pragma("unroll") for (int _h = 0; _h < 2; ++_h) _Pragma("unroll") for (int _i = 0; _i < 2; ++_i) \
        dst[_h][_i] = (unsigned)_ix[_h * HALF + sR[_i]] * lda_b + (unsigned)sC[_i] * 2u; } while (0)
#define PG8_GATHER_ISSUE(u) do { const int* _ix = S.a_rows(u); _Pragma("unroll") for (int _h = 0; _h < 2; ++_h) _Pragma("unroll") for (int _i = 0; _i < 2; ++_i) \
        voffAn[_h][_i] = (unsigned)_ix[_h * HALF + sR[_i]]; } while (0)
    Unit cur, nxt; int ui = 0;
    if (!S.next(0, cur)) return;
    constexpr bool PRE = epi_has_pre<Epi>::value; f32x4 pre[4];
    if constexpr (PRE) E.pre(cur, wr, wc, fr, fq, pre);
    f32x4 acc[2][2][4][2];
#pragma unroll
    for (int a = 0; a < 2; ++a)
#pragma unroll
        for (int b = 0; b < 2; ++b)
#pragma unroll
            for (int m = 0; m < 4; ++m)
#pragma unroll
                for (int n = 0; n < 2; ++n) acc[a][b][m][n] = (f32x4){0.f, 0.f, 0.f, 0.f};
    bf16x8 At[4][2], B0[2][2], B1[2][2]; i32x8 At8[4], B08[2], B18[2]; const int f8scale = 0x7f7f7f7f;
    const char* cA = S.a_tile(cur); const char* cB = S.b_tile(cur);
    if constexpr (GATHER) { PG8_GATHER(voffA, cur); }
    PG8_STAGE(PG8_SB(0, 0), cB, voffB); PG8_STAGE(PG8_SB(0, 1), cB + hstepB, voffB); PG8_STAGE(PG8_SA(0, 0), cA, voffA[0]); PG8_STAGE(PG8_SA(0, 1), cA, voffA[1]);
    if (wr == 1) PG8_BAR;
    PG8_WAIT_V(2); PG8_BAR;
    PG8_STAGE(PG8_SB(1, 0), cB + kstep, voffB); PG8_STAGE(PG8_SA(1, 0), cA + kstep, voffA[0]); PG8_STAGE(PG8_SB(1, 1), cB + hstepB + kstep, voffB);
    PG8_WAIT_V(6); PG8_BAR;
    for (;;) {
        const bool has_next = S.next(ui + 1, nxt);
        const char* nA = has_next ? S.a_tile(nxt) : cA; const char* nB = has_next ? S.b_tile(nxt) : cB;
        if constexpr (GATHER) { if (has_next) { PG8_GATHER_ISSUE(nxt); } }
        constexpr bool MIDH = epi_has_mid<Epi>::value;
#pragma nounroll
        for (int kh = 0; kh < (MIDH ? 2 : 1); ++kh) {
        if constexpr (MIDH) { if (kh == 1) E.mid(acc, cur, wr, wc, fr, fq); }
        const int t_lo = MIDH ? kh * (nt >> 1) : 0, t_hi = MIDH ? (kh + 1) * (nt >> 1) : nt;
#pragma nounroll
        for (int t = t_lo; t < t_hi; t += 2) {
            const bool last = (t == nt - 2);
            const char* a1 = cA + (size_t)(t + 1) * kstep;
            const char* a2 = last ? nA : cA + (size_t)(t + 2) * kstep; const char* b2 = last ? nB : cB + (size_t)(t + 2) * kstep;
            const char* a3 = a2 + kstep; const char* b3 = b2 + kstep;
            unsigned v2[2][2];
#pragma unroll
            for (int h = 0; h < 2; ++h)
#pragma unroll
                for (int i = 0; i < 2; ++i) v2[h][i] = voffA[h][i];
            if constexpr (GATHER) { if (last && has_next) {
#pragma unroll
                for (int h = 0; h < 2; ++h)
#pragma unroll
                    for (int i = 0; i < 2; ++i) { voffAn[h][i] = voffAn[h][i] * lda_b + (unsigned)sC[i] * 2u; v2[h][i] = voffAn[h][i]; } } }
            PG8_LDB(B0, 0, 0); PG8_LDB(B1, 0, 1); PG8_SCHED; PG8_LDA(At, 0, 0); PG8_STAGE(PG8_SA(1, 1), a1, voffA[1]);
            PG8_WAIT_V(8); PG8_WAIT_L(0); PG8_BAR; PG8_MMA(0, 0, At, B0); PG8_MMA(0, 1, At, B1); PG8_BAR; PG8_SCHED;
            PG8_LDA(At, 0, 1); PG8_STAGE(PG8_SB(0, 0), b2, voffB); PG8_STAGE(PG8_SB(0, 1), b2 + hstepB, voffB); PG8_STAGE(PG8_SA(0, 0), a2, v2[0]);
            PG8_WAIT_V(8); PG8_WAIT_L(0); PG8_BAR; PG8_MMA(1, 0, At, B0); PG8_MMA(1, 1, At, B1); PG8_BAR; PG8_SCHED;
            PG8_LDB(B0, 1, 0); PG8_LDB(B1, 1, 1); PG8_SCHED; PG8_LDA(At, 1, 0); PG8_STAGE(PG8_SA(0, 1), a2, v2[1]);
            PG8_WAIT_V(8); PG8_WAIT_L(0); PG8_BAR; PG8_MMA(0, 0, At, B0); PG8_MMA(0, 1, At, B1); PG8_BAR; PG8_SCHED;
            PG8_LDA(At, 1, 1); PG8_STAGE(PG8_SB(1, 0), b3, voffB); PG8_STAGE(PG8_SB(1, 1), b3 + hstepB, voffB); PG8_STAGE(PG8_SA(1, 0), a3, v2[0]);
            PG8_WAIT_V(8); PG8_WAIT_L(0); PG8_BAR; PG8_MMA(1, 0, At, B0); PG8_MMA(1, 1, At, B1); PG8_BAR; PG8_SCHED;
        }
        }
        if constexpr (ALIGN_EPI) { if (wr == 0) PG8_BAR; }
        if constexpr (F8) asm volatile("s_nop 15\n\ts_nop 15" ::: "memory");
        if constexpr (PRE) { asm volatile("s_waitcnt vmcnt(16)" ::: "memory"); E(acc, cur, wr, wc, fr, fq, pre); } else E(acc, cur, wr, wc, fr, fq);
        if (!has_next) break;
#pragma unroll
        for (int a = 0; a < 2; ++a)
#pragma unroll
            for (int b = 0; b < 2; ++b)
#pragma unroll
                for (int m = 0; m < 4; ++m)
#pragma unroll
                    for (int n = 0; n < 2; ++n) acc[a][b][m][n] = (f32x4){0.f, 0.f, 0.f, 0.f};
        cur = nxt; cA = nA; cB = nB; ++ui;
        if constexpr (PRE) E.pre(cur, wr, wc, fr, fq, pre);
        if constexpr (GATHER) {
#pragma unroll
            for (int h = 0; h < 2; ++h)
#pragma unroll
                for (int i = 0; i < 2; ++i) voffA[h][i] = voffAn[h][i]; }
        if constexpr (ALIGN_EPI) { if (wr == 1) PG8_BAR; }
    }
    PG8_WAIT_V(0);
    if constexpr (!ALIGN_EPI) { if (wr == 0) PG8_BAR; }
    PG8_BAR;
#undef PG8_SA
#undef PG8_SB
#undef PG8_STAGE
#undef PG8_LDA
#undef PG8_LDB
#undef PG8_MMA
#undef PG8_WAIT_V
#undef PG8_WAIT_L
#undef PG8_BAR
#undef PG8_SCHED
#undef PG8_GATHER
}
}

#define XB_TMO      128
#define XB_XCNT(j)  (256  + 64 * (j))
#define XB_XSUB(j)  (1280 + 64 * (j))
#define XB_XGEN(j)  (2304 + 64 * (j))
#define XB_TOP      3328
#define XB_TOPGEN   3392
#define XCD_BAR_WORDS 3456
#define XB_SPIN_CAP (1u << 18)
__device__ __forceinline__ unsigned xb_ld(unsigned* p)              { return __hip_atomic_load(p, __ATOMIC_RELAXED, __HIP_MEMORY_SCOPE_AGENT); }
__device__ __forceinline__ unsigned xb_add(unsigned* p, unsigned v) { return __hip_atomic_fetch_add(p, v, __ATOMIC_RELAXED, __HIP_MEMORY_SCOPE_AGENT); }
__device__ __forceinline__ unsigned xb_xcc_id() { return (unsigned)__builtin_amdgcn_s_getreg((3 << 11) | 20) & 0xFu; }
#define XB_SPIN(cond, bar) do { unsigned _sp = 0; while (cond) { __builtin_amdgcn_s_sleep(1); \
    if ((++_sp & 255u) == 0u) { if (xb_ld(&(bar)[XB_TMO])) break; if (_sp > XB_SPIN_CAP) { atomicAdd(&(bar)[XB_TMO], 1u); break; } } } } while (0)
struct XcdBarrier { unsigned* bar; unsigned x; volatile LAS unsigned* st; };
__device__ __forceinline__ XcdBarrier xcd_barrier_post(unsigned* bar, volatile LAS unsigned* st) {
    XcdBarrier b; b.bar = bar; b.x = xb_xcc_id(); b.st = st;
    if (threadIdx.x == 0) (void)xb_add(&bar[XB_XCNT(b.x)], 1u);
    return b;
}
__device__ __forceinline__ void xcd_barrier_complete(unsigned* bar, unsigned x, unsigned& nloc, unsigned& nx) {
    const unsigned G = gridDim.x * gridDim.y * gridDim.z;
    unsigned sum, cnt, mine, sp = 0u;
    for (;;) {
        sum = 0u; cnt = 0u; mine = 0u;
#pragma unroll
        for (unsigned j = 0; j < 16; ++j) { const unsigned c = xb_ld(&bar[XB_XCNT(j)]); sum += c; cnt += (c > 0u) ? 1u : 0u; mine = (j == x) ? c : mine; }
        if (sum == G) break;
        __builtin_amdgcn_s_sleep(1);
        if ((++sp & 255u) == 0u) { if (xb_ld(&bar[XB_TMO])) break; if (sp > XB_SPIN_CAP) { atomicAdd(&bar[XB_TMO], 1u); break; } }
    }
    nloc = mine > 0u ? mine : 1u; nx = cnt > 0u ? cnt : 1u;
}
__device__ __forceinline__ void xcd_barrier(const XcdBarrier& b) {
    asm volatile("s_waitcnt vmcnt(0)" ::: "memory");
    __syncthreads();
    if (threadIdx.x == 0) {
        unsigned* bar = b.bar;
        __builtin_amdgcn_s_waitcnt(0);
        unsigned nloc = b.st[0], nx = b.st[1];
        if (nloc == 0u) { xcd_barrier_complete(bar, b.x, nloc, nx); b.st[0] = nloc; b.st[1] = nx; }
        const unsigned old = xb_add(&bar[XB_XSUB(b.x)], 1u);
        const unsigned gen = old / nloc;
        if (old + 1u == (gen + 1u) * nloc) {
            __builtin_amdgcn_fence(__ATOMIC_RELEASE, "agent");
            asm volatile("s_waitcnt vmcnt(0)" ::: "memory");
            const unsigned og = xb_add(&bar[XB_TOP], 1u);
            const unsigned tg = og / nx;
            if (og + 1u == (tg + 1u) * nx) xb_add(&bar[XB_TOPGEN], 1u);
            else XB_SPIN(xb_ld(&bar[XB_TOPGEN]) == tg, bar);
            __builtin_amdgcn_fence(__ATOMIC_ACQUIRE, "agent");
            xb_add(&bar[XB_XGEN(b.x)], 1u);
            asm volatile("s_waitcnt vmcnt(0)" ::: "memory");
        } else {
            XB_SPIN(xb_ld(&bar[XB_XGEN(b.x)]) == gen, bar);
            __builtin_amdgcn_fence(__ATOMIC_ACQUIRE, "agent");
            asm volatile("s_waitcnt vmcnt(0)" ::: "memory");
        }
    }
    __syncthreads();
}

struct Frame {
    LAS unsigned char* lds;
    volatile LAS unsigned* MISC;
    gu32* ctl;
    int tid, lane, wave, vcu, G;
    unsigned char* ws;
    const float *x, *c, *ctx, *c_ctx, *w_ada, *b_ada, *norm1_g, *norm2_g, *w_in, *mla_q_a_g, *mla_kv_a_g, *w_q_up, *w_kv_up, *mla_q_g, *mla_k_g, *swa_q_g, *swa_k_g, *swa_sink,
        *w_branch_a, *w_branch_b, *w_out, *w_router, *b_router, *w_gate_up, *b_gate_up, *w_down, *b_down;
    float* out;
};
#define WSP(T, off) ((T*)(F.ws + (off)))
#define CAS __attribute__((address_space(4)))
__device__ __forceinline__ void frame_load(Frame& F) {
    const CAS unsigned long long* a = (const CAS unsigned long long*)__builtin_amdgcn_kernarg_segment_ptr();
    asm volatile("" : "+s"(a));
    { int t = threadIdx.x; asm volatile("" : "+v"(t)); F.tid = t; F.lane = t & 63; }
    F.x = (const float*)a[0]; F.c = (const float*)a[1]; F.ctx = (const float*)a[2]; F.c_ctx = (const float*)a[3]; F.w_ada = (const float*)a[4]; F.b_ada = (const float*)a[5]; F.norm1_g = (const float*)a[6];
    F.norm2_g = (const float*)a[7]; F.w_in = (const float*)a[8]; F.mla_q_a_g = (const float*)a[9]; F.mla_kv_a_g = (const float*)a[10]; F.w_q_up = (const float*)a[11]; F.w_kv_up = (const float*)a[12];
    F.mla_q_g = (const float*)a[13]; F.mla_k_g = (const float*)a[14]; F.swa_q_g = (const float*)a[15]; F.swa_k_g = (const float*)a[16]; F.swa_sink = (const float*)a[17]; F.w_branch_a = (const float*)a[18];
    F.w_branch_b = (const float*)a[19]; F.w_out = (const float*)a[20]; F.w_router = (const float*)a[21]; F.b_router = (const float*)a[22]; F.w_gate_up = (const float*)a[23]; F.b_gate_up = (const float*)a[24];
    F.w_down = (const float*)a[25]; F.b_down = (const float*)a[26]; F.out = (float*)a[27]; F.ws = (unsigned char*)a[28];
}

__device__ __forceinline__ void tr_item(const float* W, int N, int k0, int sc0, int sstride, bf16* WT, int K, const float* gain, LAS float* scr, int lane, int rperm = 0) {
    { const GAS float* wp = (const GAS float*)W + (size_t)(k0 + (lane >> 5)) * N + sc0 + (lane & 31) * sstride; const GAS float* gp = (const GAS float*)gain + k0 + (lane >> 5);
#pragma nounroll
      for (int i0 = 0; i0 < 32; i0 += 16) { float tv[16], gv[16];
#pragma unroll
          for (int i = 0; i < 16; ++i) { tv[i] = wp[(size_t)(2 * (i0 + i)) * N]; gv[i] = gain ? gp[2 * (i0 + i)] : 1.0f; }
          asm volatile("" ::: "memory");
#pragma unroll
          for (int i = 0; i < 16; ++i) scr[(2 * (i0 + i) + (lane >> 5)) * 33 + (lane & 31)] = tv[i] * gv[i]; } }
    LDS_WAIT(); asm volatile("" ::: "memory");
    const int c = lane & 7;
#pragma unroll
    for (int j = 0; j < 4; ++j) { const int n = (lane >> 3) + 8 * j; const int nc = rperm == 1 ? (16 * ((n >> 2) & 1) + 4 * (n >> 3) + (n & 3)) : rperm == 2 ? (16 * ((n >> 2) & 1) + 8 * ((n >> 1) & 1) + 2 * (n >> 3) + (n & 1)) : n; const LAS float* s = scr + (8 * c) * 33 + nc;
        u32x4 o; o.x = pk2(s[0 * 33], s[1 * 33]); o.y = pk2(s[2 * 33], s[3 * 33]); o.z = pk2(s[4 * 33], s[5 * 33]); o.w = pk2(s[6 * 33], s[7 * 33]);
        *(u32x4*)(WT + (size_t)n * K + k0 + 8 * c) = o; }
    LDS_WAIT(); asm volatile("" ::: "memory");
}
template <bool RPERM = false, int NB = 16>
__device__ __forceinline__ void tr_item8(const float* W, int N, int k0, int sc0, int sstride, unsigned char* WT, int K, LAS float* scr, int lane) {
    const float* wp = W + (size_t)(k0 + (lane >> 5)) * N + sc0 + (lane & 31) * sstride;
#pragma nounroll
    for (int i0 = 0; i0 < 32; i0 += NB) { float tv[NB];
#pragma unroll
        for (int i = 0; i < NB; ++i) tv[i] = wp[(size_t)(2 * (i0 + i)) * N];
#pragma unroll
        for (int i = 0; i < NB; ++i) scr[(2 * (i0 + i) + (lane >> 5)) * 33 + (lane & 31)] = tv[i] * F8_SW; }
    LDS_WAIT(); asm volatile("" ::: "memory");
    const int c = lane & 3;
#pragma unroll
    for (int j = 0; j < 2; ++j) { const int n = (lane >> 2) + 16 * j; const int ncol = RPERM ? (16 * ((n >> 2) & 1) + 4 * (n >> 3) + (n & 3)) : n; const LAS float* s = scr + (16 * c) * 33 + ncol;
        u32x4 o; o.x = pk4_fp8(s[0 * 33], s[1 * 33], s[2 * 33], s[3 * 33]); o.y = pk4_fp8(s[4 * 33], s[5 * 33], s[6 * 33], s[7 * 33]);
        o.z = pk4_fp8(s[8 * 33], s[9 * 33], s[10 * 33], s[11 * 33]); o.w = pk4_fp8(s[12 * 33], s[13 * 33], s[14 * 33], s[15 * 33]);
        *(u32x4*)(WT + (size_t)n * K + k0 + 16 * c) = o; }
    LDS_WAIT(); asm volatile("" ::: "memory");
}
template <bool INTER>
__device__ __forceinline__ void tr_item8w(const float* W, int N, int k0, int sc0, unsigned char* WT, int K, LAS float* scr, int lane) {
    const float* wp = W + (size_t)(k0 + (lane >> 4)) * N + sc0 + (lane & 15) * 4;
    f32x4 tv[8];
#pragma unroll
    for (int i = 0; i < 8; ++i) tv[i] = *(const f32x4*)(wp + (size_t)(4 * i) * N);
#pragma unroll
    for (int i = 0; i < 8; ++i) { LAS float* sp = scr + (4 * i + (lane >> 4)) * 65 + (lane & 15) * 4; sp[0] = tv[i][0] * F8_SW; sp[1] = tv[i][1] * F8_SW; sp[2] = tv[i][2] * F8_SW; sp[3] = tv[i][3] * F8_SW; }
    LDS_WAIT(); asm volatile("" ::: "memory");
    const int col = INTER ? (2 * (lane & 31) + (lane >> 5)) : lane, drow = INTER ? ((lane & 31) + 128 * (lane >> 5)) : lane;
#pragma unroll
    for (int ch = 0; ch < 2; ++ch) { const LAS float* sr = scr + (16 * ch) * 65 + col;
        u32x4 o; o.x = pk4_fp8(sr[0 * 65], sr[1 * 65], sr[2 * 65], sr[3 * 65]); o.y = pk4_fp8(sr[4 * 65], sr[5 * 65], sr[6 * 65], sr[7 * 65]);
        o.z = pk4_fp8(sr[8 * 65], sr[9 * 65], sr[10 * 65], sr[11 * 65]); o.w = pk4_fp8(sr[12 * 65], sr[13 * 65], sr[14 * 65], sr[15 * 65]);
        *(u32x4*)(WT + (size_t)drow * K + k0 + 16 * ch) = o; }
    LDS_WAIT(); asm volatile("" ::: "memory");
}
__device__ __forceinline__ int win_src(int d) {
    if (MK_FUSE3) { if (d >= 256 && d < 512) { const int t = d - 256; return 288 + 64 * ((t >> 5) & 3) + 32 * (t >> 7); }
                    if (d >= 1024 && d < 1536) { const int t = d - 1024; return 928 + 64 * (4 * (t >> 8) + ((t >> 5) & 3)) + 32 * ((t >> 7) & 1); } }
    if (d < 256) return d; if (d < 384) return d - 256 + 288; if (d < 512) return d - 384 + 416; if (d < 896) return d - 512 + 544;
    if (d < 928) return d - 896 + 256; if (d < 1024) return -1; if (d < 1536) return d - 1024 + 928; if (d < 2560) return d - 1536 + 1440; return d - 2560 + 2464;
}
__device__ __forceinline__ void p0_experts(Frame& F);
__device__ __forceinline__ void p0_prologue(Frame& F) {
    LAS float* scr = (LAS float*)(F.lds + F.wave * 16384);
    const int gw = F.vcu * NWAVES + F.wave, NGW = F.G * NWAVES;
    constexpr int I_ADA = 768, I_TRIG = 24, I_WIN = 16 * 112, I_WKV = 4 * 32, I_WQ = 6 * (MK_FUSE5 ? 32 : 24), I_WB = 8 * 32, I_WOUT = 16 * 32, I_WGU = NE * 16 * 64, I_WDN = NE * 16 * 32;
    constexpr int NITEMS = I_ADA + I_TRIG + I_WIN + I_WKV + I_WQ + 2 * I_WB + I_WOUT;
    for (int it = gw; it < NITEMS; it += NGW) {
        const int lane = F.lane;
        int r = it;
        if (r < I_ADA) {
            const int cg = r % 96, kc = r / 96, k0 = kc * 128, col = cg * 64 + lane;
            float cv18[18];
#pragma unroll
            for (int j = 0; j < 18; ++j) { const int idx = j * 64 + lane, rr = idx >> 7, kk = idx & 127; cv18[j] = (rr < 8) ? ((const GAS float*)F.c)[rr * D + k0 + kk] : ((const GAS float*)F.c_ctx)[k0 + kk]; }
            asm volatile("" ::: "memory");
#pragma unroll
            for (int j = 0; j < 18; ++j) { const float v = cv18[j]; scr[j * 64 + lane] = v / (1.0f + __expf(-v)); }
            LDS_WAIT(); asm volatile("" ::: "memory");
            float acc[9];
#pragma unroll
            for (int q = 0; q < 9; ++q) acc[q] = 0.f;
            { const GAS float* wp0 = (const GAS float*)F.w_ada + (size_t)k0 * NMOD + col; float wa[16], wb[16];
#define ADA_LD(dst, kk) do { _Pragma("unroll") for (int u = 0; u < 16; ++u) dst[u] = wp0[(size_t)((kk) + u) * NMOD]; asm volatile("" ::: "memory"); } while (0)
#define ADA_MM(src, kk) do { _Pragma("unroll") for (int u4 = 0; u4 < 4; ++u4) _Pragma("unroll") for (int q = 0; q < 9; ++q) { const f32x4 sv = *(const LAS f32x4*)(scr + q * 128 + (kk) + 4 * u4); \
                  acc[q] += sv[0] * src[4 * u4] + sv[1] * src[4 * u4 + 1] + sv[2] * src[4 * u4 + 2] + sv[3] * src[4 * u4 + 3]; } } while (0)
              ADA_LD(wa, 0);
#pragma unroll
              for (int kk0 = 0; kk0 < 128; kk0 += 32) { ADA_LD(wb, kk0 + 16); ADA_MM(wa, kk0); if (kk0 + 32 < 128) ADA_LD(wa, kk0 + 32); ADA_MM(wb, kk0 + 16); }
#undef ADA_LD
#undef ADA_MM
            }
            float* mp = WSP(float, WS_MODP);
#pragma unroll
            for (int q = 0; q < 9; ++q) mp[(size_t)(kc * 9 + q) * NMOD + col] = acc[q];
            LDS_WAIT(); asm volatile("" ::: "memory");
            continue;
        } r -= I_ADA;
        if (r < I_TRIG) {
            float* ts = WSP(float, WS_TRIG); const int i = r * 64 + lane;
            if (i < 1024) { const int pos = i >> 4, f = i & 15; const float fr = exp2f(-13.287712379549449f * (float)f / 16.0f), a = (float)pos * fr; ts[i] = __cosf(a); ts[1024 + i] = __sinf(a); }
            else { const int j = i - 1024, pos = j >> 3, f = j & 7; const float fr = exp2f(-13.287712379549449f * (float)f / 8.0f), a = (float)pos * fr; ts[2048 + j] = __cosf(a); ts[2560 + j] = __sinf(a); }
            continue;
        } r -= I_TRIG;
        if (r < I_WIN) { const int kb = r / 112, db = r % 112, d0 = db * 32, sc = win_src(d0);
            if (MK_F8IN) { unsigned char* wt = WSP(unsigned char, WS_WIN) + (size_t)d0 * D;
                const bool rp = MK_FUSE3 && ((d0 >= 256 && d0 < 512) || (d0 >= 1024 && d0 < 1536));
                if (sc >= 0) { if (rp) tr_item8<true>(F.w_in, IN_COLS, kb * 64, sc, 1, wt, D, scr, lane); else tr_item8<false>(F.w_in, IN_COLS, kb * 64, sc, 1, wt, D, scr, lane); }
                else { const int c = lane & 3;
#pragma unroll
                    for (int j = 0; j < 2; ++j) { const int n = (lane >> 2) + 16 * j; *(u32x4*)(wt + (size_t)n * D + kb * 64 + 16 * c) = (u32x4){0u, 0u, 0u, 0u}; } }
            } else { bf16* wt = WSP(bf16, WS_WIN) + (size_t)d0 * D;
                const bool rp = MK_FUSE3 && ((d0 >= 256 && d0 < 512) || (d0 >= 1024 && d0 < 1536));
                if (sc >= 0) tr_item(F.w_in, IN_COLS, kb * 64, sc, 1, wt, D, nullptr, scr, lane, rp ? 1 : 0);
                else { const int c = lane & 7;
#pragma unroll
                    for (int j = 0; j < 4; ++j) { const int n = (lane >> 3) + 8 * j; *(u32x4*)(wt + (size_t)n * D + kb * 64 + 8 * c) = (u32x4){0u, 0u, 0u, 0u}; } } }
            continue; } r -= I_WIN;
        if (r < I_WKV) { const int kb = r / 32, db = r % 32; int sc = db * 32;
            if (MK_FUSE5) { const int d0 = db * 32, pn = d0 >> 8, t = d0 & 255, bj = t >> 7, wc = (t >> 5) & 3; sc = 128 * (2 * pn + (wc >> 1)) + 64 * (wc & 1) + 32 * bj; }
            tr_item(F.w_kv_up, 1024, kb * 64, sc, 1, WSP(bf16, WS_WKV) + (size_t)db * 32 * 256, 256, F.mla_kv_a_g, scr, lane); continue; } r -= I_WKV;
        if (r < I_WQ) {
            if (MK_FUSE5) { const int kb = r / 32, db = r % 32, d0 = db * 32, pn = d0 >> 8, t = d0 & 255, bj = t >> 7, wc = (t >> 5) & 3, head = 2 * pn + (wc >> 1); bf16* wt = WSP(bf16, WS_WQ) + (size_t)d0 * 384;
                if ((wc & 1) == 0) tr_item(F.w_q_up, 768, kb * 64, 96 * head + 32 * bj, 1, wt, 384, F.mla_q_a_g, scr, lane);
                else if (bj == 0) tr_item(F.w_q_up, 768, kb * 64, 96 * head + 64, 1, wt, 384, F.mla_q_a_g, scr, lane, 2);
                else { const int c = lane & 7;
#pragma unroll
                    for (int j = 0; j < 4; ++j) { const int n = (lane >> 3) + 8 * j; *(u32x4*)(wt + (size_t)n * 384 + kb * 64 + 8 * c) = (u32x4){0u, 0u, 0u, 0u}; } }
            } else { const int kb = r / 24, db = r % 24; tr_item(F.w_q_up, 768, kb * 64, db * 32, 1, WSP(bf16, WS_WQ) + (size_t)db * 32 * 384, 384, F.mla_q_a_g, scr, lane); }
            continue; } r -= I_WQ;
        if (r < I_WB) { const int kb = r / 32, db = r % 32; if (MK_F8MID && MK_MERGE78) tr_item8(F.w_branch_a, 1024, kb * 64, db * 32, 1, WSP(unsigned char, WS_WBA) + (size_t)db * 32 * 1024, 1024, scr, lane);
            else if (MK_F8MID) tr_item8(F.w_branch_a, 1024, kb * 64, db * 32, 1, WSP(unsigned char, WS_WBA) + (size_t)db * 32 * 512, 512, scr, lane);
            else tr_item(F.w_branch_a, 1024, kb * 64, db * 32, 1, WSP(bf16, WS_WBA) + (size_t)db * 32 * 512, 512, nullptr, scr, lane); continue; } r -= I_WB;
        if (r < I_WB) { const int kb = r / 32, db = r % 32; if (MK_F8MID && MK_MERGE78) tr_item8(F.w_branch_b, 1024, kb * 64, db * 32, 1, WSP(unsigned char, WS_WBA) + (size_t)db * 32 * 1024 + 512, 1024, scr, lane);
            else if (MK_F8MID) tr_item8(F.w_branch_b, 1024, kb * 64, db * 32, 1, WSP(unsigned char, WS_WBB) + (size_t)db * 32 * 512, 512, scr, lane);
            else tr_item(F.w_branch_b, 1024, kb * 64, db * 32, 1, WSP(bf16, WS_WBB) + (size_t)db * 32 * 512, 512, nullptr, scr, lane); continue; } r -= I_WB;
        if (r < I_WOUT) { const int kb = r / 32, db = r % 32; if (MK_F8MID) tr_item8(F.w_out, 1024, kb * 64, db * 32, 1, WSP(unsigned char, WS_WOUT) + (size_t)db * 32 * 1024, 1024, scr, lane);
            else tr_item(F.w_out, 1024, kb * 64, db * 32, 1, WSP(bf16, WS_WOUT) + (size_t)db * 32 * 1024, 1024, nullptr, scr, lane); continue; } r -= I_WOUT;
    }
    if (!MK_XOVL) p0_experts(F);
}
struct XItem { const float* wp; size_t rstep; unsigned char* dst; };
__device__ __forceinline__ XItem x_item(Frame& F, int r, int lane) {
    constexpr int I_WGU = NE * 16 * 64; XItem I;
    if (r < I_WGU) { const int e = r / 1024, q = r % 1024, kb = q / 64, db = q % 64, d0 = db * 32, pn = d0 >> 8, bj = (d0 >> 7) & 1, x0 = d0 & 127;
        I.wp = F.w_gate_up + (size_t)e * 1024 * 2048 + (size_t)(kb * 64 + (lane >> 5)) * 2048 + 2 * (128 * pn + x0) + bj + (lane & 31) * 2; I.rstep = 2 * 2048;
        I.dst = WSP(unsigned char, WS_WGU) + ((size_t)e * 2048 + d0) * 1024 + kb * 64; }
    else { r -= I_WGU; const int e = r / 512, q = r % 512, kb = q / 32, db = q % 32;
        I.wp = F.w_down + (size_t)e * 1024 * 1024 + (size_t)(kb * 64 + (lane >> 5)) * 1024 + db * 32 + (lane & 31); I.rstep = 2 * 1024;
        I.dst = WSP(unsigned char, WS_WDN) + ((size_t)e * 1024 + db * 32) * 1024 + kb * 64; }
    return I;
}
__device__ __forceinline__ void x_load(const XItem& I, float (&tv)[32]) {
#pragma unroll
    for (int i = 0; i < 32; ++i) tv[i] = I.wp[(size_t)i * I.rstep];
}
__device__ __forceinline__ void x_finish(const XItem& I, float (&tv)[32], LAS float* scr, int lane) {
#pragma unroll
    for (int i = 0; i < 32; ++i) scr[(2 * i + (lane >> 5)) * 33 + (lane & 31)] = tv[i] * F8_SW;
    LDS_WAIT(); asm volatile("" ::: "memory");
    const int c = lane & 3;
#pragma unroll
    for (int j = 0; j < 2; ++j) { const int n = (lane >> 2) + 16 * j; const LAS float* s = scr + (16 * c) * 33 + n;
        u32x4 o; o.x = pk4_fp8(s[0 * 33], s[1 * 33], s[2 * 33], s[3 * 33]); o.y = pk4_fp8(s[4 * 33], s[5 * 33], s[6 * 33], s[7 * 33]);
        o.z = pk4_fp8(s[8 * 33], s[9 * 33], s[10 * 33], s[11 * 33]); o.w = pk4_fp8(s[12 * 33], s[13 * 33], s[14 * 33], s[15 * 33]);
        *(u32x4*)(I.dst + (size_t)n * 1024 + 16 * c) = o; }
    LDS_WAIT(); asm volatile("" ::: "memory");
}
__device__ __forceinline__ void p0_experts(Frame& F) {
    int lane0 = F.lane, wv = F.wave; asm volatile("" : "+v"(lane0), "+s"(wv));
    LAS float* scr = (LAS float*)(F.lds + wv * 16384);
    const int gw = F.vcu * NWAVES + wv, NGW = F.G * NWAVES;
    constexpr int I_WGU = NE * 16 * 64, I_WDN = NE * 16 * 32;
    if (MK_F8 && !MK_WIDE && MK_XPIPE) {
        const int lane = lane0; int it = gw; if (it >= I_WGU + I_WDN) return;
        float ta[32], tb[32]; XItem A = x_item(F, it, lane), B = A; x_load(A, ta);
#pragma nounroll
        for (;;) {
            const int itb = it + NGW; const bool hb = itb < I_WGU + I_WDN; if (hb) { B = x_item(F, itb, lane); x_load(B, tb); }
            x_finish(A, ta, scr, lane); if (!hb) break;
            it = itb + NGW; const bool ha = it < I_WGU + I_WDN; if (ha) { A = x_item(F, it, lane); x_load(A, ta); }
            x_finish(B, tb, scr, lane); if (!ha) break;
        }
        return;
    }
    for (int it = gw; it < I_WGU + I_WDN; it += NGW) {
        const int lane = lane0; int r = it;
        if (r < I_WGU) {
            if (MK_F8 && MK_WIDE) {
                const int e = r / 1024, q = r % 1024, kb = q / 32, cb = q % 32, j0 = 32 * cb, pn = j0 >> 7, x0 = j0 & 127;
                tr_item8w<true>(F.w_gate_up + (size_t)e * 1024 * 2048, 2048, kb * 32, 64 * cb, WSP(unsigned char, WS_WGU) + ((size_t)e * 2048 + 256 * pn + x0) * 1024, 1024, scr, lane);
            } else if (MK_F8) { const int e = r / 1024, q = r % 1024, kb = q / 64, db = q % 64, d0 = db * 32, pn = d0 >> 8, bj = (d0 >> 7) & 1, x0 = d0 & 127;
                tr_item8<false, MK_XNB>(F.w_gate_up + (size_t)e * 1024 * 2048, 2048, kb * 64, 2 * (128 * pn + x0) + bj, 2, WSP(unsigned char, WS_WGU) + ((size_t)e * 2048 + d0) * 1024, 1024, scr, lane);
            } else { const int e = r / 1024, q = r % 1024, kb = q / 64, db = q % 64, d0 = db * 32, pn = d0 >> 8, bj = (d0 >> 7) & 1, x0 = d0 & 127;
                tr_item(F.w_gate_up + (size_t)e * 1024 * 2048, 2048, kb * 64, 2 * (128 * pn + x0) + bj, 2, WSP(bf16, WS_WGU) + ((size_t)e * 2048 + d0) * 1024, 1024, nullptr, scr, lane); }
            continue; } r -= I_WGU;
        { if (MK_F8 && MK_WIDE) { const int e = r / 512, q = r % 512, kb = q / 16, cb = q % 16;
              tr_item8w<false>(F.w_down + (size_t)e * 1024 * 1024, 1024, kb * 32, 64 * cb, WSP(unsigned char, WS_WDN) + ((size_t)e * 1024 + 64 * cb) * 1024, 1024, scr, lane); }
          else if (MK_F8) { const int e = r / 512, q = r % 512, kb = q / 32, db = q % 32;
              tr_item8<false, MK_XNB>(F.w_down + (size_t)e * 1024 * 1024, 1024, kb * 64, db * 32, 1, WSP(unsigned char, WS_WDN) + ((size_t)e * 1024 + db * 32) * 1024, 1024, scr, lane); }
          else { const int e = r / 512, q = r % 512, kb = q / 32, db = q % 32;
              tr_item(F.w_down + (size_t)e * 1024 * 1024, 1024, kb * 64, db * 32, 1, WSP(bf16, WS_WDN) + ((size_t)e * 1024 + db * 32) * 1024, 1024, nullptr, scr, lane); } }
    }
}

__device__ __forceinline__ void p1_norm1(Frame& F) {
    LAS float* AS = (LAS float*)F.lds;
    LAS float* CS = AS + 2048;
    const int b = blockIdx.x, bb = b >> 5; const float* mp = WSP(float, WS_MODP);
    { const GAS float* gmp = (const GAS float*)mp; const GAS float* gba = (const GAS float*)F.b_ada; const GAS float* gg1 = (const GAS float*)F.norm1_g;
#pragma unroll
      for (int h = 0; h < 2; ++h) { float pv[4][9], gv[4];
#pragma unroll
          for (int u = 0; u < 4; ++u) { const int i = F.tid + 512 * (4 * h + u), which = i >> 11, isscale = (i >> 10) & 1, col = i & 1023, rr = which ? 8 : bb, mc = isscale * 1024 + col;
              pv[u][8] = gba[mc]; gv[u] = gg1[col];
#pragma unroll
              for (int kc = 0; kc < 8; ++kc) pv[u][kc] = gmp[(size_t)(kc * 9 + rr) * NMOD + mc]; }
          asm volatile("" ::: "memory");
#pragma unroll
          for (int u = 0; u < 4; ++u) { const int i = F.tid + 512 * (4 * h + u), which = i >> 11, isscale = (i >> 10) & 1, col = i & 1023; float sacc = pv[u][8];
#pragma unroll
              for (int kc = 0; kc < 8; ++kc) sacc += pv[u][kc];
              if (isscale) AS[which * 1024 + col] = gv[u] * (1.0f + sacc); else CS[which * 1024 + col] = sacc; } } }
    if (F.tid < 216) { const int rr = F.tid / 24, mc = 24 * b + F.tid % 24; float s = F.b_ada[mc];
#pragma unroll
        for (int kc = 0; kc < 8; ++kc) s += mp[(size_t)(kc * 9 + rr) * NMOD + mc];
        WSP(float, WS_MOD)[rr * NMOD + mc] = s; }
    __syncthreads();
    bf16* H = WSP(bf16, WS_H);
    const GAS float* gx = (const GAS float*)F.x; GAS unsigned char* gH = (GAS unsigned char*)H; const int lane = F.lane;
#define P1_ROW(v, row, a, c) do { float ss = 0.f; _Pragma("unroll") for (int q = 0; q < 4; ++q) ss += (v[q].x * v[q].x + v[q].y * v[q].y) + (v[q].z * v[q].z + v[q].w * v[q].w); \
        const float rstd = rsqrtf(wave_sum(ss) * (1.0f / D) + EPS); \
        _Pragma("unroll") for (int q = 0; q < 4; ++q) { const f32x4 av = *(const LAS f32x4*)((a) + 4 * lane + 256 * q), cv = *(const LAS f32x4*)((c) + 4 * lane + 256 * q); \
            const float h0 = v[q].x * rstd * av.x + cv.x, h1 = v[q].y * rstd * av.y + cv.y, h2v = v[q].z * rstd * av.z + cv.z, h3 = v[q].w * rstd * av.w + cv.w; \
            if (MK_F8IN) *(GAS unsigned*)(gH + (size_t)(row) * D + 4 * lane + 256 * q) = pk4_fp8(h0 * F8_SA, h1 * F8_SA, h2v * F8_SA, h3 * F8_SA); \
            else { u32x2 o; o.x = pk2(h0, h1); o.y = pk2(h2v, h3); *(GAS u32x2*)((GAS bf16*)gH + (size_t)(row) * D + 4 * lane + 256 * q) = o; } } } while (0)
    { f32x4 vc[4]; const GAS float* xr = (const GAS float*)F.ctx + (size_t)(8 * b + F.wave) * D;
#pragma unroll
      for (int q = 0; q < 4; ++q) vc[q] = *(const GAS f32x4*)(xr + 4 * lane + 256 * q);
      P1_ROW(vc, MTOK + 8 * b + F.wave, AS + 1024, CS + 1024); }
#pragma nounroll
    for (int j0 = 0; j0 < 16; j0 += MK_P1R) {
        f32x4 v[MK_P1R][4];
#pragma unroll
        for (int t = 0; t < MK_P1R; ++t) { const GAS float* xr = gx + (size_t)(128 * b + 16 * F.wave + j0 + t) * D;
#pragma unroll
            for (int q = 0; q < 4; ++q) v[t][q] = *(const GAS f32x4*)(xr + 4 * lane + 256 * q); }
        asm volatile("" ::: "memory");
#pragma unroll
        for (int t = 0; t < MK_P1R; ++t) P1_ROW(v[t], 128 * b + 16 * F.wave + j0 + t, AS, CS);
    }
#undef P1_ROW
}

struct SchedInProj {
    int G, c; const char* A; const char* Bt;
    __device__ __forceinline__ bool next(int i, pg8::Unit& u) const { int L = i * G + c; constexpr int NU = 24 + 128 * 14; if (MK_REPU == 2) { if (L >= 2 * NU) return false; L %= NU; } else if (L >= NU) return false;
        if (L < 24) { u.pm = 128 + L / 3; const int s = L % 3; u.pn = (s == 2) ? 3 : s; }
        else if (MK_FUSE3 && L < 24 + 128 * 3) { int pn; pg8::tile_map(L - 24, 128, 3, u.pm, pn); u.pn = pn == 0 ? 1 : 3 + pn; }
        else if (MK_FUSE3) { int pn; pg8::tile_map(L - 24 - 128 * 3, 128, 11, u.pm, pn); u.pn = pn == 0 ? 0 : pn < 3 ? pn + 1 : pn + 3; }
        else pg8::tile_map(L - 24, 128, 14, u.pm, u.pn);
        u.ex = 0; return true; }
    __device__ __forceinline__ const char* a_tile(const pg8::Unit& u) const { return A + (size_t)u.pm * 256 * (D * (MK_F8IN ? 1 : 2)); }
    __device__ __forceinline__ const char* b_tile(const pg8::Unit& u) const { return Bt + (size_t)u.pn * 256 * (D * (MK_F8IN ? 1 : 2)); }
    __device__ __forceinline__ const int* a_rows(const pg8::Unit&) const { return nullptr; }
};
struct SchedDense {
    int G, c, nM, nN; const char* A; const char* Bt; size_t a_tstep, b_tstep; int rep = 1;
    __device__ __forceinline__ bool next(int i, pg8::Unit& u) const { int L = i * G + c; if (L >= rep * nM * nN) return false; L %= nM * nN; pg8::tile_map(L, nM, nN, u.pm, u.pn); u.ex = 0; return true; }
    __device__ __forceinline__ const char* a_tile(const pg8::Unit& u) const { return A + (size_t)u.pm * a_tstep; }
    __device__ __forceinline__ const char* b_tile(const pg8::Unit& u) const { return Bt + (size_t)u.pn * b_tstep; }
    __device__ __forceinline__ const int* a_rows(const pg8::Unit&) const { return nullptr; }
};
struct SchedMoe {
    int G, c, R, nN; const char* A; const char* Bt; size_t a_tstep, b_estep, b_tstep; const LAS unsigned char* texp; const int* rows; int rep = 1;
    __device__ __forceinline__ bool next(int i, pg8::Unit& u) const { int L = i * G + c; if (L >= rep * R * nN) return false; L %= R * nN; pg8::tile_map(L, R, nN, u.pm, u.pn); u.ex = texp[u.pm]; return true; }
    __device__ __forceinline__ const char* a_tile(const pg8::Unit& u) const { return A + (size_t)u.pm * a_tstep; }
    __device__ __forceinline__ const char* b_tile(const pg8::Unit& u) const { return Bt + (size_t)u.ex * b_estep + (size_t)u.pn * b_tstep; }
    __device__ __forceinline__ const int* a_rows(const pg8::Unit& u) const { return rows + (size_t)u.pm * 256; }
};

struct EpiStoreBf16 {
    static constexpr bool PERM = true;
    bf16* O; int ldc; const float* rowscale; float cscale;
    __device__ __forceinline__ void operator()(const f32x4 (&acc)[2][2][4][2], const pg8::Unit& u, int wr, int wc, int fr, int fq) const {
        const int row0 = u.pm * 256 + wr * 64 + fr, col0 = u.pn * 256 + wc * 32 + 8 * fq;
#pragma unroll
        for (int ai = 0; ai < 2; ++ai)
#pragma unroll
            for (int m = 0; m < 4; ++m) { const int row = row0 + ai * 128 + m * 16; const float sc = (rowscale ? rowscale[row] : 1.0f) * cscale; bf16* rowp = O + (size_t)row * ldc + col0;
#pragma unroll
                for (int bj = 0; bj < 2; ++bj) { const f32x4 v0 = acc[ai][bj][m][0] * sc, v1 = acc[ai][bj][m][1] * sc;
                    u32x4 w; w.x = cvt_pk_bf16(v0[0], v0[1]); w.y = cvt_pk_bf16(v0[2], v0[3]); w.z = cvt_pk_bf16(v1[0], v1[1]); w.w = cvt_pk_bf16(v1[2], v1[3]);
                    *(u32x4*)(rowp + bj * 128) = w; } }
    }
};
struct EpiInProj {
    static constexpr bool PERM = true;
    bf16* RAW; float* sskv; float* ssq; bf16* QS; bf16* KS; bf16* VS; const LAS float* ts; const LAS float* gq; const LAS float* gk;
    __device__ __forceinline__ void operator()(const f32x4 (&acc)[2][2][4][2], const pg8::Unit& u, int wr, int wc, int fr, int fq) const {
        constexpr float CS = MK_F8IN ? F8_INV : 1.0f; const int pn = u.pn; const bool lat = u.pm < 128;
        if (pn == 1 || pn == 4 || pn == 5) {
            const bool isq = pn != 1, isv = (!isq) && wc >= 2; const int head = isq ? 4 * (pn - 4) + wc : (wc & 1); const LAS float* gn = isq ? gq : gk;
            f32x4 g[4];
#pragma unroll
            for (int q4 = 0; q4 < 4; ++q4) g[q4] = *(const LAS f32x4*)(gn + 16 * q4 + 4 * fq);
#pragma unroll
            for (int ai = 0; ai < 2; ++ai)
#pragma unroll
                for (int m = 0; m < 4; ++m) { const int row = u.pm * 256 + ai * 128 + wr * 64 + m * 16 + fr;
                    f32x4 x[4] = {acc[ai][0][m][0] * CS, acc[ai][0][m][1] * CS, acc[ai][1][m][0] * CS, acc[ai][1][m][1] * CS};
                    int bidx, key, pos; if (lat) { bidx = row >> 12; pos = row & 4095; key = pos; } else { const int rc = row - MTOK; bidx = rc >> 8; key = SEQ + (rc & 255); pos = 0; }
                    if (!isv) { float ss = 0.f;
#pragma unroll
                        for (int q4 = 0; q4 < 4; ++q4) ss += (x[q4][0] * x[q4][0] + x[q4][1] * x[q4][1]) + (x[q4][2] * x[q4][2] + x[q4][3] * x[q4][3]);
                        ss += __shfl_xor(ss, 16); ss += __shfl_xor(ss, 32);
                        const float rstd = rsqrtf(ss * (1.0f / 64.0f) + EPS) * (isq ? QSCALE_S : 1.0f);
#pragma unroll
                        for (int q4 = 0; q4 < 4; ++q4) x[q4] = x[q4] * g[q4] * rstd;
                        if (lat) { const int pr = pos >> 6, pc = pos & 63;
                            const f32x4 cr = *(const LAS f32x4*)(ts + pr * 16 + 4 * fq), sr = *(const LAS f32x4*)(ts + 1024 + pr * 16 + 4 * fq), cc = *(const LAS f32x4*)(ts + pc * 16 + 4 * fq), sc = *(const LAS f32x4*)(ts + 1024 + pc * 16 + 4 * fq);
                            const f32x4 y1 = x[0] * cr - x[1] * sr, y2 = x[1] * cr + x[0] * sr, y3 = x[2] * cc - x[3] * sc, y4 = x[3] * cc + x[2] * sc; x[0] = y1; x[1] = y2; x[2] = y3; x[3] = y4; } }
                    GAS bf16* dst = isq ? ((GAS bf16*)QS + (size_t)row * 512 + head * 64) : ((GAS bf16*)(isv ? VS : KS) + ((size_t)bidx * KEYS + key) * 128 + head * 64);
#pragma unroll
                    for (int q4 = 0; q4 < 4; ++q4) { u32x2 w; w.x = cvt_pk_bf16(x[q4][0], x[q4][1]); w.y = cvt_pk_bf16(x[q4][2], x[q4][3]); *(GAS u32x2*)(dst + 16 * q4 + 4 * fq) = w; } }
        } else {
            const int row0 = u.pm * 256 + wr * 64 + fr, col0 = pn * 256 + wc * 32 + 8 * fq;
#pragma unroll
            for (int ai = 0; ai < 2; ++ai)
#pragma unroll
                for (int m = 0; m < 4; ++m) { const int row = row0 + ai * 128 + m * 16; GAS bf16* rowp = (GAS bf16*)RAW + (size_t)row * NRAW + col0; float ss0 = 0.f, ss1 = 0.f;
#pragma unroll
                    for (int bj = 0; bj < 2; ++bj) { f32x4 v0 = acc[ai][bj][m][0] * CS, v1 = acc[ai][bj][m][1] * CS;
                        if (MK_SIGPRE && pn >= 6) {
#pragma unroll
                            for (int e = 0; e < 4; ++e) { v0[e] = sigmoidf_(v0[e]); v1[e] = sigmoidf_(v1[e]); } }
                        const float q = ((v0[0] * v0[0] + v0[1] * v0[1]) + (v0[2] * v0[2] + v0[3] * v0[3])) + ((v1[0] * v1[0] + v1[1] * v1[1]) + (v1[2] * v1[2] + v1[3] * v1[3])); if (bj == 0) ss0 = q; else ss1 = q;
                        u32x4 w; w.x = cvt_pk_bf16(v0[0], v0[1]); w.y = cvt_pk_bf16(v0[2], v0[3]); w.z = cvt_pk_bf16(v1[0], v1[1]); w.w = cvt_pk_bf16(v1[2], v1[3]);
                        *(GAS u32x4*)(rowp + bj * 128) = w; }
                    if (pn == 0 || pn == 2 || pn == 3) { float ss = (pn == 3) ? ss0 : ss0 + ss1; ss += __shfl_xor(ss, 16); ss += __shfl_xor(ss, 32);
                        if (fq == 0) { if (pn == 0) ((GAS float*)sskv)[row * 4 + wc] = ss; else if (lat) ((GAS float*)ssq)[row * 8 + (pn == 3 ? 4 : 0) + wc] = ss; } } }
        }
    }
};
template <int NP> struct EpiUp {
    static constexpr bool PERM = true;
    bf16* O; int ldc; const float* ssp; float invn;
    __device__ __forceinline__ void operator()(const f32x4 (&acc)[2][2][4][2], const pg8::Unit& u, int wr, int wc, int fr, int fq) const {
        const int row0 = u.pm * 256 + wr * 64 + fr, col0 = u.pn * 256 + wc * 32 + 8 * fq;
#pragma unroll
        for (int ai = 0; ai < 2; ++ai)
#pragma unroll
            for (int m = 0; m < 4; ++m) { const int row = row0 + ai * 128 + m * 16; float s = 0.f;
#pragma unroll
                for (int w = 0; w < NP; w += 4) { const f32x4 p = *(const f32x4*)(ssp + (size_t)row * NP + w); s += (p[0] + p[1]) + (p[2] + p[3]); }
                const float sc = rsqrtf(s * invn + EPS); bf16* rowp = O + (size_t)row * ldc + col0;
#pragma unroll
                for (int bj = 0; bj < 2; ++bj) { const f32x4 v0 = acc[ai][bj][m][0] * sc, v1 = acc[ai][bj][m][1] * sc;
                    u32x4 w; w.x = cvt_pk_bf16(v0[0], v0[1]); w.y = cvt_pk_bf16(v0[2], v0[3]); w.z = cvt_pk_bf16(v1[0], v1[1]); w.w = cvt_pk_bf16(v1[2], v1[3]);
                    *(u32x4*)(rowp + bj * 128) = w; } }
    }
};
template <bool K8> struct EpiKv {
    static constexpr bool PERM = true; static constexpr bool k8 = K8;
    const float* sskv; const bf16* RAW; bf16* KM; bf16* VM; const LAS float* tm; const LAS float* gk;
    __device__ __forceinline__ void operator()(const f32x4 (&acc)[2][2][4][2], const pg8::Unit& u, int wr, int wc, int fr, int fq) const {
        const int head = 2 * u.pn + (wc >> 1); const bool isv = wc & 1, lat = u.pm < 128;
        const LAS float* ggk = gk;
#pragma unroll
        for (int ai = 0; ai < 2; ++ai) {
            f32x4 pp[4]; unsigned krw[4][4];
#pragma unroll
            for (int m = 0; m < 4; ++m) { const int row = u.pm * 256 + ai * 128 + wr * 64 + m * 16 + fr; pp[m] = *(const GAS f32x4*)((const GAS float*)sskv + (size_t)row * 4);
                if (!isv) { const GAS bf16* rr = (const GAS bf16*)RAW + (size_t)row * NRAW + C_KROPE + 2 * fq;
#pragma unroll
                    for (int qd = 0; qd < 4; ++qd) krw[m][qd] = *(const GAS unsigned*)(rr + 8 * qd); } }
            asm volatile("" ::: "memory");
#pragma unroll
            for (int m = 0; m < 4; ++m) {
                const int row = u.pm * 256 + ai * 128 + wr * 64 + m * 16 + fr;
                const f32x4 p = pp[m]; const float rkv = rsqrtf(((p[0] + p[1]) + (p[2] + p[3])) * (1.0f / 256.0f) + EPS);
                int bidx, key, pos; if (lat) { bidx = row >> 12; pos = row & 4095; key = pos; } else { const int rc = row - MTOK; bidx = rc >> 8; key = SEQ + (rc & 255); pos = 0; }
                f32x4 x[2][2];
#pragma unroll
                for (int bj = 0; bj < 2; ++bj)
#pragma unroll
                    for (int n = 0; n < 2; ++n) x[bj][n] = acc[ai][bj][m][n] * rkv;
                if (isv) { GAS bf16* vo = (GAS bf16*)VM + ((size_t)bidx * KEYS + key) * 512 + head * 64 + 8 * fq;
#pragma unroll
                    for (int bj = 0; bj < 2; ++bj) { u32x4 w; w.x = cvt_pk_bf16(x[bj][0][0], x[bj][0][1]); w.y = cvt_pk_bf16(x[bj][0][2], x[bj][0][3]); w.z = cvt_pk_bf16(x[bj][1][0], x[bj][1][1]); w.w = cvt_pk_bf16(x[bj][1][2], x[bj][1][3]);
                        *(GAS u32x4*)(vo + 32 * bj) = w; }
                } else {
                    float kr[4][2]; float ss = 0.f;
#pragma unroll
                    for (int qd = 0; qd < 4; ++qd) { const unsigned w = krw[m][qd]; kr[qd][0] = bflo(w); kr[qd][1] = bfhi(w); ss += kr[qd][0] * kr[qd][0] + kr[qd][1] * kr[qd][1]; }
#pragma unroll
                    for (int bj = 0; bj < 2; ++bj)
#pragma unroll
                        for (int n = 0; n < 2; ++n) ss += (x[bj][n][0] * x[bj][n][0] + x[bj][n][1] * x[bj][n][1]) + (x[bj][n][2] * x[bj][n][2] + x[bj][n][3] * x[bj][n][3]);
                    ss += __shfl_xor(ss, 16); ss += __shfl_xor(ss, 32);
                    const float rstd = rsqrtf(ss * (1.0f / 96.0f) + EPS);
                    GAS bf16* ko = (GAS bf16*)KM + ((size_t)bidx * KEYS + key) * 768 + head * 96; GAS unsigned char* ko8 = (GAS unsigned char*)KM + ((size_t)bidx * KEYS + key) * 1024 + head * 128;
                    const int pr = pos >> 6, pc = pos & 63;
#pragma unroll
                    for (int ii = 0; ii < 2; ++ii) { const int i = 2 * fq + ii; float y0 = kr[0][ii] * rstd * ggk[64 + i], y1 = kr[1][ii] * rstd * ggk[72 + i], y2 = kr[2][ii] * rstd * ggk[80 + i], y3 = kr[3][ii] * rstd * ggk[88 + i];
                        if (lat) { const float cr = tm[pr * 8 + i], sr = tm[512 + pr * 8 + i], cc = tm[pc * 8 + i], sc = tm[512 + pc * 8 + i];
                            const float o0 = y0 * cr - y1 * sr, o1 = y1 * cr + y0 * sr, o2 = y2 * cc - y3 * sc, o3 = y3 * cc + y2 * sc; y0 = o0; y1 = o1; y2 = o2; y3 = o3; }
                        kr[0][ii] = y0; kr[1][ii] = y1; kr[2][ii] = y2; kr[3][ii] = y3; }
#pragma unroll
                    for (int qd = 0; qd < 4; ++qd) { if (k8) *(GAS unsigned short*)(ko8 + 64 + 32 * (qd & 1) + 8 * (qd >> 1) + 2 * fq) = (unsigned short)pk4_fp8(kr[qd][0] * 16.f, kr[qd][1] * 16.f, 0.f, 0.f); else *(GAS unsigned*)(ko + 64 + 8 * qd + 2 * fq) = cvt_pk_bf16(kr[qd][0], kr[qd][1]); }
#pragma unroll
                    for (int bj = 0; bj < 2; ++bj) { const f32x4 g0 = *(const LAS f32x4*)(ggk + 32 * bj + 8 * fq), g1 = *(const LAS f32x4*)(ggk + 32 * bj + 8 * fq + 4);
                        const f32x4 a = x[bj][0] * g0 * rstd, b = x[bj][1] * g1 * rstd;
                        if (k8) { u32x2 w; w.x = pk4_fp8(a[0] * 16.f, a[1] * 16.f, a[2] * 16.f, a[3] * 16.f); w.y = pk4_fp8(b[0] * 16.f, b[1] * 16.f, b[2] * 16.f, b[3] * 16.f); *(GAS u32x2*)(ko8 + 32 * (fq & 1) + 8 * (2 * bj + (fq >> 1))) = w; }
                        else { u32x4 w; w.x = cvt_pk_bf16(a[0], a[1]); w.y = cvt_pk_bf16(a[2], a[3]); w.z = cvt_pk_bf16(b[0], b[1]); w.w = cvt_pk_bf16(b[2], b[3]); *(GAS u32x4*)(ko + 32 * bj + 8 * fq) = w; } }
                    if (k8) *(GAS u32x2*)(ko8 + 64 + 32 * (fq >> 1) + 16 + 8 * (fq & 1)) = (u32x2){0u, 0u};
                } } }
    }
};
struct EpiQ {
    static constexpr bool PERM = true;
    const float* ssq; bf16* QM; float* ssqh; const LAS float* tm; const LAS float* gq;
    __device__ __forceinline__ void operator()(const f32x4 (&acc)[2][2][4][2], const pg8::Unit& u, int wr, int wc, int fr, int fq) const {
        const int head = 2 * u.pn + (wc >> 1); const bool isr = wc & 1;
        f32x4 g[2][2]; float gr[4][2];
#pragma unroll
        for (int bj = 0; bj < 2; ++bj)
#pragma unroll
            for (int n = 0; n < 2; ++n) g[bj][n] = *(const LAS f32x4*)(gq + 32 * bj + 8 * fq + 4 * n);
#pragma unroll
        for (int qd = 0; qd < 4; ++qd) { gr[qd][0] = gq[64 + 8 * qd + 2 * fq]; gr[qd][1] = gq[64 + 8 * qd + 2 * fq + 1]; }
#pragma unroll
        for (int ai = 0; ai < 2; ++ai) {
            f32x4 pq0[4], pq1[4];
#pragma unroll
            for (int m = 0; m < 4; ++m) { const int row = u.pm * 256 + ai * 128 + wr * 64 + m * 16 + fr; pq0[m] = *(const GAS f32x4*)((const GAS float*)ssq + (size_t)row * 8); pq1[m] = *(const GAS f32x4*)((const GAS float*)ssq + (size_t)row * 8 + 4); }
            asm volatile("" ::: "memory");
#pragma unroll
            for (int m = 0; m < 4; ++m) { const int row = u.pm * 256 + ai * 128 + wr * 64 + m * 16 + fr;
                const f32x4 p0 = pq0[m], p1 = pq1[m];
                const float rq = rsqrtf((((p0[0] + p0[1]) + (p0[2] + p0[3])) + ((p1[0] + p1[1]) + (p1[2] + p1[3]))) * (1.0f / 384.0f) + EPS);
                GAS bf16* qo = (GAS bf16*)QM + (size_t)row * 768 + head * 96;
                if (!isr) { float ss = 0.f;
#pragma unroll
                    for (int bj = 0; bj < 2; ++bj) { const f32x4 a = acc[ai][bj][m][0] * rq, b = acc[ai][bj][m][1] * rq;
                        ss += ((a[0] * a[0] + a[1] * a[1]) + (a[2] * a[2] + a[3] * a[3])) + ((b[0] * b[0] + b[1] * b[1]) + (b[2] * b[2] + b[3] * b[3]));
                        const f32x4 ag = a * g[bj][0] * QSCALE_M, bg = b * g[bj][1] * QSCALE_M;
                        u32x4 w; w.x = cvt_pk_bf16(ag[0], ag[1]); w.y = cvt_pk_bf16(ag[2], ag[3]); w.z = cvt_pk_bf16(bg[0], bg[1]); w.w = cvt_pk_bf16(bg[2], bg[3]); *(GAS u32x4*)(qo + 32 * bj + 8 * fq) = w; }
                    ss += __shfl_xor(ss, 16); ss += __shfl_xor(ss, 32);
                    if (fq == 0) ((GAS float*)ssqh)[((size_t)row * 8 + head) * 2] = ss;
                } else {
                    const f32x4 a = acc[ai][0][m][0] * rq, b = acc[ai][0][m][1] * rq;
                    float ss = ((a[0] * a[0] + a[1] * a[1]) + (a[2] * a[2] + a[3] * a[3])) + ((b[0] * b[0] + b[1] * b[1]) + (b[2] * b[2] + b[3] * b[3]));
                    ss += __shfl_xor(ss, 16); ss += __shfl_xor(ss, 32);
                    if (fq == 0) ((GAS float*)ssqh)[((size_t)row * 8 + head) * 2 + 1] = ss;
                    const int pos = row & 4095, pr = pos >> 6, pc = pos & 63; float o[4][2];
#pragma unroll
                    for (int ib = 0; ib < 2; ++ib) { const int i = 2 * fq + ib; const float y0 = a[ib] * gr[0][ib], y1 = a[2 + ib] * gr[1][ib], y2 = b[ib] * gr[2][ib], y3 = b[2 + ib] * gr[3][ib];
                        const float cr = tm[pr * 8 + i], sr = tm[512 + pr * 8 + i], cc = tm[pc * 8 + i], sc = tm[512 + pc * 8 + i];
                        o[0][ib] = (y0 * cr - y1 * sr) * QSCALE_M; o[1][ib] = (y1 * cr + y0 * sr) * QSCALE_M; o[2][ib] = (y2 * cc - y3 * sc) * QSCALE_M; o[3][ib] = (y3 * cc + y2 * sc) * QSCALE_M; }
#pragma unroll
                    for (int qd = 0; qd < 4; ++qd) *(GAS unsigned*)(qo + 64 + 8 * qd + 2 * fq) = cvt_pk_bf16(o[qd][0], o[qd][1]);
                } } }
    }
};
template <bool ADD> struct EpiBranch {
    static constexpr bool PERM = true;
    bf16* T; const bf16* gate; unsigned char* T8;
    __device__ __forceinline__ void operator()(const f32x4 (&acc)[2][2][4][2], const pg8::Unit& u, int wr, int wc, int fr, int fq) const {
        const int row0 = u.pm * 256 + wr * 64 + fr, col0 = u.pn * 256 + wc * 32 + 8 * fq; constexpr float ASC = MK_F8MID ? F8_INVM : 1.0f;
#pragma unroll
        for (int ai = 0; ai < 2; ++ai)
#pragma unroll
            for (int m = 0; m < 4; ++m) { const int row = row0 + ai * 128 + m * 16;
#pragma unroll
                for (int bj = 0; bj < 2; ++bj) { const int col = col0 + bj * 128;
                    const u32x4 g = *(const u32x4*)(gate + (size_t)row * NRAW + col);
                    f32x4 v0 = acc[ai][bj][m][0] * ASC, v1 = acc[ai][bj][m][1] * ASC;
                    v0[0] *= sigmoidf_(bflo(g.x)); v0[1] *= sigmoidf_(bfhi(g.x)); v0[2] *= sigmoidf_(bflo(g.y)); v0[3] *= sigmoidf_(bfhi(g.y));
                    v1[0] *= sigmoidf_(bflo(g.z)); v1[1] *= sigmoidf_(bfhi(g.z)); v1[2] *= sigmoidf_(bflo(g.w)); v1[3] *= sigmoidf_(bfhi(g.w));
                    bf16* tp = T + (size_t)row * D + col;
                    if (ADD) { const u32x4 t = *(const u32x4*)tp; v0[0] += bflo(t.x); v0[1] += bfhi(t.x); v0[2] += bflo(t.y); v0[3] += bfhi(t.y); v1[0] += bflo(t.z); v1[1] += bfhi(t.z); v1[2] += bflo(t.w); v1[3] += bfhi(t.w); }
                    if (ADD && MK_F8MID) { u32x2 w; w.x = pk4_fp8(v0[0] * F8_SO, v0[1] * F8_SO, v0[2] * F8_SO, v0[3] * F8_SO); w.y = pk4_fp8(v1[0] * F8_SO, v1[1] * F8_SO, v1[2] * F8_SO, v1[3] * F8_SO);
                        *(u32x2*)(T8 + (size_t)row * D + col) = w; }
                    else { u32x4 w; w.x = cvt_pk_bf16(v0[0], v0[1]); w.y = cvt_pk_bf16(v0[2], v0[3]); w.z = cvt_pk_bf16(v1[0], v1[1]); w.w = cvt_pk_bf16(v1[2], v1[3]);
                        *(u32x4*)tp = w; } } }
    }
};
static_assert(!MK_SIGPRE || (MK_MERGE78 && MK_FUSE3 && MK_F8MID), "MK_SIGPRE needs the merged branch GEMM and the fused in-proj epilogue");
struct EpiMerge {
    static constexpr int NST = 16; static constexpr bool PERM = true, MID = true;
    const bf16* RAW; unsigned char* T8;
    __device__ __forceinline__ void mid(f32x4 (&acc)[2][2][4][2], const pg8::Unit& u, int wr, int wc, int fr, int fq) const {
        asm volatile("" : "+v"(fr), "+v"(fq));
        const int row0 = u.pm * 256 + wr * 64 + fr, col0 = u.pn * 256 + wc * 32 + 8 * fq;
#pragma unroll
        for (int ai = 0; ai < 2; ++ai)
#pragma unroll
            for (int m2 = 0; m2 < 4; m2 += MK_MIDR) { asm volatile("" ::: "memory");
              u32x4 gav[MK_MIDR][2], gbv[MK_MIDR][2];
#pragma unroll
              for (int mm = 0; mm < MK_MIDR; ++mm) { const GAS bf16* rp = (const GAS bf16*)RAW + (size_t)(row0 + ai * 128 + (m2 + mm) * 16) * NRAW + col0;
#pragma unroll
                  for (int bj = 0; bj < 2; ++bj) { gav[mm][bj] = *(const GAS u32x4*)(rp + C_GA + bj * 128); gbv[mm][bj] = *(const GAS u32x4*)(rp + C_GB + bj * 128); } }
              asm volatile("" ::: "memory");
#pragma unroll
              for (int mm = 0; mm < MK_MIDR; ++mm) { const int m = m2 + mm;
#pragma unroll
                for (int bj = 0; bj < 2; ++bj) { const u32x4 ga = gav[mm][bj], gb = gbv[mm][bj];
                    const unsigned aw[4] = {ga.x, ga.y, ga.z, ga.w}, bw[4] = {gb.x, gb.y, gb.z, gb.w};
#pragma unroll
                    for (int q = 0; q < 4; ++q) {
                        if (MK_SIGPRE) { acc[ai][bj][m][q >> 1][2 * (q & 1)] *= bflo(aw[q]) * __builtin_amdgcn_rcpf(bflo(bw[q])); acc[ai][bj][m][q >> 1][2 * (q & 1) + 1] *= bfhi(aw[q]) * __builtin_amdgcn_rcpf(bfhi(bw[q])); }
                        else { const float ea0 = __builtin_amdgcn_exp2f(-LOG2E * bflo(aw[q])), ea1 = __builtin_amdgcn_exp2f(-LOG2E * bfhi(aw[q])), eb0 = __builtin_amdgcn_exp2f(-LOG2E * bflo(bw[q])), eb1 = __builtin_amdgcn_exp2f(-LOG2E * bfhi(bw[q]));
                        acc[ai][bj][m][q >> 1][2 * (q & 1)] *= (1.0f + eb0) * __builtin_amdgcn_rcpf(1.0f + ea0); acc[ai][bj][m][q >> 1][2 * (q & 1) + 1] *= (1.0f + eb1) * __builtin_amdgcn_rcpf(1.0f + ea1); } } } } }
    }
    __device__ __forceinline__ void operator()(const f32x4 (&acc)[2][2][4][2], const pg8::Unit& u, int wr, int wc, int fr, int fq) const {
        const int row0 = u.pm * 256 + wr * 64 + fr, col0 = u.pn * 256 + wc * 32 + 8 * fq; constexpr float SC = F8_INVM * F8_SO;
#pragma unroll
        for (int ai = 0; ai < 2; ++ai) {
            u32x4 gg[4][2];
#pragma unroll
            for (int m = 0; m < 4; ++m)
#pragma unroll
                for (int bj = 0; bj < 2; ++bj) gg[m][bj] = *(const GAS u32x4*)((const GAS bf16*)RAW + (size_t)(row0 + ai * 128 + m * 16) * NRAW + C_GB + col0 + bj * 128);
            asm volatile("" ::: "memory");
#pragma unroll
            for (int m = 0; m < 4; ++m) { const int row = row0 + ai * 128 + m * 16;
#pragma unroll
                for (int bj = 0; bj < 2; ++bj) { const u32x4 g = gg[m][bj]; const f32x4 v0 = acc[ai][bj][m][0] * SC, v1 = acc[ai][bj][m][1] * SC;
                    u32x2 w;
                    if (MK_SIGPRE) { w.x = pk4_fp8(v0[0] * bflo(g.x), v0[1] * bfhi(g.x), v0[2] * bflo(g.y), v0[3] * bfhi(g.y)); w.y = pk4_fp8(v1[0] * bflo(g.z), v1[1] * bfhi(g.z), v1[2] * bflo(g.w), v1[3] * bfhi(g.w)); }
                    else { w.x = pk4_fp8(v0[0] * sigmoidf_(bflo(g.x)), v0[1] * sigmoidf_(bfhi(g.x)), v0[2] * sigmoidf_(bflo(g.y)), v0[3] * sigmoidf_(bfhi(g.y)));
                    w.y = pk4_fp8(v1[0] * sigmoidf_(bflo(g.z)), v1[1] * sigmoidf_(bfhi(g.z)), v1[2] * sigmoidf_(bflo(g.w)), v1[3] * sigmoidf_(bfhi(g.w))); }
                    *(GAS u32x2*)((GAS unsigned char*)T8 + (size_t)row * D + col0 + bj * 128) = w; } } }
    }
};
struct EpiOutRes {
    static constexpr bool PERM = false;
    const float* x; float* out; const float* mod;
    __device__ __forceinline__ void operator()(const f32x4 (&acc)[2][2][4][2], const pg8::Unit& u, int wr, int wc, int fr, int fq) const {
        const int row0 = u.pm * 256 + wr * 64 + fr, col0 = u.pn * 256 + wc * 32 + 4 * fq; const int bb = (u.pm * 256) >> 12;
        f32x4 gv[2][2];
#pragma unroll
        for (int bj = 0; bj < 2; ++bj)
#pragma unroll
            for (int n = 0; n < 2; ++n) gv[bj][n] = *(const f32x4*)(mod + (size_t)bb * NMOD + 2048 + col0 + bj * 128 + n * 16);
#pragma unroll
        for (int ai = 0; ai < 2; ++ai)
#pragma unroll
            for (int mh = 0; mh < 4; mh += MK_EPIX) {
                f32x4 xv[MK_EPIX][2][2];
#pragma unroll
                for (int m = 0; m < MK_EPIX; ++m) { const size_t ro = (size_t)(row0 + ai * 128 + (mh + m) * 16) * D + col0;
#pragma unroll
                    for (int bj = 0; bj < 2; ++bj)
#pragma unroll
                        for (int n = 0; n < 2; ++n) xv[m][bj][n] = *(const GAS f32x4*)((const GAS float*)x + ro + bj * 128 + n * 16); }
                asm volatile("" ::: "memory");
#pragma unroll
                for (int m = 0; m < MK_EPIX; ++m) { const size_t ro = (size_t)(row0 + ai * 128 + (mh + m) * 16) * D + col0;
#pragma unroll
                    for (int bj = 0; bj < 2; ++bj)
#pragma unroll
                        for (int n = 0; n < 2; ++n) *(GAS f32x4*)((GAS float*)out + ro + bj * 128 + n * 16) = xv[m][bj][n] + gv[bj][n] * (acc[ai][bj][mh + m][n] * (MK_F8MID ? F8_INVM : 1.0f)); } }
    }
};
struct EpiSwiglu {
    static constexpr bool PERM = true, PRE = true;
    unsigned char* ACT; const float* bgu;
    __device__ __forceinline__ void pre(const pg8::Unit& u, int wr, int wc, int fr, int fq, f32x4 (&b4)[4]) const { const float* bp = bgu + (size_t)u.ex * 2048 + 2 * (u.pn * 128 + wc * 32 + 8 * fq);
#pragma unroll
        for (int q = 0; q < 4; ++q) asm_load16(b4[q], bp + 4 * q); }
    __device__ __forceinline__ void operator()(const f32x4 (&acc)[2][2][4][2], const pg8::Unit& u, int wr, int wc, int fr, int fq, const f32x4 (&b4)[4]) const {
        const int row0 = u.pm * 256 + wr * 64 + fr, j0 = u.pn * 128 + wc * 32 + 8 * fq;
        constexpr float ASC = MK_F8 ? F8_INV : 1.0f, OSC = MK_F8 ? F8_SA : 1.0f;
#pragma unroll
        for (int ai = 0; ai < 2; ++ai)
#pragma unroll
            for (int m = 0; m < 4; ++m) { f32x2 o[4];
#pragma unroll
                for (int q = 0; q < 4; ++q) { const int n = q >> 1, e0 = 2 * (q & 1);
                    f32x2 g = (f32x2){acc[ai][0][m][n][e0], acc[ai][0][m][n][e0 + 1]} * ASC + (f32x2){b4[q][0], b4[q][2]};
                    f32x2 l = (f32x2){acc[ai][1][m][n][e0], acc[ai][1][m][n][e0 + 1]} * ASC + (f32x2){b4[q][1], b4[q][3]};
                    g.x = fminf(g.x, 7.0f); g.y = fminf(g.y, 7.0f); l.x = __builtin_amdgcn_fmed3f(l.x, -7.0f, 7.0f); l.y = __builtin_amdgcn_fmed3f(l.y, -7.0f, 7.0f);
                    const f32x2 z = g * (-1.702f * LOG2E); f32x2 d; d.x = __builtin_amdgcn_exp2f(z.x); d.y = __builtin_amdgcn_exp2f(z.y); d = d + 1.0f;
                    f32x2 r; r.x = __builtin_amdgcn_rcpf(d.x); r.y = __builtin_amdgcn_rcpf(d.y);
                    o[q] = (g * r) * (l * OSC + OSC); }
                if (MK_F8) { u32x2 w; int t = __builtin_amdgcn_cvt_pk_fp8_f32(o[0].x, o[0].y, 0, false); t = __builtin_amdgcn_cvt_pk_fp8_f32(o[1].x, o[1].y, t, true); w.x = (unsigned)t;
                    t = __builtin_amdgcn_cvt_pk_fp8_f32(o[2].x, o[2].y, 0, false); t = __builtin_amdgcn_cvt_pk_fp8_f32(o[3].x, o[3].y, t, true); w.y = (unsigned)t;
                    *(u32x2*)(ACT + (size_t)(row0 + ai * 128 + m * 16) * 1024 + j0) = w; }
                else { u32x4 w; w.x = cvt_pk_bf16(o[0].x, o[0].y); w.y = cvt_pk_bf16(o[1].x, o[1].y); w.z = cvt_pk_bf16(o[2].x, o[2].y); w.w = cvt_pk_bf16(o[3].x, o[3].y);
                    *(u32x4*)(ACT + ((size_t)(row0 + ai * 128 + m * 16) * 1024 + j0) * 2) = w; } }
    }
};
struct EpiDown {
    static constexpr bool PERM = true, PRE = true;
    unsigned char* Y; const float* bdn; const float* slotw;
    __device__ __forceinline__ void pre(const pg8::Unit& u, int wr, int wc, int fr, int fq, f32x4 (&bq)[4]) const { const float* bp = bdn + (size_t)u.ex * 1024 + u.pn * 256 + wc * 32 + 8 * fq;
#pragma unroll
        for (int bj = 0; bj < 2; ++bj)
#pragma unroll
            for (int n = 0; n < 2; ++n) asm_load16(bq[bj * 2 + n], bp + bj * 128 + 4 * n); }
    __device__ __forceinline__ void operator()(const f32x4 (&acc)[2][2][4][2], const pg8::Unit& u, int wr, int wc, int fr, int fq, const f32x4 (&bq)[4]) const {
        const int row0 = u.pm * 256 + wr * 64 + fr, col0 = u.pn * 256 + wc * 32 + 8 * fq;
        f32x4 bv[2][2];
#pragma unroll
        for (int bj = 0; bj < 2; ++bj)
#pragma unroll
            for (int n = 0; n < 2; ++n) bv[bj][n] = bq[bj * 2 + n];
        float swv[2][4];
#pragma unroll
        for (int ai = 0; ai < 2; ++ai)
#pragma unroll
            for (int m = 0; m < 4; ++m) swv[ai][m] = ((const GAS float*)slotw)[row0 + ai * 128 + m * 16];
        asm volatile("" ::: "memory");
#pragma unroll
        for (int ai = 0; ai < 2; ++ai)
#pragma unroll
            for (int m = 0; m < 4; ++m) { const int row = row0 + ai * 128 + m * 16; const float sw = swv[ai][m];
#pragma unroll
                for (int bj = 0; bj < 2; ++bj) { constexpr float ASC = MK_F8 ? F8_INV : 1.0f; const f32x4 v0 = (acc[ai][bj][m][0] * ASC + bv[bj][0]) * sw, v1 = (acc[ai][bj][m][1] * ASC + bv[bj][1]) * sw;
                    if (MK_F8Y) { u32x2 w; w.x = pk4_fp8(v0[0] * F8_SY, v0[1] * F8_SY, v0[2] * F8_SY, v0[3] * F8_SY); w.y = pk4_fp8(v1[0] * F8_SY, v1[1] * F8_SY, v1[2] * F8_SY, v1[3] * F8_SY);
                        *(GAS u32x2*)((GAS unsigned char*)Y + (size_t)row * 1024 + col0 + bj * 128) = w; }
                    else { u32x4 w; w.x = cvt_pk_bf16(v0[0], v0[1]); w.y = cvt_pk_bf16(v0[2], v0[3]); w.z = cvt_pk_bf16(v1[0], v1[1]); w.w = cvt_pk_bf16(v1[2], v1[3]);
                        *(u32x4*)(Y + ((size_t)row * 1024 + col0 + bj * 128) * 2) = w; } } }
    }
};

__device__ __forceinline__ void p3_post_inproj(Frame& F) {
    LAS unsigned char* scr = F.lds + F.wave * 4096;
    const bf16* RAW = WSP(bf16, WS_R1); const float* ts = WSP(float, WS_TRIG);
    const int gw = F.vcu * NWAVES + F.wave, NGW = F.G * NWAVES, lane = F.lane, g = lane >> 4, i = lane & 15;
    bf16* QS = WSP(bf16, WS_QS); bf16* KS = WSP(bf16, WS_KS); bf16* VS = WSP(bf16, WS_VS);
    for (int row = gw; row < MALL; row += NGW) {
        const bool lat = row < MTOK; const bf16* rp = RAW + (size_t)row * NRAW;
#pragma unroll
        for (int q = 0; q < 3; ++q) *(LAS u32x4*)(scr + (lane + 64 * q) * 16) = *(const u32x4*)(rp + (lane + 64 * q) * 8);
        LDS_WAIT(); asm volatile("" ::: "memory");
        const LAS bf16* s = (const LAS bf16*)scr;
        { const u32x2 w = *(const LAS u32x2*)(s + C_KVLAT + 4 * lane); const float a = bflo(w.x), b = bfhi(w.x), c = bflo(w.y), d = bfhi(w.y);
          const float ss = wave_sum((a * a + b * b) + (c * c + d * d)); if (lane == 0) WSP(float, WS_RSKV)[row] = rsqrtf(ss * (1.0f / 256.0f) + EPS); }
        if (lat) { float ss = 0.f;
#pragma unroll
            for (int q = 0; q < 3; ++q) { const unsigned w = *(const LAS unsigned*)(s + C_QLAT + 6 * lane + 2 * q); const float a = bflo(w), b = bfhi(w); ss += a * a + b * b; }
            ss = wave_sum(ss); if (lane == 0) WSP(float, WS_RSQ)[row] = rsqrtf(ss * (1.0f / 384.0f) + EPS); }
        int bidx, key, pos;
        if (lat) { bidx = row >> 12; pos = row & 4095; key = pos; } else { const int rc = row - MTOK; bidx = rc >> 8; key = SEQ + (rc & 255); pos = 0; }
        const int pr = pos >> 6, pc = pos & 63;
        const float cr = ts[pr * 16 + i], sr = ts[1024 + pr * 16 + i], cc = ts[pc * 16 + i], sc = ts[1024 + pc * 16 + i];
#pragma unroll
        for (int pass = 0; pass < 3; ++pass) {
            const bool isq = pass < 2; const int head = isq ? (pass * 4 + g) : g; const bool act = isq ? lat : (g < 2);
            const LAS bf16* hp = s + (isq ? C_QSWA : C_KSWA) + (act ? head : 0) * 64;
            float x1 = bf2f(hp[i]), x2 = bf2f(hp[16 + i]), x3 = bf2f(hp[32 + i]), x4 = bf2f(hp[48 + i]);
            float ss = (x1 * x1 + x2 * x2) + (x3 * x3 + x4 * x4);
            ss += __shfl_xor(ss, 1); ss += __shfl_xor(ss, 2); ss += __shfl_xor(ss, 4); ss += __shfl_xor(ss, 8);
            const float rstd = rsqrtf(ss * (1.0f / 64.0f) + EPS); const float* gn = isq ? F.swa_q_g : F.swa_k_g;
            x1 *= rstd * gn[i]; x2 *= rstd * gn[16 + i]; x3 *= rstd * gn[32 + i]; x4 *= rstd * gn[48 + i];
            float y1 = x1, y2 = x2, y3 = x3, y4 = x4;
            if (lat) { y1 = x1 * cr - x2 * sr; y2 = x2 * cr + x1 * sr; y3 = x3 * cc - x4 * sc; y4 = x4 * cc + x3 * sc; }
            if (act) {
                if (isq) { bf16* o = QS + (size_t)row * 512 + head * 64; o[i] = (bf16)f2bf(y1 * QSCALE_S); o[16 + i] = (bf16)f2bf(y2 * QSCALE_S); o[32 + i] = (bf16)f2bf(y3 * QSCALE_S); o[48 + i] = (bf16)f2bf(y4 * QSCALE_S); }
                else { bf16* o = KS + ((size_t)bidx * KEYS + key) * 128 + head * 64; o[i] = (bf16)f2bf(y1); o[16 + i] = (bf16)f2bf(y2); o[32 + i] = (bf16)f2bf(y3); o[48 + i] = (bf16)f2bf(y4); }
            }
        }
        if (lane < 16) *(u32x4*)(VS + ((size_t)bidx * KEYS + key) * 128 + lane * 8) = *(const LAS u32x4*)(s + C_VSWA + lane * 8);
        LDS_WAIT(); asm volatile("" ::: "memory");
    }
}

__device__ __forceinline__ void p5_post_up(Frame& F) {
    const bf16* RAW = WSP(bf16, WS_R1); const bf16* KVUP = WSP(bf16, WS_KVUP); const bf16* QUP = WSP(bf16, WS_QUP); const float* tm = WSP(float, WS_TRIG) + 2048;
    bf16* QM = WSP(bf16, WS_QM); bf16* KM = WSP(bf16, WS_KM); bf16* VM = WSP(bf16, WS_VM);
    const int gw = F.vcu * NWAVES + F.wave, NGW = F.G * NWAVES, lane = F.lane, h = lane >> 3, i = lane & 7;
    float gk[8], gq[8], gkr[4], gqr[4];
#pragma unroll
    for (int e = 0; e < 8; ++e) { gk[e] = F.mla_k_g[8 * i + e]; gq[e] = F.mla_q_g[8 * i + e]; }
#pragma unroll
    for (int q = 0; q < 4; ++q) { gkr[q] = F.mla_k_g[64 + 8 * q + i]; gqr[q] = F.mla_q_g[64 + 8 * q + i]; }
    for (int row = gw; row < MALL; row += NGW) {
        const bool lat = row < MTOK; int bidx, key, pos;
        if (lat) { bidx = row >> 12; pos = row & 4095; key = pos; } else { const int rc = row - MTOK; bidx = rc >> 8; key = SEQ + (rc & 255); pos = 0; }
        const int pr = pos >> 6, pc = pos & 63;
        const float cr = tm[pr * 8 + i], sr = tm[512 + pr * 8 + i], cc = tm[pc * 8 + i], sc = tm[512 + pc * 8 + i];
        {
            const bf16* kp = KVUP + (size_t)row * 1024 + h * 128; const u32x4 nw = *(const u32x4*)(kp + 8 * i); const u32x4 vw = *(const u32x4*)(kp + 64 + 8 * i);
            const bf16* rr = RAW + (size_t)row * NRAW + C_KROPE; float x[4];
#pragma unroll
            for (int q = 0; q < 4; ++q) x[q] = bf2f(rr[8 * q + i]);
            float n[8] = {bflo(nw.x), bfhi(nw.x), bflo(nw.y), bfhi(nw.y), bflo(nw.z), bfhi(nw.z), bflo(nw.w), bfhi(nw.w)};
            float ss = (x[0] * x[0] + x[1] * x[1]) + (x[2] * x[2] + x[3] * x[3]);
#pragma unroll
            for (int e = 0; e < 8; ++e) ss += n[e] * n[e];
            ss += __shfl_xor(ss, 1); ss += __shfl_xor(ss, 2); ss += __shfl_xor(ss, 4);
            const float rstd = rsqrtf(ss * (1.0f / 96.0f) + EPS);
            bf16* ko = KM + ((size_t)bidx * KEYS + key) * 768 + h * 96;
            u32x4 w; w.x = pk2(n[0] * rstd * gk[0], n[1] * rstd * gk[1]); w.y = pk2(n[2] * rstd * gk[2], n[3] * rstd * gk[3]); w.z = pk2(n[4] * rstd * gk[4], n[5] * rstd * gk[5]); w.w = pk2(n[6] * rstd * gk[6], n[7] * rstd * gk[7]);
            *(u32x4*)(ko + 8 * i) = w;
            float x1 = x[0] * rstd * gkr[0], x2 = x[1] * rstd * gkr[1], x3 = x[2] * rstd * gkr[2], x4 = x[3] * rstd * gkr[3], y1 = x1, y2 = x2, y3 = x3, y4 = x4;
            if (lat) { y1 = x1 * cr - x2 * sr; y2 = x2 * cr + x1 * sr; y3 = x3 * cc - x4 * sc; y4 = x4 * cc + x3 * sc; }
            ko[64 + i] = (bf16)f2bf(y1); ko[72 + i] = (bf16)f2bf(y2); ko[80 + i] = (bf16)f2bf(y3); ko[88 + i] = (bf16)f2bf(y4);
            *(u32x4*)(VM + ((size_t)bidx * KEYS + key) * 512 + h * 64 + 8 * i) = vw;
        }
        if (lat) {
            const bf16* qp = QUP + (size_t)row * 768 + h * 96; const u32x4 nw = *(const u32x4*)(qp + 8 * i); float x[4];
#pragma unroll
            for (int q = 0; q < 4; ++q) x[q] = bf2f(qp[64 + 8 * q + i]);
            float n[8] = {bflo(nw.x), bfhi(nw.x), bflo(nw.y), bfhi(nw.y), bflo(nw.z), bfhi(nw.z), bflo(nw.w), bfhi(nw.w)};
            float ss = (x[0] * x[0] + x[1] * x[1]) + (x[2] * x[2] + x[3] * x[3]);
#pragma unroll
            for (int e = 0; e < 8; ++e) ss += n[e] * n[e];
            ss += __shfl_xor(ss, 1); ss += __shfl_xor(ss, 2); ss += __shfl_xor(ss, 4);
            const float rstd = rsqrtf(ss * (1.0f / 96.0f) + EPS) * QSCALE_M;
            bf16* qo = QM + (size_t)row * 768 + h * 96;
            u32x4 w; w.x = pk2(n[0] * rstd * gq[0], n[1] * rstd * gq[1]); w.y = pk2(n[2] * rstd * gq[2], n[3] * rstd * gq[3]); w.z = pk2(n[4] * rstd * gq[4], n[5] * rstd * gq[5]); w.w = pk2(n[6] * rstd * gq[6], n[7] * rstd * gq[7]);
            *(u32x4*)(qo + 8 * i) = w;
            const float x1 = x[0] * rstd * gqr[0], x2 = x[1] * rstd * gqr[1], x3 = x[2] * rstd * gqr[2], x4 = x[3] * rstd * gqr[3];
            qo[64 + i] = (bf16)f2bf(x1 * cr - x2 * sr); qo[72 + i] = (bf16)f2bf(x2 * cr + x1 * sr); qo[80 + i] = (bf16)f2bf(x3 * cc - x4 * sc); qo[88 + i] = (bf16)f2bf(x4 * cc + x3 * sc);
        }
    }
}

namespace att {
constexpr int KBUF = 12288, VOFF = KBUF, BUF = KBUF + 8192, WSF = 2 * BUF, OST = WSF + 2048, LDS_NEED = OST + 8 * 4096;
__device__ __forceinline__ int crow(int r, int hi) { return (r & 3) + 8 * (r >> 2) + 4 * hi; }
__device__ __forceinline__ void glds16(const void* gsrc, unsigned lds_dst) { unsigned keep;
    asm volatile("s_mov_b32 %0, m0\n\ts_mov_b32 m0, %2\n\ts_nop 0\n\tglobal_load_lds_dwordx4 %1, off\n\ts_mov_b32 m0, %0" : "=&s"(keep) : "v"(gsrc), "s"(lds_dst) : "memory"); }
#define ATT_WAIT_BAR() asm volatile("s_waitcnt vmcnt(0) lgkmcnt(0)\n\ts_barrier" ::: "memory")
__device__ __forceinline__ s16x4 vtr(const LAS unsigned char* p) { return __builtin_bit_cast(s16x4, __builtin_amdgcn_ds_read_tr16_b64_v4i16((LAS s16x4*)p)); }
template <int DK, bool SWA, bool K8 = false>
__device__ __forceinline__ void unit(LAS unsigned char* lds, const bf16* Qw  , int QP, const bf16* Kb  , int KP,
                                     const bf16* Vb, int VP, bf16* Ow  , int q0  , float m_init, float l_init, const float* qss = nullptr  ) {
    int tid = threadIdx.x; asm volatile("" : "+v"(tid)); const int lane = tid & 63, r32 = lane & 31, hi = lane >> 5; const int wid = __builtin_amdgcn_readfirstlane(tid >> 6);
    constexpr int NKP = K8 ? 8 : DK / 8, NP = NKP + 8, NKS = DK / 16;
    int nband = 0, first = 0;
    if (SWA) { first = q0 - 128 < 0 ? 0 : q0 - 128; const int lastk = q0 + 384 > SEQ ? SEQ : q0 + 384; nband = (lastk - first) >> 6; }
    const int NT = SWA ? 4 + nband : KEYS / 64;
#define ATT_KEY0(ti) (SWA ? ((ti) < 4 ? SEQ + 64 * (ti) : first + 64 * ((ti) - 4)) : 64 * (ti))
#define ATT_ISSUE(ti, bufo) do { const int _k0 = ATT_KEY0(ti); _Pragma("unroll") for (int _q = 0; _q < 3; ++_q) { const int _p = wid + 8 * _q; if (_p < NP) { \
        const bf16* _src = (_p < NKP) ? (K8 ? (const bf16*)((const unsigned char*)Kb + (size_t)(_k0 + lane) * 1024 + _p * 16) : (Kb + (size_t)(_k0 + lane) * KP + _p * 8)) : (Vb + (size_t)(_k0 + 16 * ((_p - NKP) & 3) + (lane >> 2)) * VP + ((_p - NKP) >> 2) * 32 + (lane & 3) * 8); \
        const int _dst = (_p < NKP) ? (_p * 1024) : (VOFF + (_p - NKP) * 1024); \
        __builtin_amdgcn_global_load_lds((const unsigned*)_src, (LAS unsigned*)(lds + (bufo) + _dst), 16, 0, 0); } } } while (0)
    ATT_ISSUE(0, 0);
    bf16x8 qr[NKS];
#pragma unroll
    for (int ks = 0; ks < NKS; ++ks) qr[ks] = *(const bf16x8*)(Qw + (size_t)r32 * QP + ks * 16 + hi * 8);
    if (qss) { const f32x2 sq = *(const f32x2*)(qss + (size_t)r32 * 16); const float qs = rsqrtf((sq.x + sq.y) * (1.0f / 96.0f) + EPS) * (K8 ? 0.0625f : 1.0f);
#pragma unroll
        for (int ks = 0; ks < NKS; ++ks) { const u32x4 w = __builtin_bit_cast(u32x4, qr[ks]); u32x4 o;
            o.x = cvt_pk_bf16(bflo(w.x) * qs, bfhi(w.x) * qs); o.y = cvt_pk_bf16(bflo(w.y) * qs, bfhi(w.y) * qs); o.z = cvt_pk_bf16(bflo(w.z) * qs, bfhi(w.z) * qs); o.w = cvt_pk_bf16(bflo(w.w) * qs, bfhi(w.w) * qs);
            qr[ks] = __builtin_bit_cast(bf16x8, o); } }
    float m_run = m_init, l_run = (hi == 0) ? l_init : 0.f; f32x16 o0, o1;
#pragma unroll
    for (int r = 0; r < 16; ++r) { o0[r] = 0.f; o1[r] = 0.f; }
    LAS float* wsf = (LAS float*)(lds + WSF) + wid * 64;
    const int qpos = q0 + wid * 32 + r32;
    for (int ti = 0; ti < NT; ++ti) {
        const int bufo = (ti & 1) * BUF;
        asm volatile("s_waitcnt vmcnt(0)" ::: "memory"); __syncthreads();
        if (ti + 1 < NT) ATT_ISSUE(ti + 1, ((ti + 1) & 1) * BUF);
        const LAS unsigned char* kb = lds + bufo + hi * 1024 + r32 * 16;
        f32x16 p0, p1;
#pragma unroll
        for (int r = 0; r < 16; ++r) { p0[r] = 0.f; p1[r] = 0.f; }
#pragma unroll
        for (int ks = 0; ks < NKS; ++ks) { bf16x8 a0, a1;
            if constexpr (K8) { const LAS unsigned char* k8p = lds + bufo + (4 * (ks >> 2) + 2 * hi + ((ks & 3) >> 1)) * 1024 + r32 * 16 + 8 * (ks & 1);
#pragma unroll
                for (int hf = 0; hf < 2; ++hf) { const u32x2 w = *(const LAS u32x2*)(k8p + 512 * hf);
                    const f32x2 c0 = __builtin_amdgcn_cvt_pk_f32_fp8((int)w.x, false), c1 = __builtin_amdgcn_cvt_pk_f32_fp8((int)w.x, true), c2 = __builtin_amdgcn_cvt_pk_f32_fp8((int)w.y, false), c3 = __builtin_amdgcn_cvt_pk_f32_fp8((int)w.y, true);
                    const u32x4 o = {cvt_pk_bf16(c0.x, c0.y), cvt_pk_bf16(c1.x, c1.y), cvt_pk_bf16(c2.x, c2.y), cvt_pk_bf16(c3.x, c3.y)}; if (hf == 0) a0 = __builtin_bit_cast(bf16x8, o); else a1 = __builtin_bit_cast(bf16x8, o); }
            } else { a0 = *(const LAS bf16x8*)(kb + ks * 2048); a1 = *(const LAS bf16x8*)(kb + ks * 2048 + 512); }
            p0 = __builtin_amdgcn_mfma_f32_32x32x16_bf16(a0, qr[ks], p0, 0, 0, 0); p1 = __builtin_amdgcn_mfma_f32_32x32x16_bf16(a1, qr[ks], p1, 0, 0, 0); }
        if (SWA && ti >= 4) { const int k0 = ATT_KEY0(ti);
#pragma unroll
            for (int r = 0; r < 16; ++r) { const int kp = k0 + crow(r, hi), d0 = qpos - kp, d1 = d0 - 32;
                if (d0 > 128 || d0 < -128) p0[r] = -1e30f; if (d1 > 128 || d1 < -128) p1[r] = -1e30f; } }
        float tmax = fmaxf(p0[0], p1[0]);
#pragma unroll
        for (int r = 1; r < 16; ++r) tmax = fmaxf(tmax, fmaxf(p0[r], p1[r]));
        tmax = fmaxf(tmax, __shfl_xor(tmax, 32));
        if (__any(tmax > m_run)) {
            const float m_new = fmaxf(m_run, tmax), alpha = __builtin_amdgcn_exp2f(m_run - m_new); l_run *= alpha; m_run = m_new;
            if (hi == 0) wsf[r32] = alpha;
            LDS_WAIT(); asm volatile("" ::: "memory");
#pragma unroll
            for (int g = 0; g < 4; ++g) { const f32x4 a = *(const LAS f32x4*)(wsf + 8 * g + 4 * hi);
#pragma unroll
                for (int e = 0; e < 4; ++e) { o0[4 * g + e] *= a[e]; o1[4 * g + e] *= a[e]; } }
            LDS_WAIT(); asm volatile("" ::: "memory");
        }
        float ls = 0.f;
#pragma unroll
        for (int r = 0; r < 16; ++r) { p0[r] = __builtin_amdgcn_exp2f(p0[r] - m_run); p1[r] = __builtin_amdgcn_exp2f(p1[r] - m_run); ls += p0[r] + p1[r]; }
        l_run += ls;
        u32x4 pw0, pw1, pw2, pw3;
        pw0 = (u32x4){cvt_pk_bf16(p0[0], p0[1]), cvt_pk_bf16(p0[2], p0[3]), cvt_pk_bf16(p0[4], p0[5]), cvt_pk_bf16(p0[6], p0[7])};
        pw1 = (u32x4){cvt_pk_bf16(p0[8], p0[9]), cvt_pk_bf16(p0[10], p0[11]), cvt_pk_bf16(p0[12], p0[13]), cvt_pk_bf16(p0[14], p0[15])};
        pw2 = (u32x4){cvt_pk_bf16(p1[0], p1[1]), cvt_pk_bf16(p1[2], p1[3]), cvt_pk_bf16(p1[4], p1[5]), cvt_pk_bf16(p1[6], p1[7])};
        pw3 = (u32x4){cvt_pk_bf16(p1[8], p1[9]), cvt_pk_bf16(p1[10], p1[11]), cvt_pk_bf16(p1[12], p1[13]), cvt_pk_bf16(p1[14], p1[15])};
        const LAS unsigned char* vp = lds + bufo + VOFF + ((lane >> 4) & 1) * 32 + (lane & 3) * 8 + (4 * hi + ((lane & 15) >> 2)) * 64;
#define ATT_VFR(i) ({ const s16x4 _lo = vtr(vp + ((i) >> 2) * 4096 + ((i) & 3) * 1024), _hi = vtr(vp + ((i) >> 2) * 4096 + ((i) & 3) * 1024 + 512); (bf16x8){_lo[0], _lo[1], _lo[2], _lo[3], _hi[0], _hi[1], _hi[2], _hi[3]}; })
        o0 = __builtin_amdgcn_mfma_f32_32x32x16_bf16(__builtin_bit_cast(bf16x8, pw0), ATT_VFR(0), o0, 0, 0, 0);
        o1 = __builtin_amdgcn_mfma_f32_32x32x16_bf16(__builtin_bit_cast(bf16x8, pw0), ATT_VFR(4), o1, 0, 0, 0);
        o0 = __builtin_amdgcn_mfma_f32_32x32x16_bf16(__builtin_bit_cast(bf16x8, pw1), ATT_VFR(1), o0, 0, 0, 0);
        o1 = __builtin_amdgcn_mfma_f32_32x32x16_bf16(__builtin_bit_cast(bf16x8, pw1), ATT_VFR(5), o1, 0, 0, 0);
        o0 = __builtin_amdgcn_mfma_f32_32x32x16_bf16(__builtin_bit_cast(bf16x8, pw2), ATT_VFR(2), o0, 0, 0, 0);
        o1 = __builtin_amdgcn_mfma_f32_32x32x16_bf16(__builtin_bit_cast(bf16x8, pw2), ATT_VFR(6), o1, 0, 0, 0);
        o0 = __builtin_amdgcn_mfma_f32_32x32x16_bf16(__builtin_bit_cast(bf16x8, pw3), ATT_VFR(3), o0, 0, 0, 0);
        o1 = __builtin_amdgcn_mfma_f32_32x32x16_bf16(__builtin_bit_cast(bf16x8, pw3), ATT_VFR(7), o1, 0, 0, 0);
#undef ATT_VFR
    }
    l_run += __shfl_xor(l_run, 32);
    if (hi == 0) wsf[32 + r32] = l_run;
    LDS_WAIT(); asm volatile("" ::: "memory");
    LAS bf16* stg = (LAS bf16*)(lds + OST) + wid * 2048;
#pragma unroll
    for (int g = 0; g < 4; ++g) { const f32x4 lv = *(const LAS f32x4*)(wsf + 32 + 8 * g + 4 * hi);
#pragma unroll
        for (int e = 0; e < 4; ++e) { const int r = 4 * g + e, orow = crow(r, hi); const float rl = __builtin_amdgcn_rcpf(lv[e]);
            if (MK_F8MID) { LAS unsigned char* s8 = (LAS unsigned char*)stg; s8[orow * 64 + r32] = (unsigned char)pk4_fp8(o0[r] * rl * F8_SO, 0.f, 0.f, 0.f); s8[orow * 64 + 32 + r32] = (unsigned char)pk4_fp8(o1[r] * rl * F8_SO, 0.f, 0.f, 0.f); }
            else { stg[orow * 64 + r32] = (bf16)f2bf(o0[r] * rl); stg[orow * 64 + 32 + r32] = (bf16)f2bf(o1[r] * rl); } } }
    LDS_WAIT(); asm volatile("" ::: "memory");
    if (MK_F8MID) {
#pragma unroll
        for (int q = 0; q < 2; ++q) { const int row = q * 16 + (lane >> 2), ch = lane & 3; const u32x4 v = *(const LAS u32x4*)((LAS unsigned char*)stg + row * 64 + ch * 16); *(u32x4*)((unsigned char*)Ow + (size_t)row * ((MK_MERGE78 && MK_F8MID) ? 1024 : 512) + ch * 16) = v; }
    } else {
#pragma unroll
        for (int q = 0; q < 4; ++q) { const int row = q * 8 + (lane >> 3), ch = lane & 7; const u32x4 v = *(const LAS u32x4*)(stg + row * 64 + ch * 8); *(u32x4*)(Ow + (size_t)row * 512 + ch * 8) = v; } }
    LDS_WAIT(); __syncthreads();
#undef ATT_KEY0
#undef ATT_ISSUE
}

constexpr int WSF2 = 3 * BUF, OST2 = WSF2 + 2048, LDS_NEED2 = OST2 + 8 * 4096;
template <int DK, bool SWA, bool K8 = false>
__device__ __forceinline__ void unit2(LAS unsigned char* lds, const bf16* Qw, int QP, const bf16* Kb, int KP, const bf16* Vb, int VP, bf16* Ow, int q0, float negM, float l_init, const float* qss = nullptr) {
    int tid = threadIdx.x; asm volatile("" : "+v"(tid)); const int lane = tid & 63, r32 = lane & 31, hi = lane >> 5; const int wid = __builtin_amdgcn_readfirstlane(tid >> 6);
    constexpr int NKP = K8 ? 8 : DK / 8, NP = NKP + 8, NKS = DK / 16;
    int nband = 0, first = 0;
    if (SWA) { first = q0 - 128 < 0 ? 0 : q0 - 128; const int lastk = q0 + 384 > SEQ ? SEQ : q0 + 384; nband = (lastk - first) >> 6; }
    const int NT = SWA ? 4 + nband : KEYS / 64;
#define ATT_KEY0(ti) (SWA ? ((ti) < 4 ? SEQ + 64 * (ti) : first + 64 * ((ti) - 4)) : 64 * (ti))
#define ATT_ISSUE(ti, bufo) do { const int _k0 = ATT_KEY0(ti); _Pragma("unroll") for (int _q = 0; _q < 3; ++_q) { const int _p = wid + 8 * _q; if (_p < NP) { \
        const bf16* _src = (_p < NKP) ? (K8 ? (const bf16*)((const unsigned char*)Kb + (size_t)(_k0 + lane) * 1024 + _p * 16) : (Kb + (size_t)(_k0 + lane) * KP + _p * 8)) : (Vb + (size_t)(_k0 + 16 * ((_p - NKP) & 3) + (lane >> 2)) * VP + ((_p - NKP) >> 2) * 32 + (lane & 3) * 8); \
        const int _dst = (_p < NKP) ? (_p * 1024) : (VOFF + (_p - NKP) * 1024); \
        glds16(_src, (unsigned)__builtin_amdgcn_readfirstlane((int)(lds0 + (bufo) + _dst))); } } } while (0)
    const unsigned lds0 = (unsigned)(unsigned long long)lds;
    ATT_ISSUE(0, 0); ATT_ISSUE(1, BUF);
    bf16x8 qr[NKS];
#pragma unroll
    for (int ks = 0; ks < NKS; ++ks) qr[ks] = *(const bf16x8*)(Qw + (size_t)r32 * QP + ks * 16 + hi * 8);
    pg8::i32x8 qf[2] = {{0, 0, 0, 0, 0, 0, 0, 0}, {0, 0, 0, 0, 0, 0, 0, 0}};
    if (qss) { const f32x2 sq = *(const f32x2*)(qss + (size_t)r32 * 16); const float qs = rsqrtf((sq.x + sq.y) * (1.0f / 96.0f) + EPS);
        if (K8) { const float q8 = qs * 64.0f;
#pragma unroll
            for (int ks = 0; ks < NKS; ++ks) { const u32x4 w = __builtin_bit_cast(u32x4, qr[ks]);
                qf[ks >> 2][2 * (ks & 3)] = (int)pk4_fp8(bflo(w.x) * q8, bfhi(w.x) * q8, bflo(w.y) * q8, bfhi(w.y) * q8); qf[ks >> 2][2 * (ks & 3) + 1] = (int)pk4_fp8(bflo(w.z) * q8, bfhi(w.z) * q8, bflo(w.w) * q8, bfhi(w.w) * q8); }
        } else {
#pragma unroll
        for (int ks = 0; ks < NKS; ++ks) { const u32x4 w = __builtin_bit_cast(u32x4, qr[ks]); u32x4 o;
            o.x = cvt_pk_bf16(bflo(w.x) * qs, bfhi(w.x) * qs); o.y = cvt_pk_bf16(bflo(w.y) * qs, bfhi(w.y) * qs); o.z = cvt_pk_bf16(bflo(w.z) * qs, bfhi(w.z) * qs); o.w = cvt_pk_bf16(bflo(w.w) * qs, bfhi(w.w) * qs);
            qr[ks] = __builtin_bit_cast(bf16x8, o); } } }
    const f32x16 zero16 = {0.f, 0.f, 0.f, 0.f, 0.f, 0.f, 0.f, 0.f, 0.f, 0.f, 0.f, 0.f, 0.f, 0.f, 0.f, 0.f};
    float l_run = (hi == 0) ? l_init : 0.f; f32x16 o0, o1;
#pragma unroll
    for (int r = 0; r < 16; ++r) { o0[r] = 0.f; o1[r] = 0.f; }
    LAS float* wsf = (LAS float*)(lds + WSF2) + wid * 64;
    const int qpos = q0 + wid * 32 + r32;
    const LAS unsigned char* kb0 = lds + hi * 1024 + r32 * 16;
    const LAS unsigned char* vp0 = lds + VOFF + ((lane >> 4) & 1) * 32 + (lane & 3) * 8 + (4 * hi + ((lane & 15) >> 2)) * 64;
#define ATT_QK8_HALF(S, kb8, half) do { \
        { const u32x4 _l = *(const LAS u32x4*)((kb8) + (2 * hi) * 1024 + (half) * 512), _h = *(const LAS u32x4*)((kb8) + (2 * hi + 1) * 1024 + (half) * 512); \
          const pg8::i32x8 _a = {(int)_l.x, (int)_l.y, (int)_l.z, (int)_l.w, (int)_h.x, (int)_h.y, (int)_h.z, (int)_h.w}; \
          S = __builtin_amdgcn_mfma_scale_f32_32x32x64_f8f6f4(_a, qf[0], zero16, 0, 0, 0, 0x7b7b7b7b, 0, 0x79797979); } \
        { const u32x4 _l = *(const LAS u32x4*)((kb8) + (4 + 2 * hi) * 1024 + (half) * 512), _h = *(const LAS u32x4*)((kb8) + (5 + 2 * hi) * 1024 + (half) * 512); \
          const pg8::i32x8 _a = {(int)_l.x, (int)_l.y, (int)_l.z, (int)_l.w, (int)_h.x, (int)_h.y, (int)_h.z, (int)_h.w}; \
          S = __builtin_amdgcn_mfma_scale_f32_32x32x64_f8f6f4(_a, qf[1], S, 0, 0, 0, 0x7b7b7b7b, 0, 0x79797979); } } while (0)
#define ATT_QK(S0, S1, bufo) do { if constexpr (K8) { const LAS unsigned char* _k8 = lds + (bufo) + r32 * 16; ATT_QK8_HALF(S0, _k8, 0); ATT_QK8_HALF(S1, _k8, 1); } else { const LAS unsigned char* _kb = kb0 + (bufo); \
        { const bf16x8 _a0 = *(const LAS bf16x8*)(_kb), _a1 = *(const LAS bf16x8*)(_kb + 512); \
          S0 = __builtin_amdgcn_mfma_f32_32x32x16_bf16(_a0, qr[0], zero16, 0, 0, 0); S1 = __builtin_amdgcn_mfma_f32_32x32x16_bf16(_a1, qr[0], zero16, 0, 0, 0); } \
        _Pragma("unroll") for (int _ks = 1; _ks < NKS; ++_ks) { const bf16x8 _a0 = *(const LAS bf16x8*)(_kb + _ks * 2048), _a1 = *(const LAS bf16x8*)(_kb + _ks * 2048 + 512); \
          S0 = __builtin_amdgcn_mfma_f32_32x32x16_bf16(_a0, qr[_ks], S0, 0, 0, 0); S1 = __builtin_amdgcn_mfma_f32_32x32x16_bf16(_a1, qr[_ks], S1, 0, 0, 0); } } } while (0)
#define ATT_VFR(vp, i) ({ const s16x4 _lo = vtr((vp) + ((i) >> 2) * 4096 + ((i) & 3) * 1024), _hi = vtr((vp) + ((i) >> 2) * 4096 + ((i) & 3) * 1024 + 512); (bf16x8){_lo[0], _lo[1], _lo[2], _lo[3], _hi[0], _hi[1], _hi[2], _hi[3]}; })
#define ATT_STEP(C0, C1, N0, N1, tt) do { \
        ATT_WAIT_BAR(); \
        if ((tt) + 2 < NT) ATT_ISSUE((tt) + 2, bo_nn); \
        if ((tt) + 1 < NT) ATT_QK(N0, N1, bo_nxt); \
        if (SWA && (tt) >= 4) { const int _k0 = ATT_KEY0(tt); \
            _Pragma("unroll") for (int r = 0; r < 16; ++r) { const int _d0 = qpos - (_k0 + crow(r, hi)), _d1 = _d0 - 32; \
                if (_d0 > 128 || _d0 < -128) C0[r] = -1e30f; if (_d1 > 128 || _d1 < -128) C1[r] = -1e30f; } } \
        float _ls = 0.f; \
        _Pragma("unroll") for (int r = 0; r < 16; ++r) { C0[r] = __builtin_amdgcn_exp2f(C0[r]); C1[r] = __builtin_amdgcn_exp2f(C1[r]); _ls += C0[r] + C1[r]; } \
        l_run += _ls; \
        const u32x4 _pw0 = {cvt_pk_bf16(C0[0], C0[1]), cvt_pk_bf16(C0[2], C0[3]), cvt_pk_bf16(C0[4], C0[5]), cvt_pk_bf16(C0[6], C0[7])}; \
        const u32x4 _pw1 = {cvt_pk_bf16(C0[8], C0[9]), cvt_pk_bf16(C0[10], C0[11]), cvt_pk_bf16(C0[12], C0[13]), cvt_pk_bf16(C0[14], C0[15])}; \
        const u32x4 _pw2 = {cvt_pk_bf16(C1[0], C1[1]), cvt_pk_bf16(C1[2], C1[3]), cvt_pk_bf16(C1[4], C1[5]), cvt_pk_bf16(C1[6], C1[7])}; \
        const u32x4 _pw3 = {cvt_pk_bf16(C1[8], C1[9]), cvt_pk_bf16(C1[10], C1[11]), cvt_pk_bf16(C1[12], C1[13]), cvt_pk_bf16(C1[14], C1[15])}; \
        const LAS unsigned char* _vp = vp0 + bo_cur; \
        o0 = __builtin_amdgcn_mfma_f32_32x32x16_bf16(__builtin_bit_cast(bf16x8, _pw0), ATT_VFR(_vp, 0), o0, 0, 0, 0); \
        o1 = __builtin_amdgcn_mfma_f32_32x32x16_bf16(__builtin_bit_cast(bf16x8, _pw0), ATT_VFR(_vp, 4), o1, 0, 0, 0); \
        o0 = __builtin_amdgcn_mfma_f32_32x32x16_bf16(__builtin_bit_cast(bf16x8, _pw1), ATT_VFR(_vp, 1), o0, 0, 0, 0); \
        o1 = __builtin_amdgcn_mfma_f32_32x32x16_bf16(__builtin_bit_cast(bf16x8, _pw1), ATT_VFR(_vp, 5), o1, 0, 0, 0); \
        o0 = __builtin_amdgcn_mfma_f32_32x32x16_bf16(__builtin_bit_cast(bf16x8, _pw2), ATT_VFR(_vp, 2), o0, 0, 0, 0); \
        o1 = __builtin_amdgcn_mfma_f32_32x32x16_bf16(__builtin_bit_cast(bf16x8, _pw2), ATT_VFR(_vp, 6), o1, 0, 0, 0); \
        o0 = __builtin_amdgcn_mfma_f32_32x32x16_bf16(__builtin_bit_cast(bf16x8, _pw3), ATT_VFR(_vp, 3), o0, 0, 0, 0); \
        o1 = __builtin_amdgcn_mfma_f32_32x32x16_bf16(__builtin_bit_cast(bf16x8, _pw3), ATT_VFR(_vp, 7), o1, 0, 0, 0); \
        { const int _t = bo_cur; bo_cur = bo_nxt; bo_nxt = bo_nn; bo_nn = _t; } } while (0)
    ATT_WAIT_BAR();
    f32x16 sa0, sa1, sb0, sb1;
    ATT_QK(sa0, sa1, 0);
    int bo_cur = 0, bo_nxt = BUF, bo_nn = 2 * BUF;
    for (int t = 0; t < NT; t += 2) {
        ATT_STEP(sa0, sa1, sb0, sb1, t);
        ATT_STEP(sb0, sb1, sa0, sa1, t + 1);
    }
    l_run += __shfl_xor(l_run, 32);
    if (hi == 0) wsf[32 + r32] = l_run;
    LDS_WAIT(); asm volatile("" ::: "memory");
    LAS bf16* stg = (LAS bf16*)(lds + OST2) + wid * 2048;
#pragma unroll
    for (int g = 0; g < 4; ++g) { const f32x4 lv = *(const LAS f32x4*)(wsf + 32 + 8 * g + 4 * hi);
#pragma unroll
        for (int e = 0; e < 4; ++e) { const int r = 4 * g + e, orow = crow(r, hi); const float rl = __builtin_amdgcn_rcpf(lv[e]);
            if (MK_F8MID) { LAS unsigned char* s8 = (LAS unsigned char*)stg; s8[orow * 64 + r32] = (unsigned char)pk4_fp8(o0[r] * rl * F8_SO, 0.f, 0.f, 0.f); s8[orow * 64 + 32 + r32] = (unsigned char)pk4_fp8(o1[r] * rl * F8_SO, 0.f, 0.f, 0.f); }
            else { stg[orow * 64 + r32] = (bf16)f2bf(o0[r] * rl); stg[orow * 64 + 32 + r32] = (bf16)f2bf(o1[r] * rl); } } }
    LDS_WAIT(); asm volatile("" ::: "memory");
    if (MK_F8MID) {
#pragma unroll
        for (int q = 0; q < 2; ++q) { const int row = q * 16 + (lane >> 2), ch = lane & 3; const u32x4 v = *(const LAS u32x4*)((LAS unsigned char*)stg + row * 64 + ch * 16); *(u32x4*)((unsigned char*)Ow + (size_t)row * ((MK_MERGE78 && MK_F8MID) ? 1024 : 512) + ch * 16) = v; }
    } else {
#pragma unroll
        for (int q = 0; q < 4; ++q) { const int row = q * 8 + (lane >> 3), ch = lane & 7; const u32x4 v = *(const LAS u32x4*)(stg + row * 64 + ch * 8); *(u32x4*)(Ow + (size_t)row * 512 + ch * 8) = v; } }
    ATT_WAIT_BAR();
#undef ATT_KEY0
#undef ATT_ISSUE
#undef ATT_QK
#undef ATT_QK8_HALF
#undef ATT_VFR
#undef ATT_STEP
}
constexpr int SUB3 = 16384, SUP3 = 2 * SUB3, WSF3 = 3 * SUP3, OST3 = WSF3 + 2048, LDS_NEED3 = OST3 + 8 * 4096;
static_assert(LDS_NEED3 <= LDSCTL_OFF, "attention LDS"); static_assert(GQX_OFF + 384 <= LDS_BYTES && TSX_OFF + 2176 * 4 <= LDS_BYTES, "LDS map");
template <int DK, bool SWA, bool K8 = false>
__device__ __forceinline__ void unit3(LAS unsigned char* lds, const bf16* Qw, int QP, const bf16* Kb, int KP, const bf16* Vb, int VP, bf16* Ow, int q0, float negM, float l_init, const float* qss = nullptr, int qoff = -1, int qspan = 256) {
    int tid = threadIdx.x; asm volatile("" : "+v"(tid)); const int lane = tid & 63, r32 = lane & 31, hi = lane >> 5; const int wid = __builtin_amdgcn_readfirstlane(tid >> 6);
    constexpr int NKP = K8 ? 8 : DK / 8, NP = NKP + 8, NKS = DK / 16;
    int nband = 0, first = 0;
    if (SWA) { first = q0 - 128 < 0 ? 0 : q0 - 128; const int lastk = q0 + qspan + 128 > SEQ ? SEQ : q0 + qspan + 128; nband = (lastk - first) >> 6; }
    const int NT = SWA ? 4 + nband : KEYS / 64, NT2 = NT >> 1;
#define ATT_KEY0(ti) (SWA ? ((ti) < 4 ? SEQ + 64 * (ti) : first + 64 * ((ti) - 4)) : 64 * (ti))
#define ATT_ISSUE(Ts, bufo) do { _Pragma("unroll") for (int _q = 0; _q < 4; ++_q) { const int _sub = _q >> 1, _p = wid + 8 * (_q & 1); const int _k0 = ATT_KEY0(2 * (Ts) + _sub); \
        const bf16* _src = (_p < 8) ? (K8 ? (const bf16*)((const unsigned char*)Kb + (size_t)(_k0 + lane) * 1024 + _p * 16) : (Kb + (size_t)(_k0 + lane) * KP + _p * 8)) : (Vb + (size_t)(_k0 + 16 * ((_p - 8) & 3) + (lane >> 2)) * VP + ((_p - 8) >> 2) * 32 + (lane & 3) * 8); \
        const int _dst = _sub * SUB3 + ((_p < 8) ? (_p * 1024) : (8192 + (_p - 8) * 1024)); \
        glds16(_src, (unsigned)__builtin_amdgcn_readfirstlane((int)(lds0 + (bufo) + _dst))); } } while (0)
    const unsigned lds0 = (unsigned)(unsigned long long)lds;
    static_assert(K8 || DK == 64, "unit3 needs an 8 KiB K tile");
    ATT_ISSUE(0, 0); ATT_ISSUE(1, SUP3);
    bf16x8 qr[NKS];
#pragma unroll
    for (int ks = 0; ks < NKS; ++ks) qr[ks] = *(const bf16x8*)(Qw + (size_t)r32 * QP + ks * 16 + hi * 8);
    pg8::i32x8 qf[2] = {{0, 0, 0, 0, 0, 0, 0, 0}, {0, 0, 0, 0, 0, 0, 0, 0}};
    if (qss) { const f32x2 sq = *(const f32x2*)(qss + (size_t)r32 * 16); const float qs = rsqrtf((sq.x + sq.y) * (1.0f / 96.0f) + EPS);
        if (K8) { const float q8 = qs * 64.0f;
#pragma unroll
            for (int ks = 0; ks < NKS; ++ks) { const u32x4 w = __builtin_bit_cast(u32x4, qr[ks]);
                qf[ks >> 2][2 * (ks & 3)] = (int)pk4_fp8(bflo(w.x) * q8, bfhi(w.x) * q8, bflo(w.y) * q8, bfhi(w.y) * q8); qf[ks >> 2][2 * (ks & 3) + 1] = (int)pk4_fp8(bflo(w.z) * q8, bfhi(w.z) * q8, bflo(w.w) * q8, bfhi(w.w) * q8); }
        } else {
#pragma unroll
        for (int ks = 0; ks < NKS; ++ks) { const u32x4 w = __builtin_bit_cast(u32x4, qr[ks]); u32x4 o;
            o.x = cvt_pk_bf16(bflo(w.x) * qs, bfhi(w.x) * qs); o.y = cvt_pk_bf16(bflo(w.y) * qs, bfhi(w.y) * qs); o.z = cvt_pk_bf16(bflo(w.z) * qs, bfhi(w.z) * qs); o.w = cvt_pk_bf16(bflo(w.w) * qs, bfhi(w.w) * qs);
            qr[ks] = __builtin_bit_cast(bf16x8, o); } } }
    const f32x16 zero16 = {0.f, 0.f, 0.f, 0.f, 0.f, 0.f, 0.f, 0.f, 0.f, 0.f, 0.f, 0.f, 0.f, 0.f, 0.f, 0.f};
    float l_run = (hi == 0) ? l_init : 0.f; f32x16 o0, o1;
#pragma unroll
    for (int r = 0; r < 16; ++r) { o0[r] = 0.f; o1[r] = 0.f; }
    LAS float* wsf = (LAS float*)(lds + WSF3) + wid * 64;
    const int qpos = q0 + (qoff < 0 ? wid * 32 : qoff) + r32;
    const LAS unsigned char* kb0 = lds + hi * 1024 + r32 * 16;
    const LAS unsigned char* vp0 = lds + 8192 + ((lane >> 4) & 1) * 32 + (lane & 3) * 8 + (4 * hi + ((lane & 15) >> 2)) * 64;
#define ATT_QK8_HALF(S, kb8, half) do { \
        { const u32x4 _l = *(const LAS u32x4*)((kb8) + (2 * hi) * 1024 + (half) * 512), _h = *(const LAS u32x4*)((kb8) + (2 * hi + 1) * 1024 + (half) * 512); \
          const pg8::i32x8 _a = {(int)_l.x, (int)_l.y, (int)_l.z, (int)_l.w, (int)_h.x, (int)_h.y, (int)_h.z, (int)_h.w}; \
          S = __builtin_amdgcn_mfma_scale_f32_32x32x64_f8f6f4(_a, qf[0], zero16, 0, 0, 0, 0x7b7b7b7b, 0, 0x79797979); } \
        { const u32x4 _l = *(const LAS u32x4*)((kb8) + (4 + 2 * hi) * 1024 + (half) * 512), _h = *(const LAS u32x4*)((kb8) + (5 + 2 * hi) * 1024 + (half) * 512); \
          const pg8::i32x8 _a = {(int)_l.x, (int)_l.y, (int)_l.z, (int)_l.w, (int)_h.x, (int)_h.y, (int)_h.z, (int)_h.w}; \
          S = __builtin_amdgcn_mfma_scale_f32_32x32x64_f8f6f4(_a, qf[1], S, 0, 0, 0, 0x7b7b7b7b, 0, 0x79797979); } } while (0)
#define ATT_QK(S0, S1, bufo) do { if constexpr (K8) { const LAS unsigned char* _k8 = lds + (bufo) + r32 * 16; ATT_QK8_HALF(S0, _k8, 0); ATT_QK8_HALF(S1, _k8, 1); } else { const LAS unsigned char* _kb = kb0 + (bufo); \
        { const bf16x8 _a0 = *(const LAS bf16x8*)(_kb), _a1 = *(const LAS bf16x8*)(_kb + 512); \
          S0 = __builtin_amdgcn_mfma_f32_32x32x16_bf16(_a0, qr[0], zero16, 0, 0, 0); S1 = __builtin_amdgcn_mfma_f32_32x32x16_bf16(_a1, qr[0], zero16, 0, 0, 0); } \
        _Pragma("unroll") for (int _ks = 1; _ks < NKS; ++_ks) { const bf16x8 _a0 = *(const LAS bf16x8*)(_kb + _ks * 2048), _a1 = *(const LAS bf16x8*)(_kb + _ks * 2048 + 512); \
          S0 = __builtin_amdgcn_mfma_f32_32x32x16_bf16(_a0, qr[_ks], S0, 0, 0, 0); S1 = __builtin_amdgcn_mfma_f32_32x32x16_bf16(_a1, qr[_ks], S1, 0, 0, 0); } } } while (0)
#define ATT_VFR(vp, i) ({ const s16x4 _lo = vtr((vp) + ((i) >> 2) * 4096 + ((i) & 3) * 1024), _hi = vtr((vp) + ((i) >> 2) * 4096 + ((i) & 3) * 1024 + 512); (bf16x8){_lo[0], _lo[1], _lo[2], _lo[3], _hi[0], _hi[1], _hi[2], _hi[3]}; })
#define ATT_SOFTPV(C0, C1, tt, vbase) do { \
        if (SWA && (tt) >= 4) { const int _k0 = ATT_KEY0(tt); \
            _Pragma("unroll") for (int r = 0; r < 16; ++r) { const int _d0 = qpos - (_k0 + crow(r, hi)), _d1 = _d0 - 32; \
                if (_d0 > 128 || _d0 < -128) C0[r] = -1e30f; if (_d1 > 128 || _d1 < -128) C1[r] = -1e30f; } } \
        float _ls = 0.f; \
        _Pragma("unroll") for (int r = 0; r < 16; ++r) { C0[r] = __builtin_amdgcn_exp2f(C0[r]); C1[r] = __builtin_amdgcn_exp2f(C1[r]); _ls += C0[r] + C1[r]; } \
        l_run += _ls; \
        const u32x4 _pw0 = {cvt_pk_bf16(C0[0], C0[1]), cvt_pk_bf16(C0[2], C0[3]), cvt_pk_bf16(C0[4], C0[5]), cvt_pk_bf16(C0[6], C0[7])}; \
        const u32x4 _pw1 = {cvt_pk_bf16(C0[8], C0[9]), cvt_pk_bf16(C0[10], C0[11]), cvt_pk_bf16(C0[12], C0[13]), cvt_pk_bf16(C0[14], C0[15])}; \
        const u32x4 _pw2 = {cvt_pk_bf16(C1[0], C1[1]), cvt_pk_bf16(C1[2], C1[3]), cvt_pk_bf16(C1[4], C1[5]), cvt_pk_bf16(C1[6], C1[7])}; \
        const u32x4 _pw3 = {cvt_pk_bf16(C1[8], C1[9]), cvt_pk_bf16(C1[10], C1[11]), cvt_pk_bf16(C1[12], C1[13]), cvt_pk_bf16(C1[14], C1[15])}; \
        const LAS unsigned char* _vp = vp0 + (vbase); \
        o0 = __builtin_amdgcn_mfma_f32_32x32x16_bf16(__builtin_bit_cast(bf16x8, _pw0), ATT_VFR(_vp, 0), o0, 0, 0, 0); \
        o1 = __builtin_amdgcn_mfma_f32_32x32x16_bf16(__builtin_bit_cast(bf16x8, _pw0), ATT_VFR(_vp, 4), o1, 0, 0, 0); \
        o0 = __builtin_amdgcn_mfma_f32_32x32x16_bf16(__builtin_bit_cast(bf16x8, _pw1), ATT_VFR(_vp, 1), o0, 0, 0, 0); \
        o1 = __builtin_amdgcn_mfma_f32_32x32x16_bf16(__builtin_bit_cast(bf16x8, _pw1), ATT_VFR(_vp, 5), o1, 0, 0, 0); \
        o0 = __builtin_amdgcn_mfma_f32_32x32x16_bf16(__builtin_bit_cast(bf16x8, _pw2), ATT_VFR(_vp, 2), o0, 0, 0, 0); \
        o1 = __builtin_amdgcn_mfma_f32_32x32x16_bf16(__builtin_bit_cast(bf16x8, _pw2), ATT_VFR(_vp, 6), o1, 0, 0, 0); \
        o0 = __builtin_amdgcn_mfma_f32_32x32x16_bf16(__builtin_bit_cast(bf16x8, _pw3), ATT_VFR(_vp, 3), o0, 0, 0, 0); \
        o1 = __builtin_amdgcn_mfma_f32_32x32x16_bf16(__builtin_bit_cast(bf16x8, _pw3), ATT_VFR(_vp, 7), o1, 0, 0, 0); \
        } while (0)
    ATT_WAIT_BAR();
    f32x16 sa0, sa1, sb0, sb1;
    ATT_QK(sa0, sa1, 0);
    int bo_cur = 0, bo_nxt = SUP3, bo_nn = 2 * SUP3;
    for (int T = 0; T < NT2; ++T) {
        ATT_WAIT_BAR();
        if (T + 2 < NT2) ATT_ISSUE(T + 2, bo_nn);
        ATT_QK(sb0, sb1, bo_cur + SUB3); ATT_SOFTPV(sa0, sa1, 2 * T, bo_cur);
        if (T + 1 < NT2) ATT_QK(sa0, sa1, bo_nxt);
        ATT_SOFTPV(sb0, sb1, 2 * T + 1, bo_cur + SUB3);
        { const int _t = bo_cur; bo_cur = bo_nxt; bo_nxt = bo_nn; bo_nn = _t; }
    }
    l_run += __shfl_xor(l_run, 32);
    if (hi == 0) wsf[32 + r32] = l_run;
    LDS_WAIT(); asm volatile("" ::: "memory");
    LAS bf16* stg = (LAS bf16*)(lds + OST3) + wid * 2048;
#pragma unroll
    for (int g = 0; g < 4; ++g) { const f32x4 lv = *(const LAS f32x4*)(wsf + 32 + 8 * g + 4 * hi);
#pragma unroll
        for (int e = 0; e < 4; ++e) { const int r = 4 * g + e, orow = crow(r, hi); const float rl = __builtin_amdgcn_rcpf(lv[e]);
            if (MK_F8MID) { LAS unsigned char* s8 = (LAS unsigned char*)stg; s8[orow * 64 + r32] = (unsigned char)pk4_fp8(o0[r] * rl * F8_SO, 0.f, 0.f, 0.f); s8[orow * 64 + 32 + r32] = (unsigned char)pk4_fp8(o1[r] * rl * F8_SO, 0.f, 0.f, 0.f); }
            else { stg[orow * 64 + r32] = (bf16)f2bf(o0[r] * rl); stg[orow * 64 + 32 + r32] = (bf16)f2bf(o1[r] * rl); } } }
    LDS_WAIT(); asm volatile("" ::: "memory");
    if (MK_F8MID) {
#pragma unroll
        for (int q = 0; q < 2; ++q) { const int row = q * 16 + (lane >> 2), ch = lane & 3; const u32x4 v = *(const LAS u32x4*)((LAS unsigned char*)stg + row * 64 + ch * 16); *(GAS u32x4*)((GAS unsigned char*)Ow + (size_t)row * ((MK_MERGE78 && MK_F8MID) ? 1024 : 512) + ch * 16) = v; }
    } else {
#pragma unroll
        for (int q = 0; q < 4; ++q) { const int row = q * 8 + (lane >> 3), ch = lane & 7; const u32x4 v = *(const LAS u32x4*)(stg + row * 64 + ch * 8); *(GAS u32x4*)((GAS bf16*)Ow + (size_t)row * 512 + ch * 8) = v; } }
    asm volatile("s_waitcnt lgkmcnt(0)\n\ts_barrier" ::: "memory");
#undef ATT_KEY0
#undef ATT_ISSUE
#undef ATT_QK
#undef ATT_QK8_HALF
#undef ATT_VFR
#undef ATT_SOFTPV
}
}

__device__ __forceinline__ void p6_attention(Frame& F) {
    const bf16* QM = WSP(bf16, WS_QM); const bf16* KM = WSP(bf16, WS_KM); const bf16* VM = WSP(bf16, WS_VM);
    const bf16* QS = WSP(bf16, WS_QS); const bf16* KS = WSP(bf16, WS_KS); const bf16* VS = WSP(bf16, WS_VS);
    constexpr int OES = MK_F8MID ? 1 : 2; unsigned char* OAb = WSP(unsigned char, WS_OA); unsigned char* OBb = WSP(unsigned char, WS_OB);
#define OA_PTR(row0, h) ((bf16*)((MK_MERGE78 && MK_F8MID) ? OAb + (size_t)(row0) * 1024 + (h) * 64 : OAb + ((size_t)(row0) * 512 + (h) * 64) * OES))
#define OB_PTR(row0, h) ((bf16*)((MK_MERGE78 && MK_F8MID) ? OAb + (size_t)(row0) * 1024 + 512 + (h) * 64 : OBb + ((size_t)(row0) * 512 + (h) * 64) * OES))
    float gqm = 0.f, gkm = 0.f, gqs = 0.f, gks = 0.f;
    { const int l = F.lane;
      const float q0v = ((const GAS float*)F.mla_q_g)[l], q1v = ((const GAS float*)F.mla_q_g)[64 + (l & 31)], k0v = ((const GAS float*)F.mla_k_g)[l], k1v = ((const GAS float*)F.mla_k_g)[64 + (l & 31)];
      const float sqv = ((const GAS float*)F.swa_q_g)[l], skv = ((const GAS float*)F.swa_k_g)[l];
      gqm = fmaxf(fabsf(q0v), fabsf(q1v)); gkm = fmaxf(fabsf(k0v), fabsf(k1v)); gqs = fabsf(sqv); gks = fabsf(skv);
#pragma unroll
      for (int o = 1; o < 64; o <<= 1) { gqm = fmaxf(gqm, __shfl_xor(gqm, o)); gkm = fmaxf(gkm, __shfl_xor(gkm, o)); gqs = fmaxf(gqs, __shfl_xor(gqs, o)); gks = fmaxf(gks, __shfl_xor(gks, o)); }
      gqm = __builtin_bit_cast(float, __builtin_amdgcn_readfirstlane(__builtin_bit_cast(int, gqm))); gkm = __builtin_bit_cast(float, __builtin_amdgcn_readfirstlane(__builtin_bit_cast(int, gkm)));
      gqs = __builtin_bit_cast(float, __builtin_amdgcn_readfirstlane(__builtin_bit_cast(int, gqs))); gks = __builtin_bit_cast(float, __builtin_amdgcn_readfirstlane(__builtin_bit_cast(int, gks))); }
    const float Mm = QSCALE_M * 96.0f * gqm * gkm * 1.02f, Ms = QSCALE_S * 64.0f * gqs * gks * 1.02f;
    float snk = fabsf(((const GAS float*)F.swa_sink)[F.lane & 7] * LOG2E);
#pragma unroll
    for (int o = 1; o < 8; o <<= 1) snk = fmaxf(snk, __shfl_xor(snk, o));
    snk = __builtin_bit_cast(float, __builtin_amdgcn_readfirstlane(__builtin_bit_cast(int, snk)));
    const bool fast_m = Mm < 60.0f, fast_s = Ms < 60.0f && snk < 60.0f;
    const int NU = (1024 - F.vcu + F.G - 1) / F.G; int xp = MK_XOVL ? (MK_XPOS5 ? (int)(((blockIdx.x >> 3) & 7) * 5 >> 3) : (int)((blockIdx.x >> 3) & 7)) : -1;
#pragma nounroll
    for (int k = 0; k <= 2 * NU; ++k) {
        if (k == xp) { __syncthreads(); p0_experts(F); __syncthreads(); }
        if (k < NU) { const int u = F.vcu + k * F.G;
            const int bh = u >> 4, qb = u & 15, b = bh >> 3, h = bh & 7, q0 = qb * 256; const size_t row0 = (size_t)b * SEQ + q0 + F.wave * 32;
            if (fast_m && MK_ATT8 && MK_FUSE5 && MK_ATT2T) att::unit3<96, false, true>(F.lds, QM + row0 * 768 + h * 96, 768, (const bf16*)((const unsigned char*)KM + (size_t)b * KEYS * 1024 + h * 128), 0, VM + (size_t)b * KEYS * 512 + h * 64, 512, OA_PTR(row0, h), q0, 0.f, 0.f, WSP(float, WS_SSQH) + (row0 * 8 + h) * 2);
            else if (fast_m && MK_ATT8 && MK_FUSE5) att::unit2<96, false, true>(F.lds, QM + row0 * 768 + h * 96, 768, (const bf16*)((const unsigned char*)KM + (size_t)b * KEYS * 1024 + h * 128), 0, VM + (size_t)b * KEYS * 512 + h * 64, 512, OA_PTR(row0, h), q0, 0.f, 0.f, WSP(float, WS_SSQH) + (row0 * 8 + h) * 2);
            else if (fast_m) att::unit2<96, false>(F.lds, QM + row0 * 768 + h * 96, 768, KM + (size_t)b * KEYS * 768 + h * 96, 768, VM + (size_t)b * KEYS * 512 + h * 64, 512, OA_PTR(row0, h), q0, 0.f, 0.f, MK_FUSE5 ? WSP(float, WS_SSQH) + (row0 * 8 + h) * 2 : nullptr);
            else if (MK_ATT8 && MK_FUSE5) att::unit<96, false, true>(F.lds, QM + row0 * 768 + h * 96, 768, (const bf16*)((const unsigned char*)KM + (size_t)b * KEYS * 1024 + h * 128), 0, VM + (size_t)b * KEYS * 512 + h * 64, 512, OA_PTR(row0, h), q0, -1e30f, 0.f, WSP(float, WS_SSQH) + (row0 * 8 + h) * 2);
            else att::unit<96, false>(F.lds, QM + row0 * 768 + h * 96, 768, KM + (size_t)b * KEYS * 768 + h * 96, 768, VM + (size_t)b * KEYS * 512 + h * 64, 512, OA_PTR(row0, h), q0, -1e30f, 0.f, MK_FUSE5 ? WSP(float, WS_SSQH) + (row0 * 8 + h) * 2 : nullptr);
        } else if (k < 2 * NU) { const int u = F.vcu + (k - NU) * F.G;
            if (fast_s && MK_ATT2T && MK_SWA2H) {
                const int b = u >> 7, hp = (u >> 5) & 3, qb = u & 31, q0 = qb * 128, hd = 2 * hp + (F.wave >> 2), qo = (F.wave & 3) * 32; const size_t row0 = (size_t)b * SEQ + q0 + qo; const float sk = F.swa_sink[hd] * LOG2E;
                att::unit3<64, true>(F.lds, QS + row0 * 512 + hd * 64, 512, KS + (size_t)b * KEYS * 128 + (hp >> 1) * 64, 128, VS + (size_t)b * KEYS * 128 + (hp >> 1) * 64, 128, OB_PTR(row0, hd), q0, 0.f, __builtin_amdgcn_exp2f(sk), nullptr, qo, 128);
                continue; }
            const int bh = u >> 4, qb = u & 15, b = bh >> 3, h = bh & 7, q0 = qb * 256; const size_t row0 = (size_t)b * SEQ + q0 + F.wave * 32; const float sk = F.swa_sink[h] * LOG2E;
            if (fast_s && MK_ATT2T) att::unit3<64, true>(F.lds, QS + row0 * 512 + h * 64, 512, KS + (size_t)b * KEYS * 128 + (h >> 2) * 64, 128, VS + (size_t)b * KEYS * 128 + (h >> 2) * 64, 128, OB_PTR(row0, h), q0, 0.f, __builtin_amdgcn_exp2f(sk));
            else if (fast_s) att::unit2<64, true>(F.lds, QS + row0 * 512 + h * 64, 512, KS + (size_t)b * KEYS * 128 + (h >> 2) * 64, 128, VS + (size_t)b * KEYS * 128 + (h >> 2) * 64, 128, OB_PTR(row0, h), q0, 0.f, __builtin_amdgcn_exp2f(sk));
            else att::unit<64, true>(F.lds, QS + row0 * 512 + h * 64, 512, KS + (size_t)b * KEYS * 128 + (h >> 2) * 64, 128, VS + (size_t)b * KEYS * 128 + (h >> 2) * 64, 128, OB_PTR(row0, h), q0, sk, 1.0f);
        }
    }
}

constexpr int WRP_SEG = 256 * 32 + 16;
__device__ __forceinline__ void p10_norm2_router(Frame& F) {
    LAS float* WRP = (LAS float*)F.lds;
    LAS int* hist = (LAS int*)(F.lds + MOE_OFF);
    LAS float* BIASP = (LAS float*)(F.lds + P10X_OFF);
    LAS float* RS = BIASP + 32;
    LAS float* BPART = RS + 128;
    const int b = blockIdx.x, bb = b >> 5, lane = F.lane; const float* mod = WSP(float, WS_MOD) + (size_t)bb * NMOD;
    { const GAS float* gmod = (const GAS float*)mod; const GAS float* gwr = (const GAS float*)F.w_router; const GAS float* gg = (const GAS float*)F.norm2_g;
#pragma unroll
      for (int h = 0; h < 4; ++h) { f32x4 w[4]; float g[4], sc[4];
#pragma unroll
          for (int u = 0; u < 4; ++u) { const int idx = F.tid + 512 * (4 * h + u), k = idx >> 3, e4 = (idx & 7) * 4; g[u] = gg[k]; sc[u] = gmod[4096 + k]; w[u] = *(const GAS f32x4*)(gwr + (size_t)k * 32 + e4); }
          asm volatile("" ::: "memory");
#pragma unroll
          for (int u = 0; u < 4; ++u) { const int idx = F.tid + 512 * (4 * h + u), k = idx >> 3, e4 = (idx & 7) * 4; *(LAS f32x4*)(WRP + (k >> 8) * WRP_SEG + (k & 255) * 32 + e4) = w[u] * (g[u] * (1.0f + sc[u])); } }
      const int e = F.tid & 31, part = F.tid >> 5; float sacc = 0.f;
#pragma unroll
      for (int h = 0; h < 8; ++h) { float mv[8], wv[8];
#pragma unroll
          for (int u = 0; u < 8; ++u) { const int k = part * 64 + 8 * h + u; mv[u] = gmod[3072 + k]; wv[u] = gwr[(size_t)k * 32 + e]; }
          asm volatile("" ::: "memory");
#pragma unroll
          for (int u = 0; u < 8; ++u) sacc += mv[u] * wv[u]; }
      BPART[part * 32 + e] = sacc; }
    if (F.tid < 32) hist[F.tid] = 0;
    __syncthreads();
    if (F.tid < 32) { float sacc = F.b_router[F.tid];
#pragma unroll
        for (int p = 0; p < 16; ++p) sacc += BPART[p * 32 + F.tid];
        BIASP[F.tid] = sacc; }
    f32x4 av[4], cv[4];
#pragma unroll
    for (int q = 0; q < 4; ++q) { const int col = 4 * lane + 256 * q; const f32x4 g = *(const f32x4*)(F.norm2_g + col), sc = *(const f32x4*)(mod + 4096 + col); cv[q] = *(const f32x4*)(mod + 3072 + col); av[q] = g * (sc + 1.0f); }
    __syncthreads();
    bf16* H2 = WSP(bf16, WS_H2); int* topi = WSP(int, WS_TOPI); float* topw = WSP(float, WS_TOPW);
    const int tok0 = 128 * b + 16 * F.wave;
#pragma nounroll
    for (int j0 = 0; j0 < 16; j0 += MK_P10R) {
        f32x4 v[MK_P10R][4];
#pragma unroll
        for (int t = 0; t < MK_P10R; ++t) { const GAS float* xr = (const GAS float*)F.out + (size_t)(tok0 + j0 + t) * D;
#pragma unroll
            for (int q = 0; q < 4; ++q) v[t][q] = *(const GAS f32x4*)(xr + 4 * lane + 256 * q); }
        asm volatile("" ::: "memory");
#pragma unroll
        for (int t = 0; t < MK_P10R; ++t) { const int tok = tok0 + j0 + t; float ss = 0.f;
#pragma unroll
            for (int q = 0; q < 4; ++q) ss += (v[t][q].x * v[t][q].x + v[t][q].y * v[t][q].y) + (v[t][q].z * v[t][q].z + v[t][q].w * v[t][q].w);
            const float rstd = rsqrtf(wave_sum(ss) * (1.0f / D) + EPS);
            if (lane == 0) RS[F.wave * 16 + j0 + t] = rstd;
#pragma unroll
            for (int q = 0; q < 4; ++q) { const f32x4 h = v[t][q] * rstd * av[q] + cv[q];
                if (MK_F8) { *(GAS unsigned*)((GAS unsigned char*)H2 + (size_t)tok * D + 4 * lane + 256 * q) = pk4_fp8(h.x * F8_SA, h.y * F8_SA, h.z * F8_SA, h.w * F8_SA); }
                else { u32x2 o; o.x = pk2(h.x, h.y); o.y = pk2(h.z, h.w); *(GAS u32x2*)((GAS bf16*)H2 + (size_t)tok * D + 4 * lane + 256 * q) = o; } } }
    }
    LDS_WAIT(); asm volatile("" ::: "memory");
    const int i = lane & 15, q = lane >> 4;
    f32x4 acc0 = {0.f, 0.f, 0.f, 0.f}, acc1 = {0.f, 0.f, 0.f, 0.f};
    { const GAS float* xp = (const GAS float*)F.out + (size_t)(tok0 + i) * D + 256 * q; const LAS float* wp = WRP + q * WRP_SEG + i;
      f32x4 xa[8], xb[8];
#define P10_LD8(dst, m0) do { _Pragma("unroll") for (int u = 0; u < 8; ++u) dst[u] = *(const GAS f32x4*)(xp + 4 * ((m0) + u)); asm volatile("" ::: "memory"); } while (0)
#define P10_MM8(src, m0) do { _Pragma("unroll") for (int u = 0; u < 8; ++u) { _Pragma("unroll") for (int c = 0; c < 4; ++c) { const float b0 = wp[(4 * ((m0) + u) + c) * 32], b1 = wp[(4 * ((m0) + u) + c) * 32 + 16]; \
          acc0 = __builtin_amdgcn_mfma_f32_16x16x4f32(src[u][c], b0, acc0, 0, 0, 0); acc1 = __builtin_amdgcn_mfma_f32_16x16x4f32(src[u][c], b1, acc1, 0, 0, 0); } } } while (0)
      P10_LD8(xa, 0);
#pragma unroll
      for (int m0 = 0; m0 < 64; m0 += 16) {
          P10_LD8(xb, m0 + 8);
          P10_MM8(xa, m0);
          if (m0 + 16 < 64) P10_LD8(xa, m0 + 16);
          P10_MM8(xb, m0 + 8);
      }
#undef P10_LD8
#undef P10_MM8
    }
    const float bs0 = BIASP[i], bs1 = BIASP[16 + i];
#pragma unroll
    for (int r = 0; r < 4; ++r) {
        const float rs = RS[F.wave * 16 + 4 * q + r]; float v0 = acc0[r] * rs + bs0, v1 = acc1[r] * rs + bs1;
        float tv[4]; int tix[4];
#pragma unroll
        for (int k = 0; k < 4; ++k) {
            float bv; int bi; if (v0 >= v1) { bv = v0; bi = i; } else { bv = v1; bi = 16 + i; }
#pragma unroll
            for (int st = 0; st < 4; ++st) { const float ov = st == 0 ? dpp_f<0xB1>(bv) : st == 1 ? dpp_f<0x4E>(bv) : st == 2 ? dpp_f<0x141>(bv) : dpp_f<0x140>(bv);
                const int oi = st == 0 ? dpp_i<0xB1>(bi) : st == 1 ? dpp_i<0x4E>(bi) : st == 2 ? dpp_i<0x141>(bi) : dpp_i<0x140>(bi); if (ov > bv || (ov == bv && oi < bi)) { bv = ov; bi = oi; } }
            tv[k] = bv; tix[k] = bi; if (bi == i) v0 = -3.0e38f; if (bi == 16 + i) v1 = -3.0e38f;
        }
        const float e1 = __expf(tv[1] - tv[0]), e2 = __expf(tv[2] - tv[0]), e3 = __expf(tv[3] - tv[0]), inv = 1.0f / (1.0f + e1 + e2 + e3);
        if (i < 4) { const int tok = tok0 + 4 * q + r; const float w = (i == 0 ? 1.0f : i == 1 ? e1 : i == 2 ? e2 : e3) * inv; const int ix = i == 0 ? tix[0] : i == 1 ? tix[1] : i == 2 ? tix[2] : tix[3];
            topi[tok * 4 + i] = ix; topw[tok * 4 + i] = w; __hip_atomic_fetch_add(&hist[ix], 1, __ATOMIC_RELAXED, __HIP_MEMORY_SCOPE_WORKGROUP); }
    }
    __syncthreads();
    if (F.tid < 32) WSP(int, WS_BCNT)[b * 32 + F.tid] = hist[F.tid];
}

struct MoeTab { LAS int* base; LAS int* ntile; LAS int* total; LAS int* mine; LAS int* cursor; LAS int* R; LAS unsigned char* texp; };
__device__ __forceinline__ MoeTab moe_tab(Frame& F) { MoeTab t; LAS int* p = (LAS int*)(F.lds + MOE_OFF); t.base = p + 32; t.ntile = p + 64; t.total = p + 96; t.mine = p + 128; t.cursor = p + 160; t.R = p + 192; t.texp = (LAS unsigned char*)(p + 200); return t; }
__device__ __forceinline__ void moe_tables(Frame& F) {
    const MoeTab t = moe_tab(F); LAS int* part = (LAS int*)F.lds;
    const int* bc = WSP(int, WS_BCNT); const int b = blockIdx.x;
    __syncthreads();
    if (F.tid < 256) { const int e = F.tid & 31, pt = F.tid >> 5; int tot = 0, bef = 0;
        for (int q = 0; q < 32; ++q) { const int bq = pt * 32 + q; const int cval = bc[bq * 32 + e]; tot += cval; if (bq < b) bef += cval; }
        part[pt * 32 + e] = tot; part[256 + pt * 32 + e] = bef; }
    __syncthreads();
    if (F.tid < 32) { int tot = 0, bef = 0;
#pragma unroll
        for (int pt = 0; pt < 8; ++pt) { tot += part[pt * 32 + F.tid]; bef += part[256 + pt * 32 + F.tid]; }
        const int nt = (tot + 255) >> 8; t.total[F.tid] = tot; t.mine[F.tid] = bef; t.ntile[F.tid] = nt; t.cursor[F.tid] = 0;
        int inc = nt;
#pragma unroll
        for (int o = 1; o < 32; o <<= 1) { const int up = __shfl_up(inc, o); if ((int)F.tid >= o) inc += up; }
        const int r0 = inc - nt; t.base[F.tid] = r0 * 256; if (F.tid == 31) t.R[0] = inc;
        for (int q = 0; q < nt; ++q) t.texp[r0 + q] = (unsigned char)F.tid; }
    __syncthreads();
}
__device__ __forceinline__ void p11_slots(Frame& F) {
    moe_tables(F); const MoeTab t = moe_tab(F);
    const int b = blockIdx.x, tok = 128 * b + (F.tid >> 2), k = F.tid & 3;
    const int e = WSP(int, WS_TOPI)[tok * 4 + k]; const float w = WSP(float, WS_TOPW)[tok * 4 + k];
    const int rank = __hip_atomic_fetch_add(&t.cursor[e], 1, __ATOMIC_RELAXED, __HIP_MEMORY_SCOPE_WORKGROUP); const int slot = t.base[e] + t.mine[e] + rank;
    WSP(int, WS_SLOTTOK)[slot] = tok; WSP(float, WS_SLOTW)[slot] = w; WSP(int, WS_TOKSLOT)[tok * 4 + k] = slot;
    if (b < 32) { const int s0 = t.base[b] + t.total[b], s1 = t.base[b] + t.ntile[b] * 256; for (int s = s0 + F.tid; s < s1; s += 512) { WSP(int, WS_SLOTTOK)[s] = 0; WSP(float, WS_SLOTW)[s] = 0.f; } }
}
__device__ __forceinline__ void p14_combine(Frame& F) {
    const unsigned char* Y = WSP(unsigned char, WS_R2); const int* ts = WSP(int, WS_TOKSLOT); const float* mod = WSP(float, WS_MOD);
    const int gw = F.vcu * NWAVES + F.wave, NGW = F.G * NWAVES, lane = F.lane;
    static_assert(MK_F8Y, "combine is written for e4m3 Y");
    const GAS int* gts = (const GAS int*)ts; u32x4 nsa = {0u, 0u, 0u, 0u}, nsb = {0u, 0u, 0u, 0u};
    if (2 * gw < MTOK) { nsa = *(const GAS u32x4*)(gts + 2 * gw * 4); nsb = *(const GAS u32x4*)(gts + 2 * gw * 4 + 4); }
    for (int t0 = 2 * gw; t0 < MTOK; t0 += 2 * NGW) {
        const int bb = t0 >> 12; const u32x4 sa = nsa, sb = nsb;
        { const int tn = t0 + 2 * NGW; if (tn < MTOK) { nsa = *(const GAS u32x4*)(gts + tn * 4); nsb = *(const GAS u32x4*)(gts + tn * 4 + 4); } }
        const unsigned sl[2][4] = {{sa.x, sa.y, sa.z, sa.w}, {sb.x, sb.y, sb.z, sb.w}};
        unsigned yw[2][4][4]; f32x4 xv[2][4], g2[4];
#pragma unroll
        for (int t = 0; t < 2; ++t)
#pragma unroll
            for (int k = 0; k < 4; ++k)
#pragma unroll
                for (int q = 0; q < 4; ++q) yw[t][k][q] = *(const unsigned*)(Y + (size_t)sl[t][k] * 1024 + 256 * q + 4 * lane);
#pragma unroll
        for (int t = 0; t < 2; ++t)
#pragma unroll
            for (int q = 0; q < 4; ++q) xv[t][q] = *(const f32x4*)(F.out + (size_t)(t0 + t) * D + 256 * q + 4 * lane);
#pragma unroll
        for (int q = 0; q < 4; ++q) g2[q] = *(const f32x4*)(mod + (size_t)bb * NMOD + 5120 + 256 * q + 4 * lane);
#pragma unroll
        for (int t = 0; t < 2; ++t) {
            float s[16];
#pragma unroll
            for (int e = 0; e < 16; ++e) s[e] = 0.f;
#pragma unroll
            for (int k = 0; k < 4; ++k) {
#pragma unroll
                for (int q = 0; q < 4; ++q) { const f32x2 lo = __builtin_amdgcn_cvt_pk_f32_fp8((int)yw[t][k][q], false), hi = __builtin_amdgcn_cvt_pk_f32_fp8((int)yw[t][k][q], true);
                    s[4 * q] += lo.x; s[4 * q + 1] += lo.y; s[4 * q + 2] += hi.x; s[4 * q + 3] += hi.y; } }
#pragma unroll
            for (int q = 0; q < 4; ++q) { const f32x4 ov = xv[t][q] + g2[q] * ((f32x4){s[4 * q], s[4 * q + 1], s[4 * q + 2], s[4 * q + 3]} * (1.0f / F8_SY));
                if (MK_NTOUT) __builtin_nontemporal_store(ov, (GAS f32x4*)((GAS float*)F.out + (size_t)(t0 + t) * D + 256 * q + 4 * lane));
                else *(f32x4*)(F.out + (size_t)(t0 + t) * D + 256 * q + 4 * lane) = ov; }
        }
    }
}

constexpr int NPHASE = 15;
struct Args { const float* in[27]; float* out; unsigned char* ws; int ph_lo, ph_hi; };
__global__ void __launch_bounds__(NWAVES * 64, 2) mk_fwd(Args args) {
    extern __shared__ __attribute__((aligned(16))) unsigned char lds_raw[];
    Frame F;
    F.lds = (LAS unsigned char*)lds_raw;
    F.MISC = (volatile LAS unsigned*)(F.lds + MISC_OFF);
    F.tid = threadIdx.x; F.lane = F.tid & 63; F.wave = __builtin_amdgcn_readfirstlane(F.tid >> 6);
    F.G = gridDim.x; { const int bx = blockIdx.x; F.vcu = (F.G % 8 == 0) ? (bx % 8) * (F.G / 8) + bx / 8 : bx; }
    F.ws = args.ws; F.ctl = (gu32*)(args.ws + WS_CTL); F.out = args.out;
    for (int u = F.tid; u < (LDS_BYTES - LDSCTL_OFF) / 4; u += NWAVES * 64) ((LAS unsigned*)(F.lds + LDSCTL_OFF))[u] = 0u;
    __syncthreads();
    XcdBarrier bar; bar.bar = (unsigned*)(F.ctl + CW_BAR); bar.x = 0; bar.st = nullptr;
    if (MK_N_LAUNCHES == 1) bar = xcd_barrier_post((unsigned*)(F.ctl + CW_BAR), F.MISC + 8);
    const int lo = args.ph_lo, hi = args.ph_hi;
#ifndef MK_PHMASK
#define MK_PHMASK 0x7fff
#endif
#define IN(k) ((((MK_PHMASK) >> (k)) & 1) && lo <= (k) && (k) < hi)
#define SEAM(k) do { if (IN(k) && IN((k) + 1)) xcd_barrier(bar); } while (0)

    if (IN(0)) { frame_load(F); p0_prologue(F); if (MK_REP == 0) p0_prologue(F); } SEAM(0);
#if !MK_STAGE_A
    if (IN(1)) { frame_load(F); p1_norm1(F); if (MK_REP == 10) { __syncthreads(); p1_norm1(F); } } SEAM(1);
    if (IN(2)) { frame_load(F);
        SchedInProj S{F.G, (int)blockIdx.x, (const char*)WSP(bf16, WS_H), (const char*)WSP(bf16, WS_WIN)};
        constexpr int ES = MK_F8IN ? 1 : 2;
        if (MK_FUSE3) { { LAS float* tl = (LAS float*)(F.lds + TSX_OFF); const GAS float* tsrc = (const GAS float*)WSP(float, WS_TRIG);
                { float t4[4];
#pragma unroll
                  for (int u = 0; u < 4; ++u) t4[u] = tsrc[F.tid + 512 * u];
#pragma unroll
                  for (int u = 0; u < 4; ++u) tl[F.tid + 512 * u] = t4[u]; }
                if (F.tid < 64) { tl[2048 + F.tid] = ((const GAS float*)F.swa_q_g)[F.tid]; tl[2112 + F.tid] = ((const GAS float*)F.swa_k_g)[F.tid]; }
                __syncthreads(); }
            EpiInProj E{WSP(bf16, WS_R1), WSP(float, WS_SSKV), WSP(float, WS_SSQ), WSP(bf16, WS_QS), WSP(bf16, WS_KS), WSP(bf16, WS_VS), (const LAS float*)(F.lds + TSX_OFF), (const LAS float*)(F.lds + TSX_OFF) + 2048, (const LAS float*)(F.lds + TSX_OFF) + 2112};
            pg8::gemm_phase<EpiInProj, SchedInProj, true, false, MK_F8IN != 0>(F.lds, D * ES / 128, D * ES, D * ES, S, E); }
        else { EpiStoreBf16 E{WSP(bf16, WS_R1), NRAW, nullptr, MK_F8IN ? F8_INV : 1.0f};
            pg8::gemm_phase<EpiStoreBf16, SchedInProj, true, false, MK_F8IN != 0>(F.lds, D * ES / 128, D * ES, D * ES, S, E); }
    } SEAM(2);
    if (!MK_FUSE3) { if (IN(3)) { frame_load(F); p3_post_inproj(F); } SEAM(3); }
    if (IN(4)) { frame_load(F);
        if (MK_FUSE5) { LAS float* tl = (LAS float*)(F.lds + TMX_OFF); const GAS float* tsrc = (const GAS float*)WSP(float, WS_TRIG) + 2048;
            { const float t0v = tsrc[F.tid], t1v = tsrc[F.tid + 512]; tl[F.tid] = t0v; tl[F.tid + 512] = t1v; }
            if (F.tid < 96) { ((LAS float*)(F.lds + GKX_OFF))[F.tid] = ((const GAS float*)F.mla_k_g)[F.tid]; ((LAS float*)(F.lds + GQX_OFF))[F.tid] = ((const GAS float*)F.mla_q_g)[F.tid]; }
            __syncthreads(); }
        { SchedDense S{F.G, (int)blockIdx.x, MALL / 256, 4, (const char*)(WSP(bf16, WS_R1) + C_KVLAT), (const char*)WSP(bf16, WS_WKV), (size_t)256 * NRAW * 2, (size_t)256 * 256 * 2}; S.rep = (MK_REPU == 4) ? 2 : 1;
          if (MK_FUSE5) { EpiKv<MK_ATT8 != 0> E{WSP(float, WS_SSKV), WSP(bf16, WS_R1), WSP(bf16, WS_KM), WSP(bf16, WS_VM), (const LAS float*)(F.lds + TMX_OFF), (const LAS float*)(F.lds + GKX_OFF)};
            pg8::gemm_phase<EpiKv<MK_ATT8 != 0>, SchedDense, true, false>(F.lds, 256 / 64, NRAW * 2, 256 * 2, S, E); }
          else if (MK_FUSE3) { EpiUp<4> E{WSP(bf16, WS_KVUP), 1024, WSP(float, WS_SSKV), 1.0f / 256.0f}; pg8::gemm_phase<EpiUp<4>, SchedDense, true, false>(F.lds, 256 / 64, NRAW * 2, 256 * 2, S, E); }
          else { EpiStoreBf16 E{WSP(bf16, WS_KVUP), 1024, WSP(float, WS_RSKV), 1.0f}; pg8::gemm_phase<EpiStoreBf16, SchedDense, true, false>(F.lds, 256 / 64, NRAW * 2, 256 * 2, S, E); } }
        frame_load(F);
        { SchedDense S{F.G, (int)blockIdx.x, MTOK / 256, MK_FUSE5 ? 4 : 3, (const char*)(WSP(bf16, WS_R1) + C_QLAT), (const char*)WSP(bf16, WS_WQ), (size_t)256 * NRAW * 2, (size_t)256 * 384 * 2}; S.rep = (MK_REPU == 4) ? 2 : 1;
          if (MK_FUSE5) { EpiQ E{WSP(float, WS_SSQ), WSP(bf16, WS_QM), WSP(float, WS_SSQH), (const LAS float*)(F.lds + TMX_OFF), (const LAS float*)(F.lds + GQX_OFF)}; pg8::gemm_phase<EpiQ, SchedDense, true, false>(F.lds, 384 / 64, NRAW * 2, 384 * 2, S, E); }
          else if (MK_FUSE3) { EpiUp<8> E{WSP(bf16, WS_QUP), 768, WSP(float, WS_SSQ), 1.0f / 384.0f}; pg8::gemm_phase<EpiUp<8>, SchedDense, true, false>(F.lds, 384 / 64, NRAW * 2, 384 * 2, S, E); }
          else { EpiStoreBf16 E{WSP(bf16, WS_QUP), 768, WSP(float, WS_RSQ), 1.0f}; pg8::gemm_phase<EpiStoreBf16, SchedDense, true, false>(F.lds, 384 / 64, NRAW * 2, 384 * 2, S, E); } }
    } SEAM(4);
    if (!MK_FUSE5) { if (IN(5)) { frame_load(F); p5_post_up(F); } SEAM(5); }
    if (IN(6)) { frame_load(F); p6_attention(F); if (MK_REP == 6) p6_attention(F); } SEAM(6);
    if (MK_MERGE78 && MK_F8MID) {
        if (IN(7)) { frame_load(F);
            SchedDense S{F.G, (int)blockIdx.x, MTOK / 256, 4, (const char*)WSP(unsigned char, WS_OA), (const char*)WSP(unsigned char, WS_WBA), (size_t)256 * 1024, (size_t)256 * 1024}; S.rep = (MK_REPU == 7) ? 2 : 1;
            EpiMerge E{WSP(bf16, WS_R1), WSP(unsigned char, WS_H2)};
            pg8::gemm_phase<EpiMerge, SchedDense, true, false, true>(F.lds, 8, 1024, 1024, S, E);
        } SEAM(8);
    } else {
    if (IN(7)) { frame_load(F);
        constexpr int ES = MK_F8MID ? 1 : 2;
        SchedDense S{F.G, (int)blockIdx.x, MTOK / 256, 4, (const char*)WSP(bf16, WS_OA), (const char*)WSP(bf16, WS_WBA), (size_t)256 * 512 * ES, (size_t)256 * 512 * ES}; S.rep = (MK_REPU == 7) ? 2 : 1;
        EpiBranch<false> E{WSP(bf16, WS_T), WSP(bf16, WS_R1) + C_GA, nullptr};
        pg8::gemm_phase<EpiBranch<false>, SchedDense, true, false, MK_F8MID != 0>(F.lds, 512 * ES / 128, 512 * ES, 512 * ES, S, E);
    }
    if (IN(8)) { frame_load(F);
        constexpr int ES = MK_F8MID ? 1 : 2;
        SchedDense S{F.G, (int)blockIdx.x, MTOK / 256, 4, (const char*)WSP(bf16, WS_OB), (const char*)WSP(bf16, WS_WBB), (size_t)256 * 512 * ES, (size_t)256 * 512 * ES}; S.rep = (MK_REPU == 7) ? 2 : 1;
        EpiBranch<true> E{WSP(bf16, WS_T), WSP(bf16, WS_R1) + C_GB, WSP(unsigned char, WS_H2)};
        pg8::gemm_phase<EpiBranch<true>, SchedDense, true, false, MK_F8MID != 0>(F.lds, 512 * ES / 128, 512 * ES, 512 * ES, S, E);
    } SEAM(8);
    }
    if (IN(9)) { frame_load(F);
        constexpr int ES = MK_F8MID ? 1 : 2;
        SchedDense S{F.G, (int)blockIdx.x, MTOK / 256, 4, (const char*)(MK_F8MID ? (void*)WSP(unsigned char, WS_H2) : (void*)WSP(bf16, WS_T)), (const char*)WSP(bf16, WS_WOUT), (size_t)256 * 1024 * ES, (size_t)256 * 1024 * ES}; S.rep = (MK_REPU == 9) ? 2 : 1;
        EpiOutRes E{F.x, F.out, WSP(float, WS_MOD)};
        pg8::gemm_phase<EpiOutRes, SchedDense, true, false, MK_F8MID != 0>(F.lds, 1024 * ES / 128, 1024 * ES, 1024 * ES, S, E);
    } SEAM(9);
#else
    if (IN(1)) { frame_load(F); p1_norm1(F);
        const int gw = F.vcu * NWAVES + F.wave, NGW = F.G * NWAVES;
        for (int row = gw; row < MTOK; row += NGW)
#pragma unroll
            for (int q = 0; q < 4; ++q) *(f32x4*)(F.out + (size_t)row * D + 4 * F.lane + 256 * q) = *(const f32x4*)(F.x + (size_t)row * D + 4 * F.lane + 256 * q);
    } SEAM(1);
#endif
#if MK_STAGE_A != 2
    if (IN(10)) { frame_load(F); p10_norm2_router(F); if (MK_REP == 10) p10_norm2_router(F); } SEAM(10);
    if (IN(11)) { frame_load(F); p11_slots(F); } SEAM(11);
    if (IN(12)) { frame_load(F);
        if (!IN(11)) moe_tables(F);
        const MoeTab t = moe_tab(F);
        constexpr int ES = MK_F8 ? 1 : 2;
        SchedMoe S{F.G, (int)blockIdx.x, t.R[0], 8, (const char*)WSP(bf16, WS_H2), (const char*)WSP(bf16, WS_WGU), 0, (size_t)2048 * 1024 * ES, (size_t)256 * 1024 * ES, t.texp, WSP(int, WS_SLOTTOK)}; S.rep = (MK_REPU == 12) ? 2 : 1;
        EpiSwiglu E{WSP(unsigned char, WS_R1), F.b_gate_up};
        pg8::gemm_phase<EpiSwiglu, SchedMoe, true, true, MK_F8 != 0>(F.lds, 1024 * ES / 128, 1024 * ES, 1024 * ES, S, E);
    } SEAM(12);
    if (IN(13)) { frame_load(F);
        if (!IN(11)) moe_tables(F);
        const MoeTab t = moe_tab(F);
        constexpr int ES = MK_F8 ? 1 : 2;
        SchedMoe S{F.G, (int)blockIdx.x, t.R[0], 4, (const char*)WSP(bf16, WS_R1), (const char*)WSP(bf16, WS_WDN), (size_t)256 * 1024 * ES, (size_t)1024 * 1024 * ES, (size_t)256 * 1024 * ES, t.texp, nullptr}; S.rep = (MK_REPU == 13) ? 2 : 1;
        EpiDown E{WSP(unsigned char, WS_R2), F.b_down, WSP(float, WS_SLOTW)};
        pg8::gemm_phase<EpiDown, SchedMoe, true, false, MK_F8 != 0>(F.lds, 1024 * ES / 128, 1024 * ES, 1024 * ES, S, E);
    } SEAM(13);
    if (IN(14)) { frame_load(F); p14_combine(F); }
#endif
#undef IN
#undef SEAM
}

extern "C" void kernel_launch(void* const* d_in, const int* in_sizes, int n_in, void* d_out, int out_size, void* d_ws, size_t ws_size, hipStream_t stream) {
    static int grid = 0;
    if (grid == 0) {
        if (n_in != 27 || in_sizes[0] != MTOK * D || out_size != MTOK * D || ws_size < WS_END) { fprintf(stderr, "kernel_launch: unexpected shapes (n_in %d, in0 %d, out %d, ws %zu < %zu); nothing launched\n", n_in, n_in > 0 ? in_sizes[0] : -1, out_size, ws_size, (size_t)WS_END); grid = -1; return; }
        int dev = 0, cus = 0, per_cu = 0;
        if (hipGetDevice(&dev) != hipSuccess || hipDeviceGetAttribute(&cus, hipDeviceAttributeMultiprocessorCount, dev) != hipSuccess) { grid = -1; return; }
        if (hipFuncSetAttribute((const void*)mk_fwd, hipFuncAttributeMaxDynamicSharedMemorySize, LDS_BYTES) != hipSuccess) { fprintf(stderr, "kernel_launch: hipFuncSetAttribute failed\n"); grid = -1; return; }
        if (hipOccupancyMaxActiveBlocksPerMultiprocessor(&per_cu, (const void*)mk_fwd, NWAVES * 64, LDS_BYTES) != hipSuccess || per_cu < 1) fprintf(stderr, "kernel_launch: occupancy query says %d\n", per_cu);
        (void)hipGetLastError();
        grid = cus;
        if (grid != 256) fprintf(stderr, "kernel_launch: %d CUs; the thin phases assume 256 workgroups\n", grid);
    }
    if (grid < 0) return;
    if (hipMemsetAsync((char*)d_ws + WS_CTL, 0, CTL_ZERO_BYTES, stream) != hipSuccess) return;
    Args a{};
    for (int i = 0; i < 27; ++i) a.in[i] = (const float*)d_in[i];
    a.out = (float*)d_out; a.ws = (unsigned char*)d_ws;
    if (MK_N_LAUNCHES == 1) { a.ph_lo = 0; a.ph_hi = NPHASE; hipLaunchKernelGGL(mk_fwd, dim3(grid), dim3(NWAVES * 64), LDS_BYTES, stream, a); }
    else for (int p = 0; p < NPHASE; ++p) { a.ph_lo = p; a.ph_hi = p + 1; hipLaunchKernelGGL(mk_fwd, dim3(grid), dim3(NWAVES * 64), LDS_BYTES, stream, a); }
}
```

```cpp
#include <hip/hip_runtime.h>
#include <cstdio>
#include <cstdint>

#ifndef MK_N_LAUNCHES
#define MK_N_LAUNCHES 1
#endif
#ifndef MK_F8
#define MK_F8 1
#endif
#ifndef MK_WIDE
#define MK_WIDE 0
#endif
#ifndef MK_MERGE78
#define MK_MERGE78 1
#endif
#ifndef MK_ATT2T
#define MK_ATT2T 1
#endif
#ifndef MK_ATT8
#define MK_ATT8 1
#endif
#ifndef MK_FUSE5
#define MK_FUSE5 1
#endif
#ifndef MK_FUSE3
#define MK_FUSE3 1
#endif
#ifndef MK_F8MID
#define MK_F8MID 1
#endif
#ifndef MK_F8Y
#define MK_F8Y 1
#endif
#ifndef MK_F8IN
#define MK_F8IN 1
#endif
#ifndef MK_XOVL
#define MK_XOVL 1
#endif
#ifndef MK_EPIX
#define MK_EPIX 2
#endif
#ifndef MK_MIDR
#define MK_MIDR 4
#endif
#ifndef MK_P1R
#define MK_P1R 2
#endif
#ifndef MK_P10R
#define MK_P10R 2
#endif
#ifndef MK_SWA2H
#define MK_SWA2H 1
#endif
#ifndef MK_XPOS5
#define MK_XPOS5 4
#endif
#ifndef MK_SIGPRE
#define MK_SIGPRE 1
#endif
#ifndef MK_NTOUT
#define MK_NTOUT 1
#endif
#ifndef MK_GATEPAIR
#define MK_GATEPAIR 1
#endif
#ifndef MK_XPIPE
#define MK_XPIPE 1
#endif
#ifndef MK_XNB
#define MK_XNB 32
#endif
#ifndef MK_REPU
#define MK_REPU -1
#endif
#ifndef MK_REP
#define MK_REP -1
#endif
#ifndef MK_STAGE_A
#define MK_STAGE_A 0
#endif

#define GAS __attribute__((address_space(1)))
#define LAS __attribute__((address_space(3)))
typedef unsigned short bf16;
typedef short bf16x8 __attribute__((ext_vector_type(8)));
typedef short s16x4 __attribute__((ext_vector_type(4)));
typedef float f32x2 __attribute__((ext_vector_type(2)));
typedef float f32x4 __attribute__((ext_vector_type(4)));
typedef float f32x16 __attribute__((ext_vector_type(16)));
typedef unsigned u32x2 __attribute__((ext_vector_type(2)));
typedef unsigned u32x4 __attribute__((ext_vector_type(4)));
typedef GAS unsigned gu32;

#define RLX_AGENT __ATOMIC_RELAXED, __HIP_MEMORY_SCOPE_AGENT
#define LDS_WAIT() asm volatile("s_waitcnt lgkmcnt(0)" ::: "memory")
#define VM_WAIT() asm volatile("s_waitcnt vmcnt(0)" ::: "memory")

constexpr int D = 1024, NB = 8, SEQ = 4096, CTX = 256, KEYS = SEQ + CTX;
constexpr int MTOK = NB * SEQ, MCTX = NB * CTX, MALL = MTOK + MCTX;
constexpr int NMOD = 6 * D;
constexpr int IN_COLS = 3488, NRAW = 3584;
constexpr int C_KVLAT = 0, C_KSWA = 256, C_VSWA = 384, C_QLAT = 512, C_KROPE = 896, C_QSWA = 1024, C_GA = 1536, C_GB = 2560;
constexpr int NE = 32, TOPK = 4, NASSIGN = MTOK * TOPK;
constexpr int MAXTILES = NASSIGN / 256 + NE, NSLOT = MAXTILES * 256;
constexpr float EPS = 1e-6f, LOG2E = 1.4426950408889634f;
constexpr float QSCALE_S = 0.125f * LOG2E;
constexpr float QSCALE_M = 0.10206207261596577f * LOG2E;

constexpr size_t MiB = 1u << 20;
constexpr size_t WS_CTL = 0, CTL_ZERO_BYTES = 64 * 1024;
constexpr size_t WS_MODP = 1 * MiB;
constexpr size_t WS_MOD = 3 * MiB;
constexpr size_t WS_TRIG = WS_MOD + 256 * 1024;
constexpr size_t WS_RSKV = WS_TRIG + 64 * 1024;
constexpr size_t WS_RSQ = WS_RSKV + 256 * 1024;
constexpr size_t WS_TOPI = 4 * MiB;
constexpr size_t WS_TOPW = WS_TOPI + 512 * 1024;
constexpr size_t WS_TOKSLOT = WS_TOPW + 512 * 1024;
constexpr size_t WS_BCNT = WS_TOKSLOT + 512 * 1024;
constexpr size_t WS_SLOTTOK = 6 * MiB;
constexpr size_t WS_SLOTW = 7 * MiB;
constexpr size_t WS_W = 9 * MiB;
constexpr size_t WS_WIN = WS_W;
constexpr size_t WS_WKV = WS_WIN + (size_t)NRAW * D * 2;
constexpr size_t WS_WQ = WS_WKV + 1024 * 256 * 2;
constexpr size_t WS_WBA = WS_WQ + 1024 * 384 * 2;
constexpr size_t WS_WBB = WS_WBA + 1024 * 512 * 2;
constexpr size_t WS_WOUT = WS_WBB + 1024 * 512 * 2;
constexpr size_t WS_WGU = WS_WOUT + 1024 * 1024 * 2;
constexpr size_t WS_WDN = WS_WGU + (size_t)NE * 2048 * 1024 * 2;
constexpr size_t WS_WEND = WS_WDN + (size_t)NE * 1024 * 1024 * 2;
constexpr size_t WS_R1 = 214 * MiB;
constexpr size_t WS_R2 = 486 * MiB;
constexpr size_t WS_H = WS_R2, WS_KVUP = WS_R2 + 68 * MiB, WS_QUP = WS_R2 + 136 * MiB;
constexpr size_t WS_R3 = 670 * MiB;
constexpr size_t WS_QM = WS_R3, WS_KM = WS_R3 + 48 * MiB, WS_VM = WS_R3 + 99 * MiB, WS_QS = WS_R3 + 133 * MiB, WS_KS = WS_R3 + 165 * MiB, WS_VS = WS_R3 + 174 * MiB;
constexpr size_t WS_T = WS_R3, WS_H2 = WS_R3 + 64 * MiB;
constexpr size_t WS_R4 = 853 * MiB;
constexpr size_t WS_OA = WS_R4, WS_OB = WS_R4 + 32 * MiB;
constexpr size_t WS_SSQ = 918 * MiB;
constexpr size_t WS_SSKV = 920 * MiB;
constexpr size_t WS_SSQH = 922 * MiB;
constexpr size_t WS_END = 925 * MiB;
static_assert(WS_WEND <= WS_R1, "weights fit");
static_assert(WS_R1 + (size_t)NSLOT * 1024 * 2 <= WS_R2 && WS_R1 + (size_t)MALL * NRAW * 2 <= WS_R2, "R1");
static_assert(WS_QUP + (size_t)MTOK * 768 * 2 <= WS_R3, "R2");
static_assert(WS_KM + (size_t)NB * KEYS * 768 * 2 <= WS_VM && WS_VM + (size_t)MALL * 512 * 2 <= WS_QS && WS_QS + (size_t)MTOK * 512 * 2 <= WS_KS && WS_KS + (size_t)MALL * 128 * 2 <= WS_VS && WS_VS + (size_t)MALL * 128 * 2 <= WS_R4, "R3");
static_assert(WS_R2 + (size_t)NSLOT * 1024 * 2 <= WS_R4, "Y");
static_assert(WS_RSKV + (size_t)MALL * 4 <= WS_RSQ && WS_RSQ + (size_t)MTOK * 4 <= WS_TOPI && WS_BCNT + 256 * 32 * 4 <= WS_SLOTTOK && WS_SLOTTOK + (size_t)NSLOT * 4 <= WS_SLOTW && WS_SLOTW + (size_t)NSLOT * 4 <= WS_W, "misc");
static_assert(WS_MODP + 8 * 9 * NMOD * 4 <= WS_MOD && WS_MOD + 9 * NMOD * 4 <= WS_TRIG, "mod");
constexpr int CW_BAR = 4096;

constexpr int RING_BYTES = 131072;
constexpr int LDSCTL_OFF = RING_BYTES + 2048;
constexpr int MISC_OFF = LDSCTL_OFF;
constexpr int MOE_OFF = LDSCTL_OFF + 256;
constexpr int P10X_OFF = LDSCTL_OFF + 4096;
constexpr int TSX_OFF = P10X_OFF;
constexpr int TMX_OFF = P10X_OFF + 3072, GKX_OFF = TMX_OFF + 4096, GQX_OFF = GKX_OFF + 384;
constexpr int LDS_BYTES = 147456;
constexpr int NWAVES = 8;

__device__ __forceinline__ unsigned f2bf(float f) { unsigned u = __builtin_bit_cast(unsigned, f); return (u + 0x7fffu + ((u >> 16) & 1u)) >> 16; }
__device__ __forceinline__ unsigned pk2(float lo, float hi) { return f2bf(lo) | (f2bf(hi) << 16); }
__device__ __forceinline__ float bf2f(unsigned b) { return __builtin_bit_cast(float, b << 16); }
__device__ __forceinline__ float bflo(unsigned w) { return __builtin_bit_cast(float, w << 16); }
__device__ __forceinline__ float bfhi(unsigned w) { return __builtin_bit_cast(float, w & 0xffff0000u); }
typedef __bf16 bf16x2_t __attribute__((ext_vector_type(2)));
__device__ __forceinline__ unsigned cvt_pk_bf16(float lo, float hi) { const f32x2 v = {lo, hi}; const bf16x2_t b = __builtin_convertvector(v, bf16x2_t); return __builtin_bit_cast(unsigned, b); }
constexpr float F8_SW = 64.0f, F8_SA = 4.0f, F8_INV = 1.0f / (F8_SW * F8_SA), F8_SY = 32.0f, F8_SO = 64.0f, F8_INVM = 1.0f / (F8_SO * F8_SW);
__device__ __forceinline__ float f8clamp(float v) { return __builtin_amdgcn_fmed3f(v, -448.0f, 448.0f); }
__device__ __forceinline__ unsigned pk4_fp8(float a, float b, float c, float d) { int w = __builtin_amdgcn_cvt_pk_fp8_f32(f8clamp(a), f8clamp(b), 0, false); w = __builtin_amdgcn_cvt_pk_fp8_f32(f8clamp(c), f8clamp(d), w, true); return (unsigned)w; }
template <int CTRL> __device__ __forceinline__ float dpp_f(float v) { return __builtin_bit_cast(float, __builtin_amdgcn_update_dpp(0, __builtin_bit_cast(int, v), CTRL, 0xf, 0xf, false)); }
template <int CTRL> __device__ __forceinline__ int dpp_i(int v) { return __builtin_amdgcn_update_dpp(0, v, CTRL, 0xf, 0xf, false); }
__device__ __forceinline__ float wave_sum(float v) {
    v += dpp_f<0xB1>(v); v += dpp_f<0x4E>(v); v += dpp_f<0x141>(v); v += dpp_f<0x140>(v);
    const float r0 = __builtin_bit_cast(float, __builtin_amdgcn_readlane(__builtin_bit_cast(int, v), 0)), r1 = __builtin_bit_cast(float, __builtin_amdgcn_readlane(__builtin_bit_cast(int, v), 16));
    const float r2 = __builtin_bit_cast(float, __builtin_amdgcn_readlane(__builtin_bit_cast(int, v), 32)), r3 = __builtin_bit_cast(float, __builtin_amdgcn_readlane(__builtin_bit_cast(int, v), 48));
    return (r0 + r1) + (r2 + r3);
}
__device__ __forceinline__ float sigmoidf_(float x) { return __builtin_amdgcn_rcpf(1.0f + __builtin_amdgcn_exp2f(-x * LOG2E)); }

__device__ __forceinline__ void asm_load16(f32x4& dst, const float* p) { asm volatile("global_load_dwordx4 %0, %1, off" : "=v"(dst) : "v"(p) : "memory"); }
namespace pg8 {
constexpr int BM = 256, BK = 64, HALF = 128, HTB = HALF * BK * 2, STAGE_BYTES = 8 * HTB, NXCD = 8, WGM = 8;
__host__ __device__ __forceinline__ int lds_byte(int r, int c) { const int st = (r >> 4) * 2 + (c >> 5), rr = r & 15, cc = c & 31, ob = rr * 64 + cc * 2; return st * 1024 + (ob ^ (((ob >> 9) & 1) << 5)); }
__host__ __device__ __forceinline__ void stage_rc(int b, int& R, int& C) { const int st = b / 1024, sb = b % 1024, swz = sb ^ (((sb >> 9) & 1) << 5); R = (st >> 1) * 16 + swz / 64; C = (st & 1) * 32 + (swz % 64) / 2; }
__host__ __device__ __forceinline__ int perm32(int rho) { const int n = rho >> 4, i = rho & 15; return 8 * (i >> 2) + 4 * n + (i & 3); }

struct Unit { int pm, pn, ex; };

__device__ __forceinline__ void tile_map(int L, int nM, int nN, int& pm, int& pn) {
    const int nwg = nM * nN; int wgid = L;
    { const int q = nwg / NXCD, r = nwg % NXCD, xcd = wgid % NXCD, off = wgid / NXCD; wgid = (xcd < r ? xcd * (q + 1) : r * (q + 1) + (xcd - r) * q) + off; }
    const int nig = WGM * nN, gid = wgid / nig, fm = gid * WGM, gsz = (nM - fm) < WGM ? (nM - fm) : WGM;
    pm = fm + ((wgid % nig) % gsz); pn = (wgid % nig) / gsz;
}

typedef int i32x8 __attribute__((ext_vector_type(8)));
template <class E> struct epi_has_mid { template <class T> static constexpr bool test(decltype(T::MID)*) { return T::MID; } template <class T> static constexpr bool test(...) { return false; } static constexpr bool value = test<E>(nullptr); };
template <class E> struct epi_has_pre { template <class T> static constexpr bool test(decltype(T::PRE)*) { return T::PRE; } template <class T> static constexpr bool test(...) { return false; } static constexpr bool value = test<E>(nullptr); };
template <class Epi, class Sched, bool ALIGN_EPI, bool GATHER, bool F8 = false>
__device__ __forceinline__ void gemm_phase(LAS unsigned char* lds, const int nt, const unsigned lda_b, const unsigned ldb_b, const Sched& S, const Epi& E) {
    int tid = threadIdx.x; asm volatile("" : "+v"(tid));
    const int wid = __builtin_amdgcn_readfirstlane(tid >> 6), lane = tid & 63, wr = wid >> 2, wc = wid & 3, fr = lane & 15, fq = lane >> 4;
    unsigned voffA[2][2], voffB[2], voffAn[2][2]; int sR[2], sC[2];
#pragma unroll
    for (int i = 0; i < 2; ++i) { int R, C; stage_rc(tid * 16 + i * 8192, R, C); sR[i] = R; sC[i] = C; const int Rb = Epi::PERM ? ((R & ~31) + perm32(R & 31)) : R;
        voffB[i] = (unsigned)Rb * ldb_b + (unsigned)C * 2u; voffA[0][i] = (unsigned)R * lda_b + (unsigned)C * 2u; voffA[1][i] = voffA[0][i] + (unsigned)HALF * lda_b; voffAn[0][i] = voffA[0][i]; voffAn[1][i] = voffA[1][i]; }
    const size_t kstep = (size_t)(BK * 2);
    const size_t hstepB = (size_t)HALF * ldb_b;
    const unsigned ldsw = (unsigned)wid * 1024u;
    const int aoff = lds_byte(wr * 64 + fr, fq * 8), boff = lds_byte(wc * 32 + fr, fq * 8);
#define PG8_SA(b, h) (((b) * 2 + (h)) * HTB)
#define PG8_SB(b, h) ((4 + (b) * 2 + (h)) * HTB)
#define PG8_STAGE(bufoff, gbase, voff) do { _Pragma("unroll") for (int _i = 0; _i < 2; ++_i) \
        __builtin_amdgcn_global_load_lds((const unsigned*)((const char*)(gbase) + (voff)[_i]), (LAS unsigned*)(lds + (bufoff) + ldsw + _i * 8192), 16, 0, 0); } while (0)
#define PG8_LDA(dst, b, h) do { if constexpr (F8) { _Pragma("unroll") for (int m = 0; m < 4; ++m) { const u32x4 _lo = *(const LAS u32x4*)(lds + PG8_SA(b, h) + aoff + m * 2048), _hi = *(const LAS u32x4*)(lds + PG8_SA(b, h) + aoff + m * 2048 + 1024); \
        dst##8[m] = (i32x8){(int)_lo.x, (int)_lo.y, (int)_lo.z, (int)_lo.w, (int)_hi.x, (int)_hi.y, (int)_hi.z, (int)_hi.w}; } } else { \
        _Pragma("unroll") for (int m = 0; m < 4; ++m) _Pragma("unroll") for (int k = 0; k < 2; ++k) dst[m][k] = *(const LAS bf16x8*)(lds + PG8_SA(b, h) + aoff + m * 2048 + k * 1024); } } while (0)
#define PG8_LDB(dst, b, h) do { if constexpr (F8) { _Pragma("unroll") for (int n = 0; n < 2; ++n) { const u32x4 _lo = *(const LAS u32x4*)(lds + PG8_SB(b, h) + boff + n * 2048), _hi = *(const LAS u32x4*)(lds + PG8_SB(b, h) + boff + n * 2048 + 1024); \
        dst##8[n] = (i32x8){(int)_lo.x, (int)_lo.y, (int)_lo.z, (int)_lo.w, (int)_hi.x, (int)_hi.y, (int)_hi.z, (int)_hi.w}; } } else { \
        _Pragma("unroll") for (int n = 0; n < 2; ++n) _Pragma("unroll") for (int k = 0; k < 2; ++k) dst[n][k] = *(const LAS bf16x8*)(lds + PG8_SB(b, h) + boff + n * 2048 + k * 1024); } } while (0)
#define PG8_MMA(ai, bj, At, Bt) do { __builtin_amdgcn_s_setprio(1); if constexpr (F8) { _Pragma("unroll") for (int m = 0; m < 4; ++m) _Pragma("unroll") for (int n = 0; n < 2; ++n) \
        asm volatile("v_mfma_scale_f32_16x16x128_f8f6f4 %0, %1, %2, %0, %3, %3 op_sel_hi:[0,0,0]" : "+v"(acc[ai][bj][m][n]) : "v"(Bt##8[n]), "v"(At##8[m]), "v"(f8scale)); } else { \
        _Pragma("unroll") for (int m = 0; m < 4; ++m) _Pragma("unroll") for (int n = 0; n < 2; ++n) _Pragma("unroll") for (int k = 0; k < 2; ++k) \
        acc[ai][bj][m][n] = __builtin_amdgcn_mfma_f32_16x16x32_bf16(Bt[n][k], At[m][k], acc[ai][bj][m][n], 0, 0, 0); } __builtin_amdgcn_s_setprio(0); } while (0)
#define PG8_WAIT_V(n) asm volatile("s_waitcnt vmcnt(" #n ")" ::: "memory")
#define PG8_WAIT_L(n) asm volatile("s_waitcnt lgkmcnt(" #n ")" ::: "memory")
#define PG8_BAR __builtin_amdgcn_s_barrier()
#define PG8_SCHED __builtin_amdgcn_sched_barrier(0)
#define PG8_GATHER(dst, u) do { const int* _ix = S.a_rows(u); _Pragma("unroll") for (int _h = 0; _h < 2; ++_h) _Pragma("unroll") for (int _i = 0; _i < 2; ++_i) \
        dst[_h][_i] = (unsigned)_ix[_h * HALF + sR[_i]] * lda_b + (unsigned)sC[_i] * 2u; } while (0)
#define PG8_GATHER_ISSUE(u) do { const int* _ix = S.a_rows(u); _Pragma("unroll") for (int _h = 0; _h < 2; ++_h) _Pragma("unroll") for (int _i = 0; _i < 2; ++_i) \
        voffAn[_h][_i] = (unsigned)_ix[_h * HALF + sR[_i]]; } while (0)
    Unit cur, nxt; int ui = 0;
    if (!S.next(0, cur)) return;
    constexpr bool PRE = epi_has_pre<Epi>::value; f32x4 pre[4];
    if constexpr (PRE) E.pre(cur, wr, wc, fr, fq, pre);
    f32x4 acc[2][2][4][2];
#pragma unroll
    for (int a = 0; a < 2; ++a)
#pragma unroll
        for (int b = 0; b < 2; ++b)
#pragma unroll
            for (int m = 0; m < 4; ++m)
#pragma unroll
                for (int n = 0; n < 2; ++n) acc[a][b][m][n] = (f32x4){0.f, 0.f, 0.f, 0.f};
    bf16x8 At[4][2], B0[2][2], B1[2][2]; i32x8 At8[4], B08[2], B18[2]; const int f8scale = 0x7f7f7f7f;
    const char* cA = S.a_tile(cur); const char* cB = S.b_tile(cur);
    if constexpr (GATHER) { PG8_GATHER(voffA, cur); }
    PG8_STAGE(PG8_SB(0, 0), cB, voffB); PG8_STAGE(PG8_SB(0, 1), cB + hstepB, voffB); PG8_STAGE(PG8_SA(0, 0), cA, voffA[0]); PG8_STAGE(PG8_SA(0, 1), cA, voffA[1]);
    if (wr == 1) PG8_BAR;
    PG8_WAIT_V(2); PG8_BAR;
    PG8_STAGE(PG8_SB(1, 0), cB + kstep, voffB); PG8_STAGE(PG8_SA(1, 0), cA + kstep, voffA[0]); PG8_STAGE(PG8_SB(1, 1), cB + hstepB + kstep, voffB);
    PG8_WAIT_V(6); PG8_BAR;
    for (;;) {
        const bool has_next = S.next(ui + 1, nxt);
        const char* nA = has_next ? S.a_tile(nxt) : cA; const char* nB = has_next ? S.b_tile(nxt) : cB;
        if constexpr (GATHER) { if (has_next) { PG8_GATHER_ISSUE(nxt); } }
        constexpr bool MIDH = epi_has_mid<Epi>::value;
#pragma nounroll
        for (int kh = 0; kh < (MIDH ? 2 : 1); ++kh) {
        if constexpr (MIDH) { if (kh == 1) E.mid(acc, cur, wr, wc, fr, fq); }
        const int t_lo = MIDH ? kh * (nt >> 1) : 0, t_hi = MIDH ? (kh + 1) * (nt >> 1) : nt;
#pragma nounroll
        for (int t = t_lo; t < t_hi; t += 2) {
            const bool last = (t == nt - 2);
            const char* a1 = cA + (size_t)(t + 1) * kstep;
            const char* a2 = last ? nA : cA + (size_t)(t + 2) * kstep; const char* b2 = last ? nB : cB + (size_t)(t + 2) * kstep;
            const char* a3 = a2 + kstep; const char* b3 = b2 + kstep;
            unsigned v2[2][2];
#pragma unroll
            for (int h = 0; h < 2; ++h)
#pragma unroll
                for (int i = 0; i < 2; ++i) v2[h][i] = voffA[h][i];
            if constexpr (GATHER) { if (last && has_next) {
#pragma unroll
                for (int h = 0; h < 2; ++h)
#pragma unroll
                    for (int i = 0; i < 2; ++i) { voffAn[h][i] = voffAn[h][i] * lda_b + (unsigned)sC[i] * 2u; v2[h][i] = voffAn[h][i]; } } }
            PG8_LDB(B0, 0, 0); PG8_LDB(B1, 0, 1); PG8_SCHED; PG8_LDA(At, 0, 0); PG8_STAGE(PG8_SA(1, 1), a1, voffA[1]);
            PG8_WAIT_V(8); PG8_WAIT_L(0); PG8_BAR; PG8_MMA(0, 0, At, B0); PG8_MMA(0, 1, At, B1); PG8_BAR; PG8_SCHED;
            PG8_LDA(At, 0, 1); PG8_STAGE(PG8_SB(0, 0), b2, voffB); PG8_STAGE(PG8_SB(0, 1), b2 + hstepB, voffB); PG8_STAGE(PG8_SA(0, 0), a2, v2[0]);
            PG8_WAIT_V(8); PG8_WAIT_L(0); PG8_BAR; PG8_MMA(1, 0, At, B0); PG8_MMA(1, 1, At, B1); PG8_BAR; PG8_SCHED;
            PG8_LDB(B0, 1, 0); PG8_LDB(B1, 1, 1); PG8_SCHED; PG8_LDA(At, 1, 0); PG8_STAGE(PG8_SA(0, 1), a2, v2[1]);
            PG8_WAIT_V(8); PG8_WAIT_L(0); PG8_BAR; PG8_MMA(0, 0, At, B0); PG8_MMA(0, 1, At, B1); PG8_BAR; PG8_SCHED;
            PG8_LDA(At, 1, 1); PG8_STAGE(PG8_SB(1, 0), b3, voffB); PG8_STAGE(PG8_SB(1, 1), b3 + hstepB, voffB); PG8_STAGE(PG8_SA(1, 0), a3, v2[0]);
            PG8_WAIT_V(8); PG8_WAIT_L(0); PG8_BAR; PG8_MMA(1, 0, At, B0); PG8_MMA(1, 1, At, B1); PG8_BAR; PG8_SCHED;
        }
        }
        if constexpr (ALIGN_EPI) { if (wr == 0) PG8_BAR; }
        if constexpr (F8) asm volatile("s_nop 15\n\ts_nop 15" ::: "memory");
        if constexpr (PRE) { asm volatile("s_waitcnt vmcnt(16)" ::: "memory"); E(acc, cur, wr, wc, fr, fq, pre); } else E(acc, cur, wr, wc, fr, fq);
        if (!has_next) break;
#pragma unroll
        for (int a = 0; a < 2; ++a)
#pragma unroll
            for (int b = 0; b < 2; ++b)
#pragma unroll
                for (int m = 0; m < 4; ++m)
#pragma unroll
                    for (int n = 0; n < 2; ++n) acc[a][b][m][n] = (f32x4){0.f, 0.f, 0.f, 0.f};
        cur = nxt; cA = nA; cB = nB; ++ui;
        if constexpr (PRE) E.pre(cur, wr, wc, fr, fq, pre);
        if constexpr (GATHER) {
#pragma unroll
            for (int h = 0; h < 2; ++h)
#pragma unroll
                for (int i = 0; i < 2; ++i) voffA[h][i] = voffAn[h][i]; }
        if constexpr (ALIGN_EPI) { if (wr == 1) PG8_BAR; }
    }
    PG8_WAIT_V(0);
    if constexpr (!ALIGN_EPI) { if (wr == 0) PG8_BAR; }
    PG8_BAR;
#undef PG8_SA
#undef PG8_SB
#undef PG8_STAGE
#undef PG8_LDA
#undef PG8_LDB
#undef PG8_MMA
#undef PG8_WAIT_V
#undef PG8_WAIT_L
#undef PG8_BAR
#undef PG8_SCHED
#undef PG8_GATHER
}
}

#define XB_TMO      128
#define XB_XCNT(j)  (256  + 64 * (j))
#define XB_XSUB(j)  (1280 + 64 * (j))
#define XB_XGEN(j)  (2304 + 64 * (j))
#define XB_TOP      3328
#define XB_TOPGEN   3392
#define XCD_BAR_WORDS 3456
#define XB_SPIN_CAP (1u << 18)
__device__ __forceinline__ unsigned xb_ld(unsigned* p)              { return __hip_atomic_load(p, __ATOMIC_RELAXED, __HIP_MEMORY_SCOPE_AGENT); }
__device__ __forceinline__ unsigned xb_add(unsigned* p, unsigned v) { return __hip_atomic_fetch_add(p, v, __ATOMIC_RELAXED, __HIP_MEMORY_SCOPE_AGENT); }
__device__ __forceinline__ unsigned xb_xcc_id() { return (unsigned)__builtin_amdgcn_s_getreg((3 << 11) | 20) & 0xFu; }
#define XB_SPIN(cond, bar) do { unsigned _sp = 0; while (cond) { __builtin_amdgcn_s_sleep(1); \
    if ((++_sp & 255u) == 0u) { if (xb_ld(&(bar)[XB_TMO])) break; if (_sp > XB_SPIN_CAP) { atomicAdd(&(bar)[XB_TMO], 1u); break; } } } } while (0)
struct XcdBarrier { unsigned* bar; unsigned x; volatile LAS unsigned* st; };
__device__ __forceinline__ XcdBarrier xcd_barrier_post(unsigned* bar, volatile LAS unsigned* st) {
    XcdBarrier b; b.bar = bar; b.x = xb_xcc_id(); b.st = st;
    if (threadIdx.x == 0) (void)xb_add(&bar[XB_XCNT(b.x)], 1u);
    return b;
}
__device__ __forceinline__ void xcd_barrier_complete(unsigned* bar, unsigned x, unsigned& nloc, unsigned& nx) {
    const unsigned G = gridDim.x * gridDim.y * gridDim.z;
    unsigned sum, cnt, mine, sp = 0u;
    for (;;) {
        sum = 0u; cnt = 0u; mine = 0u;
#pragma unroll
        for (unsigned j = 0; j < 16; ++j) { const unsigned c = xb_ld(&bar[XB_XCNT(j)]); sum += c; cnt += (c > 0u) ? 1u : 0u; mine = (j == x) ? c : mine; }
        if (sum == G) break;
        __builtin_amdgcn_s_sleep(1);
        if ((++sp & 255u) == 0u) { if (xb_ld(&bar[XB_TMO])) break; if (sp > XB_SPIN_CAP) { atomicAdd(&bar[XB_TMO], 1u); break; } }
    }
    nloc = mine > 0u ? mine : 1u; nx = cnt > 0u ? cnt : 1u;
}
__device__ __forceinline__ void xcd_barrier(const XcdBarrier& b) {
    asm volatile("s_waitcnt vmcnt(0)" ::: "memory");
    __syncthreads();
    if (threadIdx.x == 0) {
        unsigned* bar = b.bar;
        __builtin_amdgcn_s_waitcnt(0);
        unsigned nloc = b.st[0], nx = b.st[1];
        if (nloc == 0u) { xcd_barrier_complete(bar, b.x, nloc, nx); b.st[0] = nloc; b.st[1] = nx; }
        const unsigned old = xb_add(&bar[XB_XSUB(b.x)], 1u);
        const unsigned gen = old / nloc;
        if (old + 1u == (gen + 1u) * nloc) {
            __builtin_amdgcn_fence(__ATOMIC_RELEASE, "agent");
            asm volatile("s_waitcnt vmcnt(0)" ::: "memory");
            const unsigned og = xb_add(&bar[XB_TOP], 1u);
            const unsigned tg = og / nx;
            if (og + 1u == (tg + 1u) * nx) xb_add(&bar[XB_TOPGEN], 1u);
            else XB_SPIN(xb_ld(&bar[XB_TOPGEN]) == tg, bar);
            __builtin_amdgcn_fence(__ATOMIC_ACQUIRE, "agent");
            xb_add(&bar[XB_XGEN(b.x)], 1u);
            asm volatile("s_waitcnt vmcnt(0)" ::: "memory");
        } else {
            XB_SPIN(xb_ld(&bar[XB_XGEN(b.x)]) == gen, bar);
            __builtin_amdgcn_fence(__ATOMIC_ACQUIRE, "agent");
            asm volatile("s_waitcnt vmcnt(0)" ::: "memory");
        }
    }
    __syncthreads();
}

struct Frame {
    LAS unsigned char* lds;
    volatile LAS unsigned* MISC;
    gu32* ctl;
    int tid, lane, wave, vcu, G;
    unsigned char* ws;
    const float *x, *c, *ctx, *c_ctx, *w_ada, *b_ada, *norm1_g, *norm2_g, *w_in, *mla_q_a_g, *mla_kv_a_g, *w_q_up, *w_kv_up, *mla_q_g, *mla_k_g, *swa_q_g, *swa_k_g, *swa_sink,
        *w_branch_a, *w_branch_b, *w_out, *w_router, *b_router, *w_gate_up, *b_gate_up, *w_down, *b_down;
    float* out;
};
#define WSP(T, off) ((T*)(F.ws + (off)))
#define CAS __attribute__((address_space(4)))
__device__ __forceinline__ void frame_load(Frame& F) {
    const CAS unsigned long long* a = (const CAS unsigned long long*)__builtin_amdgcn_kernarg_segment_ptr();
    asm volatile("" : "+s"(a));
    { int t = threadIdx.x; asm volatile("" : "+v"(t)); F.tid = t; F.lane = t & 63; }
    F.x = (const float*)a[0]; F.c = (const float*)a[1]; F.ctx = (const float*)a[2]; F.c_ctx = (const float*)a[3]; F.w_ada = (const float*)a[4]; F.b_ada = (const float*)a[5]; F.norm1_g = (const float*)a[6];
    F.norm2_g = (const float*)a[7]; F.w_in = (const float*)a[8]; F.mla_q_a_g = (const float*)a[9]; F.mla_kv_a_g = (const float*)a[10]; F.w_q_up = (const float*)a[11]; F.w_kv_up = (const float*)a[12];
    F.mla_q_g = (const float*)a[13]; F.mla_k_g = (const float*)a[14]; F.swa_q_g = (const float*)a[15]; F.swa_k_g = (const float*)a[16]; F.swa_sink = (const float*)a[17]; F.w_branch_a = (const float*)a[18];
    F.w_branch_b = (const float*)a[19]; F.w_out = (const float*)a[20]; F.w_router = (const float*)a[21]; F.b_router = (const float*)a[22]; F.w_gate_up = (const float*)a[23]; F.b_gate_up = (const float*)a[24];
    F.w_down = (const float*)a[25]; F.b_down = (const float*)a[26]; F.out = (float*)a[27]; F.ws = (unsigned char*)a[28];
}

__device__ __forceinline__ void tr_item(const float* W, int N, int k0, int sc0, int sstride, bf16* WT, int K, const float* gain, LAS float* scr, int lane, int rperm = 0) {
    { const GAS float* wp = (const GAS float*)W + (size_t)(k0 + (lane >> 5)) * N + sc0 + (lane & 31) * sstride; const GAS float* gp = (const GAS float*)gain + k0 + (lane >> 5);
#pragma nounroll
      for (int i0 = 0; i0 < 32; i0 += 16) { float tv[16], gv[16];
#pragma unroll
          for (int i = 0; i < 16; ++i) { tv[i] = wp[(size_t)(2 * (i0 + i)) * N]; gv[i] = gain ? gp[2 * (i0 + i)] : 1.0f; }
          asm volatile("" ::: "memory");
#pragma unroll
          for (int i = 0; i < 16; ++i) scr[(2 * (i0 + i) + (lane >> 5)) * 33 + (lane & 31)] = tv[i] * gv[i]; } }
    LDS_WAIT(); asm volatile("" ::: "memory");
    const int c = lane & 7;
#pragma unroll
    for (int j = 0; j < 4; ++j) { const int n = (lane >> 3) + 8 * j; const int nc = rperm == 1 ? (16 * ((n >> 2) & 1) + 4 * (n >> 3) + (n & 3)) : rperm == 2 ? (16 * ((n >> 2) & 1) + 8 * ((n >> 1) & 1) + 2 * (n >> 3) + (n & 1)) : n; const LAS float* s = scr + (8 * c) * 33 + nc;
        u32x4 o; o.x = pk2(s[0 * 33], s[1 * 33]); o.y = pk2(s[2 * 33], s[3 * 33]); o.z = pk2(s[4 * 33], s[5 * 33]); o.w = pk2(s[6 * 33], s[7 * 33]);
        *(u32x4*)(WT + (size_t)n * K + k0 + 8 * c) = o; }
    LDS_WAIT(); asm volatile("" ::: "memory");
}
template <bool RPERM = false, int NB = 16>
__device__ __forceinline__ void tr_item8(const float* W, int N, int k0, int sc0, int sstride, unsigned char* WT, int K, LAS float* scr, int lane) {
    const float* wp = W + (size_t)(k0 + (lane >> 5)) * N + sc0 + (lane & 31) * sstride;
#pragma nounroll
    for (int i0 = 0; i0 < 32; i0 += NB) { float tv[NB];
#pragma unroll
        for (int i = 0; i < NB; ++i) tv[i] = wp[(size_t)(2 * (i0 + i)) * N];
#pragma unroll
        for (int i = 0; i < NB; ++i) scr[(2 * (i0 + i) + (lane >> 5)) * 33 + (lane & 31)] = tv[i] * F8_SW; }
    LDS_WAIT(); asm volatile("" ::: "memory");
    const int c = lane & 3;
#pragma unroll
    for (int j = 0; j < 2; ++j) { const int n = (lane >> 2) + 16 * j; const int ncol = RPERM ? (16 * ((n >> 2) & 1) + 4 * (n >> 3) + (n & 3)) : n; const LAS float* s = scr + (16 * c) * 33 + ncol;
        u32x4 o; o.x = pk4_fp8(s[0 * 33], s[1 * 33], s[2 * 33], s[3 * 33]); o.y = pk4_fp8(s[4 * 33], s[5 * 33], s[6 * 33], s[7 * 33]);
        o.z = pk4_fp8(s[8 * 33], s[9 * 33], s[10 * 33], s[11 * 33]); o.w = pk4_fp8(s[12 * 33], s[13 * 33], s[14 * 33], s[15 * 33]);
        *(u32x4*)(WT + (size_t)n * K + k0 + 16 * c) = o; }
    LDS_WAIT(); asm volatile("" ::: "memory");
}
template <bool INTER>
__device__ __forceinline__ void tr_item8w(const float* W, int N, int k0, int sc0, unsigned char* WT, int K, LAS float* scr, int lane) {
    const float* wp = W + (size_t)(k0 + (lane >> 4)) * N + sc0 + (lane & 15) * 4;
    f32x4 tv[8];
#pragma unroll
    for (int i = 0; i < 8; ++i) tv[i] = *(const f32x4*)(wp + (size_t)(4 * i) * N);
#pragma unroll
    for (int i = 0; i < 8; ++i) { LAS float* sp = scr + (4 * i + (lane >> 4)) * 65 + (lane & 15) * 4; sp[0] = tv[i][0] * F8_SW; sp[1] = tv[i][1] * F8_SW; sp[2] = tv[i][2] * F8_SW; sp[3] = tv[i][3] * F8_SW; }
    LDS_WAIT(); asm volatile("" ::: "memory");
    const int col = INTER ? (2 * (lane & 31) + (lane >> 5)) : lane, drow = INTER ? ((lane & 31) + 128 * (lane >> 5)) : lane;
#pragma unroll
    for (int ch = 0; ch < 2; ++ch) { const LAS float* sr = scr + (16 * ch) * 65 + col;
        u32x4 o; o.x = pk4_fp8(sr[0 * 65], sr[1 * 65], sr[2 * 65], sr[3 * 65]); o.y = pk4_fp8(sr[4 * 65], sr[5 * 65], sr[6 * 65], sr[7 * 65]);
        o.z = pk4_fp8(sr[8 * 65], sr[9 * 65], sr[10 * 65], sr[11 * 65]); o.w = pk4_fp8(sr[12 * 65], sr[13 * 65], sr[14 * 65], sr[15 * 65]);
        *(u32x4*)(WT + (size_t)drow * K + k0 + 16 * ch) = o; }
    LDS_WAIT(); asm volatile("" ::: "memory");
}
__device__ __forceinline__ int win_src(int d) {
    if (MK_FUSE3) { if (d >= 256 && d < 512) { const int t = d - 256; return 288 + 64 * ((t >> 5) & 3) + 32 * (t >> 7); }
                    if (d >= 1024 && d < 1536) { const int t = d - 1024; return 928 + 64 * (4 * (t >> 8) + ((t >> 5) & 3)) + 32 * ((t >> 7) & 1); } }
    if (MK_GATEPAIR && d >= 1536) { const int t = (d - 1536) >> 8, x = (d - 1536) & 255; return x < 128 ? 1440 + 128 * t + x : 2464 + 128 * t + (x - 128); }
    if (d < 256) return d; if (d < 384) return d - 256 + 288; if (d < 512) return d - 384 + 416; if (d < 896) return d - 512 + 544;
    if (d < 928) return d - 896 + 256; if (d < 1024) return -1; if (d < 1536) return d - 1024 + 928; if (d < 2560) return d - 1536 + 1440; return d - 2560 + 2464;
}
__device__ __forceinline__ void p0_experts(Frame& F);
__device__ __forceinline__ void p0_prologue(Frame& F) {
    LAS float* scr = (LAS float*)(F.lds + F.wave * 16384);
    const int gw = F.vcu * NWAVES + F.wave, NGW = F.G * NWAVES;
    constexpr int I_ADA = 768, I_TRIG = 24, I_WIN = 16 * 112, I_WKV = 4 * 32, I_WQ = 6 * (MK_FUSE5 ? 32 : 24), I_WB = 8 * 32, I_WOUT = 16 * 32, I_WGU = NE * 16 * 64, I_WDN = NE * 16 * 32;
    constexpr int NITEMS = I_ADA + I_TRIG + I_WIN + I_WKV + I_WQ + 2 * I_WB + I_WOUT;
    for (int it = gw; it < NITEMS; it += NGW) {
        const int lane = F.lane;
        int r = it;
        if (r < I_ADA) {
            const int cg = r % 96, kc = r / 96, k0 = kc * 128, col = cg * 64 + lane;
            float cv18[18];
#pragma unroll
            for (int j = 0; j < 18; ++j) { const int idx = j * 64 + lane, rr = idx >> 7, kk = idx & 127; cv18[j] = (rr < 8) ? ((const GAS float*)F.c)[rr * D + k0 + kk] : ((const GAS float*)F.c_ctx)[k0 + kk]; }
            asm volatile("" ::: "memory");
#pragma unroll
            for (int j = 0; j < 18; ++j) { const float v = cv18[j]; scr[j * 64 + lane] = v / (1.0f + __expf(-v)); }
            LDS_WAIT(); asm volatile("" ::: "memory");
            float acc[9];
#pragma unroll
            for (int q = 0; q < 9; ++q) acc[q] = 0.f;
            { const GAS float* wp0 = (const GAS float*)F.w_ada + (size_t)k0 * NMOD + col; float wa[16], wb[16];
#define ADA_LD(dst, kk) do { _Pragma("unroll") for (int u = 0; u < 16; ++u) dst[u] = wp0[(size_t)((kk) + u) * NMOD]; asm volatile("" ::: "memory"); } while (0)
#define ADA_MM(src, kk) do { _Pragma("unroll") for (int u4 = 0; u4 < 4; ++u4) _Pragma("unroll") for (int q = 0; q < 9; ++q) { const f32x4 sv = *(const LAS f32x4*)(scr + q * 128 + (kk) + 4 * u4); \
                  acc[q] += sv[0] * src[4 * u4] + sv[1] * src[4 * u4 + 1] + sv[2] * src[4 * u4 + 2] + sv[3] * src[4 * u4 + 3]; } } while (0)
              ADA_LD(wa, 0);
#pragma unroll
              for (int kk0 = 0; kk0 < 128; kk0 += 32) { ADA_LD(wb, kk0 + 16); ADA_MM(wa, kk0); if (kk0 + 32 < 128) ADA_LD(wa, kk0 + 32); ADA_MM(wb, kk0 + 16); }
#undef ADA_LD
#undef ADA_MM
            }
            float* mp = WSP(float, WS_MODP);
#pragma unroll
            for (int q = 0; q < 9; ++q) mp[(size_t)(kc * 9 + q) * NMOD + col] = acc[q];
            LDS_WAIT(); asm volatile("" ::: "memory");
            continue;
        } r -= I_ADA;
        if (r < I_TRIG) {
            float* ts = WSP(float, WS_TRIG); const int i = r * 64 + lane;
            if (i < 1024) { const int pos = i >> 4, f = i & 15; const float fr = exp2f(-13.287712379549449f * (float)f / 16.0f), a = (float)pos * fr; ts[i] = __cosf(a); ts[1024 + i] = __sinf(a); }
            else { const int j = i - 1024, pos = j >> 3, f = j & 7; const float fr = exp2f(-13.287712379549449f * (float)f / 8.0f), a = (float)pos * fr; ts[2048 + j] = __cosf(a); ts[2560 + j] = __sinf(a); }
            continue;
        } r -= I_TRIG;
        if (r < I_WIN) { const int kb = r / 112, db = r % 112, d0 = db * 32, sc = win_src(d0);
            if (MK_F8IN) { unsigned char* wt = WSP(unsigned char, WS_WIN) + (size_t)d0 * D;
                const bool rp = MK_FUSE3 && ((d0 >= 256 && d0 < 512) || (d0 >= 1024 && d0 < 1536));
                if (sc >= 0) { if (rp) tr_item8<true>(F.w_in, IN_COLS, kb * 64, sc, 1, wt, D, scr, lane); else tr_item8<false>(F.w_in, IN_COLS, kb * 64, sc, 1, wt, D, scr, lane); }
                else { const int c = lane & 3;
#pragma unroll
                    for (int j = 0; j < 2; ++j) { const int n = (lane >> 2) + 16 * j; *(u32x4*)(wt + (size_t)n * D + kb * 64 + 16 * c) = (u32x4){0u, 0u, 0u, 0u}; } }
            } else { bf16* wt = WSP(bf16, WS_WIN) + (size_t)d0 * D;
                const bool rp = MK_FUSE3 && ((d0 >= 256 && d0 < 512) || (d0 >= 1024 && d0 < 1536));
                if (sc >= 0) tr_item(F.w_in, IN_COLS, kb * 64, sc, 1, wt, D, nullptr, scr, lane, rp ? 1 : 0);
                else { const int c = lane & 7;
#pragma unroll
                    for (int j = 0; j < 4; ++j) { const int n = (lane >> 3) + 8 * j; *(u32x4*)(wt + (size_t)n * D + kb * 64 + 8 * c) = (u32x4){0u, 0u, 0u, 0u}; } } }
            continue; } r -= I_WIN;
        if (r < I_WKV) { const int kb = r / 32, db = r % 32; int sc = db * 32;
            if (MK_FUSE5) { const int d0 = db * 32, pn = d0 >> 8, t = d0 & 255, bj = t >> 7, wc = (t >> 5) & 3; sc = 128 * (2 * pn + (wc >> 1)) + 64 * (wc & 1) + 32 * bj; }
            tr_item(F.w_kv_up, 1024, kb * 64, sc, 1, WSP(bf16, WS_WKV) + (size_t)db * 32 * 256, 256, F.mla_kv_a_g, scr, lane); continue; } r -= I_WKV;
        if (r < I_WQ) {
            if (MK_FUSE5) { const int kb = r / 32, db = r % 32, d0 = db * 32, pn = d0 >> 8, t = d0 & 255, bj = t >> 7, wc = (t >> 5) & 3, head = 2 * pn + (wc >> 1); bf16* wt = WSP(bf16, WS_WQ) + (size_t)d0 * 384;
                if ((wc & 1) == 0) tr_item(F.w_q_up, 768, kb * 64, 96 * head + 32 * bj, 1, wt, 384, F.mla_q_a_g, scr, lane);
                else if (bj == 0) tr_item(F.w_q_up, 768, kb * 64, 96 * head + 64, 1, wt, 384, F.mla_q_a_g, scr, lane, 2);
                else { const int c = lane & 7;
#pragma unroll
                    for (int j = 0; j < 4; ++j) { const int n = (lane >> 3) + 8 * j; *(u32x4*)(wt + (size_t)n * 384 + kb * 64 + 8 * c) = (u32x4){0u, 0u, 0u, 0u}; } }
            } else { const int kb = r / 24, db = r % 24; tr_item(F.w_q_up, 768, kb * 64, db * 32, 1, WSP(bf16, WS_WQ) + (size_t)db * 32 * 384, 384, F.mla_q_a_g, scr, lane); }
            continue; } r -= I_WQ;
        if (r < I_WB) { const int kb = r / 32, db = r % 32; if (MK_F8MID && MK_MERGE78) tr_item8(F.w_branch_a, 1024, kb * 64, db * 32, 1, WSP(unsigned char, WS_WBA) + (size_t)db * 32 * 1024, 1024, scr, lane);
            else if (MK_F8MID) tr_item8(F.w_branch_a, 1024, kb * 64, db * 32, 1, WSP(unsigned char, WS_WBA) + (size_t)db * 32 * 512, 512, scr, lane);
            else tr_item(F.w_branch_a, 1024, kb * 64, db * 32, 1, WSP(bf16, WS_WBA) + (size_t)db * 32 * 512, 512, nullptr, scr, lane); continue; } r -= I_WB;
        if (r < I_WB) { const int kb = r / 32, db = r % 32; if (MK_F8MID && MK_MERGE78) tr_item8(F.w_branch_b, 1024, kb * 64, db * 32, 1, WSP(unsigned char, WS_WBA) + (size_t)db * 32 * 1024 + 512, 1024, scr, lane);
            else if (MK_F8MID) tr_item8(F.w_branch_b, 1024, kb * 64, db * 32, 1, WSP(unsigned char, WS_WBB) + (size_t)db * 32 * 512, 512, scr, lane);
            else tr_item(F.w_branch_b, 1024, kb * 64, db * 32, 1, WSP(bf16, WS_WBB) + (size_t)db * 32 * 512, 512, nullptr, scr, lane); continue; } r -= I_WB;
        if (r < I_WOUT) { const int kb = r / 32, db = r % 32; if (MK_F8MID) tr_item8(F.w_out, 1024, kb * 64, db * 32, 1, WSP(unsigned char, WS_WOUT) + (size_t)db * 32 * 1024, 1024, scr, lane);
            else tr_item(F.w_out, 1024, kb * 64, db * 32, 1, WSP(bf16, WS_WOUT) + (size_t)db * 32 * 1024, 1024, nullptr, scr, lane); continue; } r -= I_WOUT;
    }
    if (!MK_XOVL) p0_experts(F);
}
struct XItem { const float* wp; size_t rstep; unsigned char* dst; };
__device__ __forceinline__ XItem x_item(Frame& F, int r, int lane) {
    constexpr int I_WGU = NE * 16 * 64; XItem I;
    if (r < I_WGU) { const int e = r / 1024, q = r % 1024, kb = q / 64, db = q % 64, d0 = db * 32, pn = d0 >> 8, bj = (d0 >> 7) & 1, x0 = d0 & 127;
        I.wp = F.w_gate_up + (size_t)e * 1024 * 2048 + (size_t)(kb * 64 + (lane >> 5)) * 2048 + 2 * (128 * pn + x0) + bj + (lane & 31) * 2; I.rstep = 2 * 2048;
        I.dst = WSP(unsigned char, WS_WGU) + ((size_t)e * 2048 + d0) * 1024 + kb * 64; }
    else { r -= I_WGU; const int e = r / 512, q = r % 512, kb = q / 32, db = q % 32;
        I.wp = F.w_down + (size_t)e * 1024 * 1024 + (size_t)(kb * 64 + (lane >> 5)) * 1024 + db * 32 + (lane & 31); I.rstep = 2 * 1024;
        I.dst = WSP(unsigned char, WS_WDN) + ((size_t)e * 1024 + db * 32) * 1024 + kb * 64; }
    return I;
}
__device__ __forceinline__ void x_load(const XItem& I, float (&tv)[32]) {
#pragma unroll
    for (int i = 0; i < 32; ++i) tv[i] = I.wp[(size_t)i * I.rstep];
}
__device__ __forceinline__ void x_finish(const XItem& I, float (&tv)[32], LAS float* scr, int lane) {
#pragma unroll
    for (int i = 0; i < 32; ++i) scr[(2 * i + (lane >> 5)) * 33 + (lane & 31)] = tv[i] * F8_SW;
    LDS_WAIT(); asm volatile("" ::: "memory");
    const int c = lane & 3;
#pragma unroll
    for (int j = 0; j < 2; ++j) { const int n = (lane >> 2) + 16 * j; const LAS float* s = scr + (16 * c) * 33 + n;
        u32x4 o; o.x = pk4_fp8(s[0 * 33], s[1 * 33], s[2 * 33], s[3 * 33]); o.y = pk4_fp8(s[4 * 33], s[5 * 33], s[6 * 33], s[7 * 33]);
        o.z = pk4_fp8(s[8 * 33], s[9 * 33], s[10 * 33], s[11 * 33]); o.w = pk4_fp8(s[12 * 33], s[13 * 33], s[14 * 33], s[15 * 33]);
        *(u32x4*)(I.dst + (size_t)n * 1024 + 16 * c) = o; }
    LDS_WAIT(); asm volatile("" ::: "memory");
}
__device__ __forceinline__ void p0_experts(Frame& F) {
    int lane0 = F.lane, wv = F.wave; asm volatile("" : "+v"(lane0), "+s"(wv));
    LAS float* scr = (LAS float*)(F.lds + wv * 16384);
    const int gw = F.vcu * NWAVES + wv, NGW = F.G * NWAVES;
    constexpr int I_WGU = NE * 16 * 64, I_WDN = NE * 16 * 32;
    if (MK_F8 && !MK_WIDE && MK_XPIPE) {
        const int lane = lane0; int it = gw; if (it >= I_WGU + I_WDN) return;
        float ta[32], tb[32]; XItem A = x_item(F, it, lane), B = A; x_load(A, ta);
#pragma nounroll
        for (;;) {
            const int itb = it + NGW; const bool hb = itb < I_WGU + I_WDN; if (hb) { B = x_item(F, itb, lane); x_load(B, tb); }
            x_finish(A, ta, scr, lane); if (!hb) break;
            it = itb + NGW; const bool ha = it < I_WGU + I_WDN; if (ha) { A = x_item(F, it, lane); x_load(A, ta); }
            x_finish(B, tb, scr, lane); if (!ha) break;
        }
        return;
    }
    for (int it = gw; it < I_WGU + I_WDN; it += NGW) {
        const int lane = lane0; int r = it;
        if (r < I_WGU) {
            if (MK_F8 && MK_WIDE) {
                const int e = r / 1024, q = r % 1024, kb = q / 32, cb = q % 32, j0 = 32 * cb, pn = j0 >> 7, x0 = j0 & 127;
                tr_item8w<true>(F.w_gate_up + (size_t)e * 1024 * 2048, 2048, kb * 32, 64 * cb, WSP(unsigned char, WS_WGU) + ((size_t)e * 2048 + 256 * pn + x0) * 1024, 1024, scr, lane);
            } else if (MK_F8) { const int e = r / 1024, q = r % 1024, kb = q / 64, db = q % 64, d0 = db * 32, pn = d0 >> 8, bj = (d0 >> 7) & 1, x0 = d0 & 127;
                tr_item8<false, MK_XNB>(F.w_gate_up + (size_t)e * 1024 * 2048, 2048, kb * 64, 2 * (128 * pn + x0) + bj, 2, WSP(unsigned char, WS_WGU) + ((size_t)e * 2048 + d0) * 1024, 1024, scr, lane);
            } else { const int e = r / 1024, q = r % 1024, kb = q / 64, db = q % 64, d0 = db * 32, pn = d0 >> 8, bj = (d0 >> 7) & 1, x0 = d0 & 127;
                tr_item(F.w_gate_up + (size_t)e * 1024 * 2048, 2048, kb * 64, 2 * (128 * pn + x0) + bj, 2, WSP(bf16, WS_WGU) + ((size_t)e * 2048 + d0) * 1024, 1024, nullptr, scr, lane); }
            continue; } r -= I_WGU;
        { if (MK_F8 && MK_WIDE) { const int e = r / 512, q = r % 512, kb = q / 16, cb = q % 16;
              tr_item8w<false>(F.w_down + (size_t)e * 1024 * 1024, 1024, kb * 32, 64 * cb, WSP(unsigned char, WS_WDN) + ((size_t)e * 1024 + 64 * cb) * 1024, 1024, scr, lane); }
          else if (MK_F8) { const int e = r / 512, q = r % 512, kb = q / 32, db = q % 32;
              tr_item8<false, MK_XNB>(F.w_down + (size_t)e * 1024 * 1024, 1024, kb * 64, db * 32, 1, WSP(unsigned char, WS_WDN) + ((size_t)e * 1024 + db * 32) * 1024, 1024, scr, lane); }
          else { const int e = r / 512, q = r % 512, kb = q / 32, db = q % 32;
              tr_item(F.w_down + (size_t)e * 1024 * 1024, 1024, kb * 64, db * 32, 1, WSP(bf16, WS_WDN) + ((size_t)e * 1024 + db * 32) * 1024, 1024, nullptr, scr, lane); } }
    }
}

__device__ __forceinline__ void p1_norm1(Frame& F) {
    LAS float* AS = (LAS float*)F.lds;
    LAS float* CS = AS + 2048;
    const int b = blockIdx.x, bb = b >> 5; const float* mp = WSP(float, WS_MODP);
    { const GAS float* gmp = (const GAS float*)mp; const GAS float* gba = (const GAS float*)F.b_ada; const GAS float* gg1 = (const GAS float*)F.norm1_g;
#pragma unroll
      for (int h = 0; h < 2; ++h) { float pv[4][9], gv[4];
#pragma unroll
          for (int u = 0; u < 4; ++u) { const int i = F.tid + 512 * (4 * h + u), which = i >> 11, isscale = (i >> 10) & 1, col = i & 1023, rr = which ? 8 : bb, mc = isscale * 1024 + col;
              pv[u][8] = gba[mc]; gv[u] = gg1[col];
#pragma unroll
              for (int kc = 0; kc < 8; ++kc) pv[u][kc] = gmp[(size_t)(kc * 9 + rr) * NMOD + mc]; }
          asm volatile("" ::: "memory");
#pragma unroll
          for (int u = 0; u < 4; ++u) { const int i = F.tid + 512 * (4 * h + u), which = i >> 11, isscale = (i >> 10) & 1, col = i & 1023; float sacc = pv[u][8];
#pragma unroll
              for (int kc = 0; kc < 8; ++kc) sacc += pv[u][kc];
              if (isscale) AS[which * 1024 + col] = gv[u] * (1.0f + sacc); else CS[which * 1024 + col] = sacc; } } }
    if (F.tid < 216) { const int rr = F.tid / 24, mc = 24 * b + F.tid % 24; float s = F.b_ada[mc];
#pragma unroll
        for (int kc = 0; kc < 8; ++kc) s += mp[(size_t)(kc * 9 + rr) * NMOD + mc];
        WSP(float, WS_MOD)[rr * NMOD + mc] = s; }
    __syncthreads();
    bf16* H = WSP(bf16, WS_H);
    const GAS float* gx = (const GAS float*)F.x; GAS unsigned char* gH = (GAS unsigned char*)H; const int lane = F.lane;
#define P1_ROW(v, row, a, c) do { float ss = 0.f; _Pragma("unroll") for (int q = 0; q < 4; ++q) ss += (v[q].x * v[q].x + v[q].y * v[q].y) + (v[q].z * v[q].z + v[q].w * v[q].w); \
        const float rstd = rsqrtf(wave_sum(ss) * (1.0f / D) + EPS); \
        _Pragma("unroll") for (int q = 0; q < 4; ++q) { const f32x4 av = *(const LAS f32x4*)((a) + 4 * lane + 256 * q), cv = *(const LAS f32x4*)((c) + 4 * lane + 256 * q); \
            const float h0 = v[q].x * rstd * av.x + cv.x, h1 = v[q].y * rstd * av.y + cv.y, h2v = v[q].z * rstd * av.z + cv.z, h3 = v[q].w * rstd * av.w + cv.w; \
            if (MK_F8IN) *(GAS unsigned*)(gH + (size_t)(row) * D + 4 * lane + 256 * q) = pk4_fp8(h0 * F8_SA, h1 * F8_SA, h2v * F8_SA, h3 * F8_SA); \
            else { u32x2 o; o.x = pk2(h0, h1); o.y = pk2(h2v, h3); *(GAS u32x2*)((GAS bf16*)gH + (size_t)(row) * D + 4 * lane + 256 * q) = o; } } } while (0)
    { f32x4 vc[4]; const GAS float* xr = (const GAS float*)F.ctx + (size_t)(8 * b + F.wave) * D;
#pragma unroll
      for (int q = 0; q < 4; ++q) vc[q] = *(const GAS f32x4*)(xr + 4 * lane + 256 * q);
      P1_ROW(vc, MTOK + 8 * b + F.wave, AS + 1024, CS + 1024); }
#pragma nounroll
    for (int j0 = 0; j0 < 16; j0 += MK_P1R) {
        f32x4 v[MK_P1R][4];
#pragma unroll
        for (int t = 0; t < MK_P1R; ++t) { const GAS float* xr = gx + (size_t)(128 * b + 16 * F.wave + j0 + t) * D;
#pragma unroll
            for (int q = 0; q < 4; ++q) v[t][q] = *(const GAS f32x4*)(xr + 4 * lane + 256 * q); }
        asm volatile("" ::: "memory");
#pragma unroll
        for (int t = 0; t < MK_P1R; ++t) P1_ROW(v[t], 128 * b + 16 * F.wave + j0 + t, AS, CS);
    }
#undef P1_ROW
}

struct SchedInProj {
    int G, c; const char* A; const char* Bt;
    __device__ __forceinline__ bool next(int i, pg8::Unit& u) const { int L = i * G + c; constexpr int NU = 24 + 128 * 14; if (MK_REPU == 2) { if (L >= 2 * NU) return false; L %= NU; } else if (L >= NU) return false;
        if (L < 24) { u.pm = 128 + L / 3; const int s = L % 3; u.pn = (s == 2) ? 3 : s; }
        else if (MK_FUSE3 && L < 24 + 128 * 3) { int pn; pg8::tile_map(L - 24, 128, 3, u.pm, pn); u.pn = pn == 0 ? 1 : 3 + pn; }
        else if (MK_FUSE3) { int pn; pg8::tile_map(L - 24 - 128 * 3, 128, 11, u.pm, pn); u.pn = pn == 0 ? 0 : pn < 3 ? pn + 1 : pn + 3; }
        else pg8::tile_map(L - 24, 128, 14, u.pm, u.pn);
        u.ex = 0; return true; }
    __device__ __forceinline__ const char* a_tile(const pg8::Unit& u) const { return A + (size_t)u.pm * 256 * (D * (MK_F8IN ? 1 : 2)); }
    __device__ __forceinline__ const char* b_tile(const pg8::Unit& u) const { return Bt + (size_t)u.pn * 256 * (D * (MK_F8IN ? 1 : 2)); }
    __device__ __forceinline__ const int* a_rows(const pg8::Unit&) const { return nullptr; }
};
struct SchedDense {
    int G, c, nM, nN; const char* A; const char* Bt; size_t a_tstep, b_tstep; int rep = 1;
    __device__ __forceinline__ bool next(int i, pg8::Unit& u) const { int L = i * G + c; if (L >= rep * nM * nN) return false; L %= nM * nN; pg8::tile_map(L, nM, nN, u.pm, u.pn); u.ex = 0; return true; }
    __device__ __forceinline__ const char* a_tile(const pg8::Unit& u) const { return A + (size_t)u.pm * a_tstep; }
    __device__ __forceinline__ const char* b_tile(const pg8::Unit& u) const { return Bt + (size_t)u.pn * b_tstep; }
    __device__ __forceinline__ const int* a_rows(const pg8::Unit&) const { return nullptr; }
};
struct SchedMoe {
    int G, c, R, nN; const char* A; const char* Bt; size_t a_tstep, b_estep, b_tstep; const LAS unsigned char* texp; const int* rows; int rep = 1;
    __device__ __forceinline__ bool next(int i, pg8::Unit& u) const { int L = i * G + c; if (L >= rep * R * nN) return false; L %= R * nN; pg8::tile_map(L, R, nN, u.pm, u.pn); u.ex = texp[u.pm]; return true; }
    __device__ __forceinline__ const char* a_tile(const pg8::Unit& u) const { return A + (size_t)u.pm * a_tstep; }
    __device__ __forceinline__ const char* b_tile(const pg8::Unit& u) const { return Bt + (size_t)u.ex * b_estep + (size_t)u.pn * b_tstep; }
    __device__ __forceinline__ const int* a_rows(const pg8::Unit& u) const { return rows + (size_t)u.pm * 256; }
};

struct EpiStoreBf16 {
    static constexpr bool PERM = true;
    bf16* O; int ldc; const float* rowscale; float cscale;
    __device__ __forceinline__ void operator()(const f32x4 (&acc)[2][2][4][2], const pg8::Unit& u, int wr, int wc, int fr, int fq) const {
        const int row0 = u.pm * 256 + wr * 64 + fr, col0 = u.pn * 256 + wc * 32 + 8 * fq;
#pragma unroll
        for (int ai = 0; ai < 2; ++ai)
#pragma unroll
            for (int m = 0; m < 4; ++m) { const int row = row0 + ai * 128 + m * 16; const float sc = (rowscale ? rowscale[row] : 1.0f) * cscale; bf16* rowp = O + (size_t)row * ldc + col0;
#pragma unroll
                for (int bj = 0; bj < 2; ++bj) { const f32x4 v0 = acc[ai][bj][m][0] * sc, v1 = acc[ai][bj][m][1] * sc;
                    u32x4 w; w.x = cvt_pk_bf16(v0[0], v0[1]); w.y = cvt_pk_bf16(v0[2], v0[3]); w.z = cvt_pk_bf16(v1[0], v1[1]); w.w = cvt_pk_bf16(v1[2], v1[3]);
                    *(u32x4*)(rowp + bj * 128) = w; } }
    }
};
struct EpiInProj {
    static constexpr bool PERM = true;
    bf16* RAW; float* sskv; float* ssq; bf16* QS; bf16* KS; bf16* VS; const LAS float* ts; const LAS float* gq; const LAS float* gk;
    __device__ __forceinline__ void operator()(const f32x4 (&acc)[2][2][4][2], const pg8::Unit& u, int wr, int wc, int fr, int fq) const {
        constexpr float CS = MK_F8IN ? F8_INV : 1.0f; const int pn = u.pn; const bool lat = u.pm < 128;
        if (pn == 1 || pn == 4 || pn == 5) {
            const bool isq = pn != 1, isv = (!isq) && wc >= 2; const int head = isq ? 4 * (pn - 4) + wc : (wc & 1); const LAS float* gn = isq ? gq : gk;
            f32x4 g[4];
#pragma unroll
            for (int q4 = 0; q4 < 4; ++q4) g[q4] = *(const LAS f32x4*)(gn + 16 * q4 + 4 * fq);
#pragma unroll
            for (int ai = 0; ai < 2; ++ai)
#pragma unroll
                for (int m = 0; m < 4; ++m) { const int row = u.pm * 256 + ai * 128 + wr * 64 + m * 16 + fr;
                    f32x4 x[4] = {acc[ai][0][m][0] * CS, acc[ai][0][m][1] * CS, acc[ai][1][m][0] * CS, acc[ai][1][m][1] * CS};
                    int bidx, key, pos; if (lat) { bidx = row >> 12; pos = row & 4095; key = pos; } else { const int rc = row - MTOK; bidx = rc >> 8; key = SEQ + (rc & 255); pos = 0; }
                    if (!isv) { float ss = 0.f;
#pragma unroll
                        for (int q4 = 0; q4 < 4; ++q4) ss += (x[q4][0] * x[q4][0] + x[q4][1] * x[q4][1]) + (x[q4][2] * x[q4][2] + x[q4][3] * x[q4][3]);
                        ss += __shfl_xor(ss, 16); ss += __shfl_xor(ss, 32);
                        const float rstd = rsqrtf(ss * (1.0f / 64.0f) + EPS) * (isq ? QSCALE_S : 1.0f);
#pragma unroll
                        for (int q4 = 0; q4 < 4; ++q4) x[q4] = x[q4] * g[q4] * rstd;
                        if (lat) { const int pr = pos >> 6, pc = pos & 63;
                            const f32x4 cr = *(const LAS f32x4*)(ts + pr * 16 + 4 * fq), sr = *(const LAS f32x4*)(ts + 1024 + pr * 16 + 4 * fq), cc = *(const LAS f32x4*)(ts + pc * 16 + 4 * fq), sc = *(const LAS f32x4*)(ts + 1024 + pc * 16 + 4 * fq);
                            const f32x4 y1 = x[0] * cr - x[1] * sr, y2 = x[1] * cr + x[0] * sr, y3 = x[2] * cc - x[3] * sc, y4 = x[3] * cc + x[2] * sc; x[0] = y1; x[1] = y2; x[2] = y3; x[3] = y4; } }
                    GAS bf16* dst = isq ? ((GAS bf16*)QS + (size_t)row * 512 + head * 64) : ((GAS bf16*)(isv ? VS : KS) + ((size_t)bidx * KEYS + key) * 128 + head * 64);
#pragma unroll
                    for (int q4 = 0; q4 < 4; ++q4) { u32x2 w; w.x = cvt_pk_bf16(x[q4][0], x[q4][1]); w.y = cvt_pk_bf16(x[q4][2], x[q4][3]); *(GAS u32x2*)(dst + 16 * q4 + 4 * fq) = w; } }
        } else {
            const int row0 = u.pm * 256 + wr * 64 + fr, col0 = pn * 256 + wc * 32 + 8 * fq;
            if (MK_GATEPAIR && pn >= 6) {
                const int gc = 128 * (pn - 6) + wc * 32 + 8 * fq;
#pragma unroll
                for (int ai = 0; ai < 2; ++ai)
#pragma unroll
                    for (int m = 0; m < 4; ++m) { const int row = row0 + ai * 128 + m * 16; GAS bf16* rp2 = (GAS bf16*)RAW + (size_t)row * NRAW + gc; float rr[8], sbv[8];
#pragma unroll
                        for (int n = 0; n < 2; ++n)
#pragma unroll
                            for (int e = 0; e < 4; ++e) { const float ea = __builtin_amdgcn_exp2f(acc[ai][0][m][n][e] * (-LOG2E * CS)), eb = fminf(__builtin_amdgcn_exp2f(acc[ai][1][m][n][e] * (-LOG2E * CS)), 1.0e18f);
                                const float sb = __builtin_amdgcn_rcpf(1.0f + eb); sbv[4 * n + e] = sb; rr[4 * n + e] = (1.0f + eb) * __builtin_amdgcn_rcpf(1.0f + ea); }
                        u32x4 wr_, wb_; wr_.x = cvt_pk_bf16(rr[0], rr[1]); wr_.y = cvt_pk_bf16(rr[2], rr[3]); wr_.z = cvt_pk_bf16(rr[4], rr[5]); wr_.w = cvt_pk_bf16(rr[6], rr[7]);
                        wb_.x = cvt_pk_bf16(sbv[0], sbv[1]); wb_.y = cvt_pk_bf16(sbv[2], sbv[3]); wb_.z = cvt_pk_bf16(sbv[4], sbv[5]); wb_.w = cvt_pk_bf16(sbv[6], sbv[7]);
                        *(GAS u32x4*)(rp2 + C_GA) = wr_; *(GAS u32x4*)(rp2 + C_GB) = wb_; }
            } else
#pragma unroll
            for (int ai = 0; ai < 2; ++ai)
#pragma unroll
                for (int m = 0; m < 4; ++m) { const int row = row0 + ai * 128 + m * 16; GAS bf16* rowp = (GAS bf16*)RAW + (size_t)row * NRAW + col0; float ss0 = 0.f, ss1 = 0.f;
#pragma unroll
                    for (int bj = 0; bj < 2; ++bj) { f32x4 v0 = acc[ai][bj][m][0] * CS, v1 = acc[ai][bj][m][1] * CS;
                        if (MK_SIGPRE && pn >= 6) {
#pragma unroll
                            for (int e = 0; e < 4; ++e) { v0[e] = sigmoidf_(v0[e]); v1[e] = sigmoidf_(v1[e]); } }
                        const float q = ((v0[0] * v0[0] + v0[1] * v0[1]) + (v0[2] * v0[2] + v0[3] * v0[3])) + ((v1[0] * v1[0] + v1[1] * v1[1]) + (v1[2] * v1[2] + v1[3] * v1[3])); if (bj == 0) ss0 = q; else ss1 = q;
                        u32x4 w; w.x = cvt_pk_bf16(v0[0], v0[1]); w.y = cvt_pk_bf16(v0[2], v0[3]); w.z = cvt_pk_bf16(v1[0], v1[1]); w.w = cvt_pk_bf16(v1[2], v1[3]);
                        *(GAS u32x4*)(rowp + bj * 128) = w; }
                    if (pn == 0 || pn == 2 || pn == 3) { float ss = (pn == 3) ? ss0 : ss0 + ss1; ss += __shfl_xor(ss, 16); ss += __shfl_xor(ss, 32);
                        if (fq == 0) { if (pn == 0) ((GAS float*)sskv)[row * 4 + wc] = ss; else if (lat) ((GAS float*)ssq)[row * 8 + (pn == 3 ? 4 : 0) + wc] = ss; } } }
        }
    }
};
template <int NP> struct EpiUp {
    static constexpr bool PERM = true;
    bf16* O; int ldc; const float* ssp; float invn;
    __device__ __forceinline__ void operator()(const f32x4 (&acc)[2][2][4][2], const pg8::Unit& u, int wr, int wc, int fr, int fq) const {
        const int row0 = u.pm * 256 + wr * 64 + fr, col0 = u.pn * 256 + wc * 32 + 8 * fq;
#pragma unroll
        for (int ai = 0; ai < 2; ++ai)
#pragma unroll
            for (int m = 0; m < 4; ++m) { const int row = row0 + ai * 128 + m * 16; float s = 0.f;
#pragma unroll
                for (int w = 0; w < NP; w += 4) { const f32x4 p = *(const f32x4*)(ssp + (size_t)row * NP + w); s += (p[0] + p[1]) + (p[2] + p[3]); }
                const float sc = rsqrtf(s * invn + EPS); bf16* rowp = O + (size_t)row * ldc + col0;
#pragma unroll
                for (int bj = 0; bj < 2; ++bj) { const f32x4 v0 = acc[ai][bj][m][0] * sc, v1 = acc[ai][bj][m][1] * sc;
                    u32x4 w; w.x = cvt_pk_bf16(v0[0], v0[1]); w.y = cvt_pk_bf16(v0[2], v0[3]); w.z = cvt_pk_bf16(v1[0], v1[1]); w.w = cvt_pk_bf16(v1[2], v1[3]);
                    *(u32x4*)(rowp + bj * 128) = w; } }
    }
};
template <bool K8> struct EpiKv {
    static constexpr bool PERM = true; static constexpr bool k8 = K8;
    const float* sskv; const bf16* RAW; bf16* KM; bf16* VM; const LAS float* tm; const LAS float* gk;
    __device__ __forceinline__ void operator()(const f32x4 (&acc)[2][2][4][2], const pg8::Unit& u, int wr, int wc, int fr, int fq) const {
        const int head = 2 * u.pn + (wc >> 1); const bool isv = wc & 1, lat = u.pm < 128;
        const LAS float* ggk = gk;
#pragma unroll
        for (int ai = 0; ai < 2; ++ai) {
            f32x4 pp[4]; unsigned krw[4][4];
#pragma unroll
            for (int m = 0; m < 4; ++m) { const int row = u.pm * 256 + ai * 128 + wr * 64 + m * 16 + fr; pp[m] = *(const GAS f32x4*)((const GAS float*)sskv + (size_t)row * 4);
                if (!isv) { const GAS bf16* rr = (const GAS bf16*)RAW + (size_t)row * NRAW + C_KROPE + 2 * fq;
#pragma unroll
                    for (int qd = 0; qd < 4; ++qd) krw[m][qd] = *(const GAS unsigned*)(rr + 8 * qd); } }
            asm volatile("" ::: "memory");
#pragma unroll
            for (int m = 0; m < 4; ++m) {
                const int row = u.pm * 256 + ai * 128 + wr * 64 + m * 16 + fr;
                const f32x4 p = pp[m]; const float rkv = rsqrtf(((p[0] + p[1]) + (p[2] + p[3])) * (1.0f / 256.0f) + EPS);
                int bidx, key, pos; if (lat) { bidx = row >> 12; pos = row & 4095; key = pos; } else { const int rc = row - MTOK; bidx = rc >> 8; key = SEQ + (rc & 255); pos = 0; }
                f32x4 x[2][2];
#pragma unroll
                for (int bj = 0; bj < 2; ++bj)
#pragma unroll
                    for (int n = 0; n < 2; ++n) x[bj][n] = acc[ai][bj][m][n] * rkv;
                if (isv) { GAS bf16* vo = (GAS bf16*)VM + ((size_t)bidx * KEYS + key) * 512 + head * 64 + 8 * fq;
#pragma unroll
                    for (int bj = 0; bj < 2; ++bj) { u32x4 w; w.x = cvt_pk_bf16(x[bj][0][0], x[bj][0][1]); w.y = cvt_pk_bf16(x[bj][0][2], x[bj][0][3]); w.z = cvt_pk_bf16(x[bj][1][0], x[bj][1][1]); w.w = cvt_pk_bf16(x[bj][1][2], x[bj][1][3]);
                        *(GAS u32x4*)(vo + 32 * bj) = w; }
                } else {
                    float kr[4][2]; float ss = 0.f;
#pragma unroll
                    for (int qd = 0; qd < 4; ++qd) { const unsigned w = krw[m][qd]; kr[qd][0] = bflo(w); kr[qd][1] = bfhi(w); ss += kr[qd][0] * kr[qd][0] + kr[qd][1] * kr[qd][1]; }
#pragma unroll
                    for (int bj = 0; bj < 2; ++bj)
#pragma unroll
                        for (int n = 0; n < 2; ++n) ss += (x[bj][n][0] * x[bj][n][0] + x[bj][n][1] * x[bj][n][1]) + (x[bj][n][2] * x[bj][n][2] + x[bj][n][3] * x[bj][n][3]);
                    ss += __shfl_xor(ss, 16); ss += __shfl_xor(ss, 32);
                    const float rstd = rsqrtf(ss * (1.0f / 96.0f) + EPS);
                    GAS bf16* ko = (GAS bf16*)KM + ((size_t)bidx * KEYS + key) * 768 + head * 96; GAS unsigned char* ko8 = (GAS unsigned char*)KM + ((size_t)bidx * KEYS + key) * 1024 + head * 128;
                    const int pr = pos >> 6, pc = pos & 63;
#pragma unroll
                    for (int ii = 0; ii < 2; ++ii) { const int i = 2 * fq + ii; float y0 = kr[0][ii] * rstd * ggk[64 + i], y1 = kr[1][ii] * rstd * ggk[72 + i], y2 = kr[2][ii] * rstd * ggk[80 + i], y3 = kr[3][ii] * rstd * ggk[88 + i];
                        if (lat) { const float cr = tm[pr * 8 + i], sr = tm[512 + pr * 8 + i], cc = tm[pc * 8 + i], sc = tm[512 + pc * 8 + i];
                            const float o0 = y0 * cr - y1 * sr, o1 = y1 * cr + y0 * sr, o2 = y2 * cc - y3 * sc, o3 = y3 * cc + y2 * sc; y0 = o0; y1 = o1; y2 = o2; y3 = o3; }
                        kr[0][ii] = y0; kr[1][ii] = y1; kr[2][ii] = y2; kr[3][ii] = y3; }
#pragma unroll
                    for (int qd = 0; qd < 4; ++qd) { if (k8) *(GAS unsigned short*)(ko8 + 64 + 32 * (qd & 1) + 8 * (qd >> 1) + 2 * fq) = (unsigned short)pk4_fp8(kr[qd][0] * 16.f, kr[qd][1] * 16.f, 0.f, 0.f); else *(GAS unsigned*)(ko + 64 + 8 * qd + 2 * fq) = cvt_pk_bf16(kr[qd][0], kr[qd][1]); }
#pragma unroll
                    for (int bj = 0; bj < 2; ++bj) { const f32x4 g0 = *(const LAS f32x4*)(ggk + 32 * bj + 8 * fq), g1 = *(const LAS f32x4*)(ggk + 32 * bj + 8 * fq + 4);
                        const f32x4 a = x[bj][0] * g0 * rstd, b = x[bj][1] * g1 * rstd;
                        if (k8) { u32x2 w; w.x = pk4_fp8(a[0] * 16.f, a[1] * 16.f, a[2] * 16.f, a[3] * 16.f); w.y = pk4_fp8(b[0] * 16.f, b[1] * 16.f, b[2] * 16.f, b[3] * 16.f); *(GAS u32x2*)(ko8 + 32 * (fq & 1) + 8 * (2 * bj + (fq >> 1))) = w; }
                        else { u32x4 w; w.x = cvt_pk_bf16(a[0], a[1]); w.y = cvt_pk_bf16(a[2], a[3]); w.z = cvt_pk_bf16(b[0], b[1]); w.w = cvt_pk_bf16(b[2], b[3]); *(GAS u32x4*)(ko + 32 * bj + 8 * fq) = w; } }
                    if (k8) *(GAS u32x2*)(ko8 + 64 + 32 * (fq >> 1) + 16 + 8 * (fq & 1)) = (u32x2){0u, 0u};
                } } }
    }
};
struct EpiQ {
    static constexpr bool PERM = true;
    const float* ssq; bf16* QM; float* ssqh; const LAS float* tm; const LAS float* gq;
    __device__ __forceinline__ void operator()(const f32x4 (&acc)[2][2][4][2], const pg8::Unit& u, int wr, int wc, int fr, int fq) const {
        const int head = 2 * u.pn + (wc >> 1); const bool isr = wc & 1;
        f32x4 g[2][2]; float gr[4][2];
#pragma unroll
        for (int bj = 0; bj < 2; ++bj)
#pragma unroll
            for (int n = 0; n < 2; ++n) g[bj][n] = *(const LAS f32x4*)(gq + 32 * bj + 8 * fq + 4 * n);
#pragma unroll
        for (int qd = 0; qd < 4; ++qd) { gr[qd][0] = gq[64 + 8 * qd + 2 * fq]; gr[qd][1] = gq[64 + 8 * qd + 2 * fq + 1]; }
#pragma unroll
        for (int ai = 0; ai < 2; ++ai) {
            f32x4 pq0[4], pq1[4];
#pragma unroll
            for (int m = 0; m < 4; ++m) { const int row = u.pm * 256 + ai * 128 + wr * 64 + m * 16 + fr; pq0[m] = *(const GAS f32x4*)((const GAS float*)ssq + (size_t)row * 8); pq1[m] = *(const GAS f32x4*)((const GAS float*)ssq + (size_t)row * 8 + 4); }
            asm volatile("" ::: "memory");
#pragma unroll
            for (int m = 0; m < 4; ++m) { const int row = u.pm * 256 + ai * 128 + wr * 64 + m * 16 + fr;
                const f32x4 p0 = pq0[m], p1 = pq1[m];
                const float rq = rsqrtf((((p0[0] + p0[1]) + (p0[2] + p0[3])) + ((p1[0] + p1[1]) + (p1[2] + p1[3]))) * (1.0f / 384.0f) + EPS);
                GAS bf16* qo = (GAS bf16*)QM + (size_t)row * 768 + head * 96;
                if (!isr) { float ss = 0.f;
#pragma unroll
                    for (int bj = 0; bj < 2; ++bj) { const f32x4 a = acc[ai][bj][m][0] * rq, b = acc[ai][bj][m][1] * rq;
                        ss += ((a[0] * a[0] + a[1] * a[1]) + (a[2] * a[2] + a[3] * a[3])) + ((b[0] * b[0] + b[1] * b[1]) + (b[2] * b[2] + b[3] * b[3]));
                        const f32x4 ag = a * g[bj][0] * QSCALE_M, bg = b * g[bj][1] * QSCALE_M;
                        u32x4 w; w.x = cvt_pk_bf16(ag[0], ag[1]); w.y = cvt_pk_bf16(ag[2], ag[3]); w.z = cvt_pk_bf16(bg[0], bg[1]); w.w = cvt_pk_bf16(bg[2], bg[3]); *(GAS u32x4*)(qo + 32 * bj + 8 * fq) = w; }
                    ss += __shfl_xor(ss, 16); ss += __shfl_xor(ss, 32);
                    if (fq == 0) ((GAS float*)ssqh)[((size_t)row * 8 + head) * 2] = ss;
                } else {
                    const f32x4 a = acc[ai][0][m][0] * rq, b = acc[ai][0][m][1] * rq;
                    float ss = ((a[0] * a[0] + a[1] * a[1]) + (a[2] * a[2] + a[3] * a[3])) + ((b[0] * b[0] + b[1] * b[1]) + (b[2] * b[2] + b[3] * b[3]));
                    ss += __shfl_xor(ss, 16); ss += __shfl_xor(ss, 32);
                    if (fq == 0) ((GAS float*)ssqh)[((size_t)row * 8 + head) * 2 + 1] = ss;
                    const int pos = row & 4095, pr = pos >> 6, pc = pos & 63; float o[4][2];
#pragma unroll
                    for (int ib = 0; ib < 2; ++ib) { const int i = 2 * fq + ib; const float y0 = a[ib] * gr[0][ib], y1 = a[2 + ib] * gr[1][ib], y2 = b[ib] * gr[2][ib], y3 = b[2 + ib] * gr[3][ib];
                        const float cr = tm[pr * 8 + i], sr = tm[512 + pr * 8 + i], cc = tm[pc * 8 + i], sc = tm[512 + pc * 8 + i];
                        o[0][ib] = (y0 * cr - y1 * sr) * QSCALE_M; o[1][ib] = (y1 * cr + y0 * sr) * QSCALE_M; o[2][ib] = (y2 * cc - y3 * sc) * QSCALE_M; o[3][ib] = (y3 * cc + y2 * sc) * QSCALE_M; }
#pragma unroll
                    for (int qd = 0; qd < 4; ++qd) *(GAS unsigned*)(qo + 64 + 8 * qd + 2 * fq) = cvt_pk_bf16(o[qd][0], o[qd][1]);
                } } }
    }
};
template <bool ADD> struct EpiBranch {
    static constexpr bool PERM = true;
    bf16* T; const bf16* gate; unsigned char* T8;
    __device__ __forceinline__ void operator()(const f32x4 (&acc)[2][2][4][2], const pg8::Unit& u, int wr, int wc, int fr, int fq) const {
        const int row0 = u.pm * 256 + wr * 64 + fr, col0 = u.pn * 256 + wc * 32 + 8 * fq; constexpr float ASC = MK_F8MID ? F8_INVM : 1.0f;
#pragma unroll
        for (int ai = 0; ai < 2; ++ai)
#pragma unroll
            for (int m = 0; m < 4; ++m) { const int row = row0 + ai * 128 + m * 16;
#pragma unroll
                for (int bj = 0; bj < 2; ++bj) { const int col = col0 + bj * 128;
                    const u32x4 g = *(const u32x4*)(gate + (size_t)row * NRAW + col);
                    f32x4 v0 = acc[ai][bj][m][0] * ASC, v1 = acc[ai][bj][m][1] * ASC;
                    v0[0] *= sigmoidf_(bflo(g.x)); v0[1] *= sigmoidf_(bfhi(g.x)); v0[2] *= sigmoidf_(bflo(g.y)); v0[3] *= sigmoidf_(bfhi(g.y));
                    v1[0] *= sigmoidf_(bflo(g.z)); v1[1] *= sigmoidf_(bfhi(g.z)); v1[2] *= sigmoidf_(bflo(g.w)); v1[3] *= sigmoidf_(bfhi(g.w));
                    bf16* tp = T + (size_t)row * D + col;
                    if (ADD) { const u32x4 t = *(const u32x4*)tp; v0[0] += bflo(t.x); v0[1] += bfhi(t.x); v0[2] += bflo(t.y); v0[3] += bfhi(t.y); v1[0] += bflo(t.z); v1[1] += bfhi(t.z); v1[2] += bflo(t.w); v1[3] += bfhi(t.w); }
                    if (ADD && MK_F8MID) { u32x2 w; w.x = pk4_fp8(v0[0] * F8_SO, v0[1] * F8_SO, v0[2] * F8_SO, v0[3] * F8_SO); w.y = pk4_fp8(v1[0] * F8_SO, v1[1] * F8_SO, v1[2] * F8_SO, v1[3] * F8_SO);
                        *(u32x2*)(T8 + (size_t)row * D + col) = w; }
                    else { u32x4 w; w.x = cvt_pk_bf16(v0[0], v0[1]); w.y = cvt_pk_bf16(v0[2], v0[3]); w.z = cvt_pk_bf16(v1[0], v1[1]); w.w = cvt_pk_bf16(v1[2], v1[3]);
                        *(u32x4*)tp = w; } } }
    }
};
static_assert(!MK_GATEPAIR || MK_SIGPRE, "MK_GATEPAIR needs MK_SIGPRE");
static_assert(!MK_SIGPRE || (MK_MERGE78 && MK_FUSE3 && MK_F8MID), "MK_SIGPRE needs the merged branch GEMM and the fused in-proj epilogue");
struct EpiMerge {
    static constexpr int NST = 16; static constexpr bool PERM = true, MID = true;
    const bf16* RAW; unsigned char* T8;
    __device__ __forceinline__ void mid(f32x4 (&acc)[2][2][4][2], const pg8::Unit& u, int wr, int wc, int fr, int fq) const {
        asm volatile("" : "+v"(fr), "+v"(fq));
        const int row0 = u.pm * 256 + wr * 64 + fr, col0 = u.pn * 256 + wc * 32 + 8 * fq;
#pragma unroll
        for (int ai = 0; ai < 2; ++ai)
#pragma unroll
            for (int m2 = 0; m2 < 4; m2 += MK_MIDR) { asm volatile("" ::: "memory");
              u32x4 gav[MK_MIDR][2], gbv[MK_MIDR][2];
#pragma unroll
              for (int mm = 0; mm < MK_MIDR; ++mm) { const GAS bf16* rp = (const GAS bf16*)RAW + (size_t)(row0 + ai * 128 + (m2 + mm) * 16) * NRAW + col0;
#pragma unroll
                  for (int bj = 0; bj < 2; ++bj) { gav[mm][bj] = *(const GAS u32x4*)(rp + C_GA + bj * 128); if (!MK_GATEPAIR) gbv[mm][bj] = *(const GAS u32x4*)(rp + C_GB + bj * 128); else gbv[mm][bj] = gav[mm][bj]; } }
              asm volatile("" ::: "memory");
#pragma unroll
              for (int mm = 0; mm < MK_MIDR; ++mm) { const int m = m2 + mm;
#pragma unroll
                for (int bj = 0; bj < 2; ++bj) { const u32x4 ga = gav[mm][bj], gb = gbv[mm][bj];
                    const unsigned aw[4] = {ga.x, ga.y, ga.z, ga.w}, bw[4] = {gb.x, gb.y, gb.z, gb.w};
#pragma unroll
                    for (int q = 0; q < 4; ++q) {
                        if (MK_GATEPAIR) { acc[ai][bj][m][q >> 1][2 * (q & 1)] *= bflo(aw[q]); acc[ai][bj][m][q >> 1][2 * (q & 1) + 1] *= bfhi(aw[q]); }
                        else if (MK_SIGPRE) { acc[ai][bj][m][q >> 1][2 * (q & 1)] *= bflo(aw[q]) * __builtin_amdgcn_rcpf(bflo(bw[q])); acc[ai][bj][m][q >> 1][2 * (q & 1) + 1] *= bfhi(aw[q]) * __builtin_amdgcn_rcpf(bfhi(bw[q])); }
                        else { const float ea0 = __builtin_amdgcn_exp2f(-LOG2E * bflo(aw[q])), ea1 = __builtin_amdgcn_exp2f(-LOG2E * bfhi(aw[q])), eb0 = __builtin_amdgcn_exp2f(-LOG2E * bflo(bw[q])), eb1 = __builtin_amdgcn_exp2f(-LOG2E * bfhi(bw[q]));
                        acc[ai][bj][m][q >> 1][2 * (q & 1)] *= (1.0f + eb0) * __builtin_amdgcn_rcpf(1.0f + ea0); acc[ai][bj][m][q >> 1][2 * (q & 1) + 1] *= (1.0f + eb1) * __builtin_amdgcn_rcpf(1.0f + ea1); } } } } }
    }
    __device__ __forceinline__ void operator()(const f32x4 (&acc)[2][2][4][2], const pg8::Unit& u, int wr, int wc, int fr, int fq) const {
        const int row0 = u.pm * 256 + wr * 64 + fr, col0 = u.pn * 256 + wc * 32 + 8 * fq; constexpr float SC = F8_INVM * F8_SO;
#pragma unroll
        for (int ai = 0; ai < 2; ++ai) {
            u32x4 gg[4][2];
#pragma unroll
            for (int m = 0; m < 4; ++m)
#pragma unroll
                for (int bj = 0; bj < 2; ++bj) gg[m][bj] = *(const GAS u32x4*)((const GAS bf16*)RAW + (size_t)(row0 + ai * 128 + m * 16) * NRAW + C_GB + col0 + bj * 128);
            asm volatile("" ::: "memory");
#pragma unroll
            for (int m = 0; m < 4; ++m) { const int row = row0 + ai * 128 + m * 16;
#pragma unroll
                for (int bj = 0; bj < 2; ++bj) { const u32x4 g = gg[m][bj]; const f32x4 v0 = acc[ai][bj][m][0] * SC, v1 = acc[ai][bj][m][1] * SC;
                    u32x2 w;
                    if (MK_SIGPRE) { w.x = pk4_fp8(v0[0] * bflo(g.x), v0[1] * bfhi(g.x), v0[2] * bflo(g.y), v0[3] * bfhi(g.y)); w.y = pk4_fp8(v1[0] * bflo(g.z), v1[1] * bfhi(g.z), v1[2] * bflo(g.w), v1[3] * bfhi(g.w)); }
                    else { w.x = pk4_fp8(v0[0] * sigmoidf_(bflo(g.x)), v0[1] * sigmoidf_(bfhi(g.x)), v0[2] * sigmoidf_(bflo(g.y)), v0[3] * sigmoidf_(bfhi(g.y)));
                    w.y = pk4_fp8(v1[0] * sigmoidf_(bflo(g.z)), v1[1] * sigmoidf_(bfhi(g.z)), v1[2] * sigmoidf_(bflo(g.w)), v1[3] * sigmoidf_(bfhi(g.w))); }
                    *(GAS u32x2*)((GAS unsigned char*)T8 + (size_t)row * D + col0 + bj * 128) = w; } } }
    }
};
struct EpiOutRes {
    static constexpr bool PERM = false;
    const float* x; float* out; const float* mod;
    __device__ __forceinline__ void operator()(const f32x4 (&acc)[2][2][4][2], const pg8::Unit& u, int wr, int wc, int fr, int fq) const {
        const int row0 = u.pm * 256 + wr * 64 + fr, col0 = u.pn * 256 + wc * 32 + 4 * fq; const int bb = (u.pm * 256) >> 12;
        f32x4 gv[2][2];
#pragma unroll
        for (int bj = 0; bj < 2; ++bj)
#pragma unroll
            for (int n = 0; n < 2; ++n) gv[bj][n] = *(const f32x4*)(mod + (size_t)bb * NMOD + 2048 + col0 + bj * 128 + n * 16);
#pragma unroll
        for (int ai = 0; ai < 2; ++ai)
#pragma unroll
            for (int mh = 0; mh < 4; mh += MK_EPIX) {
                f32x4 xv[MK_EPIX][2][2];
#pragma unroll
                for (int m = 0; m < MK_EPIX; ++m) { const size_t ro = (size_t)(row0 + ai * 128 + (mh + m) * 16) * D + col0;
#pragma unroll
                    for (int bj = 0; bj < 2; ++bj)
#pragma unroll
                        for (int n = 0; n < 2; ++n) xv[m][bj][n] = *(const GAS f32x4*)((const GAS float*)x + ro + bj * 128 + n * 16); }
                asm volatile("" ::: "memory");
#pragma unroll
                for (int m = 0; m < MK_EPIX; ++m) { const size_t ro = (size_t)(row0 + ai * 128 + (mh + m) * 16) * D + col0;
#pragma unroll
                    for (int bj = 0; bj < 2; ++bj)
#pragma unroll
                        for (int n = 0; n < 2; ++n) *(GAS f32x4*)((GAS float*)out + ro + bj * 128 + n * 16) = xv[m][bj][n] + gv[bj][n] * (acc[ai][bj][mh + m][n] * (MK_F8MID ? F8_INVM : 1.0f)); } }
    }
};
struct EpiSwiglu {
    static constexpr bool PERM = true, PRE = true;
    unsigned char* ACT; const float* bgu;
    __device__ __forceinline__ void pre(const pg8::Unit& u, int wr, int wc, int fr, int fq, f32x4 (&b4)[4]) const { const float* bp = bgu + (size_t)u.ex * 2048 + 2 * (u.pn * 128 + wc * 32 + 8 * fq);
#pragma unroll
        for (int q = 0; q < 4; ++q) asm_load16(b4[q], bp + 4 * q); }
    __device__ __forceinline__ void operator()(const f32x4 (&acc)[2][2][4][2], const pg8::Unit& u, int wr, int wc, int fr, int fq, const f32x4 (&b4)[4]) const {
        const int row0 = u.pm * 256 + wr * 64 + fr, j0 = u.pn * 128 + wc * 32 + 8 * fq;
        constexpr float ASC = MK_F8 ? F8_INV : 1.0f, OSC = MK_F8 ? F8_SA : 1.0f;
#pragma unroll
        for (int ai = 0; ai < 2; ++ai)
#pragma unroll
            for (int m = 0; m < 4; ++m) { f32x2 o[4];
#pragma unroll
                for (int q = 0; q < 4; ++q) { const int n = q >> 1, e0 = 2 * (q & 1);
                    f32x2 g = (f32x2){acc[ai][0][m][n][e0], acc[ai][0][m][n][e0 + 1]} * ASC + (f32x2){b4[q][0], b4[q][2]};
                    f32x2 l = (f32x2){acc[ai][1][m][n][e0], acc[ai][1][m][n][e0 + 1]} * ASC + (f32x2){b4[q][1], b4[q][3]};
                    g.x = fminf(g.x, 7.0f); g.y = fminf(g.y, 7.0f); l.x = __builtin_amdgcn_fmed3f(l.x, -7.0f, 7.0f); l.y = __builtin_amdgcn_fmed3f(l.y, -7.0f, 7.0f);
                    const f32x2 z = g * (-1.702f * LOG2E); f32x2 d; d.x = __builtin_amdgcn_exp2f(z.x); d.y = __builtin_amdgcn_exp2f(z.y); d = d + 1.0f;
                    f32x2 r; r.x = __builtin_amdgcn_rcpf(d.x); r.y = __builtin_amdgcn_rcpf(d.y);
                    o[q] = (g * r) * (l * OSC + OSC); }
                if (MK_F8) { u32x2 w; int t = __builtin_amdgcn_cvt_pk_fp8_f32(o[0].x, o[0].y, 0, false); t = __builtin_amdgcn_cvt_pk_fp8_f32(o[1].x, o[1].y, t, true); w.x = (unsigned)t;
                    t = __builtin_amdgcn_cvt_pk_fp8_f32(o[2].x, o[2].y, 0, false); t = __builtin_amdgcn_cvt_pk_fp8_f32(o[3].x, o[3].y, t, true); w.y = (unsigned)t;
                    *(u32x2*)(ACT + (size_t)(row0 + ai * 128 + m * 16) * 1024 + j0) = w; }
                else { u32x4 w; w.x = cvt_pk_bf16(o[0].x, o[0].y); w.y = cvt_pk_bf16(o[1].x, o[1].y); w.z = cvt_pk_bf16(o[2].x, o[2].y); w.w = cvt_pk_bf16(o[3].x, o[3].y);
                    *(u32x4*)(ACT + ((size_t)(row0 + ai * 128 + m * 16) * 1024 + j0) * 2) = w; } }
    }
};
struct EpiDown {
    static constexpr bool PERM = true, PRE = true;
    unsigned char* Y; const float* bdn; const float* slotw;
    __device__ __forceinline__ void pre(const pg8::Unit& u, int wr, int wc, int fr, int fq, f32x4 (&bq)[4]) const { const float* bp = bdn + (size_t)u.ex * 1024 + u.pn * 256 + wc * 32 + 8 * fq;
#pragma unroll
        for (int bj = 0; bj < 2; ++bj)
#pragma unroll
            for (int n = 0; n < 2; ++n) asm_load16(bq[bj * 2 + n], bp + bj * 128 + 4 * n); }
    __device__ __forceinline__ void operator()(const f32x4 (&acc)[2][2][4][2], const pg8::Unit& u, int wr, int wc, int fr, int fq, const f32x4 (&bq)[4]) const {
        const int row0 = u.pm * 256 + wr * 64 + fr, col0 = u.pn * 256 + wc * 32 + 8 * fq;
        f32x4 bv[2][2];
#pragma unroll
        for (int bj = 0; bj < 2; ++bj)
#pragma unroll
            for (int n = 0; n < 2; ++n) bv[bj][n] = bq[bj * 2 + n];
        float swv[2][4];
#pragma unroll
        for (int ai = 0; ai < 2; ++ai)
#pragma unroll
            for (int m = 0; m < 4; ++m) swv[ai][m] = ((const GAS float*)slotw)[row0 + ai * 128 + m * 16];
        asm volatile("" ::: "memory");
#pragma unroll
        for (int ai = 0; ai < 2; ++ai)
#pragma unroll
            for (int m = 0; m < 4; ++m) { const int row = row0 + ai * 128 + m * 16; const float sw = swv[ai][m];
#pragma unroll
                for (int bj = 0; bj < 2; ++bj) { constexpr float ASC = MK_F8 ? F8_INV : 1.0f; const f32x4 v0 = (acc[ai][bj][m][0] * ASC + bv[bj][0]) * sw, v1 = (acc[ai][bj][m][1] * ASC + bv[bj][1]) * sw;
                    if (MK_F8Y) { u32x2 w; w.x = pk4_fp8(v0[0] * F8_SY, v0[1] * F8_SY, v0[2] * F8_SY, v0[3] * F8_SY); w.y = pk4_fp8(v1[0] * F8_SY, v1[1] * F8_SY, v1[2] * F8_SY, v1[3] * F8_SY);
                        *(GAS u32x2*)((GAS unsigned char*)Y + (size_t)row * 1024 + col0 + bj * 128) = w; }
                    else { u32x4 w; w.x = cvt_pk_bf16(v0[0], v0[1]); w.y = cvt_pk_bf16(v0[2], v0[3]); w.z = cvt_pk_bf16(v1[0], v1[1]); w.w = cvt_pk_bf16(v1[2], v1[3]);
                        *(u32x4*)(Y + ((size_t)row * 1024 + col0 + bj * 128) * 2) = w; } } }
    }
};

__device__ __forceinline__ void p3_post_inproj(Frame& F) {
    LAS unsigned char* scr = F.lds + F.wave * 4096;
    const bf16* RAW = WSP(bf16, WS_R1); const float* ts = WSP(float, WS_TRIG);
    const int gw = F.vcu * NWAVES + F.wave, NGW = F.G * NWAVES, lane = F.lane, g = lane >> 4, i = lane & 15;
    bf16* QS = WSP(bf16, WS_QS); bf16* KS = WSP(bf16, WS_KS); bf16* VS = WSP(bf16, WS_VS);
    for (int row = gw; row < MALL; row += NGW) {
        const bool lat = row < MTOK; const bf16* rp = RAW + (size_t)row * NRAW;
#pragma unroll
        for (int q = 0; q < 3; ++q) *(LAS u32x4*)(scr + (lane + 64 * q) * 16) = *(const u32x4*)(rp + (lane + 64 * q) * 8);
        LDS_WAIT(); asm volatile("" ::: "memory");
        const LAS bf16* s = (const LAS bf16*)scr;
        { const u32x2 w = *(const LAS u32x2*)(s + C_KVLAT + 4 * lane); const float a = bflo(w.x), b = bfhi(w.x), c = bflo(w.y), d = bfhi(w.y);
          const float ss = wave_sum((a * a + b * b) + (c * c + d * d)); if (lane == 0) WSP(float, WS_RSKV)[row] = rsqrtf(ss * (1.0f / 256.0f) + EPS); }
        if (lat) { float ss = 0.f;
#pragma unroll
            for (int q = 0; q < 3; ++q) { const unsigned w = *(const LAS unsigned*)(s + C_QLAT + 6 * lane + 2 * q); const float a = bflo(w), b = bfhi(w); ss += a * a + b * b; }
            ss = wave_sum(ss); if (lane == 0) WSP(float, WS_RSQ)[row] = rsqrtf(ss * (1.0f / 384.0f) + EPS); }
        int bidx, key, pos;
        if (lat) { bidx = row >> 12; pos = row & 4095; key = pos; } else { const int rc = row - MTOK; bidx = rc >> 8; key = SEQ + (rc & 255); pos = 0; }
        const int pr = pos >> 6, pc = pos & 63;
        const float cr = ts[pr * 16 + i], sr = ts[1024 + pr * 16 + i], cc = ts[pc * 16 + i], sc = ts[1024 + pc * 16 + i];
#pragma unroll
        for (int pass = 0; pass < 3; ++pass) {
            const bool isq = pass < 2; const int head = isq ? (pass * 4 + g) : g; const bool act = isq ? lat : (g < 2);
            const LAS bf16* hp = s + (isq ? C_QSWA : C_KSWA) + (act ? head : 0) * 64;
            float x1 = bf2f(hp[i]), x2 = bf2f(hp[16 + i]), x3 = bf2f(hp[32 + i]), x4 = bf2f(hp[48 + i]);
            float ss = (x1 * x1 + x2 * x2) + (x3 * x3 + x4 * x4);
            ss += __shfl_xor(ss, 1); ss += __shfl_xor(ss, 2); ss += __shfl_xor(ss, 4); ss += __shfl_xor(ss, 8);
            const float rstd = rsqrtf(ss * (1.0f / 64.0f) + EPS); const float* gn = isq ? F.swa_q_g : F.swa_k_g;
            x1 *= rstd * gn[i]; x2 *= rstd * gn[16 + i]; x3 *= rstd * gn[32 + i]; x4 *= rstd * gn[48 + i];
            float y1 = x1, y2 = x2, y3 = x3, y4 = x4;
            if (lat) { y1 = x1 * cr - x2 * sr; y2 = x2 * cr + x1 * sr; y3 = x3 * cc - x4 * sc; y4 = x4 * cc + x3 * sc; }
            if (act) {
                if (isq) { bf16* o = QS + (size_t)row * 512 + head * 64; o[i] = (bf16)f2bf(y1 * QSCALE_S); o[16 + i] = (bf16)f2bf(y2 * QSCALE_S); o[32 + i] = (bf16)f2bf(y3 * QSCALE_S); o[48 + i] = (bf16)f2bf(y4 * QSCALE_S); }
                else { bf16* o = KS + ((size_t)bidx * KEYS + key) * 128 + head * 64; o[i] = (bf16)f2bf(y1); o[16 + i] = (bf16)f2bf(y2); o[32 + i] = (bf16)f2bf(y3); o[48 + i] = (bf16)f2bf(y4); }
            }
        }
        if (lane < 16) *(u32x4*)(VS + ((size_t)bidx * KEYS + key) * 128 + lane * 8) = *(const LAS u32x4*)(s + C_VSWA + lane * 8);
        LDS_WAIT(); asm volatile("" ::: "memory");
    }
}

__device__ __forceinline__ void p5_post_up(Frame& F) {
    const bf16* RAW = WSP(bf16, WS_R1); const bf16* KVUP = WSP(bf16, WS_KVUP); const bf16* QUP = WSP(bf16, WS_QUP); const float* tm = WSP(float, WS_TRIG) + 2048;
    bf16* QM = WSP(bf16, WS_QM); bf16* KM = WSP(bf16, WS_KM); bf16* VM = WSP(bf16, WS_VM);
    const int gw = F.vcu * NWAVES + F.wave, NGW = F.G * NWAVES, lane = F.lane, h = lane >> 3, i = lane & 7;
    float gk[8], gq[8], gkr[4], gqr[4];
#pragma unroll
    for (int e = 0; e < 8; ++e) { gk[e] = F.mla_k_g[8 * i + e]; gq[e] = F.mla_q_g[8 * i + e]; }
#pragma unroll
    for (int q = 0; q < 4; ++q) { gkr[q] = F.mla_k_g[64 + 8 * q + i]; gqr[q] = F.mla_q_g[64 + 8 * q + i]; }
    for (int row = gw; row < MALL; row += NGW) {
        const bool lat = row < MTOK; int bidx, key, pos;
        if (lat) { bidx = row >> 12; pos = row & 4095; key = pos; } else { const int rc = row - MTOK; bidx = rc >> 8; key = SEQ + (rc & 255); pos = 0; }
        const int pr = pos >> 6, pc = pos & 63;
        const float cr = tm[pr * 8 + i], sr = tm[512 + pr * 8 + i], cc = tm[pc * 8 + i], sc = tm[512 + pc * 8 + i];
        {
            const bf16* kp = KVUP + (size_t)row * 1024 + h * 128; const u32x4 nw = *(const u32x4*)(kp + 8 * i); const u32x4 vw = *(const u32x4*)(kp + 64 + 8 * i);
            const bf16* rr = RAW + (size_t)row * NRAW + C_KROPE; float x[4];
#pragma unroll
            for (int q = 0; q < 4; ++q) x[q] = bf2f(rr[8 * q + i]);
            float n[8] = {bflo(nw.x), bfhi(nw.x), bflo(nw.y), bfhi(nw.y), bflo(nw.z), bfhi(nw.z), bflo(nw.w), bfhi(nw.w)};
            float ss = (x[0] * x[0] + x[1] * x[1]) + (x[2] * x[2] + x[3] * x[3]);
#pragma unroll
            for (int e = 0; e < 8; ++e) ss += n[e] * n[e];
            ss += __shfl_xor(ss, 1); ss += __shfl_xor(ss, 2); ss += __shfl_xor(ss, 4);
            const float rstd = rsqrtf(ss * (1.0f / 96.0f) + EPS);
            bf16* ko = KM + ((size_t)bidx * KEYS + key) * 768 + h * 96;
            u32x4 w; w.x = pk2(n[0] * rstd * gk[0], n[1] * rstd * gk[1]); w.y = pk2(n[2] * rstd * gk[2], n[3] * rstd * gk[3]); w.z = pk2(n[4] * rstd * gk[4], n[5] * rstd * gk[5]); w.w = pk2(n[6] * rstd * gk[6], n[7] * rstd * gk[7]);
            *(u32x4*)(ko + 8 * i) = w;
            float x1 = x[0] * rstd * gkr[0], x2 = x[1] * rstd * gkr[1], x3 = x[2] * rstd * gkr[2], x4 = x[3] * rstd * gkr[3], y1 = x1, y2 = x2, y3 = x3, y4 = x4;
            if (lat) { y1 = x1 * cr - x2 * sr; y2 = x2 * cr + x1 * sr; y3 = x3 * cc - x4 * sc; y4 = x4 * cc + x3 * sc; }
            ko[64 + i] = (bf16)f2bf(y1); ko[72 + i] = (bf16)f2bf(y2); ko[80 + i] = (bf16)f2bf(y3); ko[88 + i] = (bf16)f2bf(y4);
            *(u32x4*)(VM + ((size_t)bidx * KEYS + key) * 512 + h * 64 + 8 * i) = vw;
        }
        if (lat) {
            const bf16* qp = QUP + (size_t)row * 768 + h * 96; const u32x4 nw = *(const u32x4*)(qp + 8 * i); float x[4];
#pragma unroll
            for (int q = 0; q < 4; ++q) x[q] = bf2f(qp[64 + 8 * q + i]);
            float n[8] = {bflo(nw.x), bfhi(nw.x), bflo(nw.y), bfhi(nw.y), bflo(nw.z), bfhi(nw.z), bflo(nw.w), bfhi(nw.w)};
            float ss = (x[0] * x[0] + x[1] * x[1]) + (x[2] * x[2] + x[3] * x[3]);
#pragma unroll
            for (int e = 0; e < 8; ++e) ss += n[e] * n[e];
            ss += __shfl_xor(ss, 1); ss += __shfl_xor(ss, 2); ss += __shfl_xor(ss, 4);
            const float rstd = rsqrtf(ss * (1.0f / 96.0f) + EPS) * QSCALE_M;
            bf16* qo = QM + (size_t)row * 768 + h * 96;
            u32x4 w; w.x = pk2(n[0] * rstd * gq[0], n[1] * rstd * gq[1]); w.y = pk2(n[2] * rstd * gq[2], n[3] * rstd * gq[3]); w.z = pk2(n[4] * rstd * gq[4], n[5] * rstd * gq[5]); w.w = pk2(n[6] * rstd * gq[6], n[7] * rstd * gq[7]);
            *(u32x4*)(qo + 8 * i) = w;
            const float x1 = x[0] * rstd * gqr[0], x2 = x[1] * rstd * gqr[1], x3 = x[2] * rstd * gqr[2], x4 = x[3] * rstd * gqr[3];
            qo[64 + i] = (bf16)f2bf(x1 * cr - x2 * sr); qo[72 + i] = (bf16)f2bf(x2 * cr + x1 * sr); qo[80 + i] = (bf16)f2bf(x3 * cc - x4 * sc); qo[88 + i] = (bf16)f2bf(x4 * cc + x3 * sc);
        }
    }
}

namespace att {
constexpr int KBUF = 12288, VOFF = KBUF, BUF = KBUF + 8192, WSF = 2 * BUF, OST = WSF + 2048, LDS_NEED = OST + 8 * 4096;
__device__ __forceinline__ int crow(int r, int hi) { return (r & 3) + 8 * (r >> 2) + 4 * hi; }
__device__ __forceinline__ void glds16(const void* gsrc, unsigned lds_dst) { unsigned keep;
    asm volatile("s_mov_b32 %0, m0\n\ts_mov_b32 m0, %2\n\ts_nop 0\n\tglobal_load_lds_dwordx4 %1, off\n\ts_mov_b32 m0, %0" : "=&s"(keep) : "v"(gsrc), "s"(lds_dst) : "memory"); }
#define ATT_WAIT_BAR() asm volatile("s_waitcnt vmcnt(0) lgkmcnt(0)\n\ts_barrier" ::: "memory")
__device__ __forceinline__ s16x4 vtr(const LAS unsigned char* p) { return __builtin_bit_cast(s16x4, __builtin_amdgcn_ds_read_tr16_b64_v4i16((LAS s16x4*)p)); }
template <int DK, bool SWA, bool K8 = false>
__device__ __forceinline__ void unit(LAS unsigned char* lds, const bf16* Qw  , int QP, const bf16* Kb  , int KP,
                                     const bf16* Vb, int VP, bf16* Ow  , int q0  , float m_init, float l_init, const float* qss = nullptr  ) {
    int tid = threadIdx.x; asm volatile("" : "+v"(tid)); const int lane = tid & 63, r32 = lane & 31, hi = lane >> 5; const int wid = __builtin_amdgcn_readfirstlane(tid >> 6);
    constexpr int NKP = K8 ? 8 : DK / 8, NP = NKP + 8, NKS = DK / 16;
    int nband = 0, first = 0;
    if (SWA) { first = q0 - 128 < 0 ? 0 : q0 - 128; const int lastk = q0 + 384 > SEQ ? SEQ : q0 + 384; nband = (lastk - first) >> 6; }
    const int NT = SWA ? 4 + nband : KEYS / 64;
#define ATT_KEY0(ti) (SWA ? ((ti) < 4 ? SEQ + 64 * (ti) : first + 64 * ((ti) - 4)) : 64 * (ti))
#define ATT_ISSUE(ti, bufo) do { const int _k0 = ATT_KEY0(ti); _Pragma("unroll") for (int _q = 0; _q < 3; ++_q) { const int _p = wid + 8 * _q; if (_p < NP) { \
        const bf16* _src = (_p < NKP) ? (K8 ? (const bf16*)((const unsigned char*)Kb + (size_t)(_k0 + lane) * 1024 + _p * 16) : (Kb + (size_t)(_k0 + lane) * KP + _p * 8)) : (Vb + (size_t)(_k0 + 16 * ((_p - NKP) & 3) + (lane >> 2)) * VP + ((_p - NKP) >> 2) * 32 + (lane & 3) * 8); \
        const int _dst = (_p < NKP) ? (_p * 1024) : (VOFF + (_p - NKP) * 1024); \
        __builtin_amdgcn_global_load_lds((const unsigned*)_src, (LAS unsigned*)(lds + (bufo) + _dst), 16, 0, 0); } } } while (0)
    ATT_ISSUE(0, 0);
    bf16x8 qr[NKS];
#pragma unroll
    for (int ks = 0; ks < NKS; ++ks) qr[ks] = *(const bf16x8*)(Qw + (size_t)r32 * QP + ks * 16 + hi * 8);
    if (qss) { const f32x2 sq = *(const f32x2*)(qss + (size_t)r32 * 16); const float qs = rsqrtf((sq.x + sq.y) * (1.0f / 96.0f) + EPS) * (K8 ? 0.0625f : 1.0f);
#pragma unroll
        for (int ks = 0; ks < NKS; ++ks) { const u32x4 w = __builtin_bit_cast(u32x4, qr[ks]); u32x4 o;
            o.x = cvt_pk_bf16(bflo(w.x) * qs, bfhi(w.x) * qs); o.y = cvt_pk_bf16(bflo(w.y) * qs, bfhi(w.y) * qs); o.z = cvt_pk_bf16(bflo(w.z) * qs, bfhi(w.z) * qs); o.w = cvt_pk_bf16(bflo(w.w) * qs, bfhi(w.w) * qs);
            qr[ks] = __builtin_bit_cast(bf16x8, o); } }
    float m_run = m_init, l_run = (hi == 0) ? l_init : 0.f; f32x16 o0, o1;
#pragma unroll
    for (int r = 0; r < 16; ++r) { o0[r] = 0.f; o1[r] = 0.f; }
    LAS float* wsf = (LAS float*)(lds + WSF) + wid * 64;
    const int qpos = q0 + wid * 32 + r32;
    for (int ti = 0; ti < NT; ++ti) {
        const int bufo = (ti & 1) * BUF;
        asm volatile("s_waitcnt vmcnt(0)" ::: "memory"); __syncthreads();
        if (ti + 1 < NT) ATT_ISSUE(ti + 1, ((ti + 1) & 1) * BUF);
        const LAS unsigned char* kb = lds + bufo + hi * 1024 + r32 * 16;
        f32x16 p0, p1;
#pragma unroll
        for (int r = 0; r < 16; ++r) { p0[r] = 0.f; p1[r] = 0.f; }
#pragma unroll
        for (int ks = 0; ks < NKS; ++ks) { bf16x8 a0, a1;
            if constexpr (K8) { const LAS unsigned char* k8p = lds + bufo + (4 * (ks >> 2) + 2 * hi + ((ks & 3) >> 1)) * 1024 + r32 * 16 + 8 * (ks & 1);
#pragma unroll
                for (int hf = 0; hf < 2; ++hf) { const u32x2 w = *(const LAS u32x2*)(k8p + 512 * hf);
                    const f32x2 c0 = __builtin_amdgcn_cvt_pk_f32_fp8((int)w.x, false), c1 = __builtin_amdgcn_cvt_pk_f32_fp8((int)w.x, true), c2 = __builtin_amdgcn_cvt_pk_f32_fp8((int)w.y, false), c3 = __builtin_amdgcn_cvt_pk_f32_fp8((int)w.y, true);
                    const u32x4 o = {cvt_pk_bf16(c0.x, c0.y), cvt_pk_bf16(c1.x, c1.y), cvt_pk_bf16(c2.x, c2.y), cvt_pk_bf16(c3.x, c3.y)}; if (hf == 0) a0 = __builtin_bit_cast(bf16x8, o); else a1 = __builtin_bit_cast(bf16x8, o); }
            } else { a0 = *(const LAS bf16x8*)(kb + ks * 2048); a1 = *(const LAS bf16x8*)(kb + ks * 2048 + 512); }
            p0 = __builtin_amdgcn_mfma_f32_32x32x16_bf16(a0, qr[ks], p0, 0, 0, 0); p1 = __builtin_amdgcn_mfma_f32_32x32x16_bf16(a1, qr[ks], p1, 0, 0, 0); }
        if (SWA && ti >= 4) { const int k0 = ATT_KEY0(ti);
#pragma unroll
            for (int r = 0; r < 16; ++r) { const int kp = k0 + crow(r, hi), d0 = qpos - kp, d1 = d0 - 32;
                if (d0 > 128 || d0 < -128) p0[r] = -1e30f; if (d1 > 128 || d1 < -128) p1[r] = -1e30f; } }
        float tmax = fmaxf(p0[0], p1[0]);
#pragma unroll
        for (int r = 1; r < 16; ++r) tmax = fmaxf(tmax, fmaxf(p0[r], p1[r]));
        tmax = fmaxf(tmax, __shfl_xor(tmax, 32));
        if (__any(tmax > m_run)) {
            const float m_new = fmaxf(m_run, tmax), alpha = __builtin_amdgcn_exp2f(m_run - m_new); l_run *= alpha; m_run = m_new;
            if (hi == 0) wsf[r32] = alpha;
            LDS_WAIT(); asm volatile("" ::: "memory");
#pragma unroll
            for (int g = 0; g < 4; ++g) { const f32x4 a = *(const LAS f32x4*)(wsf + 8 * g + 4 * hi);
#pragma unroll
                for (int e = 0; e < 4; ++e) { o0[4 * g + e] *= a[e]; o1[4 * g + e] *= a[e]; } }
            LDS_WAIT(); asm volatile("" ::: "memory");
        }
        float ls = 0.f;
#pragma unroll
        for (int r = 0; r < 16; ++r) { p0[r] = __builtin_amdgcn_exp2f(p0[r] - m_run); p1[r] = __builtin_amdgcn_exp2f(p1[r] - m_run); ls += p0[r] + p1[r]; }
        l_run += ls;
        u32x4 pw0, pw1, pw2, pw3;
        pw0 = (u32x4){cvt_pk_bf16(p0[0], p0[1]), cvt_pk_bf16(p0[2], p0[3]), cvt_pk_bf16(p0[4], p0[5]), cvt_pk_bf16(p0[6], p0[7])};
        pw1 = (u32x4){cvt_pk_bf16(p0[8], p0[9]), cvt_pk_bf16(p0[10], p0[11]), cvt_pk_bf16(p0[12], p0[13]), cvt_pk_bf16(p0[14], p0[15])};
        pw2 = (u32x4){cvt_pk_bf16(p1[0], p1[1]), cvt_pk_bf16(p1[2], p1[3]), cvt_pk_bf16(p1[4], p1[5]), cvt_pk_bf16(p1[6], p1[7])};
        pw3 = (u32x4){cvt_pk_bf16(p1[8], p1[9]), cvt_pk_bf16(p1[10], p1[11]), cvt_pk_bf16(p1[12], p1[13]), cvt_pk_bf16(p1[14], p1[15])};
        const LAS unsigned char* vp = lds + bufo + VOFF + ((lane >> 4) & 1) * 32 + (lane & 3) * 8 + (4 * hi + ((lane & 15) >> 2)) * 64;
#define ATT_VFR(i) ({ const s16x4 _lo = vtr(vp + ((i) >> 2) * 4096 + ((i) & 3) * 1024), _hi = vtr(vp + ((i) >> 2) * 4096 + ((i) & 3) * 1024 + 512); (bf16x8){_lo[0], _lo[1], _lo[2], _lo[3], _hi[0], _hi[1], _hi[2], _hi[3]}; })
        o0 = __builtin_amdgcn_mfma_f32_32x32x16_bf16(__builtin_bit_cast(bf16x8, pw0), ATT_VFR(0), o0, 0, 0, 0);
        o1 = __builtin_amdgcn_mfma_f32_32x32x16_bf16(__builtin_bit_cast(bf16x8, pw0), ATT_VFR(4), o1, 0, 0, 0);
        o0 = __builtin_amdgcn_mfma_f32_32x32x16_bf16(__builtin_bit_cast(bf16x8, pw1), ATT_VFR(1), o0, 0, 0, 0);
        o1 = __builtin_amdgcn_mfma_f32_32x32x16_bf16(__builtin_bit_cast(bf16x8, pw1), ATT_VFR(5), o1, 0, 0, 0);
        o0 = __builtin_amdgcn_mfma_f32_32x32x16_bf16(__builtin_bit_cast(bf16x8, pw2), ATT_VFR(2), o0, 0, 0, 0);
        o1 = __builtin_amdgcn_mfma_f32_32x32x16_bf16(__builtin_bit_cast(bf16x8, pw2), ATT_VFR(6), o1, 0, 0, 0);
        o0 = __builtin_amdgcn_mfma_f32_32x32x16_bf16(__builtin_bit_cast(bf16x8, pw3), ATT_VFR(3), o0, 0, 0, 0);
        o1 = __builtin_amdgcn_mfma_f32_32x32x16_bf16(__builtin_bit_cast(bf16x8, pw3), ATT_VFR(7), o1, 0, 0, 0);
#undef ATT_VFR
    }
    l_run += __shfl_xor(l_run, 32);
    if (hi == 0) wsf[32 + r32] = l_run;
    LDS_WAIT(); asm volatile("" ::: "memory");
    LAS bf16* stg = (LAS bf16*)(lds + OST) + wid * 2048;
#pragma unroll
    for (int g = 0; g < 4; ++g) { const f32x4 lv = *(const LAS f32x4*)(wsf + 32 + 8 * g + 4 * hi);
#pragma unroll
        for (int e = 0; e < 4; ++e) { const int r = 4 * g + e, orow = crow(r, hi); const float rl = __builtin_amdgcn_rcpf(lv[e]);
            if (MK_F8MID) { LAS unsigned char* s8 = (LAS unsigned char*)stg; s8[orow * 64 + r32] = (unsigned char)pk4_fp8(o0[r] * rl * F8_SO, 0.f, 0.f, 0.f); s8[orow * 64 + 32 + r32] = (unsigned char)pk4_fp8(o1[r] * rl * F8_SO, 0.f, 0.f, 0.f); }
            else { stg[orow * 64 + r32] = (bf16)f2bf(o0[r] * rl); stg[orow * 64 + 32 + r32] = (bf16)f2bf(o1[r] * rl); } } }
    LDS_WAIT(); asm volatile("" ::: "memory");
    if (MK_F8MID) {
#pragma unroll
        for (int q = 0; q < 2; ++q) { const int row = q * 16 + (lane >> 2), ch = lane & 3; const u32x4 v = *(const LAS u32x4*)((LAS unsigned char*)stg + row * 64 + ch * 16); *(u32x4*)((unsigned char*)Ow + (size_t)row * ((MK_MERGE78 && MK_F8MID) ? 1024 : 512) + ch * 16) = v; }
    } else {
#pragma unroll
        for (int q = 0; q < 4; ++q) { const int row = q * 8 + (lane >> 3), ch = lane & 7; const u32x4 v = *(const LAS u32x4*)(stg + row * 64 + ch * 8); *(u32x4*)(Ow + (size_t)row * 512 + ch * 8) = v; } }
    LDS_WAIT(); __syncthreads();
#undef ATT_KEY0
#undef ATT_ISSUE
}

constexpr int WSF2 = 3 * BUF, OST2 = WSF2 + 2048, LDS_NEED2 = OST2 + 8 * 4096;
template <int DK, bool SWA, bool K8 = false>
__device__ __forceinline__ void unit2(LAS unsigned char* lds, const bf16* Qw, int QP, const bf16* Kb, int KP, const bf16* Vb, int VP, bf16* Ow, int q0, float negM, float l_init, const float* qss = nullptr) {
    int tid = threadIdx.x; asm volatile("" : "+v"(tid)); const int lane = tid & 63, r32 = lane & 31, hi = lane >> 5; const int wid = __builtin_amdgcn_readfirstlane(tid >> 6);
    constexpr int NKP = K8 ? 8 : DK / 8, NP = NKP + 8, NKS = DK / 16;
    int nband = 0, first = 0;
    if (SWA) { first = q0 - 128 < 0 ? 0 : q0 - 128; const int lastk = q0 + 384 > SEQ ? SEQ : q0 + 384; nband = (lastk - first) >> 6; }
    const int NT = SWA ? 4 + nband : KEYS / 64;
#define ATT_KEY0(ti) (SWA ? ((ti) < 4 ? SEQ + 64 * (ti) : first + 64 * ((ti) - 4)) : 64 * (ti))
#define ATT_ISSUE(ti, bufo) do { const int _k0 = ATT_KEY0(ti); _Pragma("unroll") for (int _q = 0; _q < 3; ++_q) { const int _p = wid + 8 * _q; if (_p < NP) { \
        const bf16* _src = (_p < NKP) ? (K8 ? (const bf16*)((const unsigned char*)Kb + (size_t)(_k0 + lane) * 1024 + _p * 16) : (Kb + (size_t)(_k0 + lane) * KP + _p * 8)) : (Vb + (size_t)(_k0 + 16 * ((_p - NKP) & 3) + (lane >> 2)) * VP + ((_p - NKP) >> 2) * 32 + (lane & 3) * 8); \
        const int _dst = (_p < NKP) ? (_p * 1024) : (VOFF + (_p - NKP) * 1024); \
        glds16(_src, (unsigned)__builtin_amdgcn_readfirstlane((int)(lds0 + (bufo) + _dst))); } } } while (0)
    const unsigned lds0 = (unsigned)(unsigned long long)lds;
    ATT_ISSUE(0, 0); ATT_ISSUE(1, BUF);
    bf16x8 qr[NKS];
#pragma unroll
    for (int ks = 0; ks < NKS; ++ks) qr[ks] = *(const bf16x8*)(Qw + (size_t)r32 * QP + ks * 16 + hi * 8);
    pg8::i32x8 qf[2] = {{0, 0, 0, 0, 0, 0, 0, 0}, {0, 0, 0, 0, 0, 0, 0, 0}};
    if (qss) { const f32x2 sq = *(const f32x2*)(qss + (size_t)r32 * 16); const float qs = rsqrtf((sq.x + sq.y) * (1.0f / 96.0f) + EPS);
        if (K8) { const float q8 = qs * 64.0f;
#pragma unroll
            for (int ks = 0; ks < NKS; ++ks) { const u32x4 w = __builtin_bit_cast(u32x4, qr[ks]);
                qf[ks >> 2][2 * (ks & 3)] = (int)pk4_fp8(bflo(w.x) * q8, bfhi(w.x) * q8, bflo(w.y) * q8, bfhi(w.y) * q8); qf[ks >> 2][2 * (ks & 3) + 1] = (int)pk4_fp8(bflo(w.z) * q8, bfhi(w.z) * q8, bflo(w.w) * q8, bfhi(w.w) * q8); }
        } else {
#pragma unroll
        for (int ks = 0; ks < NKS; ++ks) { const u32x4 w = __builtin_bit_cast(u32x4, qr[ks]); u32x4 o;
            o.x = cvt_pk_bf16(bflo(w.x) * qs, bfhi(w.x) * qs); o.y = cvt_pk_bf16(bflo(w.y) * qs, bfhi(w.y) * qs); o.z = cvt_pk_bf16(bflo(w.z) * qs, bfhi(w.z) * qs); o.w = cvt_pk_bf16(bflo(w.w) * qs, bfhi(w.w) * qs);
            qr[ks] = __builtin_bit_cast(bf16x8, o); } } }
    const f32x16 zero16 = {0.f, 0.f, 0.f, 0.f, 0.f, 0.f, 0.f, 0.f, 0.f, 0.f, 0.f, 0.f, 0.f, 0.f, 0.f, 0.f};
    float l_run = (hi == 0) ? l_init : 0.f; f32x16 o0, o1;
#pragma unroll
    for (int r = 0; r < 16; ++r) { o0[r] = 0.f; o1[r] = 0.f; }
    LAS float* wsf = (LAS float*)(lds + WSF2) + wid * 64;
    const int qpos = q0 + wid * 32 + r32;
    const LAS unsigned char* kb0 = lds + hi * 1024 + r32 * 16;
    const LAS unsigned char* vp0 = lds + VOFF + ((lane >> 4) & 1) * 32 + (lane & 3) * 8 + (4 * hi + ((lane & 15) >> 2)) * 64;
#define ATT_QK8_HALF(S, kb8, half) do { \
        { const u32x4 _l = *(const LAS u32x4*)((kb8) + (2 * hi) * 1024 + (half) * 512), _h = *(const LAS u32x4*)((kb8) + (2 * hi + 1) * 1024 + (half) * 512); \
          const pg8::i32x8 _a = {(int)_l.x, (int)_l.y, (int)_l.z, (int)_l.w, (int)_h.x, (int)_h.y, (int)_h.z, (int)_h.w}; \
          S = __builtin_amdgcn_mfma_scale_f32_32x32x64_f8f6f4(_a, qf[0], zero16, 0, 0, 0, 0x7b7b7b7b, 0, 0x79797979); } \
        { const u32x4 _l = *(const LAS u32x4*)((kb8) + (4 + 2 * hi) * 1024 + (half) * 512), _h = *(const LAS u32x4*)((kb8) + (5 + 2 * hi) * 1024 + (half) * 512); \
          const pg8::i32x8 _a = {(int)_l.x, (int)_l.y, (int)_l.z, (int)_l.w, (int)_h.x, (int)_h.y, (int)_h.z, (int)_h.w}; \
          S = __builtin_amdgcn_mfma_scale_f32_32x32x64_f8f6f4(_a, qf[1], S, 0, 0, 0, 0x7b7b7b7b, 0, 0x79797979); } } while (0)
#define ATT_QK(S0, S1, bufo) do { if constexpr (K8) { const LAS unsigned char* _k8 = lds + (bufo) + r32 * 16; ATT_QK8_HALF(S0, _k8, 0); ATT_QK8_HALF(S1, _k8, 1); } else { const LAS unsigned char* _kb = kb0 + (bufo); \
        { const bf16x8 _a0 = *(const LAS bf16x8*)(_kb), _a1 = *(const LAS bf16x8*)(_kb + 512); \
          S0 = __builtin_amdgcn_mfma_f32_32x32x16_bf16(_a0, qr[0], zero16, 0, 0, 0); S1 = __builtin_amdgcn_mfma_f32_32x32x16_bf16(_a1, qr[0], zero16, 0, 0, 0); } \
        _Pragma("unroll") for (int _ks = 1; _ks < NKS; ++_ks) { const bf16x8 _a0 = *(const LAS bf16x8*)(_kb + _ks * 2048), _a1 = *(const LAS bf16x8*)(_kb + _ks * 2048 + 512); \
          S0 = __builtin_amdgcn_mfma_f32_32x32x16_bf16(_a0, qr[_ks], S0, 0, 0, 0); S1 = __builtin_amdgcn_mfma_f32_32x32x16_bf16(_a1, qr[_ks], S1, 0, 0, 0); } } } while (0)
#define ATT_VFR(vp, i) ({ const s16x4 _lo = vtr((vp) + ((i) >> 2) * 4096 + ((i) & 3) * 1024), _hi = vtr((vp) + ((i) >> 2) * 4096 + ((i) & 3) * 1024 + 512); (bf16x8){_lo[0], _lo[1], _lo[2], _lo[3], _hi[0], _hi[1], _hi[2], _hi[3]}; })
#define ATT_STEP(C0, C1, N0, N1, tt) do { \
        ATT_WAIT_BAR(); \
        if ((tt) + 2 < NT) ATT_ISSUE((tt) + 2, bo_nn); \
        if ((tt) + 1 < NT) ATT_QK(N0, N1, bo_nxt); \
        if (SWA && (tt) >= 4) { const int _k0 = ATT_KEY0(tt); \
            _Pragma("unroll") for (int r = 0; r < 16; ++r) { const int _d0 = qpos - (_k0 + crow(r, hi)), _d1 = _d0 - 32; \
                if (_d0 > 128 || _d0 < -128) C0[r] = -1e30f; if (_d1 > 128 || _d1 < -128) C1[r] = -1e30f; } } \
        float _ls = 0.f; \
        _Pragma("unroll") for (int r = 0; r < 16; ++r) { C0[r] = __builtin_amdgcn_exp2f(C0[r]); C1[r] = __builtin_amdgcn_exp2f(C1[r]); _ls += C0[r] + C1[r]; } \
        l_run += _ls; \
        const u32x4 _pw0 = {cvt_pk_bf16(C0[0], C0[1]), cvt_pk_bf16(C0[2], C0[3]), cvt_pk_bf16(C0[4], C0[5]), cvt_pk_bf16(C0[6], C0[7])}; \
        const u32x4 _pw1 = {cvt_pk_bf16(C0[8], C0[9]), cvt_pk_bf16(C0[10], C0[11]), cvt_pk_bf16(C0[12], C0[13]), cvt_pk_bf16(C0[14], C0[15])}; \
        const u32x4 _pw2 = {cvt_pk_bf16(C1[0], C1[1]), cvt_pk_bf16(C1[2], C1[3]), cvt_pk_bf16(C1[4], C1[5]), cvt_pk_bf16(C1[6], C1[7])}; \
        const u32x4 _pw3 = {cvt_pk_bf16(C1[8], C1[9]), cvt_pk_bf16(C1[10], C1[11]), cvt_pk_bf16(C1[12], C1[13]), cvt_pk_bf16(C1[14], C1[15])}; \
        const LAS unsigned char* _vp = vp0 + bo_cur; \
        o0 = __builtin_amdgcn_mfma_f32_32x32x16_bf16(__builtin_bit_cast(bf16x8, _pw0), ATT_VFR(_vp, 0), o0, 0, 0, 0); \
        o1 = __builtin_amdgcn_mfma_f32_32x32x16_bf16(__builtin_bit_cast(bf16x8, _pw0), ATT_VFR(_vp, 4), o1, 0, 0, 0); \
        o0 = __builtin_amdgcn_mfma_f32_32x32x16_bf16(__builtin_bit_cast(bf16x8, _pw1), ATT_VFR(_vp, 1), o0, 0, 0, 0); \
        o1 = __builtin_amdgcn_mfma_f32_32x32x16_bf16(__builtin_bit_cast(bf16x8, _pw1), ATT_VFR(_vp, 5), o1, 0, 0, 0); \
        o0 = __builtin_amdgcn_mfma_f32_32x32x16_bf16(__builtin_bit_cast(bf16x8, _pw2), ATT_VFR(_vp, 2), o0, 0, 0, 0); \
        o1 = __builtin_amdgcn_mfma_f32_32x32x16_bf16(__builtin_bit_cast(bf16x8, _pw2), ATT_VFR(_vp, 6), o1, 0, 0, 0); \
        o0 = __builtin_amdgcn_mfma_f32_32x32x16_bf16(__builtin_bit_cast(bf16x8, _pw3), ATT_VFR(_vp, 3), o0, 0, 0, 0); \
        o1 = __builtin_amdgcn_mfma_f32_32x32x16_bf16(__builtin_bit_cast(bf16x8, _pw3), ATT_VFR(_vp, 7), o1, 0, 0, 0); \
        { const int _t = bo_cur; bo_cur = bo_nxt; bo_nxt = bo_nn; bo_nn = _t; } } while (0)
    ATT_WAIT_BAR();
    f32x16 sa0, sa1, sb0, sb1;
    ATT_QK(sa0, sa1, 0);
    int bo_cur = 0, bo_nxt = BUF, bo_nn = 2 * BUF;
    for (int t = 0; t < NT; t += 2) {
        ATT_STEP(sa0, sa1, sb0, sb1, t);
        ATT_STEP(sb0, sb1, sa0, sa1, t + 1);
    }
    l_run += __shfl_xor(l_run, 32);
    if (hi == 0) wsf[32 + r32] = l_run;
    LDS_WAIT(); asm volatile("" ::: "memory");
    LAS bf16* stg = (LAS bf16*)(lds + OST2) + wid * 2048;
#pragma unroll
    for (int g = 0; g < 4; ++g) { const f32x4 lv = *(const LAS f32x4*)(wsf + 32 + 8 * g + 4 * hi);
#pragma unroll
        for (int e = 0; e < 4; ++e) { const int r = 4 * g + e, orow = crow(r, hi); const float rl = __builtin_amdgcn_rcpf(lv[e]);
            if (MK_F8MID) { LAS unsigned char* s8 = (LAS unsigned char*)stg; s8[orow * 64 + r32] = (unsigned char)pk4_fp8(o0[r] * rl * F8_SO, 0.f, 0.f, 0.f); s8[orow * 64 + 32 + r32] = (unsigned char)pk4_fp8(o1[r] * rl * F8_SO, 0.f, 0.f, 0.f); }
            else { stg[orow * 64 + r32] = (bf16)f2bf(o0[r] * rl); stg[orow * 64 + 32 + r32] = (bf16)f2bf(o1[r] * rl); } } }
    LDS_WAIT(); asm volatile("" ::: "memory");
    if (MK_F8MID) {
#pragma unroll
        for (int q = 0; q < 2; ++q) { const int row = q * 16 + (lane >> 2), ch = lane & 3; const u32x4 v = *(const LAS u32x4*)((LAS unsigned char*)stg + row * 64 + ch * 16); *(u32x4*)((unsigned char*)Ow + (size_t)row * ((MK_MERGE78 && MK_F8MID) ? 1024 : 512) + ch * 16) = v; }
    } else {
#pragma unroll
        for (int q = 0; q < 4; ++q) { const int row = q * 8 + (lane >> 3), ch = lane & 7; const u32x4 v = *(const LAS u32x4*)(stg + row * 64 + ch * 8); *(u32x4*)(Ow + (size_t)row * 512 + ch * 8) = v; } }
    ATT_WAIT_BAR();
#undef ATT_KEY0
#undef ATT_ISSUE
#undef ATT_QK
#undef ATT_QK8_HALF
#undef ATT_VFR
#undef ATT_STEP
}
constexpr int SUB3 = 16384, SUP3 = 2 * SUB3, WSF3 = 3 * SUP3, OST3 = WSF3 + 2048, LDS_NEED3 = OST3 + 8 * 4096;
static_assert(LDS_NEED3 <= LDSCTL_OFF, "attention LDS"); static_assert(GQX_OFF + 384 <= LDS_BYTES && TSX_OFF + 2176 * 4 <= LDS_BYTES, "LDS map");
template <int DK, bool SWA, bool K8 = false>
__device__ __forceinline__ void unit3(LAS unsigned char* lds, const bf16* Qw, int QP, const bf16* Kb, int KP, const bf16* Vb, int VP, bf16* Ow, int q0, float negM, float l_init, const float* qss = nullptr, int qoff = -1, int qspan = 256) {
    int tid = threadIdx.x; asm volatile("" : "+v"(tid)); const int lane = tid & 63, r32 = lane & 31, hi = lane >> 5; const int wid = __builtin_amdgcn_readfirstlane(tid >> 6);
    constexpr int NKP = K8 ? 8 : DK / 8, NP = NKP + 8, NKS = DK / 16;
    int nband = 0, first = 0;
    if (SWA) { first = q0 - 128 < 0 ? 0 : q0 - 128; const int lastk = q0 + qspan + 128 > SEQ ? SEQ : q0 + qspan + 128; nband = (lastk - first) >> 6; }
    const int NT = SWA ? 4 + nband : KEYS / 64, NT2 = NT >> 1;
#define ATT_KEY0(ti) (SWA ? ((ti) < 4 ? SEQ + 64 * (ti) : first + 64 * ((ti) - 4)) : 64 * (ti))
#define ATT_ISSUE(Ts, bufo) do { _Pragma("unroll") for (int _q = 0; _q < 4; ++_q) { const int _sub = _q >> 1, _p = wid + 8 * (_q & 1); const int _k0 = ATT_KEY0(2 * (Ts) + _sub); \
        const bf16* _src = (_p < 8) ? (K8 ? (const bf16*)((const unsigned char*)Kb + (size_t)(_k0 + lane) * 1024 + _p * 16) : (Kb + (size_t)(_k0 + lane) * KP + _p * 8)) : (Vb + (size_t)(_k0 + 16 * ((_p - 8) & 3) + (lane >> 2)) * VP + ((_p - 8) >> 2) * 32 + (lane & 3) * 8); \
        const int _dst = _sub * SUB3 + ((_p < 8) ? (_p * 1024) : (8192 + (_p - 8) * 1024)); \
        glds16(_src, (unsigned)__builtin_amdgcn_readfirstlane((int)(lds0 + (bufo) + _dst))); } } while (0)
    const unsigned lds0 = (unsigned)(unsigned long long)lds;
    static_assert(K8 || DK == 64, "unit3 needs an 8 KiB K tile");
    ATT_ISSUE(0, 0); ATT_ISSUE(1, SUP3);
    bf16x8 qr[NKS];
#pragma unroll
    for (int ks = 0; ks < NKS; ++ks) qr[ks] = *(const bf16x8*)(Qw + (size_t)r32 * QP + ks * 16 + hi * 8);
    pg8::i32x8 qf[2] = {{0, 0, 0, 0, 0, 0, 0, 0}, {0, 0, 0, 0, 0, 0, 0, 0}};
    if (qss) { const f32x2 sq = *(const f32x2*)(qss + (size_t)r32 * 16); const float qs = rsqrtf((sq.x + sq.y) * (1.0f / 96.0f) + EPS);
        if (K8) { const float q8 = qs * 64.0f;
#pragma unroll
            for (int ks = 0; ks < NKS; ++ks) { const u32x4 w = __builtin_bit_cast(u32x4, qr[ks]);
                qf[ks >> 2][2 * (ks & 3)] = (int)pk4_fp8(bflo(w.x) * q8, bfhi(w.x) * q8, bflo(w.y) * q8, bfhi(w.y) * q8); qf[ks >> 2][2 * (ks & 3) + 1] = (int)pk4_fp8(bflo(w.z) * q8, bfhi(w.z) * q8, bflo(w.w) * q8, bfhi(w.w) * q8); }
        } else {
#pragma unroll
        for (int ks = 0; ks < NKS; ++ks) { const u32x4 w = __builtin_bit_cast(u32x4, qr[ks]); u32x4 o;
            o.x = cvt_pk_bf16(bflo(w.x) * qs, bfhi(w.x) * qs); o.y = cvt_pk_bf16(bflo(w.y) * qs, bfhi(w.y) * qs); o.z = cvt_pk_bf16(bflo(w.z) * qs, bfhi(w.z) * qs); o.w = cvt_pk_bf16(bflo(w.w) * qs, bfhi(w.w) * qs);
            qr[ks] = __builtin_bit_cast(bf16x8, o); } } }
    const f32x16 zero16 = {0.f, 0.f, 0.f, 0.f, 0.f, 0.f, 0.f, 0.f, 0.f, 0.f, 0.f, 0.f, 0.f, 0.f, 0.f, 0.f};
    float l_run = (hi == 0) ? l_init : 0.f; f32x16 o0, o1;
#pragma unroll
    for (int r = 0; r < 16; ++r) { o0[r] = 0.f; o1[r] = 0.f; }
    LAS float* wsf = (LAS float*)(lds + WSF3) + wid * 64;
    const int qpos = q0 + (qoff < 0 ? wid * 32 : qoff) + r32;
    const LAS unsigned char* kb0 = lds + hi * 1024 + r32 * 16;
    const LAS unsigned char* vp0 = lds + 8192 + ((lane >> 4) & 1) * 32 + (lane & 3) * 8 + (4 * hi + ((lane & 15) >> 2)) * 64;
#define ATT_QK8_HALF(S, kb8, half) do { \
        { const u32x4 _l = *(const LAS u32x4*)((kb8) + (2 * hi) * 1024 + (half) * 512), _h = *(const LAS u32x4*)((kb8) + (2 * hi + 1) * 1024 + (half) * 512); \
          const pg8::i32x8 _a = {(int)_l.x, (int)_l.y, (int)_l.z, (int)_l.w, (int)_h.x, (int)_h.y, (int)_h.z, (int)_h.w}; \
          S = __builtin_amdgcn_mfma_scale_f32_32x32x64_f8f6f4(_a, qf[0], zero16, 0, 0, 0, 0x7b7b7b7b, 0, 0x79797979); } \
        { const u32x4 _l = *(const LAS u32x4*)((kb8) + (4 + 2 * hi) * 1024 + (half) * 512), _h = *(const LAS u32x4*)((kb8) + (5 + 2 * hi) * 1024 + (half) * 512); \
          const pg8::i32x8 _a = {(int)_l.x, (int)_l.y, (int)_l.z, (int)_l.w, (int)_h.x, (int)_h.y, (int)_h.z, (int)_h.w}; \
          S = __builtin_amdgcn_mfma_scale_f32_32x32x64_f8f6f4(_a, qf[1], S, 0, 0, 0, 0x7b7b7b7b, 0, 0x79797979); } } while (0)
#define ATT_QK(S0, S1, bufo) do { if constexpr (K8) { const LAS unsigned char* _k8 = lds + (bufo) + r32 * 16; ATT_QK8_HALF(S0, _k8, 0); ATT_QK8_HALF(S1, _k8, 1); } else { const LAS unsigned char* _kb = kb0 + (bufo); \
        { const bf16x8 _a0 = *(const LAS bf16x8*)(_kb), _a1 = *(const LAS bf16x8*)(_kb + 512); \
          S0 = __builtin_amdgcn_mfma_f32_32x32x16_bf16(_a0, qr[0], zero16, 0, 0, 0); S1 = __builtin_amdgcn_mfma_f32_32x32x16_bf16(_a1, qr[0], zero16, 0, 0, 0); } \
        _Pragma("unroll") for (int _ks = 1; _ks < NKS; ++_ks) { const bf16x8 _a0 = *(const LAS bf16x8*)(_kb + _ks * 2048), _a1 = *(const LAS bf16x8*)(_kb + _ks * 2048 + 512); \
          S0 = __builtin_amdgcn_mfma_f32_32x32x16_bf16(_a0, qr[_ks], S0, 0, 0, 0); S1 = __builtin_amdgcn_mfma_f32_32x32x16_bf16(_a1, qr[_ks], S1, 0, 0, 0); } } } while (0)
#define ATT_VFR(vp, i) ({ const s16x4 _lo = vtr((vp) + ((i) >> 2) * 4096 + ((i) & 3) * 1024), _hi = vtr((vp) + ((i) >> 2) * 4096 + ((i) & 3) * 1024 + 512); (bf16x8){_lo[0], _lo[1], _lo[2], _lo[3], _hi[0], _hi[1], _hi[2], _hi[3]}; })
#define ATT_SOFTPV(C0, C1, tt, vbase) do { \
        if (SWA && (tt) >= 4) { const int _k0 = ATT_KEY0(tt); \
            _Pragma("unroll") for (int r = 0; r < 16; ++r) { const int _d0 = qpos - (_k0 + crow(r, hi)), _d1 = _d0 - 32; \
                if (_d0 > 128 || _d0 < -128) C0[r] = -1e30f; if (_d1 > 128 || _d1 < -128) C1[r] = -1e30f; } } \
        float _ls = 0.f; \
        _Pragma("unroll") for (int r = 0; r < 16; ++r) { C0[r] = __builtin_amdgcn_exp2f(C0[r]); C1[r] = __builtin_amdgcn_exp2f(C1[r]); _ls += C0[r] + C1[r]; } \
        l_run += _ls; \
        const u32x4 _pw0 = {cvt_pk_bf16(C0[0], C0[1]), cvt_pk_bf16(C0[2], C0[3]), cvt_pk_bf16(C0[4], C0[5]), cvt_pk_bf16(C0[6], C0[7])}; \
        const u32x4 _pw1 = {cvt_pk_bf16(C0[8], C0[9]), cvt_pk_bf16(C0[10], C0[11]), cvt_pk_bf16(C0[12], C0[13]), cvt_pk_bf16(C0[14], C0[15])}; \
        const u32x4 _pw2 = {cvt_pk_bf16(C1[0], C1[1]), cvt_pk_bf16(C1[2], C1[3]), cvt_pk_bf16(C1[4], C1[5]), cvt_pk_bf16(C1[6], C1[7])}; \
        const u32x4 _pw3 = {cvt_pk_bf16(C1[8], C1[9]), cvt_pk_bf16(C1[10], C1[11]), cvt_pk_bf16(C1[12], C1[13]), cvt_pk_bf16(C1[14], C1[15])}; \
        const LAS unsigned char* _vp = vp0 + (vbase); \
        o0 = __builtin_amdgcn_mfma_f32_32x32x16_bf16(__builtin_bit_cast(bf16x8, _pw0), ATT_VFR(_vp, 0), o0, 0, 0, 0); \
        o1 = __builtin_amdgcn_mfma_f32_32x32x16_bf16(__builtin_bit_cast(bf16x8, _pw0), ATT_VFR(_vp, 4), o1, 0, 0, 0); \
        o0 = __builtin_amdgcn_mfma_f32_32x32x16_bf16(__builtin_bit_cast(bf16x8, _pw1), ATT_VFR(_vp, 1), o0, 0, 0, 0); \
        o1 = __builtin_amdgcn_mfma_f32_32x32x16_bf16(__builtin_bit_cast(bf16x8, _pw1), ATT_VFR(_vp, 5), o1, 0, 0, 0); \
        o0 = __builtin_amdgcn_mfma_f32_32x32x16_bf16(__builtin_bit_cast(bf16x8, _pw2), ATT_VFR(_vp, 2), o0, 0, 0, 0); \
        o1 = __builtin_amdgcn_mfma_f32_32x32x16_bf16(__builtin_bit_cast(bf16x8, _pw2), ATT_VFR(_vp, 6), o1, 0, 0, 0); \
        o0 = __builtin_amdgcn_mfma_f32_32x32x16_bf16(__builtin_bit_cast(bf16x8, _pw3), ATT_VFR(_vp, 3), o0, 0, 0, 0); \
        o1 = __builtin_amdgcn_mfma_f32_32x32x16_bf16(__builtin_bit_cast(bf16x8, _pw3), ATT_VFR(_vp, 7), o1, 0, 0, 0); \
        } while (0)
    ATT_WAIT_BAR();
    f32x16 sa0, sa1, sb0, sb1;
    ATT_QK(sa0, sa1, 0);
    int bo_cur = 0, bo_nxt = SUP3, bo_nn = 2 * SUP3;
    for (int T = 0; T < NT2; ++T) {
        ATT_WAIT_BAR();
        if (T + 2 < NT2) ATT_ISSUE(T + 2, bo_nn);
        ATT_QK(sb0, sb1, bo_cur + SUB3); ATT_SOFTPV(sa0, sa1, 2 * T, bo_cur);
        if (T + 1 < NT2) ATT_QK(sa0, sa1, bo_nxt);
        ATT_SOFTPV(sb0, sb1, 2 * T + 1, bo_cur + SUB3);
        { const int _t = bo_cur; bo_cur = bo_nxt; bo_nxt = bo_nn; bo_nn = _t; }
    }
    l_run += __shfl_xor(l_run, 32);
    if (hi == 0) wsf[32 + r32] = l_run;
    LDS_WAIT(); asm volatile("" ::: "memory");
    LAS bf16* stg = (LAS bf16*)(lds + OST3) + wid * 2048;
#pragma unroll
    for (int g = 0; g < 4; ++g) { const f32x4 lv = *(const LAS f32x4*)(wsf + 32 + 8 * g + 4 * hi);
#pragma unroll
        for (int e = 0; e < 4; ++e) { const int r = 4 * g + e, orow = crow(r, hi); const float rl = __builtin_amdgcn_rcpf(lv[e]);
            if (MK_F8MID) { LAS unsigned char* s8 = (LAS unsigned char*)stg; s8[orow * 64 + r32] = (unsigned char)pk4_fp8(o0[r] * rl * F8_SO, 0.f, 0.f, 0.f); s8[orow * 64 + 32 + r32] = (unsigned char)pk4_fp8(o1[r] * rl * F8_SO, 0.f, 0.f, 0.f); }
            else { stg[orow * 64 + r32] = (bf16)f2bf(o0[r] * rl); stg[orow * 64 + 32 + r32] = (bf16)f2bf(o1[r] * rl); } } }
    LDS_WAIT(); asm volatile("" ::: "memory");
    if (MK_F8MID) {
#pragma unroll
        for (int q = 0; q < 2; ++q) { const int row = q * 16 + (lane >> 2), ch = lane & 3; const u32x4 v = *(const LAS u32x4*)((LAS unsigned char*)stg + row * 64 + ch * 16); *(GAS u32x4*)((GAS unsigned char*)Ow + (size_t)row * ((MK_MERGE78 && MK_F8MID) ? 1024 : 512) + ch * 16) = v; }
    } else {
#pragma unroll
        for (int q = 0; q < 4; ++q) { const int row = q * 8 + (lane >> 3), ch = lane & 7; const u32x4 v = *(const LAS u32x4*)(stg + row * 64 + ch * 8); *(GAS u32x4*)((GAS bf16*)Ow + (size_t)row * 512 + ch * 8) = v; } }
    asm volatile("s_waitcnt lgkmcnt(0)\n\ts_barrier" ::: "memory");
#undef ATT_KEY0
#undef ATT_ISSUE
#undef ATT_QK
#undef ATT_QK8_HALF
#undef ATT_VFR
#undef ATT_SOFTPV
}
}

__device__ __forceinline__ void p6_attention(Frame& F) {
    const bf16* QM = WSP(bf16, WS_QM); const bf16* KM = WSP(bf16, WS_KM); const bf16* VM = WSP(bf16, WS_VM);
    const bf16* QS = WSP(bf16, WS_QS); const bf16* KS = WSP(bf16, WS_KS); const bf16* VS = WSP(bf16, WS_VS);
    constexpr int OES = MK_F8MID ? 1 : 2; unsigned char* OAb = WSP(unsigned char, WS_OA); unsigned char* OBb = WSP(unsigned char, WS_OB);
#define OA_PTR(row0, h) ((bf16*)((MK_MERGE78 && MK_F8MID) ? OAb + (size_t)(row0) * 1024 + (h) * 64 : OAb + ((size_t)(row0) * 512 + (h) * 64) * OES))
#define OB_PTR(row0, h) ((bf16*)((MK_MERGE78 && MK_F8MID) ? OAb + (size_t)(row0) * 1024 + 512 + (h) * 64 : OBb + ((size_t)(row0) * 512 + (h) * 64) * OES))
    float gqm = 0.f, gkm = 0.f, gqs = 0.f, gks = 0.f;
    { const int l = F.lane;
      const float q0v = ((const GAS float*)F.mla_q_g)[l], q1v = ((const GAS float*)F.mla_q_g)[64 + (l & 31)], k0v = ((const GAS float*)F.mla_k_g)[l], k1v = ((const GAS float*)F.mla_k_g)[64 + (l & 31)];
      const float sqv = ((const GAS float*)F.swa_q_g)[l], skv = ((const GAS float*)F.swa_k_g)[l];
      gqm = fmaxf(fabsf(q0v), fabsf(q1v)); gkm = fmaxf(fabsf(k0v), fabsf(k1v)); gqs = fabsf(sqv); gks = fabsf(skv);
#pragma unroll
      for (int o = 1; o < 64; o <<= 1) { gqm = fmaxf(gqm, __shfl_xor(gqm, o)); gkm = fmaxf(gkm, __shfl_xor(gkm, o)); gqs = fmaxf(gqs, __shfl_xor(gqs, o)); gks = fmaxf(gks, __shfl_xor(gks, o)); }
      gqm = __builtin_bit_cast(float, __builtin_amdgcn_readfirstlane(__builtin_bit_cast(int, gqm))); gkm = __builtin_bit_cast(float, __builtin_amdgcn_readfirstlane(__builtin_bit_cast(int, gkm)));
      gqs = __builtin_bit_cast(float, __builtin_amdgcn_readfirstlane(__builtin_bit_cast(int, gqs))); gks = __builtin_bit_cast(float, __builtin_amdgcn_readfirstlane(__builtin_bit_cast(int, gks))); }
    const float Mm = QSCALE_M * 96.0f * gqm * gkm * 1.02f, Ms = QSCALE_S * 64.0f * gqs * gks * 1.02f;
    float snk = fabsf(((const GAS float*)F.swa_sink)[F.lane & 7] * LOG2E);
#pragma unroll
    for (int o = 1; o < 8; o <<= 1) snk = fmaxf(snk, __shfl_xor(snk, o));
    snk = __builtin_bit_cast(float, __builtin_amdgcn_readfirstlane(__builtin_bit_cast(int, snk)));
    const bool fast_m = Mm < 60.0f, fast_s = Ms < 60.0f && snk < 60.0f;
    const int NU = (1024 - F.vcu + F.G - 1) / F.G; int xp = MK_XOVL ? (MK_XPOS5 == 4 ? 1 + ((F.vcu >> 4) & 3) : MK_XPOS5 == 2 ? 1 + (int)(((blockIdx.x >> 3) & 7) >> 1) : MK_XPOS5 ? (int)(((blockIdx.x >> 3) & 7) * 5 >> 3) : (int)((blockIdx.x >> 3) & 7)) : -1;
#pragma nounroll
    for (int k = 0; k <= 2 * NU; ++k) {
        if (k == xp) { __syncthreads(); p0_experts(F); __syncthreads(); }
        if (k < NU) { const int u = F.vcu + k * F.G;
            const int bh = u >> 4, qb = u & 15, b = bh >> 3, h = bh & 7, q0 = qb * 256; const size_t row0 = (size_t)b * SEQ + q0 + F.wave * 32;
            if (fast_m && MK_ATT8 && MK_FUSE5 && MK_ATT2T) att::unit3<96, false, true>(F.lds, QM + row0 * 768 + h * 96, 768, (const bf16*)((const unsigned char*)KM + (size_t)b * KEYS * 1024 + h * 128), 0, VM + (size_t)b * KEYS * 512 + h * 64, 512, OA_PTR(row0, h), q0, 0.f, 0.f, WSP(float, WS_SSQH) + (row0 * 8 + h) * 2);
            else if (fast_m && MK_ATT8 && MK_FUSE5) att::unit2<96, false, true>(F.lds, QM + row0 * 768 + h * 96, 768, (const bf16*)((const unsigned char*)KM + (size_t)b * KEYS * 1024 + h * 128), 0, VM + (size_t)b * KEYS * 512 + h * 64, 512, OA_PTR(row0, h), q0, 0.f, 0.f, WSP(float, WS_SSQH) + (row0 * 8 + h) * 2);
            else if (fast_m) att::unit2<96, false>(F.lds, QM + row0 * 768 + h * 96, 768, KM + (size_t)b * KEYS * 768 + h * 96, 768, VM + (size_t)b * KEYS * 512 + h * 64, 512, OA_PTR(row0, h), q0, 0.f, 0.f, MK_FUSE5 ? WSP(float, WS_SSQH) + (row0 * 8 + h) * 2 : nullptr);
            else if (MK_ATT8 && MK_FUSE5) att::unit<96, false, true>(F.lds, QM + row0 * 768 + h * 96, 768, (const bf16*)((const unsigned char*)KM + (size_t)b * KEYS * 1024 + h * 128), 0, VM + (size_t)b * KEYS * 512 + h * 64, 512, OA_PTR(row0, h), q0, -1e30f, 0.f, WSP(float, WS_SSQH) + (row0 * 8 + h) * 2);
            else att::unit<96, false>(F.lds, QM + row0 * 768 + h * 96, 768, KM + (size_t)b * KEYS * 768 + h * 96, 768, VM + (size_t)b * KEYS * 512 + h * 64, 512, OA_PTR(row0, h), q0, -1e30f, 0.f, MK_FUSE5 ? WSP(float, WS_SSQH) + (row0 * 8 + h) * 2 : nullptr);
        } else if (k < 2 * NU) { const int u = F.vcu + (k - NU) * F.G;
            if (fast_s && MK_ATT2T && MK_SWA2H) {
                const int b = u >> 7, hp = (u >> 5) & 3, qb = u & 31, q0 = qb * 128, hd = 2 * hp + (F.wave >> 2), qo = (F.wave & 3) * 32; const size_t row0 = (size_t)b * SEQ + q0 + qo; const float sk = F.swa_sink[hd] * LOG2E;
                att::unit3<64, true>(F.lds, QS + row0 * 512 + hd * 64, 512, KS + (size_t)b * KEYS * 128 + (hp >> 1) * 64, 128, VS + (size_t)b * KEYS * 128 + (hp >> 1) * 64, 128, OB_PTR(row0, hd), q0, 0.f, __builtin_amdgcn_exp2f(sk), nullptr, qo, 128);
                continue; }
            const int bh = u >> 4, qb = u & 15, b = bh >> 3, h = bh & 7, q0 = qb * 256; const size_t row0 = (size_t)b * SEQ + q0 + F.wave * 32; const float sk = F.swa_sink[h] * LOG2E;
            if (fast_s && MK_ATT2T) att::unit3<64, true>(F.lds, QS + row0 * 512 + h * 64, 512, KS + (size_t)b * KEYS * 128 + (h >> 2) * 64, 128, VS + (size_t)b * KEYS * 128 + (h >> 2) * 64, 128, OB_PTR(row0, h), q0, 0.f, __builtin_amdgcn_exp2f(sk));
            else if (fast_s) att::unit2<64, true>(F.lds, QS + row0 * 512 + h * 64, 512, KS + (size_t)b * KEYS * 128 + (h >> 2) * 64, 128, VS + (size_t)b * KEYS * 128 + (h >> 2) * 64, 128, OB_PTR(row0, h), q0, 0.f, __builtin_amdgcn_exp2f(sk));
            else att::unit<64, true>(F.lds, QS + row0 * 512 + h * 64, 512, KS + (size_t)b * KEYS * 128 + (h >> 2) * 64, 128, VS + (size_t)b * KEYS * 128 + (h >> 2) * 64, 128, OB_PTR(row0, h), q0, sk, 1.0f);
        }
    }
}

constexpr int WRP_SEG = 256 * 32 + 16;
__device__ __forceinline__ void p10_norm2_router(Frame& F) {
    LAS float* WRP = (LAS float*)F.lds;
    LAS int* hist = (LAS int*)(F.lds + MOE_OFF);
    LAS float* BIASP = (LAS float*)(F.lds + P10X_OFF);
    LAS float* RS = BIASP + 32;
    LAS float* BPART = RS + 128;
    const int b = blockIdx.x, bb = b >> 5, lane = F.lane; const float* mod = WSP(float, WS_MOD) + (size_t)bb * NMOD;
    { const GAS float* gmod = (const GAS float*)mod; const GAS float* gwr = (const GAS float*)F.w_router; const GAS float* gg = (const GAS float*)F.norm2_g;
#pragma unroll
      for (int h = 0; h < 4; ++h) { f32x4 w[4]; float g[4], sc[4];
#pragma unroll
          for (int u = 0; u < 4; ++u) { const int idx = F.tid + 512 * (4 * h + u), k = idx >> 3, e4 = (idx & 7) * 4; g[u] = gg[k]; sc[u] = gmod[4096 + k]; w[u] = *(const GAS f32x4*)(gwr + (size_t)k * 32 + e4); }
          asm volatile("" ::: "memory");
#pragma unroll
          for (int u = 0; u < 4; ++u) { const int idx = F.tid + 512 * (4 * h + u), k = idx >> 3, e4 = (idx & 7) * 4; *(LAS f32x4*)(WRP + (k >> 8) * WRP_SEG + (k & 255) * 32 + e4) = w[u] * (g[u] * (1.0f + sc[u])); } }
      const int e = F.tid & 31, part = F.tid >> 5; float sacc = 0.f;
#pragma unroll
      for (int h = 0; h < 8; ++h) { float mv[8], wv[8];
#pragma unroll
          for (int u = 0; u < 8; ++u) { const int k = part * 64 + 8 * h + u; mv[u] = gmod[3072 + k]; wv[u] = gwr[(size_t)k * 32 + e]; }
          asm volatile("" ::: "memory");
#pragma unroll
          for (int u = 0; u < 8; ++u) sacc += mv[u] * wv[u]; }
      BPART[part * 32 + e] = sacc; }
    if (F.tid < 32) hist[F.tid] = 0;
    __syncthreads();
    if (F.tid < 32) { float sacc = F.b_router[F.tid];
#pragma unroll
        for (int p = 0; p < 16; ++p) sacc += BPART[p * 32 + F.tid];
        BIASP[F.tid] = sacc; }
    f32x4 av[4], cv[4];
#pragma unroll
    for (int q = 0; q < 4; ++q) { const int col = 4 * lane + 256 * q; const f32x4 g = *(const f32x4*)(F.norm2_g + col), sc = *(const f32x4*)(mod + 4096 + col); cv[q] = *(const f32x4*)(mod + 3072 + col); av[q] = g * (sc + 1.0f); }
    __syncthreads();
    bf16* H2 = WSP(bf16, WS_H2); int* topi = WSP(int, WS_TOPI); float* topw = WSP(float, WS_TOPW);
    const int tok0 = 128 * b + 16 * F.wave;
#pragma nounroll
    for (int j0 = 0; j0 < 16; j0 += MK_P10R) {
        f32x4 v[MK_P10R][4];
#pragma unroll
        for (int t = 0; t < MK_P10R; ++t) { const GAS float* xr = (const GAS float*)F.out + (size_t)(tok0 + j0 + t) * D;
#pragma unroll
            for (int q = 0; q < 4; ++q) v[t][q] = *(const GAS f32x4*)(xr + 4 * lane + 256 * q); }
        asm volatile("" ::: "memory");
#pragma unroll
        for (int t = 0; t < MK_P10R; ++t) { const int tok = tok0 + j0 + t; float ss = 0.f;
#pragma unroll
            for (int q = 0; q < 4; ++q) ss += (v[t][q].x * v[t][q].x + v[t][q].y * v[t][q].y) + (v[t][q].z * v[t][q].z + v[t][q].w * v[t][q].w);
            const float rstd = rsqrtf(wave_sum(ss) * (1.0f / D) + EPS);
            if (lane == 0) RS[F.wave * 16 + j0 + t] = rstd;
#pragma unroll
            for (int q = 0; q < 4; ++q) { const f32x4 h = v[t][q] * rstd * av[q] + cv[q];
                if (MK_F8) { *(GAS unsigned*)((GAS unsigned char*)H2 + (size_t)tok * D + 4 * lane + 256 * q) = pk4_fp8(h.x * F8_SA, h.y * F8_SA, h.z * F8_SA, h.w * F8_SA); }
                else { u32x2 o; o.x = pk2(h.x, h.y); o.y = pk2(h.z, h.w); *(GAS u32x2*)((GAS bf16*)H2 + (size_t)tok * D + 4 * lane + 256 * q) = o; } } }
    }
    LDS_WAIT(); asm volatile("" ::: "memory");
    const int i = lane & 15, q = lane >> 4;
    f32x4 acc0 = {0.f, 0.f, 0.f, 0.f}, acc1 = {0.f, 0.f, 0.f, 0.f};
    { const GAS float* xp = (const GAS float*)F.out + (size_t)(tok0 + i) * D + 256 * q; const LAS float* wp = WRP + q * WRP_SEG + i;
      f32x4 xa[8], xb[8];
#define P10_LD8(dst, m0) do { _Pragma("unroll") for (int u = 0; u < 8; ++u) dst[u] = *(const GAS f32x4*)(xp + 4 * ((m0) + u)); asm volatile("" ::: "memory"); } while (0)
#define P10_MM8(src, m0) do { _Pragma("unroll") for (int u = 0; u < 8; ++u) { _Pragma("unroll") for (int c = 0; c < 4; ++c) { const float b0 = wp[(4 * ((m0) + u) + c) * 32], b1 = wp[(4 * ((m0) + u) + c) * 32 + 16]; \
          acc0 = __builtin_amdgcn_mfma_f32_16x16x4f32(src[u][c], b0, acc0, 0, 0, 0); acc1 = __builtin_amdgcn_mfma_f32_16x16x4f32(src[u][c], b1, acc1, 0, 0, 0); } } } while (0)
      P10_LD8(xa, 0);
#pragma unroll
      for (int m0 = 0; m0 < 64; m0 += 16) {
          P10_LD8(xb, m0 + 8);
          P10_MM8(xa, m0);
          if (m0 + 16 < 64) P10_LD8(xa, m0 + 16);
          P10_MM8(xb, m0 + 8);
      }
#undef P10_LD8
#undef P10_MM8
    }
    const float bs0 = BIASP[i], bs1 = BIASP[16 + i];
#pragma unroll
    for (int r = 0; r < 4; ++r) {
        const float rs = RS[F.wave * 16 + 4 * q + r]; float v0 = acc0[r] * rs + bs0, v1 = acc1[r] * rs + bs1;
        float tv[4]; int tix[4];
#pragma unroll
        for (int k = 0; k < 4; ++k) {
            float bv; int bi; if (v0 >= v1) { bv = v0; bi = i; } else { bv = v1; bi = 16 + i; }
#pragma unroll
            for (int st = 0; st < 4; ++st) { const float ov = st == 0 ? dpp_f<0xB1>(bv) : st == 1 ? dpp_f<0x4E>(bv) : st == 2 ? dpp_f<0x141>(bv) : dpp_f<0x140>(bv);
                const int oi = st == 0 ? dpp_i<0xB1>(bi) : st == 1 ? dpp_i<0x4E>(bi) : st == 2 ? dpp_i<0x141>(bi) : dpp_i<0x140>(bi); if (ov > bv || (ov == bv && oi < bi)) { bv = ov; bi = oi; } }
            tv[k] = bv; tix[k] = bi; if (bi == i) v0 = -3.0e38f; if (bi == 16 + i) v1 = -3.0e38f;
        }
        const float e1 = __expf(tv[1] - tv[0]), e2 = __expf(tv[2] - tv[0]), e3 = __expf(tv[3] - tv[0]), inv = 1.0f / (1.0f + e1 + e2 + e3);
        if (i < 4) { const int tok = tok0 + 4 * q + r; const float w = (i == 0 ? 1.0f : i == 1 ? e1 : i == 2 ? e2 : e3) * inv; const int ix = i == 0 ? tix[0] : i == 1 ? tix[1] : i == 2 ? tix[2] : tix[3];
            topi[tok * 4 + i] = ix; topw[tok * 4 + i] = w; __hip_atomic_fetch_add(&hist[ix], 1, __ATOMIC_RELAXED, __HIP_MEMORY_SCOPE_WORKGROUP); }
    }
    __syncthreads();
    if (F.tid < 32) WSP(int, WS_BCNT)[b * 32 + F.tid] = hist[F.tid];
}

struct MoeTab { LAS int* base; LAS int* ntile; LAS int* total; LAS int* mine; LAS int* cursor; LAS int* R; LAS unsigned char* texp; };
__device__ __forceinline__ MoeTab moe_tab(Frame& F) { MoeTab t; LAS int* p = (LAS int*)(F.lds + MOE_OFF); t.base = p + 32; t.ntile = p + 64; t.total = p + 96; t.mine = p + 128; t.cursor = p + 160; t.R = p + 192; t.texp = (LAS unsigned char*)(p + 200); return t; }
__device__ __forceinline__ void moe_tables(Frame& F) {
    const MoeTab t = moe_tab(F); LAS int* part = (LAS int*)F.lds;
    const int* bc = WSP(int, WS_BCNT); const int b = blockIdx.x;
    __syncthreads();
    if (F.tid < 256) { const int e = F.tid & 31, pt = F.tid >> 5; int tot = 0, bef = 0;
        for (int q = 0; q < 32; ++q) { const int bq = pt * 32 + q; const int cval = bc[bq * 32 + e]; tot += cval; if (bq < b) bef += cval; }
        part[pt * 32 + e] = tot; part[256 + pt * 32 + e] = bef; }
    __syncthreads();
    if (F.tid < 32) { int tot = 0, bef = 0;
#pragma unroll
        for (int pt = 0; pt < 8; ++pt) { tot += part[pt * 32 + F.tid]; bef += part[256 + pt * 32 + F.tid]; }
        const int nt = (tot + 255) >> 8; t.total[F.tid] = tot; t.mine[F.tid] = bef; t.ntile[F.tid] = nt; t.cursor[F.tid] = 0;
        int inc = nt;
#pragma unroll
        for (int o = 1; o < 32; o <<= 1) { const int up = __shfl_up(inc, o); if ((int)F.tid >= o) inc += up; }
        const int r0 = inc - nt; t.base[F.tid] = r0 * 256; if (F.tid == 31) t.R[0] = inc;
        for (int q = 0; q < nt; ++q) t.texp[r0 + q] = (unsigned char)F.tid; }
    __syncthreads();
}
__device__ __forceinline__ void p11_slots(Frame& F) {
    moe_tables(F); const MoeTab t = moe_tab(F);
    const int b = blockIdx.x, tok = 128 * b + (F.tid >> 2), k = F.tid & 3;
    const int e = WSP(int, WS_TOPI)[tok * 4 + k]; const float w = WSP(float, WS_TOPW)[tok * 4 + k];
    const int rank = __hip_atomic_fetch_add(&t.cursor[e], 1, __ATOMIC_RELAXED, __HIP_MEMORY_SCOPE_WORKGROUP); const int slot = t.base[e] + t.mine[e] + rank;
    WSP(int, WS_SLOTTOK)[slot] = tok; WSP(float, WS_SLOTW)[slot] = w; WSP(int, WS_TOKSLOT)[tok * 4 + k] = slot;
    if (b < 32) { const int s0 = t.base[b] + t.total[b], s1 = t.base[b] + t.ntile[b] * 256; for (int s = s0 + F.tid; s < s1; s += 512) { WSP(int, WS_SLOTTOK)[s] = 0; WSP(float, WS_SLOTW)[s] = 0.f; } }
}
__device__ __forceinline__ void p14_combine(Frame& F) {
    const unsigned char* Y = WSP(unsigned char, WS_R2); const int* ts = WSP(int, WS_TOKSLOT); const float* mod = WSP(float, WS_MOD);
    const int gw = F.vcu * NWAVES + F.wave, NGW = F.G * NWAVES, lane = F.lane;
    static_assert(MK_F8Y, "combine is written for e4m3 Y");
    const GAS int* gts = (const GAS int*)ts; u32x4 nsa = {0u, 0u, 0u, 0u}, nsb = {0u, 0u, 0u, 0u};
    if (2 * gw < MTOK) { nsa = *(const GAS u32x4*)(gts + 2 * gw * 4); nsb = *(const GAS u32x4*)(gts + 2 * gw * 4 + 4); }
    for (int t0 = 2 * gw; t0 < MTOK; t0 += 2 * NGW) {
        const int bb = t0 >> 12; const u32x4 sa = nsa, sb = nsb;
        { const int tn = t0 + 2 * NGW; if (tn < MTOK) { nsa = *(const GAS u32x4*)(gts + tn * 4); nsb = *(const GAS u32x4*)(gts + tn * 4 + 4); } }
        const unsigned sl[2][4] = {{sa.x, sa.y, sa.z, sa.w}, {sb.x, sb.y, sb.z, sb.w}};
        unsigned yw[2][4][4]; f32x4 xv[2][4], g2[4];
#pragma unroll
        for (int t = 0; t < 2; ++t)
#pragma unroll
            for (int k = 0; k < 4; ++k)
#pragma unroll
                for (int q = 0; q < 4; ++q) yw[t][k][q] = *(const unsigned*)(Y + (size_t)sl[t][k] * 1024 + 256 * q + 4 * lane);
#pragma unroll
        for (int t = 0; t < 2; ++t)
#pragma unroll
            for (int q = 0; q < 4; ++q) xv[t][q] = *(const f32x4*)(F.out + (size_t)(t0 + t) * D + 256 * q + 4 * lane);
#pragma unroll
        for (int q = 0; q < 4; ++q) g2[q] = *(const f32x4*)(mod + (size_t)bb * NMOD + 5120 + 256 * q + 4 * lane);
#pragma unroll
        for (int t = 0; t < 2; ++t) {
            float s[16];
#pragma unroll
            for (int e = 0; e < 16; ++e) s[e] = 0.f;
#pragma unroll
            for (int k = 0; k < 4; ++k) {
#pragma unroll
                for (int q = 0; q < 4; ++q) { const f32x2 lo = __builtin_amdgcn_cvt_pk_f32_fp8((int)yw[t][k][q], false), hi = __builtin_amdgcn_cvt_pk_f32_fp8((int)yw[t][k][q], true);
                    s[4 * q] += lo.x; s[4 * q + 1] += lo.y; s[4 * q + 2] += hi.x; s[4 * q + 3] += hi.y; } }
#pragma unroll
            for (int q = 0; q < 4; ++q) { const f32x4 ov = xv[t][q] + g2[q] * ((f32x4){s[4 * q], s[4 * q + 1], s[4 * q + 2], s[4 * q + 3]} * (1.0f / F8_SY));
                if (MK_NTOUT) __builtin_nontemporal_store(ov, (GAS f32x4*)((GAS float*)F.out + (size_t)(t0 + t) * D + 256 * q + 4 * lane));
                else *(f32x4*)(F.out + (size_t)(t0 + t) * D + 256 * q + 4 * lane) = ov; }
        }
    }
}

constexpr int NPHASE = 15;
struct Args { const float* in[27]; float* out; unsigned char* ws; int ph_lo, ph_hi; };
__global__ void __launch_bounds__(NWAVES * 64, 2) mk_fwd(Args args) {
    extern __shared__ __attribute__((aligned(16))) unsigned char lds_raw[];
    Frame F;
    F.lds = (LAS unsigned char*)lds_raw;
    F.MISC = (volatile LAS unsigned*)(F.lds + MISC_OFF);
    F.tid = threadIdx.x; F.lane = F.tid & 63; F.wave = __builtin_amdgcn_readfirstlane(F.tid >> 6);
    F.G = gridDim.x; { const int bx = blockIdx.x; F.vcu = (F.G % 8 == 0) ? (bx % 8) * (F.G / 8) + bx / 8 : bx; }
    F.ws = args.ws; F.ctl = (gu32*)(args.ws + WS_CTL); F.out = args.out;
    for (int u = F.tid; u < (LDS_BYTES - LDSCTL_OFF) / 4; u += NWAVES * 64) ((LAS unsigned*)(F.lds + LDSCTL_OFF))[u] = 0u;
    __syncthreads();
    XcdBarrier bar; bar.bar = (unsigned*)(F.ctl + CW_BAR); bar.x = 0; bar.st = nullptr;
    if (MK_N_LAUNCHES == 1) bar = xcd_barrier_post((unsigned*)(F.ctl + CW_BAR), F.MISC + 8);
    const int lo = args.ph_lo, hi = args.ph_hi;
#ifndef MK_PHMASK
#define MK_PHMASK 0x7fff
#endif
#define IN(k) ((((MK_PHMASK) >> (k)) & 1) && lo <= (k) && (k) < hi)
#define SEAM(k) do { if (IN(k) && IN((k) + 1)) xcd_barrier(bar); } while (0)

    if (IN(0)) { frame_load(F); p0_prologue(F); if (MK_REP == 0) p0_prologue(F); } SEAM(0);
#if !MK_STAGE_A
    if (IN(1)) { frame_load(F); p1_norm1(F); if (MK_REP == 10) { __syncthreads(); p1_norm1(F); } } SEAM(1);
    if (IN(2)) { frame_load(F);
        SchedInProj S{F.G, (int)blockIdx.x, (const char*)WSP(bf16, WS_H), (const char*)WSP(bf16, WS_WIN)};
        constexpr int ES = MK_F8IN ? 1 : 2;
        if (MK_FUSE3) { { LAS float* tl = (LAS float*)(F.lds + TSX_OFF); const GAS float* tsrc = (const GAS float*)WSP(float, WS_TRIG);
                { float t4[4];
#pragma unroll
                  for (int u = 0; u < 4; ++u) t4[u] = tsrc[F.tid + 512 * u];
#pragma unroll
                  for (int u = 0; u < 4; ++u) tl[F.tid + 512 * u] = t4[u]; }
                if (F.tid < 64) { tl[2048 + F.tid] = ((const GAS float*)F.swa_q_g)[F.tid]; tl[2112 + F.tid] = ((const GAS float*)F.swa_k_g)[F.tid]; }
                __syncthreads(); }
            EpiInProj E{WSP(bf16, WS_R1), WSP(float, WS_SSKV), WSP(float, WS_SSQ), WSP(bf16, WS_QS), WSP(bf16, WS_KS), WSP(bf16, WS_VS), (const LAS float*)(F.lds + TSX_OFF), (const LAS float*)(F.lds + TSX_OFF) + 2048, (const LAS float*)(F.lds + TSX_OFF) + 2112};
            pg8::gemm_phase<EpiInProj, SchedInProj, true, false, MK_F8IN != 0>(F.lds, D * ES / 128, D * ES, D * ES, S, E); }
        else { EpiStoreBf16 E{WSP(bf16, WS_R1), NRAW, nullptr, MK_F8IN ? F8_INV : 1.0f};
            pg8::gemm_phase<EpiStoreBf16, SchedInProj, true, false, MK_F8IN != 0>(F.lds, D * ES / 128, D * ES, D * ES, S, E); }
    } SEAM(2);
    if (!MK_FUSE3) { if (IN(3)) { frame_load(F); p3_post_inproj(F); } SEAM(3); }
    if (IN(4)) { frame_load(F);
        if (MK_FUSE5) { LAS float* tl = (LAS float*)(F.lds + TMX_OFF); const GAS float* tsrc = (const GAS float*)WSP(float, WS_TRIG) + 2048;
            { const float t0v = tsrc[F.tid], t1v = tsrc[F.tid + 512]; tl[F.tid] = t0v; tl[F.tid + 512] = t1v; }
            if (F.tid < 96) { ((LAS float*)(F.lds + GKX_OFF))[F.tid] = ((const GAS float*)F.mla_k_g)[F.tid]; ((LAS float*)(F.lds + GQX_OFF))[F.tid] = ((const GAS float*)F.mla_q_g)[F.tid]; }
            __syncthreads(); }
        { SchedDense S{F.G, (int)blockIdx.x, MALL / 256, 4, (const char*)(WSP(bf16, WS_R1) + C_KVLAT), (const char*)WSP(bf16, WS_WKV), (size_t)256 * NRAW * 2, (size_t)256 * 256 * 2}; S.rep = (MK_REPU == 4) ? 2 : 1;
          if (MK_FUSE5) { EpiKv<MK_ATT8 != 0> E{WSP(float, WS_SSKV), WSP(bf16, WS_R1), WSP(bf16, WS_KM), WSP(bf16, WS_VM), (const LAS float*)(F.lds + TMX_OFF), (const LAS float*)(F.lds + GKX_OFF)};
            pg8::gemm_phase<EpiKv<MK_ATT8 != 0>, SchedDense, true, false>(F.lds, 256 / 64, NRAW * 2, 256 * 2, S, E); }
          else if (MK_FUSE3) { EpiUp<4> E{WSP(bf16, WS_KVUP), 1024, WSP(float, WS_SSKV), 1.0f / 256.0f}; pg8::gemm_phase<EpiUp<4>, SchedDense, true, false>(F.lds, 256 / 64, NRAW * 2, 256 * 2, S, E); }
          else { EpiStoreBf16 E{WSP(bf16, WS_KVUP), 1024, WSP(float, WS_RSKV), 1.0f}; pg8::gemm_phase<EpiStoreBf16, SchedDense, true, false>(F.lds, 256 / 64, NRAW * 2, 256 * 2, S, E); } }
        frame_load(F);
        { SchedDense S{F.G, (int)blockIdx.x, MTOK / 256, MK_FUSE5 ? 4 : 3, (const char*)(WSP(bf16, WS_R1) + C_QLAT), (const char*)WSP(bf16, WS_WQ), (size_t)256 * NRAW * 2, (size_t)256 * 384 * 2}; S.rep = (MK_REPU == 4) ? 2 : 1;
          if (MK_FUSE5) { EpiQ E{WSP(float, WS_SSQ), WSP(bf16, WS_QM), WSP(float, WS_SSQH), (const LAS float*)(F.lds + TMX_OFF), (const LAS float*)(F.lds + GQX_OFF)}; pg8::gemm_phase<EpiQ, SchedDense, true, false>(F.lds, 384 / 64, NRAW * 2, 384 * 2, S, E); }
          else if (MK_FUSE3) { EpiUp<8> E{WSP(bf16, WS_QUP), 768, WSP(float, WS_SSQ), 1.0f / 384.0f}; pg8::gemm_phase<EpiUp<8>, SchedDense, true, false>(F.lds, 384 / 64, NRAW * 2, 384 * 2, S, E); }
          else { EpiStoreBf16 E{WSP(bf16, WS_QUP), 768, WSP(float, WS_RSQ), 1.0f}; pg8::gemm_phase<EpiStoreBf16, SchedDense, true, false>(F.lds, 384 / 64, NRAW * 2, 384 * 2, S, E); } }
    } SEAM(4);
    if (!MK_FUSE5) { if (IN(5)) { frame_load(F); p5_post_up(F); } SEAM(5); }
    if (IN(6)) { frame_load(F); p6_attention(F); if (MK_REP == 6) p6_attention(F); } SEAM(6);
    if (MK_MERGE78 && MK_F8MID) {
        if (IN(7)) { frame_load(F);
            SchedDense S{F.G, (int)blockIdx.x, MTOK / 256, 4, (const char*)WSP(unsigned char, WS_OA), (const char*)WSP(unsigned char, WS_WBA), (size_t)256 * 1024, (size_t)256 * 1024}; S.rep = (MK_REPU == 7) ? 2 : 1;
            EpiMerge E{WSP(bf16, WS_R1), WSP(unsigned char, WS_H2)};
            pg8::gemm_phase<EpiMerge, SchedDense, true, false, true>(F.lds, 8, 1024, 1024, S, E);
        } SEAM(8);
    } else {
    if (IN(7)) { frame_load(F);
        constexpr int ES = MK_F8MID ? 1 : 2;
        SchedDense S{F.G, (int)blockIdx.x, MTOK / 256, 4, (const char*)WSP(bf16, WS_OA), (const char*)WSP(bf16, WS_WBA), (size_t)256 * 512 * ES, (size_t)256 * 512 * ES}; S.rep = (MK_REPU == 7) ? 2 : 1;
        EpiBranch<false> E{WSP(bf16, WS_T), WSP(bf16, WS_R1) + C_GA, nullptr};
        pg8::gemm_phase<EpiBranch<false>, SchedDense, true, false, MK_F8MID != 0>(F.lds, 512 * ES / 128, 512 * ES, 512 * ES, S, E);
    }
    if (IN(8)) { frame_load(F);
        constexpr int ES = MK_F8MID ? 1 : 2;
        SchedDense S{F.G, (int)blockIdx.x, MTOK / 256, 4, (const char*)WSP(bf16, WS_OB), (const char*)WSP(bf16, WS_WBB), (size_t)256 * 512 * ES, (size_t)256 * 512 * ES}; S.rep = (MK_REPU == 7) ? 2 : 1;
        EpiBranch<true> E{WSP(bf16, WS_T), WSP(bf16, WS_R1) + C_GB, WSP(unsigned char, WS_H2)};
        pg8::gemm_phase<EpiBranch<true>, SchedDense, true, false, MK_F8MID != 0>(F.lds, 512 * ES / 128, 512 * ES, 512 * ES, S, E);
    } SEAM(8);
    }
    if (IN(9)) { frame_load(F);
        constexpr int ES = MK_F8MID ? 1 : 2;
        SchedDense S{F.G, (int)blockIdx.x, MTOK / 256, 4, (const char*)(MK_F8MID ? (void*)WSP(unsigned char, WS_H2) : (void*)WSP(bf16, WS_T)), (const char*)WSP(bf16, WS_WOUT), (size_t)256 * 1024 * ES, (size_t)256 * 1024 * ES}; S.rep = (MK_REPU == 9) ? 2 : 1;
        EpiOutRes E{F.x, F.out, WSP(float, WS_MOD)};
        pg8::gemm_phase<EpiOutRes, SchedDense, true, false, MK_F8MID != 0>(F.lds, 1024 * ES / 128, 1024 * ES, 1024 * ES, S, E);
    } SEAM(9);
#else
    if (IN(1)) { frame_load(F); p1_norm1(F);
        const int gw = F.vcu * NWAVES + F.wave, NGW = F.G * NWAVES;
        for (int row = gw; row < MTOK; row += NGW)
#pragma unroll
            for (int q = 0; q < 4; ++q) *(f32x4*)(F.out + (size_t)row * D + 4 * F.lane + 256 * q) = *(const f32x4*)(F.x + (size_t)row * D + 4 * F.lane + 256 * q);
    } SEAM(1);
#endif
#if MK_STAGE_A != 2
    if (IN(10)) { frame_load(F); p10_norm2_router(F); if (MK_REP == 10) p10_norm2_router(F); } SEAM(10);
    if (IN(11)) { frame_load(F); p11_slots(F); } SEAM(11);
    if (IN(12)) { frame_load(F);
        if (!IN(11)) moe_tables(F);
        const MoeTab t = moe_tab(F);
        constexpr int ES = MK_F8 ? 1 : 2;
        SchedMoe S{F.G, (int)blockIdx.x, t.R[0], 8, (const char*)WSP(bf16, WS_H2), (const char*)WSP(bf16, WS_WGU), 0, (size_t)2048 * 1024 * ES, (size_t)256 * 1024 * ES, t.texp, WSP(int, WS_SLOTTOK)}; S.rep = (MK_REPU == 12) ? 2 : 1;
        EpiSwiglu E{WSP(unsigned char, WS_R1), F.b_gate_up};
        pg8::gemm_phase<EpiSwiglu, SchedMoe, true, true, MK_F8 != 0>(F.lds, 1024 * ES / 128, 1024 * ES, 1024 * ES, S, E);
    } SEAM(12);
    if (IN(13)) { frame_load(F);
        if (!IN(11)) moe_tables(F);
        const MoeTab t = moe_tab(F);
        constexpr int ES = MK_F8 ? 1 : 2;
        SchedMoe S{F.G, (int)blockIdx.x, t.R[0], 4, (const char*)WSP(bf16, WS_R1), (const char*)WSP(bf16, WS_WDN), (size_t)256 * 1024 * ES, (size_t)1024 * 1024 * ES, (size_t)256 * 1024 * ES, t.texp, nullptr}; S.rep = (MK_REPU == 13) ? 2 : 1;
        EpiDown E{WSP(unsigned char, WS_R2), F.b_down, WSP(float, WS_SLOTW)};
        pg8::gemm_phase<EpiDown, SchedMoe, true, false, MK_F8 != 0>(F.lds, 1024 * ES / 128, 1024 * ES, 1024 * ES, S, E);
    } SEAM(13);
    if (IN(14)) { frame_load(F); p14_combine(F); }
#endif
#undef IN
#undef SEAM
}

extern "C" void kernel_launch(void* const* d_in, const int* in_sizes, int n_in, void* d_out, int out_size, void* d_ws, size_t ws_size, hipStream_t stream) {
    static int grid = 0;
    if (grid == 0) {
        if (n_in != 27 || in_sizes[0] != MTOK * D || out_size != MTOK * D || ws_size < WS_END) { fprintf(stderr, "kernel_launch: unexpected shapes (n_in %d, in0 %d, out %d, ws %zu < %zu); nothing launched\n", n_in, n_in > 0 ? in_sizes[0] : -1, out_size, ws_size, (size_t)WS_END); grid = -1; return; }
        int dev = 0, cus = 0, per_cu = 0;
        if (hipGetDevice(&dev) != hipSuccess || hipDeviceGetAttribute(&cus, hipDeviceAttributeMultiprocessorCount, dev) != hipSuccess) { grid = -1; return; }
        if (hipFuncSetAttribute((const void*)mk_fwd, hipFuncAttributeMaxDynamicSharedMemorySize, LDS_BYTES) != hipSuccess) { fprintf(stderr, "kernel_launch: hipFuncSetAttribute failed\n"); grid = -1; return; }
        if (hipOccupancyMaxActiveBlocksPerMultiprocessor(&per_cu, (const void*)mk_fwd, NWAVES * 64, LDS_BYTES) != hipSuccess || per_cu < 1) fprintf(stderr, "kernel_launch: occupancy query says %d\n", per_cu);
        (void)hipGetLastError();
        grid = cus;
        if (grid != 256) fprintf(stderr, "kernel_launch: %d CUs; the thin phases assume 256 workgroups\n", grid);
    }
    if (grid < 0) return;
    if (hipMemsetAsync((char*)d_ws + WS_CTL, 0, CTL_ZERO_BYTES, stream) != hipSuccess) return;
    Args a{};
    for (int i = 0; i < 27; ++i) a.in[i] = (const float*)d_in[i];
    a.out = (float*)d_out; a.ws = (unsigned char*)d_ws;
    if (MK_N_LAUNCHES == 1) { a.ph_lo = 0; a.ph_hi = NPHASE; hipLaunchKernelGGL(mk_fwd, dim3(grid), dim3(NWAVES * 64), LDS_BYTES, stream, a); }
    else for (int p = 0; p < NPHASE; ++p) { a.ph_lo = p; a.ph_hi = p + 1; hipLaunchKernelGGL(mk_fwd, dim3(grid), dim3(NWAVES * 64), LDS_BYTES, stream, a); }
}
```
